# Optimizing an MI355X kernel written in HIP

```python
import jax, jax.numpy as jnp
from jax import lax
import numpy as np

D_MODEL = 1024
BATCH = 32
SEQ = 2048
DEPTH = 4
DEC_BATCH = 16
DEC_SEQ = 4096
PAST_LEN = 128

GRID_W = 64
N_MIXERS = 2
POOL_WINDOWS = (2, 4, 8, 16)
N_POOL_GROUPS = 4
POOL_GROUP = D_MODEL // N_POOL_GROUPS
N_HEADS = 16
HEAD_DIM = D_MODEL // N_HEADS
WIN_ROWS = 8
WIN_COLS = 16
Q_BLOCK_COLS = 16
K_BLOCK_COLS = Q_BLOCK_COLS + WIN_COLS
N_COL_BLOCKS = GRID_W // Q_BLOCK_COLS
D_FF = 4 * D_MODEL
RMS_EPS = 1e-6
NEG_INF = -1e30
N_POOL_LAYERS = (DEPTH + 1) // 2
N_ATTN_LAYERS = DEPTH // 2

kernel_name = "hybrid_pool_natten_encoder"


def rms_norm(x, g):
    xf = x.astype(jnp.float32)
    y = xf * lax.rsqrt(jnp.mean(xf * xf, axis=-1, keepdims=True) + RMS_EPS)
    return (y * g.astype(jnp.float32)).astype(x.dtype)


def pool_mixer(h, w_groups, scale):
    b, s, _ = h.shape
    hg = h.reshape(b, s, N_POOL_GROUPS, POOL_GROUP).astype(jnp.float32)
    cs = jnp.concatenate([jnp.zeros((b, 1, N_POOL_GROUPS, POOL_GROUP), jnp.float32),
                          jnp.cumsum(hg, axis=1)], axis=1)
    t = jnp.arange(s)[:, None]
    w = jnp.array(POOL_WINDOWS, dtype=jnp.int32)[None, :]
    lo = jnp.clip(t - w // 2, 0, s - 1)
    hi = jnp.clip(t + w // 2 - 1, 0, s - 1)
    g_idx = jnp.arange(N_POOL_GROUPS)[None, :]
    window_sum = cs[:, hi + 1, g_idx, :] - cs[:, lo, g_idx, :]
    count = (hi - lo + 1).astype(jnp.float32)[None, :, :, None]
    pooled = (window_sum / count - hg).astype(h.dtype)
    mixed = jnp.einsum('bsgc,gcd->bsgd', pooled, w_groups)
    return mixed.reshape(b, s, D_MODEL) * scale


def _column_structure():
    qc = np.arange(GRID_W).reshape(N_COL_BLOCKS, Q_BLOCK_COLS)
    kb_start = np.clip(np.arange(N_COL_BLOCKS) * Q_BLOCK_COLS - WIN_COLS // 2, 0, GRID_W - K_BLOCK_COLS)
    kc = kb_start[:, None] + np.arange(K_BLOCK_COLS)[None, :]
    win_start = np.clip(qc - WIN_COLS // 2, 0, GRID_W - WIN_COLS)
    col_valid = (kc[:, None, :] >= win_start[:, :, None]) & (kc[:, None, :] < win_start[:, :, None] + WIN_COLS)
    dc_idx = np.clip(kc[:, None, :] - qc[:, :, None] + WIN_COLS - 1, 0, 2 * WIN_COLS - 2)
    return kc, col_valid, dc_idx


def neighborhood_attention(h, w_qkv, w_o, rpb):
    b, s, _ = h.shape
    rows = s // GRID_W
    kr = min(WIN_ROWS, rows)
    qkv = h @ w_qkv
    q, k, v = jnp.split(qkv, 3, axis=-1)
    q = q.reshape(b, rows, GRID_W, N_HEADS, HEAD_DIM) * (HEAD_DIM ** -0.5)
    k = k.reshape(b, rows, GRID_W, N_HEADS, HEAD_DIM)
    v = v.reshape(b, rows, GRID_W, N_HEADS, HEAD_DIM)
    kc_np, col_valid_np, dc_idx_np = _column_structure()
    kc = jnp.asarray(kc_np)
    col_valid = jnp.asarray(col_valid_np)[:, :, None, :]
    dc_idx = jnp.asarray(dc_idx_np)[:, :, None, :]

    def row_block(args):
        r, q_row = args
        r0 = jnp.clip(r - kr // 2, 0, rows - kr)
        k_rows = lax.dynamic_slice_in_dim(k, r0, kr, axis=1)
        v_rows = lax.dynamic_slice_in_dim(v, r0, kr, axis=1)
        k_blk = k_rows[:, :, kc]
        v_blk = v_rows[:, :, kc]
        qb = q_row.reshape(b, N_COL_BLOCKS, Q_BLOCK_COLS, N_HEADS, HEAD_DIM)
        sc = jnp.einsum('bjqhd,brjchd->bhjqrc', qb, k_blk,
                        preferred_element_type=jnp.float32)
        dr_idx = (r0 + jnp.arange(kr) - r + WIN_ROWS - 1)[None, None, :, None]
        bias = rpb[:, dr_idx, dc_idx]
        sc = jnp.where(col_valid, sc + bias[None].astype(jnp.float32), NEG_INF)
        p = jax.nn.softmax(sc, axis=(-2, -1)).astype(v.dtype)
        o = jnp.einsum('bhjqrc,brjchd->bjqhd', p, v_blk)
        return o.reshape(b, GRID_W, D_MODEL)

    out = lax.map(row_block, (jnp.arange(rows), jnp.moveaxis(q, 1, 0)))
    out = jnp.moveaxis(out, 0, 1).reshape(b, s, D_MODEL)
    return out @ w_o


def trunk(x, norm_mix, pool_w, pool_scale, w_qkv, rpb, w_o, norm_mlp, w_up, w_down, norm_final):
    for i in range(DEPTH):
        h = rms_norm(x, norm_mix[i])
        j = i // N_MIXERS
        if i % N_MIXERS == 0:
            x = x + pool_mixer(h, pool_w[j], pool_scale[j])
        else:
            x = x + neighborhood_attention(h, w_qkv[j], w_o[j], rpb[j])
        h = rms_norm(x, norm_mlp[i])
        x = x + jnp.square(jax.nn.relu(h @ w_up[i])) @ w_down[i]
    return rms_norm(x, norm_final)


def setup_inputs(seed: int = 0) -> dict:
    key = jax.random.key(seed)
    ks = jax.random.split(key, 12)
    f32 = jnp.float32
    return {
        "x_prompt": jax.random.normal(ks[0], (BATCH, SEQ, D_MODEL), f32),
        "x_sample": jax.random.normal(ks[1], (DEC_BATCH, DEC_SEQ, D_MODEL), f32),
        "norm_mix": 1.0 + 0.02 * jax.random.normal(ks[2], (DEPTH, D_MODEL), f32),
        "pool_w": jax.random.normal(ks[3], (N_POOL_LAYERS, N_POOL_GROUPS, POOL_GROUP, POOL_GROUP), f32) * POOL_GROUP ** -0.5,
        "pool_scale": 1.0 + 0.02 * jax.random.normal(ks[4], (N_POOL_LAYERS, D_MODEL), f32),
        "w_qkv": jax.random.normal(ks[5], (N_ATTN_LAYERS, D_MODEL, 3 * D_MODEL), f32) * D_MODEL ** -0.5,
        "rpb": 0.1 * jax.random.normal(ks[6], (N_ATTN_LAYERS, N_HEADS, 2 * WIN_ROWS - 1, 2 * WIN_COLS - 1), f32),
        "w_o": jax.random.normal(ks[7], (N_ATTN_LAYERS, D_MODEL, D_MODEL), f32) * D_MODEL ** -0.5,
        "norm_mlp": 1.0 + 0.02 * jax.random.normal(ks[8], (DEPTH, D_MODEL), f32),
        "w_up": jax.random.normal(ks[9], (DEPTH, D_MODEL, D_FF), f32) * D_MODEL ** -0.5,
        "w_down": jax.random.normal(ks[10], (DEPTH, D_FF, D_MODEL), f32) * D_FF ** -0.5,
        "norm_final": 1.0 + 0.02 * jax.random.normal(ks[11], (D_MODEL,), f32),
    }


def reference(x_prompt, x_sample, norm_mix, pool_w, pool_scale, w_qkv, rpb, w_o, norm_mlp, w_up, w_down, norm_final):
    y_prompt = trunk(x_prompt, norm_mix, pool_w, pool_scale, w_qkv, rpb, w_o, norm_mlp, w_up, w_down, norm_final)
    y_sample = trunk(x_sample, norm_mix, pool_w, pool_scale, w_qkv, rpb, w_o, norm_mlp, w_up, w_down, norm_final)
    return (y_prompt, y_sample)
```

```cpp
#include <hip/hip_runtime.h>
#include <hip/hip_cooperative_groups.h>
#include <cstdio>
#include <cstdint>
namespace cg = cooperative_groups;
namespace pg8 {
#define PG8_LAS __attribute__((address_space(3)))
typedef unsigned short bf16_t;
typedef short bf16x8 __attribute__((ext_vector_type(8)));
typedef float f32x4 __attribute__((ext_vector_type(4)));
typedef unsigned u32x4 __attribute__((ext_vector_type(4)));
constexpr int BM = 256, BK = 64, HALF = 128, HTB = HALF * BK * 2  , STAGE_BYTES = 8 * HTB, NXCD = 8, WGM = 8;

__host__ __device__ __forceinline__ int lds_byte(int r, int c) { const int st = (r >> 4) * 2 + (c >> 5), rr = r & 15, cc = c & 31, ob = rr * 64 + cc * 2; return st * 1024 + (ob ^ (((ob >> 9) & 1) << 5)); }
__host__ __device__ __forceinline__ void stage_rc(int b, int& R, int& C) { const int st = b / 1024, sb = b % 1024, swz = sb ^ (((sb >> 9) & 1) << 5); R = (st >> 1) * 16 + swz / 64; C = (st & 1) * 32 + (swz % 64) / 2; }
__host__ __device__ __forceinline__ int perm32(int rho) { const int n = rho >> 4, i = rho & 15; return 8 * (i >> 2) + 4 * n + (i & 3); }

struct Unit { int pm, pn; };
struct Gemm { const bf16_t* A; const bf16_t* Bt; int M, N, K; size_t a_pn_stride; };

struct StaticOrder {
    int nM, nN, nwg, G, c;
    __host__ __device__ void init(int M, int N, int G_, int c_) { nM = M / BM; nN = N / BM; nwg = nM * nN; G = G_; c = c_; }
    __host__ __device__ bool next(int i, Unit& u) const {
        const long L = (long)i * G + c; if (L >= nwg) return false;
        int wgid = (int)L; { const int q = nwg / NXCD, r = nwg % NXCD, xcd = wgid % NXCD, off = wgid / NXCD; wgid = (xcd < r ? xcd * (q + 1) : r * (q + 1) + (xcd - r) * q) + off; }
        const int nig = WGM * nN, gid = wgid / nig, fm = gid * WGM, gsz = (nM - fm) < WGM ? (nM - fm) : WGM;
        u.pm = fm + ((wgid % nig) % gsz); u.pn = (wgid % nig) / gsz; return true;
    }
    __device__ __forceinline__ void a_ready(const Unit&) const {}
    __device__ __forceinline__ void done(const Unit&) const {}
};

__device__ __forceinline__ unsigned cvt_pk_bf16(float lo, float hi) { unsigned r; asm volatile("v_cvt_pk_bf16_f32 %0, %1, %2" : "=v"(r) : "v"(lo), "v"(hi)); return r; }
typedef float f32x2 __attribute__((ext_vector_type(2)));
template <int ACT> struct EpiBf16 {
    static constexpr bool PERM = true, AFTER_DRAIN = false;
    bf16_t* O; int ldc; int split_cols; size_t split_stride; float scale0;
    __device__ __forceinline__ void operator()(const f32x4 (&acc)[2][2][4][2], const Unit& u, int wr, int wc, int fr, int fq) const {
        const int row0 = u.pm * BM + wr * 64 + fr; int colt = u.pn * BM; bf16_t* base = O;
        float sc = 1.f; if (split_cols) { const int t = colt / split_cols; base += (size_t)t * split_stride; colt -= t * split_cols; if (t == 0) sc = scale0; }
        const int col0 = colt + wc * 32 + 8 * fq;
#pragma unroll
        for (int ai = 0; ai < 2; ++ai)
#pragma unroll
            for (int m = 0; m < 4; ++m) { bf16_t* rowp = base + (size_t)(row0 + ai * HALF + m * 16) * ldc + col0;
#pragma unroll
                for (int bj = 0; bj < 2; ++bj) { f32x4 v0 = acc[ai][bj][m][0], v1 = acc[ai][bj][m][1];
                    if (ACT == 2) {
#pragma unroll
                        for (int e = 0; e < 4; ++e) { const float a = fmaxf(v0[e], 0.f), b = fmaxf(v1[e], 0.f); v0[e] = a * a; v1[e] = b * b; } }
                    v0 = v0 * sc; v1 = v1 * sc; u32x4 w; w.x = cvt_pk_bf16(v0[0], v0[1]); w.y = cvt_pk_bf16(v0[2], v0[3]); w.z = cvt_pk_bf16(v1[0], v1[1]); w.w = cvt_pk_bf16(v1[2], v1[3]);
                    *(u32x4*)(rowp + bj * HALF) = w; } }
    }
};
struct EpiRes {
    static constexpr bool PERM = false, AFTER_DRAIN = false;
    const float* base; float* out; int ldc;
    __device__ __forceinline__ void operator()(const f32x4 (&acc)[2][2][4][2], const Unit& u, int wr, int wc, int fr, int fq) const {
        const int col0 = u.pn * BM + wc * 32 + 4 * fq;
#pragma unroll
        for (int ai = 0; ai < 2; ++ai)
#pragma unroll
            for (int m = 0; m < 4; ++m) { const size_t off = (size_t)(u.pm * BM + ai * HALF + wr * 64 + m * 16 + fr) * ldc + col0;
#pragma unroll
                for (int bj = 0; bj < 2; ++bj)
#pragma unroll
                    for (int n = 0; n < 2; ++n) { const f32x4 bs = *(const f32x4*)(base + off + bj * HALF + n * 16); *(f32x4*)(out + off + bj * HALF + n * 16) = bs + acc[ai][bj][m][n]; } }
    }
};
template <class Epi, class Sched, bool ALIGN_EPI = false, bool SP2 = false>
__device__ __forceinline__ void gemm_phase(PG8_LAS unsigned char* lds, const Gemm g, const Sched& S, const Epi& E, const int tid_in) {
    const int tid = tid_in, wid = __builtin_amdgcn_readfirstlane(tid >> 6), lane = tid & 63, wr = wid >> 2, wc = wid & 3, fr = lane & 15, fq = lane >> 4;
    const int K = g.K, nt = K / BK;
    unsigned voffA[2], voffB[2];
#pragma unroll
    for (int i = 0; i < 2; ++i) { int R, C; stage_rc(tid * 16 + i * 8192, R, C); const int Rb = Epi::PERM ? ((R & ~31) + perm32(R & 31)) : R;
        voffA[i] = (unsigned)(R * K + C) * 2u; voffB[i] = (unsigned)(Rb * K + C) * 2u; }
    const size_t kstep = (size_t)(BK * 2);
    const size_t hstep = (size_t)HALF * K * 2;
    const size_t tstep = 2 * hstep;
    const unsigned ldsw = (unsigned)wid * 1024u;
    const int aoff = lds_byte(wr * 64 + fr, fq * 8), boff = lds_byte(wc * 32 + fr, fq * 8);
#define PG8_SA(b, h) (((b) * 2 + (h)) * HTB)
#define PG8_SB(b, h) ((4 + (b) * 2 + (h)) * HTB)
#define PG8_STAGE(bufoff, gbase, voff) do { _Pragma("unroll") for (int _i = 0; _i < 2; ++_i) \
        __builtin_amdgcn_global_load_lds((const unsigned*)((const char*)(gbase) + (voff)[_i]), (PG8_LAS unsigned*)(lds + (bufoff) + ldsw + _i * 8192), 16, 0, 0); } while (0)
#define PG8_LDA(dst, b, h) do { _Pragma("unroll") for (int m = 0; m < 4; ++m) _Pragma("unroll") for (int k = 0; k < 2; ++k) dst[m][k] = *(const PG8_LAS bf16x8*)(lds + PG8_SA(b, h) + aoff + m * 2048 + k * 1024); } while (0)
#define PG8_LDB(dst, b, h) do { _Pragma("unroll") for (int n = 0; n < 2; ++n) _Pragma("unroll") for (int k = 0; k < 2; ++k) dst[n][k] = *(const PG8_LAS bf16x8*)(lds + PG8_SB(b, h) + boff + n * 2048 + k * 1024); } while (0)
#define PG8_MMA(ai, bj, At, Bt) do { __builtin_amdgcn_s_setprio(1); _Pragma("unroll") for (int m = 0; m < 4; ++m) _Pragma("unroll") for (int n = 0; n < 2; ++n) _Pragma("unroll") for (int k = 0; k < 2; ++k) \
        acc[ai][bj][m][n] = __builtin_amdgcn_mfma_f32_16x16x32_bf16(Bt[n][k], At[m][k], acc[ai][bj][m][n], 0, 0, 0); __builtin_amdgcn_s_setprio(0); } while (0)
#define PG8_WAIT_V(n) asm volatile("s_waitcnt vmcnt(" #n ")" ::: "memory")
#define PG8_WAIT_L(n) asm volatile("s_waitcnt lgkmcnt(" #n ")" ::: "memory")
#define PG8_BAR __builtin_amdgcn_s_barrier()
#define PG8_SCHED __builtin_amdgcn_sched_barrier(0)
    Unit cur, nxt; int ui = 0;
    if (!S.next(0, cur)) return;
    f32x4 acc[2][2][4][2];
#pragma unroll
    for (int a = 0; a < 2; ++a)
#pragma unroll
        for (int b = 0; b < 2; ++b)
#pragma unroll
            for (int m = 0; m < 4; ++m)
#pragma unroll
                for (int n = 0; n < 2; ++n) acc[a][b][m][n] = (f32x4){0.f, 0.f, 0.f, 0.f};
    bf16x8 At[4][2], B0[2][2], B1[2][2];
    const char* cA = (const char*)g.A + (size_t)cur.pm * tstep + (size_t)cur.pn * g.a_pn_stride; const char* cB = (const char*)g.Bt + (size_t)cur.pn * tstep;
    S.a_ready(cur);
    if constexpr (SP2) {
        PG8_STAGE(PG8_SB(0, 0), cB, voffB); PG8_STAGE(PG8_SB(0, 1), cB + hstep, voffB); PG8_STAGE(PG8_SA(0, 0), cA, voffA); PG8_STAGE(PG8_SA(0, 1), cA + hstep, voffA);
        if (wr == 1) PG8_BAR;
        PG8_WAIT_V(2); PG8_BAR;
        PG8_STAGE(PG8_SB(1, 0), cB + kstep, voffB); PG8_STAGE(PG8_SA(1, 0), cA + kstep, voffA); PG8_STAGE(PG8_SB(1, 1), cB + hstep + kstep, voffB);
        PG8_WAIT_V(6); PG8_BAR;
    } else {
        PG8_STAGE(PG8_SB(0, 0), cB, voffB); PG8_STAGE(PG8_SA(0, 0), cA, voffA); PG8_STAGE(PG8_SB(0, 1), cB + hstep, voffB); PG8_STAGE(PG8_SA(0, 1), cA + hstep, voffA);
        if (wr == 1) PG8_BAR;
        PG8_WAIT_V(4); PG8_BAR;
        PG8_STAGE(PG8_SB(1, 0), cB + kstep, voffB); PG8_STAGE(PG8_SA(1, 0), cA + kstep, voffA); PG8_STAGE(PG8_SB(1, 1), cB + hstep + kstep, voffB);
        PG8_WAIT_V(6); PG8_BAR;
    }
    for (;;) {
        const bool has_next = S.next(ui + 1, nxt);
        const char* nA = has_next ? (const char*)g.A + (size_t)nxt.pm * tstep + (size_t)nxt.pn * g.a_pn_stride : cA; const char* nB = has_next ? (const char*)g.Bt + (size_t)nxt.pn * tstep : cB;
        for (int t = 0; t < nt; t += 2) {
            const bool last = (t == nt - 2);
            const char* a1 = cA + (size_t)(t + 1) * kstep;
            const char* a2 = last ? nA : cA + (size_t)(t + 2) * kstep; const char* b2 = last ? nB : cB + (size_t)(t + 2) * kstep;
            const char* a3 = a2 + kstep; const char* b3 = b2 + kstep;
            if (last && has_next) S.a_ready(nxt);
            if constexpr (SP2) {
            PG8_LDB(B0, 0, 0); PG8_LDB(B1, 0, 1); PG8_SCHED; PG8_LDA(At, 0, 0); PG8_STAGE(PG8_SA(1, 1), a1 + hstep, voffA);
            PG8_WAIT_V(8); PG8_WAIT_L(0); PG8_BAR; PG8_MMA(0, 0, At, B0); PG8_MMA(0, 1, At, B1); PG8_BAR; PG8_SCHED;
            PG8_LDA(At, 0, 1); PG8_STAGE(PG8_SB(0, 0), b2, voffB); PG8_STAGE(PG8_SB(0, 1), b2 + hstep, voffB); PG8_STAGE(PG8_SA(0, 0), a2, voffA);
            PG8_WAIT_V(8); PG8_WAIT_L(0); PG8_BAR; PG8_MMA(1, 0, At, B0); PG8_MMA(1, 1, At, B1); PG8_BAR; PG8_SCHED;
            PG8_LDB(B0, 1, 0); PG8_LDB(B1, 1, 1); PG8_SCHED; PG8_LDA(At, 1, 0); PG8_STAGE(PG8_SA(0, 1), a2 + hstep, voffA);
            PG8_WAIT_V(8); PG8_WAIT_L(0); PG8_BAR; PG8_MMA(0, 0, At, B0); PG8_MMA(0, 1, At, B1); PG8_BAR; PG8_SCHED;
            PG8_LDA(At, 1, 1); PG8_STAGE(PG8_SB(1, 0), b3, voffB); PG8_STAGE(PG8_SB(1, 1), b3 + hstep, voffB); PG8_STAGE(PG8_SA(1, 0), a3, voffA);
            PG8_WAIT_V(8); PG8_WAIT_L(0); PG8_BAR; PG8_MMA(1, 0, At, B0); PG8_MMA(1, 1, At, B1); PG8_BAR; PG8_SCHED;
            } else {
            PG8_LDB(B0, 0, 0); PG8_SCHED; PG8_LDA(At, 0, 0); PG8_STAGE(PG8_SA(1, 1), a1 + hstep, voffA);
            PG8_WAIT_L(8); PG8_BAR; PG8_WAIT_L(0); PG8_MMA(0, 0, At, B0); PG8_BAR; PG8_SCHED;
            PG8_LDB(B1, 0, 1); PG8_STAGE(PG8_SB(0, 0), b2, voffB);
            PG8_BAR; PG8_WAIT_L(0); PG8_MMA(0, 1, At, B1); PG8_BAR;
            PG8_LDA(At, 0, 1); PG8_STAGE(PG8_SA(0, 0), a2, voffA);
            PG8_BAR; PG8_WAIT_L(0); PG8_MMA(1, 0, At, B0); PG8_BAR; PG8_SCHED;
            PG8_STAGE(PG8_SB(0, 1), b2 + hstep, voffB);
            PG8_WAIT_V(6); PG8_BAR; PG8_MMA(1, 1, At, B1); PG8_BAR;
            PG8_LDB(B0, 1, 0); PG8_SCHED; PG8_LDA(At, 1, 0); PG8_STAGE(PG8_SA(0, 1), a2 + hstep, voffA);
            PG8_WAIT_L(8); PG8_BAR; PG8_WAIT_L(0); PG8_MMA(0, 0, At, B0); PG8_BAR; PG8_SCHED;
            PG8_LDB(B1, 1, 1); PG8_STAGE(PG8_SB(1, 0), b3, voffB);
            PG8_BAR; PG8_WAIT_L(0); PG8_MMA(0, 1, At, B1); PG8_BAR;
            PG8_LDA(At, 1, 1); PG8_STAGE(PG8_SA(1, 0), a3, voffA);
            PG8_BAR; PG8_WAIT_L(0); PG8_MMA(1, 0, At, B0); PG8_BAR; PG8_SCHED;
            PG8_STAGE(PG8_SB(1, 1), b3 + hstep, voffB);
            PG8_WAIT_V(6); PG8_BAR; PG8_MMA(1, 1, At, B1); PG8_BAR;
            }
        }
        if constexpr (ALIGN_EPI) { if (wr == 0) PG8_BAR; }
        if constexpr (!Epi::AFTER_DRAIN) { E(acc, cur, wr, wc, fr, fq); S.done(cur); }
        if (!has_next) break;
#pragma unroll
        for (int a = 0; a < 2; ++a)
#pragma unroll
            for (int b = 0; b < 2; ++b)
#pragma unroll
                for (int m = 0; m < 4; ++m)
#pragma unroll
                    for (int n = 0; n < 2; ++n) acc[a][b][m][n] = (f32x4){0.f, 0.f, 0.f, 0.f};
        cur = nxt; cA = nA; cB = nB; ++ui;
        if constexpr (ALIGN_EPI) { if (wr == 1) PG8_BAR; }
    }
    PG8_WAIT_V(0);
    if constexpr (!ALIGN_EPI) { if (wr == 0) PG8_BAR; }
    PG8_BAR;
    if constexpr (Epi::AFTER_DRAIN) { E.fused(acc, cur, wr, wc, fr, fq, lds, wid, lane); S.done(cur); }
#undef PG8_SA
#undef PG8_SB
#undef PG8_STAGE
#undef PG8_LDA
#undef PG8_LDB
#undef PG8_MMA
#undef PG8_WAIT_V
#undef PG8_WAIT_L
#undef PG8_BAR
#undef PG8_SCHED
}
}
#ifndef PG8_SP2
#define PG8_SP2 true
#endif
#ifndef PG8_ALIGN
#define PG8_ALIGN true
#endif

constexpr int NWAVES = 8;
constexpr int D = 1024, FF = 4096, NH = 16, HD = 64, DEPTH = 4;
constexpr int NTOK = 131072;
constexpr int GROUP_TOK = 65536;
#ifndef MK_CH
#define MK_CH 65536
#endif
constexpr int CH = MK_CH;
constexpr int NCHUNK = NTOK / CH;
constexpr float RMS_EPS = 1e-6f;
constexpr float LOG2E = 1.4426950408889634f;
static_assert(GROUP_TOK % CH == 0 && CH % 4096 == 0, "chunking");

constexpr size_t MiB = 1u << 20;
constexpr size_t WS_WPOOL = 2 * MiB;
constexpr size_t WS_WQKV = 4 * MiB;
constexpr size_t WS_WO = 16 * MiB;
constexpr size_t WS_WUP = 20 * MiB;
constexpr size_t WS_WDN = 52 * MiB;
constexpr size_t WS_XN = 96 * MiB;
constexpr size_t WS_ACT = WS_XN + (size_t)CH * D * 2;
constexpr size_t WS_END = WS_ACT + (size_t)CH * FF * 2;
static_assert(WS_XN >= WS_WDN + 32 * MiB && WS_END <= 1024 * MiB, "d_ws map");

constexpr int RING_BYTES = 131072;
constexpr int BIAS_OFF = RING_BYTES;
constexpr int LDS_BYTES = 147456;

#define GAS __attribute__((address_space(1)))
#define LAS __attribute__((address_space(3)))
typedef unsigned short bf16;
typedef unsigned v4u __attribute__((ext_vector_type(4)));
typedef unsigned v2u __attribute__((ext_vector_type(2)));
typedef float f32x4 __attribute__((ext_vector_type(4)));
typedef short bf16x8 __attribute__((ext_vector_type(8)));
typedef short s16x4 __attribute__((ext_vector_type(4)));
#define LDS_WAIT() asm volatile("s_waitcnt lgkmcnt(0)" ::: "memory")
__device__ __forceinline__ unsigned f2bf(float f) { unsigned u = __builtin_bit_cast(unsigned, f); return (u + 0x7fffu + ((u >> 16) & 1u)) >> 16; }
__device__ __forceinline__ unsigned pk2(float lo, float hi) { return f2bf(lo) | (f2bf(hi) << 16); }
__device__ __forceinline__ float bf2f(unsigned short b) { return __builtin_bit_cast(float, (unsigned)b << 16); }
__device__ __forceinline__ float wave_sum(float v) {
#pragma unroll
    for (int o = 1; o < 64; o <<= 1) v += __shfl_xor(v, o);
    return v;
}

__device__ __forceinline__ void transpose_item(const float* W, int K, int N, bf16* WT, int row_off, const float* nscale, LAS float* scr, int item, int lane) {
    const int nblk = N / 32, kb = item / nblk, nb = item % nblk, k0 = 64 * kb, n0 = 32 * nb;
#pragma unroll 8
    for (int i = 0; i < 32; ++i) { const int kk = 2 * i + (lane >> 5); scr[kk * 33 + (lane & 31)] = W[(size_t)(k0 + kk) * N + n0 + (lane & 31)]; }
    LDS_WAIT(); asm volatile("" ::: "memory");
    const int c = lane & 7;
#pragma unroll
    for (int j = 0; j < 4; ++j) { const int n = (lane >> 3) + 8 * j; const LAS float* s = scr + (8 * c) * 33 + n;
        const float sc = nscale ? nscale[n0 + n] : 1.f;
        v4u o; o.x = pk2(s[0 * 33] * sc, s[1 * 33] * sc); o.y = pk2(s[2 * 33] * sc, s[3 * 33] * sc); o.z = pk2(s[4 * 33] * sc, s[5 * 33] * sc); o.w = pk2(s[6 * 33] * sc, s[7 * 33] * sc);
        *(GAS v4u*)(WT + (size_t)(row_off + n0 + n) * K + k0 + 8 * c) = o; }
    LDS_WAIT(); asm volatile("" ::: "memory");
}

struct Ptrs {
    const float *x_in[2], *norm_mix, *pool_w, *pool_scale, *w_qkv, *rpb, *w_o, *norm_mlp, *w_up, *w_down, *norm_final;
    float* out; unsigned char* ws;
};

__device__ __forceinline__ void prologue(const Ptrs& P, LAS unsigned char* lds, int gw, int NGW, int wave, int lane) {
    LAS float* scr = (LAS float*)(lds + wave * 16384);
    bf16* WPOOL = (bf16*)(P.ws + WS_WPOOL); bf16* WQKV = (bf16*)(P.ws + WS_WQKV); bf16* WO = (bf16*)(P.ws + WS_WO); bf16* WUP = (bf16*)(P.ws + WS_WUP); bf16* WDN = (bf16*)(P.ws + WS_WDN);
    constexpr int I_POOL = (256 / 64) * (256 / 32), I_QKV = (D / 64) * (3 * D / 32), I_O = (D / 64) * (D / 32), I_UP = (D / 64) * (FF / 32), I_DN = (FF / 64) * (D / 32);
    constexpr int NITEMS = 8 * I_POOL + 2 * I_QKV + 2 * I_O + 4 * I_UP + 4 * I_DN;
    for (int it = gw; it < NITEMS; it += NGW) {
        int r = it;
        if (r < 8 * I_POOL) { const int mtx = r / I_POOL, j = mtx >> 2, g = mtx & 3; transpose_item(P.pool_w + (size_t)mtx * 65536, 256, 256, WPOOL + (size_t)j * 1024 * 256, g * 256, P.pool_scale + j * 1024 + g * 256, scr, r % I_POOL, lane); continue; } r -= 8 * I_POOL;
        if (r < 2 * I_QKV) { const int j = r / I_QKV; transpose_item(P.w_qkv + (size_t)j * D * 3 * D, D, 3 * D, WQKV + (size_t)j * 3 * D * D, 0, nullptr, scr, r % I_QKV, lane); continue; } r -= 2 * I_QKV;
        if (r < 2 * I_O) { const int j = r / I_O; transpose_item(P.w_o + (size_t)j * D * D, D, D, WO + (size_t)j * D * D, 0, nullptr, scr, r % I_O, lane); continue; } r -= 2 * I_O;
        if (r < 4 * I_UP) { const int j = r / I_UP; transpose_item(P.w_up + (size_t)j * D * FF, D, FF, WUP + (size_t)j * D * FF, 0, nullptr, scr, r % I_UP, lane); continue; } r -= 4 * I_UP;
        { const int j = r / I_DN; transpose_item(P.w_down + (size_t)j * D * FF, FF, D, WDN + (size_t)j * D * FF, 0, nullptr, scr, r % I_DN, lane); }
    }
}

__device__ __forceinline__ void norm_rows_bf16(const float* x, const float* gain, bf16* o, int gw, int NGW, int lane) {
    f32x4 g[4];
#pragma unroll
    for (int j = 0; j < 4; ++j) g[j] = *((const f32x4*)gain + lane + 64 * j);
    for (int m = gw; m < CH; m += NGW) {
        const GAS f32x4* xr = (const GAS f32x4*)(x + (size_t)m * D) + lane;
        f32x4 v[4]; float s = 0.f;
#pragma unroll
        for (int j = 0; j < 4; ++j) { v[j] = xr[64 * j]; s += (v[j].x * v[j].x + v[j].y * v[j].y) + (v[j].z * v[j].z + v[j].w * v[j].w); }
        const float r = 1.0f / sqrtf(wave_sum(s) * (1.f / D) + RMS_EPS);
        GAS v2u* o8 = (GAS v2u*)(o + (size_t)m * D) + lane;
#pragma unroll
        for (int j = 0; j < 4; ++j) { v2u w; w.x = pk2(v[j].x * r * g[j].x, v[j].y * r * g[j].y); w.y = pk2(v[j].z * r * g[j].z, v[j].w * r * g[j].w); o8[64 * j] = w; }
    }
}
__device__ __forceinline__ void norm_rows_f32_inplace(float* x, const float* gain, int nrows, int gw, int NGW, int lane) {
    f32x4 g[4];
#pragma unroll
    for (int j = 0; j < 4; ++j) g[j] = *((const f32x4*)gain + lane + 64 * j);
    for (int m = gw; m < nrows; m += NGW) {
        GAS f32x4* xr = (GAS f32x4*)(x + (size_t)m * D) + lane;
        f32x4 v[4]; float s = 0.f;
#pragma unroll
        for (int j = 0; j < 4; ++j) { v[j] = xr[64 * j]; s += (v[j].x * v[j].x + v[j].y * v[j].y) + (v[j].z * v[j].z + v[j].w * v[j].w); }
        const float r = 1.0f / sqrtf(wave_sum(s) * (1.f / D) + RMS_EPS);
#pragma unroll
        for (int j = 0; j < 4; ++j) xr[64 * j] = v[j] * r * g[j];
    }
}

constexpr int PT = 32, PROWS = 48;
__device__ __forceinline__ void pool_phase(LAS unsigned char* lds, const float* x, const float* gain, bf16* Pg, int seq_len, int vcu, int G, int tid, int wave, int lane) {
    f32x4 g[4];
#pragma unroll
    for (int j = 0; j < 4; ++j) g[j] = *((const f32x4*)gain + lane + 64 * j);
    const int grp = tid >> 7, w = 2 << grp, hw = w >> 1;
    for (int tile = vcu; tile < CH / PT; tile += G) {
        const int m0 = tile * PT;
        const int sb = m0 / seq_len * seq_len;
        const int t0 = m0 - sb;
        for (int i = wave; i < PROWS; i += NWAVES) {
            const int t = t0 - 8 + i;
            if (t < 0 || t >= seq_len) continue;
            const GAS f32x4* xr = (const GAS f32x4*)(x + (size_t)(sb + t) * D) + lane;
            f32x4 v[4]; float s = 0.f;
#pragma unroll
            for (int j = 0; j < 4; ++j) { v[j] = xr[64 * j]; s += (v[j].x * v[j].x + v[j].y * v[j].y) + (v[j].z * v[j].z + v[j].w * v[j].w); }
            const float r = 1.0f / sqrtf(wave_sum(s) * (1.f / D) + RMS_EPS);
            LAS v2u* hr = (LAS v2u*)(lds + i * 2048) + lane;
#pragma unroll
            for (int j = 0; j < 4; ++j) { v2u o; o.x = pk2(v[j].x * r * g[j].x, v[j].y * r * g[j].y); o.y = pk2(v[j].z * r * g[j].z, v[j].w * r * g[j].w); hr[64 * j] = o; }
        }
        __syncthreads();
        const LAS unsigned* hcol = (const LAS unsigned*)lds + tid;
        GAS unsigned* po = (GAS unsigned*)(Pg + (size_t)grp * CH * 256 + (size_t)m0 * 256) + (tid & 127);
        for (int tt = 0; tt < PT; ++tt) {
            const int t = t0 + tt;
            const int lo = max(t - hw, 0), hi = min(t + hw - 1, seq_len - 1);
            float s0 = 0.f, s1 = 0.f;
            for (int q = lo; q <= hi; ++q) { const unsigned u = hcol[(q - t0 + 8) * 512]; s0 += __builtin_bit_cast(float, u << 16); s1 += __builtin_bit_cast(float, u & 0xffff0000u); }
            const unsigned uc = hcol[(tt + 8) * 512];
            const float inv = 1.0f / (float)(hi - lo + 1);
            po[(size_t)tt * 128] = pk2(s0 * inv - __builtin_bit_cast(float, uc << 16), s1 * inv - __builtin_bit_cast(float, uc & 0xffff0000u));
        }
        __syncthreads();
    }
}

__device__ __forceinline__ s16x4 vtr(const LAS unsigned char* p) { return __builtin_bit_cast(s16x4, __builtin_amdgcn_ds_read_tr16_b64_v4i16((LAS s16x4*)p)); }
__device__ __forceinline__ void attn_phase(LAS unsigned char* lds, bf16* Qb, const bf16* Kb, const bf16* Vb, const float* rpb_l, int seq_len, int G, int bx, int tid, int wave, int lane) {
    const int fr = lane & 15, fq = lane >> 4;
    const int rows = seq_len >> 6, rows_shift = (seq_len == 2048) ? 5 : 6;
    constexpr int NI = (CH / 64) * 8;
    int nx, xc, lc, per;
    if ((G & 7) == 0) { nx = G >> 3; xc = bx & 7; lc = bx >> 3; per = NI >> 3; } else { nx = G; xc = 0; lc = bx; per = NI; }
    LAS float* bias = (LAS float*)(lds + BIAS_OFF);
    const int qb = wave & 3, hh = wave >> 2;
    const int qc = (qb < 3) ? (8 + 16 * qb + fr) : (fr < 8 ? fr : 48 + fr);
    const int a0 = (qb < 3) ? qb : 0, a1 = (qb < 3) ? qb + 1 : 3;
    const int wst = min(max(qc - 8, 0), 48);
    const int q4 = (lane & 15) >> 2, p4 = lane & 3;
    for (int loc = lc; loc < per; loc += nx) {
        const int id = xc * per + loc;
        const int r = id & (rows - 1), bh = id >> rows_shift, hp = bh & 7, b = bh >> 3;
        const int tb = b * seq_len;
        const int r0 = min(max(r - 4, 0), rows - 8);
        for (int k = tid; k < 930; k += NWAVES * 64) bias[k] = rpb_l[hp * 930 + k] * LOG2E;
        {
            v4u vv[16];
#pragma unroll
            for (int p = 0; p < 16; ++p) { const int kr = p >> 1, c = (p & 1) * 32 + (tid >> 4);
                vv[p] = *(const GAS v4u*)(Vb + (size_t)(tb + (r0 + kr) * 64 + c) * D + hp * 128 + (tid & 15) * 8); }
#pragma unroll
            for (int p = 0; p < 16; ++p) { const int kr = p >> 1, c = (p & 1) * 32 + (tid >> 4), ch = tid & 15;
                const int img = (c >> 4) * 4 + (kr >> 1), rho = 8 * ((c & 15) >> 2) + 4 * (kr & 1) + (c & 3);
                *(LAS v4u*)(lds + img * 8192 + 256 * rho + 16 * (ch ^ (((rho & 3) << 2) | ((rho >> 2) & 3)))) = vv[p]; }
        }
        __syncthreads();
        const int h = 2 * hp + hh;
        const size_t qoff = (size_t)(tb + r * 64 + qc) * D + h * 64;
        const bf16x8 qf0 = *(const GAS bf16x8*)(Qb + qoff + 8 * fq), qf1 = *(const GAS bf16x8*)(Qb + qoff + 32 + 8 * fq);
        f32x4 S[8][2];
        float mx = -3.0e38f;
        const bf16* kbase = Kb + (size_t)(tb + r0 * 64 + fr) * D + h * 64 + 8 * fq;
        bf16x8 kf[2][2][2];
        const LAS float* bptr[2][4];
#pragma unroll
        for (int ai = 0; ai < 2; ++ai)
#pragma unroll
            for (int i = 0; i < 4; ++i) { const int kc = 16 * (ai ? a1 : a0) + 4 * fq + i; bptr[ai][i] = bias + hh * 465 + (r0 - r + 7) * 31 + min(max(kc - qc + 15, 0), 30); }
#pragma unroll
        for (int ai = 0; ai < 2; ++ai) { const bf16* kp = kbase + (size_t)(16 * (ai ? a1 : a0)) * D; kf[0][ai][0] = *(const GAS bf16x8*)kp; kf[0][ai][1] = *(const GAS bf16x8*)(kp + 32); }
#pragma unroll
        for (int kr = 0; kr < 8; ++kr) {
            if (kr < 7) {
#pragma unroll
                for (int ai = 0; ai < 2; ++ai) { const bf16* kp = kbase + (size_t)((kr + 1) * 64 + 16 * (ai ? a1 : a0)) * D; kf[(kr + 1) & 1][ai][0] = *(const GAS bf16x8*)kp; kf[(kr + 1) & 1][ai][1] = *(const GAS bf16x8*)(kp + 32); }
            }
#pragma unroll
            for (int ai = 0; ai < 2; ++ai) {
                const int a = ai ? a1 : a0;
                f32x4 z = {0.f, 0.f, 0.f, 0.f};
                z = __builtin_amdgcn_mfma_f32_16x16x32_bf16(kf[kr & 1][ai][0], qf0, z, 0, 0, 0);
                z = __builtin_amdgcn_mfma_f32_16x16x32_bf16(kf[kr & 1][ai][1], qf1, z, 0, 0, 0);
#pragma unroll
                for (int i = 0; i < 4; ++i) { const int kc = 16 * a + 4 * fq + i;
                    const bool valid = (kc >= wst) && (kc < wst + 16);
                    z[i] = valid ? z[i] + bptr[ai][i][kr * 31] : -1.0e30f; mx = fmaxf(mx, z[i]); }
                S[kr][ai] = z;
            }
            __builtin_amdgcn_sched_barrier(0);
        }
        mx = fmaxf(mx, __shfl_xor(mx, 16)); mx = fmaxf(mx, __shfl_xor(mx, 32));
        float sum = 0.f;
#pragma unroll
        for (int kr = 0; kr < 8; ++kr)
#pragma unroll
            for (int ai = 0; ai < 2; ++ai)
#pragma unroll
                for (int i = 0; i < 4; ++i) { const float p = __builtin_amdgcn_exp2f(S[kr][ai][i] - mx); S[kr][ai][i] = p; sum += p; }
        sum += __shfl_xor(sum, 16); sum += __shfl_xor(sum, 32);
        f32x4 O[4];
#pragma unroll
        for (int c = 0; c < 4; ++c) O[c] = (f32x4){0.f, 0.f, 0.f, 0.f};
        const LAS unsigned char* vb[2][2][4];
#pragma unroll
        for (int ai = 0; ai < 2; ++ai)
#pragma unroll
            for (int t = 0; t < 2; ++t)
#pragma unroll
                for (int c = 0; c < 4; ++c) { const int rho = 8 * fq + 4 * t + q4, chn = 2 * (4 * hh + c) + (p4 >> 1);
                    vb[ai][t][c] = lds + (ai ? a1 : a0) * 32768 + 256 * rho + 16 * (chn ^ (((rho & 3) << 2) | ((rho >> 2) & 3))) + 8 * (p4 & 1); }
#pragma unroll
        for (int u = 0; u < 4; ++u) {
#pragma unroll
            for (int ai = 0; ai < 2; ++ai) {
                v4u pw; pw.x = pk2(S[2 * u][ai][0], S[2 * u][ai][1]); pw.y = pk2(S[2 * u][ai][2], S[2 * u][ai][3]); pw.z = pk2(S[2 * u + 1][ai][0], S[2 * u + 1][ai][1]); pw.w = pk2(S[2 * u + 1][ai][2], S[2 * u + 1][ai][3]);
                const bf16x8 pf = __builtin_bit_cast(bf16x8, pw);
#pragma unroll
                for (int c = 0; c < 4; ++c) {
                    const s16x4 v0 = vtr(vb[ai][0][c] + u * 8192), v1 = vtr(vb[ai][1][c] + u * 8192);
                    const bf16x8 vf = __builtin_shufflevector(v0, v1, 0, 1, 2, 3, 4, 5, 6, 7);
                    O[c] = __builtin_amdgcn_mfma_f32_16x16x32_bf16(vf, pf, O[c], 0, 0, 0);
                }
            }
            __builtin_amdgcn_sched_barrier(0);
        }
        const float inv = 1.0f / sum;
#pragma unroll
        for (int c = 0; c < 4; ++c) { v2u w; w.x = pk2(O[c][0] * inv, O[c][1] * inv); w.y = pk2(O[c][2] * inv, O[c][3] * inv);
            *(GAS v2u*)(Qb + qoff + 16 * c + 4 * fq) = w; }
        __syncthreads();
    }
}

enum { K_POOL = 1, K_NORM = 2, K_GEMM_RES = 3, K_GEMM_QKV = 4, K_GEMM_UP = 5, K_ATTN = 6, K_FINAL = 7 };
enum { F_A_X = 1, F_A_IN = 2, F_AUX_X = 4, F_AUX_IN = 8 };
struct Ph { int kind, flags, N, K; const void* A; const void* B; void* C; const void* aux; unsigned long long a_pn_stride, pad; };
constexpr int PPC = 25;
struct Args { Ptrs p; Ph tab[PPC]; };
__global__ void __launch_bounds__(NWAVES * 64, 2) fwd_megakernel(Args args) {
    extern __shared__ __attribute__((aligned(16))) unsigned char lds_raw[];
    cg::grid_group grid = cg::this_grid();
    LAS unsigned char* lds = (LAS unsigned char*)lds_raw;
    {
        const int tid = threadIdx.x, lane = tid & 63, wave = __builtin_amdgcn_readfirstlane(tid >> 6);
        const int G = gridDim.x, bx = blockIdx.x;
        const int vcu = (G % 8 == 0) ? (bx % 8) * (G / 8) + bx / 8 : bx;
        prologue(args.p, lds, vcu * NWAVES + wave, G * NWAVES, wave, lane);
    }
    grid.sync();

    for (int ph = 0; ph < NCHUNK * PPC; ++ph) {
        int tid = threadIdx.x; asm volatile("" : "+v"(tid));
        int G = gridDim.x, bx = blockIdx.x; asm volatile("" : "+s"(G), "+s"(bx));
        const int lane = tid & 63, wave = __builtin_amdgcn_readfirstlane(tid >> 6);
        const int vcu = (G % 8 == 0) ? (bx % 8) * (G / 8) + bx / 8 : bx;
        const int gw = vcu * NWAVES + wave, NGW = G * NWAVES;
        const int ck = ph / PPC, idx = ph - ck * PPC;
        const Ph d = args.tab[idx];
        const int tok0 = ck * CH, grp = tok0 / GROUP_TOK, seq_len = grp ? 4096 : 2048;
        const float* xin = args.p.x_in[grp] + (size_t)(tok0 - grp * GROUP_TOK) * D;
        float* X = args.p.out + (size_t)tok0 * D;
        const void* A = (d.flags & F_A_X) ? (const void*)X : (d.flags & F_A_IN) ? (const void*)xin : d.A;
        const void* aux = (d.flags & F_AUX_X) ? (const void*)X : (d.flags & F_AUX_IN) ? (const void*)xin : d.aux;
        switch (d.kind) {
        case K_POOL: pool_phase(lds, (const float*)A, (const float*)aux, (bf16*)d.C, seq_len, vcu, G, tid, wave, lane); break;
        case K_NORM: norm_rows_bf16((const float*)A, (const float*)aux, (bf16*)d.C, gw, NGW, lane); break;
        case K_GEMM_RES: { pg8::Gemm g{(const bf16*)A, (const bf16*)d.B, CH, d.N, d.K, (size_t)d.a_pn_stride}; pg8::StaticOrder S; S.init(CH, d.N, G, bx);
            pg8::EpiRes E{(const float*)aux, X, D};
            pg8::gemm_phase<pg8::EpiRes, pg8::StaticOrder, PG8_ALIGN, PG8_SP2>(lds, g, S, E, tid); } break;
        case K_GEMM_QKV: { pg8::Gemm g{(const bf16*)A, (const bf16*)d.B, CH, d.N, d.K, 0}; pg8::StaticOrder S; S.init(CH, d.N, G, bx);
            pg8::EpiBf16<0> E{(bf16*)d.C, D, D, (size_t)CH * D, 0.125f * LOG2E};
            pg8::gemm_phase<pg8::EpiBf16<0>, pg8::StaticOrder, PG8_ALIGN, PG8_SP2>(lds, g, S, E, tid); } break;
        case K_GEMM_UP: { pg8::Gemm g{(const bf16*)A, (const bf16*)d.B, CH, d.N, d.K, 0}; pg8::StaticOrder S; S.init(CH, d.N, G, bx);
            pg8::EpiBf16<2> E{(bf16*)d.C, FF, 0, 0, 1.f};
            pg8::gemm_phase<pg8::EpiBf16<2>, pg8::StaticOrder, PG8_ALIGN, PG8_SP2>(lds, g, S, E, tid); } break;
        case K_ATTN: attn_phase(lds, (bf16*)d.C, (const bf16*)d.C + (size_t)CH * D, (const bf16*)d.C + 2 * (size_t)CH * D, (const float*)aux, seq_len, G, bx, tid, wave, lane); break;
        default: norm_rows_f32_inplace(X, (const float*)aux, CH, gw, NGW, lane); break;
        }
        if (d.kind != K_FINAL) grid.sync();
    }
}

extern "C" void kernel_launch(void* const* d_in, const int* in_sizes, int n_in, void* d_out, int out_size, void* d_ws, size_t ws_size, hipStream_t stream) {
    static int grid = 0;
    if (grid == 0) {
        if (n_in != 12 || in_sizes[0] != GROUP_TOK * D || in_sizes[1] != GROUP_TOK * D || out_size != NTOK * D || ws_size < WS_END) {
            fprintf(stderr, "kernel_launch: unexpected shapes (n_in %d, out %d, ws %zu < %zu); nothing launched\n", n_in, out_size, ws_size, (size_t)WS_END); grid = -1; return; }
        int dev = 0, cus = 0, per_cu = 0;
        if (hipGetDevice(&dev) != hipSuccess || hipDeviceGetAttribute(&cus, hipDeviceAttributeMultiprocessorCount, dev) != hipSuccess) { fprintf(stderr, "kernel_launch: device query failed\n"); grid = -1; return; }
        if (hipFuncSetAttribute((const void*)fwd_megakernel, hipFuncAttributeMaxDynamicSharedMemorySize, LDS_BYTES) != hipSuccess) { fprintf(stderr, "kernel_launch: hipFuncSetAttribute failed\n"); grid = -1; return; }
        if (hipOccupancyMaxActiveBlocksPerMultiprocessor(&per_cu, (const void*)fwd_megakernel, NWAVES * 64, LDS_BYTES) != hipSuccess || per_cu < 1) { fprintf(stderr, "kernel_launch: occupancy query gave %d\n", per_cu); per_cu = 1; }
        (void)hipGetLastError();
        grid = cus * per_cu;
    }
    if (grid < 0) return;
    Args a{};
    Ptrs& p = a.p;
    p.x_in[0] = (const float*)d_in[0]; p.x_in[1] = (const float*)d_in[1]; p.norm_mix = (const float*)d_in[2]; p.pool_w = (const float*)d_in[3]; p.pool_scale = (const float*)d_in[4];
    p.w_qkv = (const float*)d_in[5]; p.rpb = (const float*)d_in[6]; p.w_o = (const float*)d_in[7]; p.norm_mlp = (const float*)d_in[8]; p.w_up = (const float*)d_in[9];
    p.w_down = (const float*)d_in[10]; p.norm_final = (const float*)d_in[11]; p.out = (float*)d_out; p.ws = (unsigned char*)d_ws;
    unsigned char* ws = (unsigned char*)d_ws;
    bf16* WPOOL = (bf16*)(ws + WS_WPOOL); bf16* WQKV = (bf16*)(ws + WS_WQKV); bf16* WO = (bf16*)(ws + WS_WO); bf16* WUP = (bf16*)(ws + WS_WUP); bf16* WDN = (bf16*)(ws + WS_WDN);
    bf16* XN = (bf16*)(ws + WS_XN); bf16* QB = (bf16*)(ws + WS_ACT); bf16* HB = (bf16*)(ws + WS_ACT);
    int n = 0;
    auto add = [&](int kind, int flags, int N, int K, const void* A, const void* B, void* C, const void* aux, unsigned long long aps) {
        Ph& d = a.tab[n++]; d.kind = kind; d.flags = flags; d.N = N; d.K = K; d.A = A; d.B = B; d.C = C; d.aux = aux; d.a_pn_stride = aps; d.pad = 0; };
    for (int layer = 0; layer < DEPTH; ++layer) {
        const int j = layer >> 1; const int fx = layer == 0 ? F_A_IN : F_A_X, fauxx = layer == 0 ? F_AUX_IN : F_AUX_X;
        if ((layer & 1) == 0) {
            add(K_POOL, fx, 0, 0, nullptr, nullptr, XN, p.norm_mix + layer * D, 0);
            add(K_GEMM_RES, fauxx, D, 256, XN, WPOOL + (size_t)j * 1024 * 256, nullptr, nullptr, (unsigned long long)CH * 256 * 2);
        } else {
            add(K_NORM, fx, 0, 0, nullptr, nullptr, XN, p.norm_mix + layer * D, 0);
            add(K_GEMM_QKV, 0, 3 * D, D, XN, WQKV + (size_t)j * 3 * D * D, QB, nullptr, 0);
            add(K_ATTN, 0, 0, 0, nullptr, nullptr, QB, p.rpb + (size_t)j * NH * 15 * 31, 0);
            add(K_GEMM_RES, F_AUX_X, D, D, QB, WO + (size_t)j * D * D, nullptr, nullptr, 0);
        }
        add(K_NORM, F_A_X, 0, 0, nullptr, nullptr, XN, p.norm_mlp + layer * D, 0);
        add(K_GEMM_UP, 0, FF, D, XN, WUP + (size_t)layer * D * FF, HB, nullptr, 0);
        add(K_GEMM_RES, F_AUX_X, D, FF, HB, WDN + (size_t)layer * D * FF, nullptr, nullptr, 0);
    }
    add(K_FINAL, 0, 0, 0, nullptr, nullptr, nullptr, p.norm_final, 0);
    if (n != PPC) { fprintf(stderr, "kernel_launch: phase table has %d entries, expected %d\n", n, PPC); return; }
    void* kargs[] = {&a};
    hipError_t e = hipLaunchCooperativeKernel((const void*)fwd_megakernel, dim3(grid), dim3(NWAVES * 64), kargs, LDS_BYTES, stream);
    if (e != hipSuccess) fprintf(stderr, "kernel_launch: cooperative launch failed: %s (grid %d)\n", hipGetErrorString(e), grid);
}
```

```cpp
#include <hip/hip_runtime.h>
#include <hip/hip_cooperative_groups.h>
#include <cstdio>
#include <cstdint>
namespace cg = cooperative_groups;
namespace pg8 {
#define PG8_LAS __attribute__((address_space(3)))
typedef unsigned short bf16_t;
typedef short bf16x8 __attribute__((ext_vector_type(8)));
typedef float f32x4 __attribute__((ext_vector_type(4)));
typedef unsigned u32x4 __attribute__((ext_vector_type(4)));
constexpr int BM = 256, BK = 64, HALF = 128, HTB = HALF * BK * 2  , STAGE_BYTES = 8 * HTB, NXCD = 8, WGM = 8;

__host__ __device__ __forceinline__ int lds_byte(int r, int c) { const int st = (r >> 4) * 2 + (c >> 5), rr = r & 15, cc = c & 31, ob = rr * 64 + cc * 2; return st * 1024 + (ob ^ (((ob >> 9) & 1) << 5)); }
__host__ __device__ __forceinline__ void stage_rc(int b, int& R, int& C) { const int st = b / 1024, sb = b % 1024, swz = sb ^ (((sb >> 9) & 1) << 5); R = (st >> 1) * 16 + swz / 64; C = (st & 1) * 32 + (swz % 64) / 2; }
__host__ __device__ __forceinline__ int perm32(int rho) { const int n = rho >> 4, i = rho & 15; return 8 * (i >> 2) + 4 * n + (i & 3); }

struct Unit { int pm, pn; };
struct Gemm { const bf16_t* A; const bf16_t* Bt; int M, N, K; size_t a_pn_stride; };

struct StaticOrder {
    int nM, nN, nwg, G, c;
    __host__ __device__ void init(int M, int N, int G_, int c_) { nM = M / BM; nN = N / BM; nwg = nM * nN; G = G_; c = c_; }
    __host__ __device__ bool next(int i, Unit& u) const {
        const long L = (long)i * G + c; if (L >= nwg) return false;
        int wgid = (int)L; { const int q = nwg / NXCD, r = nwg % NXCD, xcd = wgid % NXCD, off = wgid / NXCD; wgid = (xcd < r ? xcd * (q + 1) : r * (q + 1) + (xcd - r) * q) + off; }
        const int nig = WGM * nN, gid = wgid / nig, fm = gid * WGM, gsz = (nM - fm) < WGM ? (nM - fm) : WGM;
        u.pm = fm + ((wgid % nig) % gsz); u.pn = (wgid % nig) / gsz; return true;
    }
    __device__ __forceinline__ void a_ready(const Unit&) const {}
    __device__ __forceinline__ void done(const Unit&) const {}
};

__device__ __forceinline__ unsigned cvt_pk_bf16(float lo, float hi) { unsigned r; asm volatile("v_cvt_pk_bf16_f32 %0, %1, %2" : "=v"(r) : "v"(lo), "v"(hi)); return r; }
typedef float f32x2 __attribute__((ext_vector_type(2)));
template <int ACT, bool RS> struct EpiBf16 {
    static constexpr bool PERM = true, AFTER_DRAIN = false;
    bf16_t* O; int ldc; int split_cols; size_t split_stride; float scale0; const float* st;
    __device__ __forceinline__ void operator()(const f32x4 (&acc)[2][2][4][2], const Unit& u, int wr, int wc, int fr, int fq) const {
        const int row0 = u.pm * BM + wr * 64 + fr; int colt = u.pn * BM; bf16_t* base = O;
        float sc = 1.f; if (split_cols) { const int t = colt / split_cols; base += (size_t)t * split_stride; colt -= t * split_cols; if (t == 0) sc = scale0; }
        const int col0 = colt + wc * 32 + 8 * fq;
#pragma unroll
        for (int ai = 0; ai < 2; ++ai)
#pragma unroll
            for (int m = 0; m < 4; ++m) { const int row = row0 + ai * HALF + m * 16; bf16_t* rowp = base + (size_t)row * ldc + col0;
                float f = sc;
                if (RS) { const f32x4 pv = *(const f32x4*)(st + (size_t)row * 16 + 4 * fq); float ss = (pv[0] + pv[1]) + (pv[2] + pv[3]); ss += __shfl_xor(ss, 16); ss += __shfl_xor(ss, 32);
                    const float r = __builtin_amdgcn_rsqf(ss * (1.0f / 1024.0f) + 1e-6f); f *= (ACT == 2) ? r * r : r; }
#pragma unroll
                for (int bj = 0; bj < 2; ++bj) { f32x4 v0 = acc[ai][bj][m][0], v1 = acc[ai][bj][m][1];
                    if (ACT == 2) {
#pragma unroll
                        for (int e = 0; e < 4; ++e) { const float a = fmaxf(v0[e], 0.f), b = fmaxf(v1[e], 0.f); v0[e] = a * a; v1[e] = b * b; } }
                    v0 = v0 * f; v1 = v1 * f; u32x4 w; w.x = cvt_pk_bf16(v0[0], v0[1]); w.y = cvt_pk_bf16(v0[2], v0[3]); w.z = cvt_pk_bf16(v1[0], v1[1]); w.w = cvt_pk_bf16(v1[2], v1[3]);
                    *(u32x4*)(rowp + bj * HALF) = w; } }
    }
};
struct EpiRes {
    static constexpr bool PERM = true, AFTER_DRAIN = false;
    const float* base; float* out; bf16_t* xn; float* st; int ldc;
    __device__ __forceinline__ void operator()(const f32x4 (&acc)[2][2][4][2], const Unit& u, int wr, int wc, int fr, int fq) const {
        const int col0 = u.pn * BM + wc * 32 + 8 * fq;
#pragma unroll
        for (int ai = 0; ai < 2; ++ai)
#pragma unroll
            for (int m = 0; m < 4; ++m) { const int row = u.pm * BM + ai * HALF + wr * 64 + m * 16 + fr; const size_t off = (size_t)row * ldc + col0; float ss = 0.f;
#pragma unroll
                for (int bj = 0; bj < 2; ++bj) {
                    const f32x4 o0 = *(const f32x4*)(base + off + bj * HALF) + acc[ai][bj][m][0], o1 = *(const f32x4*)(base + off + bj * HALF + 4) + acc[ai][bj][m][1];
                    *(f32x4*)(out + off + bj * HALF) = o0; *(f32x4*)(out + off + bj * HALF + 4) = o1;
                    if (xn) { u32x4 w; w.x = cvt_pk_bf16(o0[0], o0[1]); w.y = cvt_pk_bf16(o0[2], o0[3]); w.z = cvt_pk_bf16(o1[0], o1[1]); w.w = cvt_pk_bf16(o1[2], o1[3]);
                        *(u32x4*)(xn + off + bj * HALF) = w;
                        ss += (o0[0] * o0[0] + o0[1] * o0[1]) + (o0[2] * o0[2] + o0[3] * o0[3]) + (o1[0] * o1[0] + o1[1] * o1[1]) + (o1[2] * o1[2] + o1[3] * o1[3]); } }
                if (xn) { ss += __shfl_xor(ss, 16); ss += __shfl_xor(ss, 32); if (fq == 0) st[(size_t)row * 16 + u.pn * 4 + wc] = ss; } }
    }
};
template <class Epi, class Sched, bool ALIGN_EPI = false, bool SP2 = false>
__device__ __forceinline__ void gemm_phase(PG8_LAS unsigned char* lds, const Gemm g, const Sched& S, const Epi& E, const int tid_in) {
    const int tid = tid_in, wid = __builtin_amdgcn_readfirstlane(tid >> 6), lane = tid & 63, wr = wid >> 2, wc = wid & 3, fr = lane & 15, fq = lane >> 4;
    const int K = g.K, nt = K / BK;
    unsigned voffA[2], voffB[2];
#pragma unroll
    for (int i = 0; i < 2; ++i) { int R, C; stage_rc(tid * 16 + i * 8192, R, C); const int Rb = Epi::PERM ? ((R & ~31) + perm32(R & 31)) : R;
        voffA[i] = (unsigned)(R * K + C) * 2u; voffB[i] = (unsigned)(Rb * K + C) * 2u; }
    const size_t kstep = (size_t)(BK * 2);
    const size_t hstep = (size_t)HALF * K * 2;
    const size_t tstep = 2 * hstep;
    const unsigned ldsw = (unsigned)wid * 1024u;
    const int aoff = lds_byte(wr * 64 + fr, fq * 8), boff = lds_byte(wc * 32 + fr, fq * 8);
#define PG8_SA(b, h) (((b) * 2 + (h)) * HTB)
#define PG8_SB(b, h) ((4 + (b) * 2 + (h)) * HTB)
#define PG8_STAGE(bufoff, gbase, voff) do { _Pragma("unroll") for (int _i = 0; _i < 2; ++_i) \
        __builtin_amdgcn_global_load_lds((const unsigned*)((const char*)(gbase) + (voff)[_i]), (PG8_LAS unsigned*)(lds + (bufoff) + ldsw + _i * 8192), 16, 0, 0); } while (0)
#define PG8_LDA(dst, b, h) do { _Pragma("unroll") for (int m = 0; m < 4; ++m) _Pragma("unroll") for (int k = 0; k < 2; ++k) dst[m][k] = *(const PG8_LAS bf16x8*)(lds + PG8_SA(b, h) + aoff + m * 2048 + k * 1024); } while (0)
#define PG8_LDB(dst, b, h) do { _Pragma("unroll") for (int n = 0; n < 2; ++n) _Pragma("unroll") for (int k = 0; k < 2; ++k) dst[n][k] = *(const PG8_LAS bf16x8*)(lds + PG8_SB(b, h) + boff + n * 2048 + k * 1024); } while (0)
#define PG8_MMA(ai, bj, At, Bt) do { __builtin_amdgcn_s_setprio(1); _Pragma("unroll") for (int m = 0; m < 4; ++m) _Pragma("unroll") for (int n = 0; n < 2; ++n) _Pragma("unroll") for (int k = 0; k < 2; ++k) \
        acc[ai][bj][m][n] = __builtin_amdgcn_mfma_f32_16x16x32_bf16(Bt[n][k], At[m][k], acc[ai][bj][m][n], 0, 0, 0); __builtin_amdgcn_s_setprio(0); } while (0)
#define PG8_WAIT_V(n) asm volatile("s_waitcnt vmcnt(" #n ")" ::: "memory")
#define PG8_WAIT_L(n) asm volatile("s_waitcnt lgkmcnt(" #n ")" ::: "memory")
#define PG8_BAR __builtin_amdgcn_s_barrier()
#define PG8_SCHED __builtin_amdgcn_sched_barrier(0)
    Unit cur, nxt; int ui = 0;
    if (!S.next(0, cur)) return;
    f32x4 acc[2][2][4][2];
#pragma unroll
    for (int a = 0; a < 2; ++a)
#pragma unroll
        for (int b = 0; b < 2; ++b)
#pragma unroll
            for (int m = 0; m < 4; ++m)
#pragma unroll
                for (int n = 0; n < 2; ++n) acc[a][b][m][n] = (f32x4){0.f, 0.f, 0.f, 0.f};
    bf16x8 At[4][2], B0[2][2], B1[2][2];
    const char* cA = (const char*)g.A + (size_t)cur.pm * tstep + (size_t)cur.pn * g.a_pn_stride; const char* cB = (const char*)g.Bt + (size_t)cur.pn * tstep;
    S.a_ready(cur);
    if constexpr (SP2) {
        PG8_STAGE(PG8_SB(0, 0), cB, voffB); PG8_STAGE(PG8_SB(0, 1), cB + hstep, voffB); PG8_STAGE(PG8_SA(0, 0), cA, voffA); PG8_STAGE(PG8_SA(0, 1), cA + hstep, voffA);
        if (wr == 1) PG8_BAR;
        PG8_WAIT_V(2); PG8_BAR;
        PG8_STAGE(PG8_SB(1, 0), cB + kstep, voffB); PG8_STAGE(PG8_SA(1, 0), cA + kstep, voffA); PG8_STAGE(PG8_SB(1, 1), cB + hstep + kstep, voffB);
        PG8_WAIT_V(6); PG8_BAR;
    } else {
        PG8_STAGE(PG8_SB(0, 0), cB, voffB); PG8_STAGE(PG8_SA(0, 0), cA, voffA); PG8_STAGE(PG8_SB(0, 1), cB + hstep, voffB); PG8_STAGE(PG8_SA(0, 1), cA + hstep, voffA);
        if (wr == 1) PG8_BAR;
        PG8_WAIT_V(4); PG8_BAR;
        PG8_STAGE(PG8_SB(1, 0), cB + kstep, voffB); PG8_STAGE(PG8_SA(1, 0), cA + kstep, voffA); PG8_STAGE(PG8_SB(1, 1), cB + hstep + kstep, voffB);
        PG8_WAIT_V(6); PG8_BAR;
    }
    for (;;) {
        const bool has_next = S.next(ui + 1, nxt);
        const char* nA = has_next ? (const char*)g.A + (size_t)nxt.pm * tstep + (size_t)nxt.pn * g.a_pn_stride : cA; const char* nB = has_next ? (const char*)g.Bt + (size_t)nxt.pn * tstep : cB;
        for (int t = 0; t < nt; t += 2) {
            const bool last = (t == nt - 2);
            const char* a1 = cA + (size_t)(t + 1) * kstep;
            const char* a2 = last ? nA : cA + (size_t)(t + 2) * kstep; const char* b2 = last ? nB : cB + (size_t)(t + 2) * kstep;
            const char* a3 = a2 + kstep; const char* b3 = b2 + kstep;
            if (last && has_next) S.a_ready(nxt);
            if constexpr (SP2) {
            PG8_LDB(B0, 0, 0); PG8_LDB(B1, 0, 1); PG8_SCHED; PG8_LDA(At, 0, 0); PG8_STAGE(PG8_SA(1, 1), a1 + hstep, voffA);
            PG8_WAIT_V(8); PG8_WAIT_L(0); PG8_BAR; PG8_MMA(0, 0, At, B0); PG8_MMA(0, 1, At, B1); PG8_BAR; PG8_SCHED;
            PG8_LDA(At, 0, 1); PG8_STAGE(PG8_SB(0, 0), b2, voffB); PG8_STAGE(PG8_SB(0, 1), b2 + hstep, voffB); PG8_STAGE(PG8_SA(0, 0), a2, voffA);
            PG8_WAIT_V(8); PG8_WAIT_L(0); PG8_BAR; PG8_MMA(1, 0, At, B0); PG8_MMA(1, 1, At, B1); PG8_BAR; PG8_SCHED;
            PG8_LDB(B0, 1, 0); PG8_LDB(B1, 1, 1); PG8_SCHED; PG8_LDA(At, 1, 0); PG8_STAGE(PG8_SA(0, 1), a2 + hstep, voffA);
            PG8_WAIT_V(8); PG8_WAIT_L(0); PG8_BAR; PG8_MMA(0, 0, At, B0); PG8_MMA(0, 1, At, B1); PG8_BAR; PG8_SCHED;
            PG8_LDA(At, 1, 1); PG8_STAGE(PG8_SB(1, 0), b3, voffB); PG8_STAGE(PG8_SB(1, 1), b3 + hstep, voffB); PG8_STAGE(PG8_SA(1, 0), a3, voffA);
            PG8_WAIT_V(8); PG8_WAIT_L(0); PG8_BAR; PG8_MMA(1, 0, At, B0); PG8_MMA(1, 1, At, B1); PG8_BAR; PG8_SCHED;
            } else {
            PG8_LDB(B0, 0, 0); PG8_SCHED; PG8_LDA(At, 0, 0); PG8_STAGE(PG8_SA(1, 1), a1 + hstep, voffA);
            PG8_WAIT_L(8); PG8_BAR; PG8_WAIT_L(0); PG8_MMA(0, 0, At, B0); PG8_BAR; PG8_SCHED;
            PG8_LDB(B1, 0, 1); PG8_STAGE(PG8_SB(0, 0), b2, voffB);
            PG8_BAR; PG8_WAIT_L(0); PG8_MMA(0, 1, At, B1); PG8_BAR;
            PG8_LDA(At, 0, 1); PG8_STAGE(PG8_SA(0, 0), a2, voffA);
            PG8_BAR; PG8_WAIT_L(0); PG8_MMA(1, 0, At, B0); PG8_BAR; PG8_SCHED;
            PG8_STAGE(PG8_SB(0, 1), b2 + hstep, voffB);
            PG8_WAIT_V(6); PG8_BAR; PG8_MMA(1, 1, At, B1); PG8_BAR;
            PG8_LDB(B0, 1, 0); PG8_SCHED; PG8_LDA(At, 1, 0); PG8_STAGE(PG8_SA(0, 1), a2 + hstep, voffA);
            PG8_WAIT_L(8); PG8_BAR; PG8_WAIT_L(0); PG8_MMA(0, 0, At, B0); PG8_BAR; PG8_SCHED;
            PG8_LDB(B1, 1, 1); PG8_STAGE(PG8_SB(1, 0), b3, voffB);
            PG8_BAR; PG8_WAIT_L(0); PG8_MMA(0, 1, At, B1); PG8_BAR;
            PG8_LDA(At, 1, 1); PG8_STAGE(PG8_SA(1, 0), a3, voffA);
            PG8_BAR; PG8_WAIT_L(0); PG8_MMA(1, 0, At, B0); PG8_BAR; PG8_SCHED;
            PG8_STAGE(PG8_SB(1, 1), b3 + hstep, voffB);
            PG8_WAIT_V(6); PG8_BAR; PG8_MMA(1, 1, At, B1); PG8_BAR;
            }
        }
        if constexpr (ALIGN_EPI) { if (wr == 0) PG8_BAR; }
        if constexpr (!Epi::AFTER_DRAIN) { E(acc, cur, wr, wc, fr, fq); S.done(cur); }
        if (!has_next) break;
#pragma unroll
        for (int a = 0; a < 2; ++a)
#pragma unroll
            for (int b = 0; b < 2; ++b)
#pragma unroll
                for (int m = 0; m < 4; ++m)
#pragma unroll
                    for (int n = 0; n < 2; ++n) acc[a][b][m][n] = (f32x4){0.f, 0.f, 0.f, 0.f};
        cur = nxt; cA = nA; cB = nB; ++ui;
        if constexpr (ALIGN_EPI) { if (wr == 1) PG8_BAR; }
    }
    PG8_WAIT_V(0);
    if constexpr (!ALIGN_EPI) { if (wr == 0) PG8_BAR; }
    PG8_BAR;
    if constexpr (Epi::AFTER_DRAIN) { E.fused(acc, cur, wr, wc, fr, fq, lds, wid, lane); S.done(cur); }
#undef PG8_SA
#undef PG8_SB
#undef PG8_STAGE
#undef PG8_LDA
#undef PG8_LDB
#undef PG8_MMA
#undef PG8_WAIT_V
#undef PG8_WAIT_L
#undef PG8_BAR
#undef PG8_SCHED
}
}
#ifndef PG8_SP2
#define PG8_SP2 true
#endif
#ifndef PG8_ALIGN
#define PG8_ALIGN true
#endif

constexpr int NWAVES = 8;
constexpr int D = 1024, FF = 4096, NH = 16, HD = 64, DEPTH = 4;
constexpr int NTOK = 131072;
constexpr int GROUP_TOK = 65536;
#ifndef MK_CH
#define MK_CH 65536
#endif
constexpr int CH = MK_CH;
constexpr int NCHUNK = NTOK / CH;
constexpr float RMS_EPS = 1e-6f;
constexpr float LOG2E = 1.4426950408889634f;
static_assert(GROUP_TOK % CH == 0 && CH % 4096 == 0, "chunking");

constexpr size_t MiB = 1u << 20;
constexpr size_t WS_WPOOL = 2 * MiB;
constexpr size_t WS_WQKV = 4 * MiB;
constexpr size_t WS_WO = 16 * MiB;
constexpr size_t WS_WUP = 20 * MiB;
constexpr size_t WS_WDN = 52 * MiB;
constexpr size_t WS_XN = 96 * MiB;
constexpr size_t WS_PG = WS_XN + (size_t)CH * D * 2;
constexpr size_t WS_ACT = WS_PG + (size_t)CH * D * 2;
constexpr size_t WS_CTL = 0, CTL_ZERO_BYTES = 65536;
constexpr size_t WS_STAT = 86 * MiB;
static_assert(WS_STAT + 2 * (size_t)CH * 64 <= WS_XN, "stat arrays");
constexpr size_t WS_END = WS_ACT + (size_t)CH * FF * 2;
static_assert(WS_XN >= WS_WDN + 32 * MiB && WS_END <= 1024 * MiB, "d_ws map");

constexpr int RING_BYTES = 131072;
constexpr int BIAS_OFF = RING_BYTES;
constexpr int MISC_OFF = RING_BYTES + 4096;
constexpr int LDS_BYTES = 147456;

#define GAS __attribute__((address_space(1)))
#define LAS __attribute__((address_space(3)))
typedef unsigned short bf16;
typedef unsigned v4u __attribute__((ext_vector_type(4)));
typedef unsigned v2u __attribute__((ext_vector_type(2)));
typedef float f32x4 __attribute__((ext_vector_type(4)));
typedef short bf16x8 __attribute__((ext_vector_type(8)));
typedef short s16x4 __attribute__((ext_vector_type(4)));
#define LDS_WAIT() asm volatile("s_waitcnt lgkmcnt(0)" ::: "memory")
__device__ __forceinline__ unsigned f2bf(float f) { unsigned u = __builtin_bit_cast(unsigned, f); return (u + 0x7fffu + ((u >> 16) & 1u)) >> 16; }
__device__ __forceinline__ unsigned pk2(float lo, float hi) { return f2bf(lo) | (f2bf(hi) << 16); }
__device__ __forceinline__ float bf2f(unsigned short b) { return __builtin_bit_cast(float, (unsigned)b << 16); }
__device__ __forceinline__ float wave_sum(float v) {
#pragma unroll
    for (int o = 1; o < 64; o <<= 1) v += __shfl_xor(v, o);
    return v;
}

__device__ __forceinline__ void transpose_item(const float* W, int K, int N, bf16* WT, int row_off, const float* nscale, const float* kscale, LAS float* scr, int item, int lane) {
    const int nblk = N / 32, kb = item / nblk, nb = item % nblk, k0 = 64 * kb, n0 = 32 * nb;
#pragma unroll 8
    for (int i = 0; i < 32; ++i) { const int kk = 2 * i + (lane >> 5); scr[kk * 33 + (lane & 31)] = W[(size_t)(k0 + kk) * N + n0 + (lane & 31)]; }
    LDS_WAIT(); asm volatile("" ::: "memory");
    const int c = lane & 7;
    float ks[8];
#pragma unroll
    for (int e = 0; e < 8; ++e) ks[e] = kscale ? kscale[k0 + 8 * c + e] : 1.f;
#pragma unroll
    for (int j = 0; j < 4; ++j) { const int n = (lane >> 3) + 8 * j; const LAS float* s = scr + (8 * c) * 33 + n;
        const float sc = nscale ? nscale[n0 + n] : 1.f;
        v4u o; o.x = pk2(s[0 * 33] * sc * ks[0], s[1 * 33] * sc * ks[1]); o.y = pk2(s[2 * 33] * sc * ks[2], s[3 * 33] * sc * ks[3]); o.z = pk2(s[4 * 33] * sc * ks[4], s[5 * 33] * sc * ks[5]); o.w = pk2(s[6 * 33] * sc * ks[6], s[7 * 33] * sc * ks[7]);
        *(GAS v4u*)(WT + (size_t)(row_off + n0 + n) * K + k0 + 8 * c) = o; }
    LDS_WAIT(); asm volatile("" ::: "memory");
}

struct Ptrs {
    const float *x_in[2], *norm_mix, *pool_w, *pool_scale, *w_qkv, *rpb, *w_o, *norm_mlp, *w_up, *w_down, *norm_final;
    float* out; unsigned char* ws;
};

__device__ __forceinline__ void prologue(const Ptrs& P, LAS unsigned char* lds, int gw, int NGW, int wave, int lane) {
    LAS float* scr = (LAS float*)(lds + wave * 16384);
    bf16* WPOOL = (bf16*)(P.ws + WS_WPOOL); bf16* WQKV = (bf16*)(P.ws + WS_WQKV); bf16* WO = (bf16*)(P.ws + WS_WO); bf16* WUP = (bf16*)(P.ws + WS_WUP); bf16* WDN = (bf16*)(P.ws + WS_WDN);
    constexpr int I_POOL = (256 / 64) * (256 / 32), I_QKV = (D / 64) * (3 * D / 32), I_O = (D / 64) * (D / 32), I_UP = (D / 64) * (FF / 32), I_DN = (FF / 64) * (D / 32);
    constexpr int NITEMS = 8 * I_POOL + 2 * I_QKV + 2 * I_O + 4 * I_UP + 4 * I_DN;
    for (int it = gw; it < NITEMS; it += NGW) {
        int r = it;
        if (r < 8 * I_POOL) { const int mtx = r / I_POOL, j = mtx >> 2, g = mtx & 3; transpose_item(P.pool_w + (size_t)mtx * 65536, 256, 256, WPOOL + (size_t)j * 1024 * 256, g * 256, P.pool_scale + j * 1024 + g * 256, nullptr, scr, r % I_POOL, lane); continue; } r -= 8 * I_POOL;
        if (r < 2 * I_QKV) { const int j = r / I_QKV; transpose_item(P.w_qkv + (size_t)j * D * 3 * D, D, 3 * D, WQKV + (size_t)j * 3 * D * D, 0, nullptr, P.norm_mix + (2 * j + 1) * D, scr, r % I_QKV, lane); continue; } r -= 2 * I_QKV;
        if (r < 2 * I_O) { const int j = r / I_O; transpose_item(P.w_o + (size_t)j * D * D, D, D, WO + (size_t)j * D * D, 0, nullptr, nullptr, scr, r % I_O, lane); continue; } r -= 2 * I_O;
        if (r < 4 * I_UP) { const int j = r / I_UP; transpose_item(P.w_up + (size_t)j * D * FF, D, FF, WUP + (size_t)j * D * FF, 0, nullptr, P.norm_mlp + j * D, scr, r % I_UP, lane); continue; } r -= 4 * I_UP;
        { const int j = r / I_DN; transpose_item(P.w_down + (size_t)j * D * FF, FF, D, WDN + (size_t)j * D * FF, 0, nullptr, nullptr, scr, r % I_DN, lane); }
    }
}

__device__ __forceinline__ void norm_rows_bf16(const float* x, const float* gain, bf16* o, int gw, int NGW, int lane) {
    f32x4 g[4];
#pragma unroll
    for (int j = 0; j < 4; ++j) g[j] = *((const f32x4*)gain + lane + 64 * j);
    for (int m = gw; m < CH; m += NGW) {
        const GAS f32x4* xr = (const GAS f32x4*)(x + (size_t)m * D) + lane;
        f32x4 v[4]; float s = 0.f;
#pragma unroll
        for (int j = 0; j < 4; ++j) { v[j] = xr[64 * j]; s += (v[j].x * v[j].x + v[j].y * v[j].y) + (v[j].z * v[j].z + v[j].w * v[j].w); }
        const float r = 1.0f / sqrtf(wave_sum(s) * (1.f / D) + RMS_EPS);
        GAS v2u* o8 = (GAS v2u*)(o + (size_t)m * D) + lane;
#pragma unroll
        for (int j = 0; j < 4; ++j) { v2u w; w.x = pk2(v[j].x * r * g[j].x, v[j].y * r * g[j].y); w.y = pk2(v[j].z * r * g[j].z, v[j].w * r * g[j].w); o8[64 * j] = w; }
    }
}
__device__ __forceinline__ void norm_rows_f32_inplace(float* x, const float* gain, int nrows, int gw, int NGW, int lane) {
    f32x4 g[4];
#pragma unroll
    for (int j = 0; j < 4; ++j) g[j] = *((const f32x4*)gain + lane + 64 * j);
    for (int m = gw; m < nrows; m += NGW) {
        GAS f32x4* xr = (GAS f32x4*)(x + (size_t)m * D) + lane;
        f32x4 v[4]; float s = 0.f;
#pragma unroll
        for (int j = 0; j < 4; ++j) { v[j] = xr[64 * j]; s += (v[j].x * v[j].x + v[j].y * v[j].y) + (v[j].z * v[j].z + v[j].w * v[j].w); }
        const float r = 1.0f / sqrtf(wave_sum(s) * (1.f / D) + RMS_EPS);
#pragma unroll
        for (int j = 0; j < 4; ++j) xr[64 * j] = v[j] * r * g[j];
    }
}

constexpr int PT = 32, PROWS = 48;
__device__ __forceinline__ void pool_phase(LAS unsigned char* lds, const float* x, const float* gain, bf16* Pg, int seq_len, int vcu, int G, int tid, int wave, int lane) {
    f32x4 g[4];
#pragma unroll
    for (int j = 0; j < 4; ++j) g[j] = *((const f32x4*)gain + lane + 64 * j);
    const int grp = tid >> 7, w = 2 << grp, hw = w >> 1;
    for (int tile = vcu; tile < CH / PT; tile += G) {
        const int m0 = tile * PT;
        const int sb = m0 / seq_len * seq_len;
        const int t0 = m0 - sb;
        for (int i = wave; i < PROWS; i += NWAVES) {
            const int t = t0 - 8 + i;
            if (t < 0 || t >= seq_len) continue;
            const GAS f32x4* xr = (const GAS f32x4*)(x + (size_t)(sb + t) * D) + lane;
            f32x4 v[4]; float s = 0.f;
#pragma unroll
            for (int j = 0; j < 4; ++j) { v[j] = xr[64 * j]; s += (v[j].x * v[j].x + v[j].y * v[j].y) + (v[j].z * v[j].z + v[j].w * v[j].w); }
            const float r = 1.0f / sqrtf(wave_sum(s) * (1.f / D) + RMS_EPS);
            LAS v2u* hr = (LAS v2u*)(lds + i * 2048) + lane;
#pragma unroll
            for (int j = 0; j < 4; ++j) { v2u o; o.x = pk2(v[j].x * r * g[j].x, v[j].y * r * g[j].y); o.y = pk2(v[j].z * r * g[j].z, v[j].w * r * g[j].w); hr[64 * j] = o; }
        }
        __syncthreads();
        const LAS unsigned* hcol = (const LAS unsigned*)lds + tid;
        GAS unsigned* po = (GAS unsigned*)(Pg + (size_t)grp * CH * 256 + (size_t)m0 * 256) + (tid & 127);
        for (int tt = 0; tt < PT; ++tt) {
            const int t = t0 + tt;
            const int lo = max(t - hw, 0), hi = min(t + hw - 1, seq_len - 1);
            float s0 = 0.f, s1 = 0.f;
            for (int q = lo; q <= hi; ++q) { const unsigned u = hcol[(q - t0 + 8) * 512]; s0 += __builtin_bit_cast(float, u << 16); s1 += __builtin_bit_cast(float, u & 0xffff0000u); }
            const unsigned uc = hcol[(tt + 8) * 512];
            const float inv = 1.0f / (float)(hi - lo + 1);
            po[(size_t)tt * 128] = pk2(s0 * inv - __builtin_bit_cast(float, uc << 16), s1 * inv - __builtin_bit_cast(float, uc & 0xffff0000u));
        }
        __syncthreads();
    }
}

#define RLX_AGENT __ATOMIC_RELAXED, __HIP_MEMORY_SCOPE_AGENT
#define XB_TMO      128
#define XB_XCNT(j)  (256  + 64 * (j))
#define XB_XSUB(j)  (1280 + 64 * (j))
#define XB_XGEN(j)  (2304 + 64 * (j))
#define XB_TOP      3328
#define XB_TOPGEN   3392
#define XCD_BAR_WORDS 3456
#define XB_SPIN_CAP (1u << 18)

__device__ __forceinline__ unsigned xb_ld(unsigned* p)              { return __hip_atomic_load(p, __ATOMIC_RELAXED, __HIP_MEMORY_SCOPE_AGENT); }
__device__ __forceinline__ unsigned xb_add(unsigned* p, unsigned v) { return __hip_atomic_fetch_add(p, v, __ATOMIC_RELAXED, __HIP_MEMORY_SCOPE_AGENT); }
__device__ __forceinline__ unsigned xb_xcc_id() { return (unsigned)__builtin_amdgcn_s_getreg((3 << 11) | 20) & 0xFu; }
#define XB_SPIN(cond, bar) do { unsigned _sp = 0; while (cond) { __builtin_amdgcn_s_sleep(1); \
    if ((++_sp & 255u) == 0u) { if (xb_ld(&(bar)[XB_TMO])) break; if (_sp > XB_SPIN_CAP) { atomicAdd(&(bar)[XB_TMO], 1u); break; } } } } while (0)

struct XcdBarrier {
    unsigned* bar; unsigned x;
    volatile LAS unsigned* st;
};

__device__ __forceinline__ XcdBarrier xcd_barrier_post(unsigned* bar, volatile LAS unsigned* st) {
    XcdBarrier b; b.bar = bar; b.x = xb_xcc_id(); b.st = st;
    if (threadIdx.x == 0) (void)xb_add(&bar[XB_XCNT(b.x)], 1u);
    return b;
}
__device__ __forceinline__ void xcd_barrier_complete(unsigned* bar, unsigned x, unsigned& nloc, unsigned& nx) {
    const unsigned G = gridDim.x * gridDim.y * gridDim.z;
    unsigned sum, cnt, mine, sp = 0u;
    for (;;) {
        sum = 0u; cnt = 0u; mine = 0u;
#pragma unroll
        for (unsigned j = 0; j < 16; ++j) { const unsigned c = xb_ld(&bar[XB_XCNT(j)]); sum += c; cnt += (c > 0u) ? 1u : 0u; mine = (j == x) ? c : mine; }
        if (sum == G) break;
        __builtin_amdgcn_s_sleep(1);
        if ((++sp & 255u) == 0u) { if (xb_ld(&bar[XB_TMO])) break; if (sp > XB_SPIN_CAP) { atomicAdd(&bar[XB_TMO], 1u); break; } }
    }
    nloc = mine > 0u ? mine : 1u; nx = cnt > 0u ? cnt : 1u;
}

__device__ __forceinline__ void xcd_barrier(const XcdBarrier& b) {
    asm volatile("s_waitcnt vmcnt(0)" ::: "memory");
    __syncthreads();
    if (threadIdx.x == 0) {
        unsigned* bar = b.bar;
        __builtin_amdgcn_s_waitcnt(0);
        unsigned nloc = b.st[0], nx = b.st[1];
        if (nloc == 0u) { xcd_barrier_complete(bar, b.x, nloc, nx); b.st[0] = nloc; b.st[1] = nx; }
        const unsigned old = xb_add(&bar[XB_XSUB(b.x)], 1u);
        const unsigned gen = old / nloc;
        if (old + 1u == (gen + 1u) * nloc) {
            __builtin_amdgcn_fence(__ATOMIC_RELEASE, "agent");
            asm volatile("s_waitcnt vmcnt(0)" ::: "memory");
            const unsigned og = xb_add(&bar[XB_TOP], 1u);
            const unsigned tg = og / nx;
            if (og + 1u == (tg + 1u) * nx) xb_add(&bar[XB_TOPGEN], 1u);
            else XB_SPIN(xb_ld(&bar[XB_TOPGEN]) == tg, bar);
            __builtin_amdgcn_fence(__ATOMIC_ACQUIRE, "agent");
            xb_add(&bar[XB_XGEN(b.x)], 1u);
            asm volatile("s_waitcnt vmcnt(0)" ::: "memory");
        } else {
            XB_SPIN(xb_ld(&bar[XB_XGEN(b.x)]) == gen, bar);
            __builtin_amdgcn_fence(__ATOMIC_ACQUIRE, "agent");
            asm volatile("s_waitcnt vmcnt(0)" ::: "memory");
        }
    }
    __syncthreads();
}


__device__ __forceinline__ s16x4 vtr(const LAS unsigned char* p) { return __builtin_bit_cast(s16x4, __builtin_amdgcn_ds_read_tr16_b64_v4i16((LAS s16x4*)p)); }
__device__ __forceinline__ void attn_phase(LAS unsigned char* lds, bf16* Qb, const bf16* Kb, const bf16* Vb, const float* rpb_l, int seq_len, int G, int bx, int tid, int wave, int lane) {
    const int fr = lane & 15, fq = lane >> 4;
    const int rows = seq_len >> 6, rows_shift = (seq_len == 2048) ? 5 : 6;
    constexpr int NI = (CH / 64) * 8;
    int nx, xc, lc, per;
    if ((G & 7) == 0) { nx = G >> 3; xc = bx & 7; lc = bx >> 3; per = NI >> 3; } else { nx = G; xc = 0; lc = bx; per = NI; }
    LAS float* bias = (LAS float*)(lds + BIAS_OFF);
    const int qb = wave & 3, hh = wave >> 2;
    const int qc = (qb < 3) ? (8 + 16 * qb + fr) : (fr < 8 ? fr : 48 + fr);
    const int a0 = (qb < 3) ? qb : 0, a1 = (qb < 3) ? qb + 1 : 3;
    const int wst = min(max(qc - 8, 0), 48);
    const int q4 = (lane & 15) >> 2, p4 = lane & 3;
    for (int loc = lc; loc < per; loc += nx) {
        const int id = xc * per + loc;
        const int r = id & (rows - 1), bh = id >> rows_shift, hp = bh & 7, b = bh >> 3;
        const int tb = b * seq_len;
        const int r0 = min(max(r - 4, 0), rows - 8);
        for (int k = tid; k < 930; k += NWAVES * 64) bias[k] = rpb_l[hp * 930 + k] * LOG2E;
        {
            v4u vv[16];
#pragma unroll
            for (int p = 0; p < 16; ++p) { const int kr = p >> 1, c = (p & 1) * 32 + (tid >> 4);
                vv[p] = *(const GAS v4u*)(Vb + (size_t)(tb + (r0 + kr) * 64 + c) * D + hp * 128 + (tid & 15) * 8); }
#pragma unroll
            for (int p = 0; p < 16; ++p) { const int kr = p >> 1, c = (p & 1) * 32 + (tid >> 4), ch = tid & 15;
                const int img = (c >> 4) * 4 + (kr >> 1), rho = 8 * ((c & 15) >> 2) + 4 * (kr & 1) + (c & 3);
                *(LAS v4u*)(lds + img * 8192 + 256 * rho + 16 * (ch ^ (((rho & 3) << 2) | ((rho >> 2) & 3)))) = vv[p]; }
        }
        __syncthreads();
        const int h = 2 * hp + hh;
        const size_t qoff = (size_t)(tb + r * 64 + qc) * D + h * 64;
        const bf16x8 qf0 = *(const GAS bf16x8*)(Qb + qoff + 8 * fq), qf1 = *(const GAS bf16x8*)(Qb + qoff + 32 + 8 * fq);
        f32x4 S[8][2];
        float mx = -3.0e38f;
        const bf16* kbase = Kb + (size_t)(tb + r0 * 64 + fr) * D + h * 64 + 8 * fq;
        bf16x8 kf[2][2][2];
        const LAS float* bptr[2][4];
#pragma unroll
        for (int ai = 0; ai < 2; ++ai)
#pragma unroll
            for (int i = 0; i < 4; ++i) { const int kc = 16 * (ai ? a1 : a0) + 4 * fq + i; bptr[ai][i] = bias + hh * 465 + (r0 - r + 7) * 31 + min(max(kc - qc + 15, 0), 30); }
#pragma unroll
        for (int ai = 0; ai < 2; ++ai) { const bf16* kp = kbase + (size_t)(16 * (ai ? a1 : a0)) * D; kf[0][ai][0] = *(const GAS bf16x8*)kp; kf[0][ai][1] = *(const GAS bf16x8*)(kp + 32); }
#pragma unroll
        for (int kr = 0; kr < 8; ++kr) {
            if (kr < 7) {
#pragma unroll
                for (int ai = 0; ai < 2; ++ai) { const bf16* kp = kbase + (size_t)((kr + 1) * 64 + 16 * (ai ? a1 : a0)) * D; kf[(kr + 1) & 1][ai][0] = *(const GAS bf16x8*)kp; kf[(kr + 1) & 1][ai][1] = *(const GAS bf16x8*)(kp + 32); }
            }
#pragma unroll
            for (int ai = 0; ai < 2; ++ai) {
                const int a = ai ? a1 : a0;
                f32x4 z = {0.f, 0.f, 0.f, 0.f};
                z = __builtin_amdgcn_mfma_f32_16x16x32_bf16(kf[kr & 1][ai][0], qf0, z, 0, 0, 0);
                z = __builtin_amdgcn_mfma_f32_16x16x32_bf16(kf[kr & 1][ai][1], qf1, z, 0, 0, 0);
#pragma unroll
                for (int i = 0; i < 4; ++i) { const int kc = 16 * a + 4 * fq + i;
                    const bool valid = (kc >= wst) && (kc < wst + 16);
                    z[i] = valid ? z[i] + bptr[ai][i][kr * 31] : -1.0e30f; mx = fmaxf(mx, z[i]); }
                S[kr][ai] = z;
            }
            __builtin_amdgcn_sched_barrier(0);
        }
        mx = fmaxf(mx, __shfl_xor(mx, 16)); mx = fmaxf(mx, __shfl_xor(mx, 32));
        float sum = 0.f;
#pragma unroll
        for (int kr = 0; kr < 8; ++kr)
#pragma unroll
            for (int ai = 0; ai < 2; ++ai)
#pragma unroll
                for (int i = 0; i < 4; ++i) { const float p = __builtin_amdgcn_exp2f(S[kr][ai][i] - mx); S[kr][ai][i] = p; sum += p; }
        sum += __shfl_xor(sum, 16); sum += __shfl_xor(sum, 32);
        f32x4 O[4];
#pragma unroll
        for (int c = 0; c < 4; ++c) O[c] = (f32x4){0.f, 0.f, 0.f, 0.f};
        const LAS unsigned char* vb[2][2][4];
#pragma unroll
        for (int ai = 0; ai < 2; ++ai)
#pragma unroll
            for (int t = 0; t < 2; ++t)
#pragma unroll
                for (int c = 0; c < 4; ++c) { const int rho = 8 * fq + 4 * t + q4, chn = 2 * (4 * hh + c) + (p4 >> 1);
                    vb[ai][t][c] = lds + (ai ? a1 : a0) * 32768 + 256 * rho + 16 * (chn ^ (((rho & 3) << 2) | ((rho >> 2) & 3))) + 8 * (p4 & 1); }
#pragma unroll
        for (int u = 0; u < 4; ++u) {
#pragma unroll
            for (int ai = 0; ai < 2; ++ai) {
                v4u pw; pw.x = pk2(S[2 * u][ai][0], S[2 * u][ai][1]); pw.y = pk2(S[2 * u][ai][2], S[2 * u][ai][3]); pw.z = pk2(S[2 * u + 1][ai][0], S[2 * u + 1][ai][1]); pw.w = pk2(S[2 * u + 1][ai][2], S[2 * u + 1][ai][3]);
                const bf16x8 pf = __builtin_bit_cast(bf16x8, pw);
#pragma unroll
                for (int c = 0; c < 4; ++c) {
                    const s16x4 v0 = vtr(vb[ai][0][c] + u * 8192), v1 = vtr(vb[ai][1][c] + u * 8192);
                    const bf16x8 vf = __builtin_shufflevector(v0, v1, 0, 1, 2, 3, 4, 5, 6, 7);
                    O[c] = __builtin_amdgcn_mfma_f32_16x16x32_bf16(vf, pf, O[c], 0, 0, 0);
                }
            }
            __builtin_amdgcn_sched_barrier(0);
        }
        const float inv = 1.0f / sum;
#pragma unroll
        for (int c = 0; c < 4; ++c) { v2u w; w.x = pk2(O[c][0] * inv, O[c][1] * inv); w.y = pk2(O[c][2] * inv, O[c][3] * inv);
            *(GAS v2u*)(Qb + qoff + 16 * c + 4 * fq) = w; }
        __syncthreads();
    }
}

enum { K_POOL = 1, K_GEMM_RES = 3, K_GEMM_QKV = 4, K_GEMM_UP = 5, K_ATTN = 6, K_FINAL = 7 };
enum { F_A_X = 1, F_A_IN = 2, F_AUX_X = 4, F_AUX_IN = 8 };
struct Ph { int kind, flags, N, K; const void* A; const void* B; void* C; const void* aux; float* st; float* stz; unsigned long long a_pn_stride, pad; };
constexpr int PPC = 19;
struct Args { Ptrs p; Ph tab[PPC]; };
__global__ void __launch_bounds__(NWAVES * 64, 2) fwd_megakernel(Args args) {
    extern __shared__ __attribute__((aligned(16))) unsigned char lds_raw[];
    cg::grid_group grid = cg::this_grid();
    LAS unsigned char* lds = (LAS unsigned char*)lds_raw;
    volatile LAS unsigned* MISC = (volatile LAS unsigned*)(lds + MISC_OFF);
    for (int u = threadIdx.x; u < 32; u += NWAVES * 64) MISC[u] = 0u;
    __syncthreads();
    const XcdBarrier bar = xcd_barrier_post((unsigned*)(args.p.ws + WS_CTL), MISC + 8);
    {
        const int tid = threadIdx.x, lane = tid & 63, wave = __builtin_amdgcn_readfirstlane(tid >> 6);
        const int G = gridDim.x, bx = blockIdx.x;
        const int vcu = (G % 8 == 0) ? (bx % 8) * (G / 8) + bx / 8 : bx;
        prologue(args.p, lds, vcu * NWAVES + wave, G * NWAVES, wave, lane);
    }
    grid.sync();

    for (int ph = 0; ph < NCHUNK * PPC; ++ph) {
        int tid = threadIdx.x; asm volatile("" : "+v"(tid));
        int G = gridDim.x, bx = blockIdx.x; asm volatile("" : "+s"(G), "+s"(bx));
        const int lane = tid & 63, wave = __builtin_amdgcn_readfirstlane(tid >> 6);
        const int vcu = (G % 8 == 0) ? (bx % 8) * (G / 8) + bx / 8 : bx;
        const int gw = vcu * NWAVES + wave, NGW = G * NWAVES;
        const int ck = ph / PPC, idx = ph - ck * PPC;
        const Ph d = args.tab[idx];
        const int tok0 = ck * CH, grp = tok0 / GROUP_TOK, seq_len = grp ? 4096 : 2048;
        const float* xin = args.p.x_in[grp] + (size_t)(tok0 - grp * GROUP_TOK) * D;
        float* X = args.p.out + (size_t)tok0 * D;
        const void* A = (d.flags & F_A_X) ? (const void*)X : (d.flags & F_A_IN) ? (const void*)xin : d.A;
        const void* aux = (d.flags & F_AUX_X) ? (const void*)X : (d.flags & F_AUX_IN) ? (const void*)xin : d.aux;
        if (d.stz) for (int i = vcu * (NWAVES * 64) + tid; i < CH; i += G * NWAVES * 64) d.stz[i] = 0.f;
        switch (d.kind) {
        case K_POOL: pool_phase(lds, (const float*)A, (const float*)aux, (bf16*)d.C, seq_len, vcu, G, tid, wave, lane); break;
        case K_GEMM_RES: { pg8::Gemm g{(const bf16*)A, (const bf16*)d.B, CH, d.N, d.K, (size_t)d.a_pn_stride}; pg8::StaticOrder S; S.init(CH, d.N, G, bx);
            pg8::EpiRes E{(const float*)aux, X, (bf16*)d.C, d.st, D};
            pg8::gemm_phase<pg8::EpiRes, pg8::StaticOrder, PG8_ALIGN, PG8_SP2>(lds, g, S, E, tid); } break;
        case K_GEMM_QKV: { pg8::Gemm g{(const bf16*)A, (const bf16*)d.B, CH, d.N, d.K, 0}; pg8::StaticOrder S; S.init(CH, d.N, G, bx);
            pg8::EpiBf16<0, true> E{(bf16*)d.C, D, D, (size_t)CH * D, 0.125f * LOG2E, d.st};
            pg8::gemm_phase<pg8::EpiBf16<0, true>, pg8::StaticOrder, PG8_ALIGN, PG8_SP2>(lds, g, S, E, tid); } break;
        case K_GEMM_UP: { pg8::Gemm g{(const bf16*)A, (const bf16*)d.B, CH, d.N, d.K, 0}; pg8::StaticOrder S; S.init(CH, d.N, G, bx);
            pg8::EpiBf16<2, true> E{(bf16*)d.C, FF, 0, 0, 1.f, d.st};
            pg8::gemm_phase<pg8::EpiBf16<2, true>, pg8::StaticOrder, PG8_ALIGN, PG8_SP2>(lds, g, S, E, tid); } break;
        case K_ATTN: attn_phase(lds, (bf16*)d.C, (const bf16*)d.C + (size_t)CH * D, (const bf16*)d.C + 2 * (size_t)CH * D, (const float*)aux, seq_len, G, bx, tid, wave, lane); break;
        default: norm_rows_f32_inplace(X, (const float*)aux, CH, gw, NGW, lane); break;
        }
        if (d.kind != K_FINAL) xcd_barrier(bar);
    }
}

extern "C" void kernel_launch(void* const* d_in, const int* in_sizes, int n_in, void* d_out, int out_size, void* d_ws, size_t ws_size, hipStream_t stream) {
    static int grid = 0;
    if (grid == 0) {
        if (n_in != 12 || in_sizes[0] != GROUP_TOK * D || in_sizes[1] != GROUP_TOK * D || out_size != NTOK * D || ws_size < WS_END) {
            fprintf(stderr, "kernel_launch: unexpected shapes (n_in %d, out %d, ws %zu < %zu); nothing launched\n", n_in, out_size, ws_size, (size_t)WS_END); grid = -1; return; }
        int dev = 0, cus = 0, per_cu = 0;
        if (hipGetDevice(&dev) != hipSuccess || hipDeviceGetAttribute(&cus, hipDeviceAttributeMultiprocessorCount, dev) != hipSuccess) { fprintf(stderr, "kernel_launch: device query failed\n"); grid = -1; return; }
        if (hipFuncSetAttribute((const void*)fwd_megakernel, hipFuncAttributeMaxDynamicSharedMemorySize, LDS_BYTES) != hipSuccess) { fprintf(stderr, "kernel_launch: hipFuncSetAttribute failed\n"); grid = -1; return; }
        if (hipOccupancyMaxActiveBlocksPerMultiprocessor(&per_cu, (const void*)fwd_megakernel, NWAVES * 64, LDS_BYTES) != hipSuccess || per_cu < 1) { fprintf(stderr, "kernel_launch: occupancy query gave %d\n", per_cu); per_cu = 1; }
        (void)hipGetLastError();
        grid = cus * per_cu;
    }
    if (grid < 0) return;
    if (hipMemsetAsync((char*)d_ws + WS_CTL, 0, CTL_ZERO_BYTES, stream) != hipSuccess) { fprintf(stderr, "kernel_launch: hipMemsetAsync failed\n"); return; }
    Args a{};
    Ptrs& p = a.p;
    p.x_in[0] = (const float*)d_in[0]; p.x_in[1] = (const float*)d_in[1]; p.norm_mix = (const float*)d_in[2]; p.pool_w = (const float*)d_in[3]; p.pool_scale = (const float*)d_in[4];
    p.w_qkv = (const float*)d_in[5]; p.rpb = (const float*)d_in[6]; p.w_o = (const float*)d_in[7]; p.norm_mlp = (const float*)d_in[8]; p.w_up = (const float*)d_in[9];
    p.w_down = (const float*)d_in[10]; p.norm_final = (const float*)d_in[11]; p.out = (float*)d_out; p.ws = (unsigned char*)d_ws;
    unsigned char* ws = (unsigned char*)d_ws;
    bf16* WPOOL = (bf16*)(ws + WS_WPOOL); bf16* WQKV = (bf16*)(ws + WS_WQKV); bf16* WO = (bf16*)(ws + WS_WO); bf16* WUP = (bf16*)(ws + WS_WUP); bf16* WDN = (bf16*)(ws + WS_WDN);
    bf16* XN = (bf16*)(ws + WS_XN); bf16* PG = (bf16*)(ws + WS_PG); bf16* QB = (bf16*)(ws + WS_ACT); bf16* HB = (bf16*)(ws + WS_ACT);
    float* SA = (float*)(ws + WS_STAT); float* SB = SA + (size_t)CH * 16;
    int n = 0;
    auto add = [&](int kind, int flags, int N, int K, const void* A, const void* B, void* C, const void* aux, float* st, float* stz, unsigned long long aps) {
        Ph& d = a.tab[n++]; d.kind = kind; d.flags = flags; d.N = N; d.K = K; d.A = A; d.B = B; d.C = C; d.aux = aux; d.st = st; d.stz = stz; d.a_pn_stride = aps; d.pad = 0; };
    for (int layer = 0; layer < DEPTH; ++layer) {
        const int j = layer >> 1;
        if ((layer & 1) == 0) {
            add(K_POOL, layer == 0 ? F_A_IN : F_A_X, 0, 0, nullptr, nullptr, PG, p.norm_mix + layer * D, nullptr, nullptr, 0);
            add(K_GEMM_RES, layer == 0 ? F_AUX_IN : F_AUX_X, D, 256, PG, WPOOL + (size_t)j * 1024 * 256, XN, nullptr, SA, nullptr, (unsigned long long)CH * 256 * 2);
        } else {
            add(K_GEMM_QKV, 0, 3 * D, D, XN, WQKV + (size_t)j * 3 * D * D, QB, nullptr, SB, nullptr, 0);
            add(K_ATTN, 0, 0, 0, nullptr, nullptr, QB, p.rpb + (size_t)j * NH * 15 * 31, nullptr, nullptr, 0);
            add(K_GEMM_RES, F_AUX_X, D, D, QB, WO + (size_t)j * D * D, XN, nullptr, SA, nullptr, 0);
        }
        add(K_GEMM_UP, 0, FF, D, XN, WUP + (size_t)layer * D * FF, HB, nullptr, SA, nullptr, 0);
        add(K_GEMM_RES, F_AUX_X, D, FF, HB, WDN + (size_t)layer * D * FF, (layer & 1) == 0 ? XN : nullptr, nullptr, SB, nullptr, 0);
    }
    add(K_FINAL, 0, 0, 0, nullptr, nullptr, nullptr, p.norm_final, nullptr, nullptr, 0);
    if (n != PPC) { fprintf(stderr, "kernel_launch: phase table has %d entries, expected %d\n", n, PPC); return; }
    void* kargs[] = {&a};
    hipError_t e = hipLaunchCooperativeKernel((const void*)fwd_megakernel, dim3(grid), dim3(NWAVES * 64), kargs, LDS_BYTES, stream);
    if (e != hipSuccess) fprintf(stderr, "kernel_launch: cooperative launch failed: %s (grid %d)\n", hipGetErrorString(e), grid);
}
```

```cpp
#include <hip/hip_runtime.h>
#include <hip/hip_cooperative_groups.h>
#include <cstdio>
#include <cstdint>
namespace cg = cooperative_groups;
namespace pg8 {
#define PG8_LAS __attribute__((address_space(3)))
typedef unsigned short bf16_t;
typedef short bf16x8 __attribute__((ext_vector_type(8)));
typedef float f32x4 __attribute__((ext_vector_type(4)));
typedef unsigned u32x4 __attribute__((ext_vector_type(4)));
constexpr int BM = 256, BK = 64, HALF = 128, HTB = HALF * BK * 2  , STAGE_BYTES = 8 * HTB, NXCD = 8, WGM = 8;

__host__ __device__ __forceinline__ int lds_byte(int r, int c) { const int st = (r >> 4) * 2 + (c >> 5), rr = r & 15, cc = c & 31, ob = rr * 64 + cc * 2; return st * 1024 + (ob ^ (((ob >> 9) & 1) << 5)); }
__host__ __device__ __forceinline__ void stage_rc(int b, int& R, int& C) { const int st = b / 1024, sb = b % 1024, swz = sb ^ (((sb >> 9) & 1) << 5); R = (st >> 1) * 16 + swz / 64; C = (st & 1) * 32 + (swz % 64) / 2; }
__host__ __device__ __forceinline__ int perm32(int rho) { const int n = rho >> 4, i = rho & 15; return 8 * (i >> 2) + 4 * n + (i & 3); }

struct Unit { int pm, pn; };
struct Gemm { const bf16_t* A; const bf16_t* Bt; int M, N, K; size_t a_pn_stride; };

struct StaticOrder {
    int nM, nN, nwg, G, c;
    __host__ __device__ void init(int M, int N, int G_, int c_) { nM = M / BM; nN = N / BM; nwg = nM * nN; G = G_; c = c_; }
    __host__ __device__ bool next(int i, Unit& u) const {
        const long L = (long)i * G + c; if (L >= nwg) return false;
        int wgid = (int)L; { const int q = nwg / NXCD, r = nwg % NXCD, xcd = wgid % NXCD, off = wgid / NXCD; wgid = (xcd < r ? xcd * (q + 1) : r * (q + 1) + (xcd - r) * q) + off; }
        const int nig = WGM * nN, gid = wgid / nig, fm = gid * WGM, gsz = (nM - fm) < WGM ? (nM - fm) : WGM;
        u.pm = fm + ((wgid % nig) % gsz); u.pn = (wgid % nig) / gsz; return true;
    }
    __device__ __forceinline__ void a_ready(const Unit&) const {}
    __device__ __forceinline__ void done(const Unit&) const {}
};

__device__ __forceinline__ unsigned cvt_pk_bf16(float lo, float hi) { unsigned r; asm volatile("v_cvt_pk_bf16_f32 %0, %1, %2" : "=v"(r) : "v"(lo), "v"(hi)); return r; }
typedef float f32x2 __attribute__((ext_vector_type(2)));
template <int ACT, bool RS> struct EpiBf16 {
    static constexpr bool PERM = true, AFTER_DRAIN = false;
    bf16_t* O; int ldc; int split_cols; size_t split_stride; float scale0; const float* st;
    __device__ __forceinline__ void operator()(const f32x4 (&acc)[2][2][4][2], const Unit& u, int wr, int wc, int fr, int fq) const {
        const int row0 = u.pm * BM + wr * 64 + fr; int colt = u.pn * BM; bf16_t* base = O;
        float sc = 1.f; bool kplane = false;
        if (split_cols) { const int t = colt / split_cols; base += (size_t)t * split_stride; colt -= t * split_cols; if (t == 0) sc = scale0; kplane = (t == 1); }
        const size_t kprows = split_stride / 1024;
        const int col0 = colt + wc * 32 + 8 * fq;
        f32x4 pv[2][4];
        if (RS) {
#pragma unroll
            for (int ai = 0; ai < 2; ++ai)
#pragma unroll
                for (int m = 0; m < 4; ++m) pv[ai][m] = *(const f32x4*)(st + (size_t)(row0 + ai * HALF + m * 16) * 16 + 4 * fq);
            __builtin_amdgcn_sched_barrier(0);
        }
#pragma unroll
        for (int ai = 0; ai < 2; ++ai)
#pragma unroll
            for (int m = 0; m < 4; ++m) { const int row = row0 + ai * HALF + m * 16; bf16_t* rowp = base + (size_t)row * ldc + col0;
                float f = sc;
                if (RS) { float ss = (pv[ai][m][0] + pv[ai][m][1]) + (pv[ai][m][2] + pv[ai][m][3]); ss += __shfl_xor(ss, 16); ss += __shfl_xor(ss, 32);
                    const float r = __builtin_amdgcn_rsqf(ss * (1.0f / 1024.0f) + 1e-6f); f *= (ACT == 2) ? r * r : r; }
#pragma unroll
                for (int bj = 0; bj < 2; ++bj) { f32x4 v0 = acc[ai][bj][m][0], v1 = acc[ai][bj][m][1];
                    if (ACT == 2) {
#pragma unroll
                        for (int e = 0; e < 4; ++e) { const float a = fmaxf(v0[e], 0.f), b = fmaxf(v1[e], 0.f); v0[e] = a * a; v1[e] = b * b; } }
                    v0 = v0 * f; v1 = v1 * f; u32x4 w; w.x = cvt_pk_bf16(v0[0], v0[1]); w.y = cvt_pk_bf16(v0[2], v0[3]); w.z = cvt_pk_bf16(v1[0], v1[1]); w.w = cvt_pk_bf16(v1[2], v1[3]);
                    if (kplane) *(u32x4*)(base + ((size_t)(((colt >> 6) + 2 * bj + (wc >> 1)) * 8 + (wc & 1) * 4 + fq) * kprows + row) * 8) = w;
                    else *(u32x4*)(rowp + bj * HALF) = w; } }
    }
};
struct EpiRes {
    static constexpr bool PERM = true, AFTER_DRAIN = false;
    const float* base; float* out; bf16_t* xn; float* st; int ldc;
    __device__ __forceinline__ void operator()(const f32x4 (&acc)[2][2][4][2], const Unit& u, int wr, int wc, int fr, int fq) const {
        const int col0 = u.pn * BM + wc * 32 + 8 * fq;
#pragma unroll
        for (int ai = 0; ai < 2; ++ai) {
            f32x4 bs[4][2][2];
#pragma unroll
            for (int m = 0; m < 4; ++m) { const size_t off = (size_t)(u.pm * BM + ai * HALF + wr * 64 + m * 16 + fr) * ldc + col0;
#pragma unroll
                for (int bj = 0; bj < 2; ++bj) { bs[m][bj][0] = *(const f32x4*)(base + off + bj * HALF); bs[m][bj][1] = *(const f32x4*)(base + off + bj * HALF + 4); } }
            __builtin_amdgcn_sched_barrier(0);
#pragma unroll
            for (int m = 0; m < 4; ++m) { const int row = u.pm * BM + ai * HALF + wr * 64 + m * 16 + fr; const size_t off = (size_t)row * ldc + col0; float ss = 0.f;
#pragma unroll
                for (int bj = 0; bj < 2; ++bj) {
                    const f32x4 o0 = bs[m][bj][0] + acc[ai][bj][m][0], o1 = bs[m][bj][1] + acc[ai][bj][m][1];
                    *(f32x4*)(out + off + bj * HALF) = o0; *(f32x4*)(out + off + bj * HALF + 4) = o1;
                    if (xn) { u32x4 w; w.x = cvt_pk_bf16(o0[0], o0[1]); w.y = cvt_pk_bf16(o0[2], o0[3]); w.z = cvt_pk_bf16(o1[0], o1[1]); w.w = cvt_pk_bf16(o1[2], o1[3]);
                        *(u32x4*)(xn + off + bj * HALF) = w;
                        ss += (o0[0] * o0[0] + o0[1] * o0[1]) + (o0[2] * o0[2] + o0[3] * o0[3]) + (o1[0] * o1[0] + o1[1] * o1[1]) + (o1[2] * o1[2] + o1[3] * o1[3]); } }
                if (xn) { ss += __shfl_xor(ss, 16); ss += __shfl_xor(ss, 32); if (fq == 0) st[(size_t)row * 16 + u.pn * 4 + wc] = ss; } }
            __builtin_amdgcn_sched_barrier(0);
        }
    }
};
template <class Epi, class Sched, bool ALIGN_EPI = false, bool SP2 = false>
__device__ __forceinline__ void gemm_phase(PG8_LAS unsigned char* lds, const Gemm g, const Sched& S, const Epi& E, const int tid_in) {
    const int tid = tid_in, wid = __builtin_amdgcn_readfirstlane(tid >> 6), lane = tid & 63, wr = wid >> 2, wc = wid & 3, fr = lane & 15, fq = lane >> 4;
    const int K = g.K, nt = K / BK;
    unsigned voffA[2], voffB[2];
#pragma unroll
    for (int i = 0; i < 2; ++i) { int R, C; stage_rc(tid * 16 + i * 8192, R, C); const int Rb = Epi::PERM ? ((R & ~31) + perm32(R & 31)) : R;
        voffA[i] = (unsigned)(R * K + C) * 2u; voffB[i] = (unsigned)(Rb * K + C) * 2u; }
    const size_t kstep = (size_t)(BK * 2);
    const size_t hstep = (size_t)HALF * K * 2;
    const size_t tstep = 2 * hstep;
    const unsigned ldsw = (unsigned)wid * 1024u;
    const int aoff = lds_byte(wr * 64 + fr, fq * 8), boff = lds_byte(wc * 32 + fr, fq * 8);
#define PG8_SA(b, h) (((b) * 2 + (h)) * HTB)
#define PG8_SB(b, h) ((4 + (b) * 2 + (h)) * HTB)
#define PG8_STAGE(bufoff, gbase, voff) do { _Pragma("unroll") for (int _i = 0; _i < 2; ++_i) \
        __builtin_amdgcn_global_load_lds((const unsigned*)((const char*)(gbase) + (voff)[_i]), (PG8_LAS unsigned*)(lds + (bufoff) + ldsw + _i * 8192), 16, 0, 0); } while (0)
#define PG8_LDA(dst, b, h) do { _Pragma("unroll") for (int m = 0; m < 4; ++m) _Pragma("unroll") for (int k = 0; k < 2; ++k) dst[m][k] = *(const PG8_LAS bf16x8*)(lds + PG8_SA(b, h) + aoff + m * 2048 + k * 1024); } while (0)
#define PG8_LDB(dst, b, h) do { _Pragma("unroll") for (int n = 0; n < 2; ++n) _Pragma("unroll") for (int k = 0; k < 2; ++k) dst[n][k] = *(const PG8_LAS bf16x8*)(lds + PG8_SB(b, h) + boff + n * 2048 + k * 1024); } while (0)
#define PG8_MMA(ai, bj, At, Bt) do { __builtin_amdgcn_s_setprio(1); _Pragma("unroll") for (int m = 0; m < 4; ++m) _Pragma("unroll") for (int n = 0; n < 2; ++n) _Pragma("unroll") for (int k = 0; k < 2; ++k) \
        acc[ai][bj][m][n] = __builtin_amdgcn_mfma_f32_16x16x32_bf16(Bt[n][k], At[m][k], acc[ai][bj][m][n], 0, 0, 0); __builtin_amdgcn_s_setprio(0); } while (0)
#define PG8_WAIT_V(n) asm volatile("s_waitcnt vmcnt(" #n ")" ::: "memory")
#define PG8_WAIT_L(n) asm volatile("s_waitcnt lgkmcnt(" #n ")" ::: "memory")
#define PG8_BAR __builtin_amdgcn_s_barrier()
#define PG8_SCHED __builtin_amdgcn_sched_barrier(0)
    Unit cur, nxt; int ui = 0;
    if (!S.next(0, cur)) return;
    f32x4 acc[2][2][4][2];
#pragma unroll
    for (int a = 0; a < 2; ++a)
#pragma unroll
        for (int b = 0; b < 2; ++b)
#pragma unroll
            for (int m = 0; m < 4; ++m)
#pragma unroll
                for (int n = 0; n < 2; ++n) acc[a][b][m][n] = (f32x4){0.f, 0.f, 0.f, 0.f};
    bf16x8 At[4][2], B0[2][2], B1[2][2];
    const char* cA = (const char*)g.A + (size_t)cur.pm * tstep + (size_t)cur.pn * g.a_pn_stride; const char* cB = (const char*)g.Bt + (size_t)cur.pn * tstep;
    S.a_ready(cur);
    if constexpr (SP2) {
        PG8_STAGE(PG8_SB(0, 0), cB, voffB); PG8_STAGE(PG8_SB(0, 1), cB + hstep, voffB); PG8_STAGE(PG8_SA(0, 0), cA, voffA); PG8_STAGE(PG8_SA(0, 1), cA + hstep, voffA);
        if (wr == 1) PG8_BAR;
        PG8_WAIT_V(2); PG8_BAR;
        PG8_STAGE(PG8_SB(1, 0), cB + kstep, voffB); PG8_STAGE(PG8_SA(1, 0), cA + kstep, voffA); PG8_STAGE(PG8_SB(1, 1), cB + hstep + kstep, voffB);
        PG8_WAIT_V(6); PG8_BAR;
    } else {
        PG8_STAGE(PG8_SB(0, 0), cB, voffB); PG8_STAGE(PG8_SA(0, 0), cA, voffA); PG8_STAGE(PG8_SB(0, 1), cB + hstep, voffB); PG8_STAGE(PG8_SA(0, 1), cA + hstep, voffA);
        if (wr == 1) PG8_BAR;
        PG8_WAIT_V(4); PG8_BAR;
        PG8_STAGE(PG8_SB(1, 0), cB + kstep, voffB); PG8_STAGE(PG8_SA(1, 0), cA + kstep, voffA); PG8_STAGE(PG8_SB(1, 1), cB + hstep + kstep, voffB);
        PG8_WAIT_V(6); PG8_BAR;
    }
    for (;;) {
        const bool has_next = S.next(ui + 1, nxt);
        const char* nA = has_next ? (const char*)g.A + (size_t)nxt.pm * tstep + (size_t)nxt.pn * g.a_pn_stride : cA; const char* nB = has_next ? (const char*)g.Bt + (size_t)nxt.pn * tstep : cB;
        for (int t = 0; t < nt; t += 2) {
            const bool last = (t == nt - 2);
            const char* a1 = cA + (size_t)(t + 1) * kstep;
            const char* a2 = last ? nA : cA + (size_t)(t + 2) * kstep; const char* b2 = last ? nB : cB + (size_t)(t + 2) * kstep;
            const char* a3 = a2 + kstep; const char* b3 = b2 + kstep;
            if (last && has_next) S.a_ready(nxt);
            if constexpr (SP2) {
            PG8_LDB(B0, 0, 0); PG8_LDB(B1, 0, 1); PG8_SCHED; PG8_LDA(At, 0, 0); PG8_STAGE(PG8_SA(1, 1), a1 + hstep, voffA);
            PG8_WAIT_V(8); PG8_WAIT_L(0); PG8_BAR; PG8_MMA(0, 0, At, B0); PG8_MMA(0, 1, At, B1); PG8_BAR; PG8_SCHED;
            PG8_LDA(At, 0, 1); PG8_STAGE(PG8_SB(0, 0), b2, voffB); PG8_STAGE(PG8_SB(0, 1), b2 + hstep, voffB); PG8_STAGE(PG8_SA(0, 0), a2, voffA);
            PG8_WAIT_V(8); PG8_WAIT_L(0); PG8_BAR; PG8_MMA(1, 0, At, B0); PG8_MMA(1, 1, At, B1); PG8_BAR; PG8_SCHED;
            PG8_LDB(B0, 1, 0); PG8_LDB(B1, 1, 1); PG8_SCHED; PG8_LDA(At, 1, 0); PG8_STAGE(PG8_SA(0, 1), a2 + hstep, voffA);
            PG8_WAIT_V(8); PG8_WAIT_L(0); PG8_BAR; PG8_MMA(0, 0, At, B0); PG8_MMA(0, 1, At, B1); PG8_BAR; PG8_SCHED;
            PG8_LDA(At, 1, 1); PG8_STAGE(PG8_SB(1, 0), b3, voffB); PG8_STAGE(PG8_SB(1, 1), b3 + hstep, voffB); PG8_STAGE(PG8_SA(1, 0), a3, voffA);
            PG8_WAIT_V(8); PG8_WAIT_L(0); PG8_BAR; PG8_MMA(1, 0, At, B0); PG8_MMA(1, 1, At, B1); PG8_BAR; PG8_SCHED;
            } else {
            PG8_LDB(B0, 0, 0); PG8_SCHED; PG8_LDA(At, 0, 0); PG8_STAGE(PG8_SA(1, 1), a1 + hstep, voffA);
            PG8_WAIT_L(8); PG8_BAR; PG8_WAIT_L(0); PG8_MMA(0, 0, At, B0); PG8_BAR; PG8_SCHED;
            PG8_LDB(B1, 0, 1); PG8_STAGE(PG8_SB(0, 0), b2, voffB);
            PG8_BAR; PG8_WAIT_L(0); PG8_MMA(0, 1, At, B1); PG8_BAR;
            PG8_LDA(At, 0, 1); PG8_STAGE(PG8_SA(0, 0), a2, voffA);
            PG8_BAR; PG8_WAIT_L(0); PG8_MMA(1, 0, At, B0); PG8_BAR; PG8_SCHED;
            PG8_STAGE(PG8_SB(0, 1), b2 + hstep, voffB);
            PG8_WAIT_V(6); PG8_BAR; PG8_MMA(1, 1, At, B1); PG8_BAR;
            PG8_LDB(B0, 1, 0); PG8_SCHED; PG8_LDA(At, 1, 0); PG8_STAGE(PG8_SA(0, 1), a2 + hstep, voffA);
            PG8_WAIT_L(8); PG8_BAR; PG8_WAIT_L(0); PG8_MMA(0, 0, At, B0); PG8_BAR; PG8_SCHED;
            PG8_LDB(B1, 1, 1); PG8_STAGE(PG8_SB(1, 0), b3, voffB);
            PG8_BAR; PG8_WAIT_L(0); PG8_MMA(0, 1, At, B1); PG8_BAR;
            PG8_LDA(At, 1, 1); PG8_STAGE(PG8_SA(1, 0), a3, voffA);
            PG8_BAR; PG8_WAIT_L(0); PG8_MMA(1, 0, At, B0); PG8_BAR; PG8_SCHED;
            PG8_STAGE(PG8_SB(1, 1), b3 + hstep, voffB);
            PG8_WAIT_V(6); PG8_BAR; PG8_MMA(1, 1, At, B1); PG8_BAR;
            }
        }
        if constexpr (ALIGN_EPI) { if (wr == 0) PG8_BAR; }
        if constexpr (!Epi::AFTER_DRAIN) { E(acc, cur, wr, wc, fr, fq); S.done(cur); }
        if (!has_next) break;
#pragma unroll
        for (int a = 0; a < 2; ++a)
#pragma unroll
            for (int b = 0; b < 2; ++b)
#pragma unroll
                for (int m = 0; m < 4; ++m)
#pragma unroll
                    for (int n = 0; n < 2; ++n) acc[a][b][m][n] = (f32x4){0.f, 0.f, 0.f, 0.f};
        cur = nxt; cA = nA; cB = nB; ++ui;
        if constexpr (ALIGN_EPI) { if (wr == 1) PG8_BAR; }
    }
    PG8_WAIT_V(0);
    if constexpr (!ALIGN_EPI) { if (wr == 0) PG8_BAR; }
    PG8_BAR;
    if constexpr (Epi::AFTER_DRAIN) { E.fused(acc, cur, wr, wc, fr, fq, lds, wid, lane); S.done(cur); }
#undef PG8_SA
#undef PG8_SB
#undef PG8_STAGE
#undef PG8_LDA
#undef PG8_LDB
#undef PG8_MMA
#undef PG8_WAIT_V
#undef PG8_WAIT_L
#undef PG8_BAR
#undef PG8_SCHED
}
}
#ifndef PG8_SP2
#define PG8_SP2 true
#endif
#ifndef PG8_ALIGN
#define PG8_ALIGN true
#endif

constexpr int NWAVES = 8;
constexpr int D = 1024, FF = 4096, NH = 16, HD = 64, DEPTH = 4;
constexpr int NTOK = 131072;
constexpr int GROUP_TOK = 65536;
#ifndef MK_CH
#define MK_CH 65536
#endif
constexpr int CH = MK_CH;
constexpr int NCHUNK = NTOK / CH;
constexpr float RMS_EPS = 1e-6f;
constexpr float LOG2E = 1.4426950408889634f;
static_assert(GROUP_TOK % CH == 0 && CH % 4096 == 0, "chunking");

constexpr size_t MiB = 1u << 20;
constexpr size_t WS_WPOOL = 2 * MiB;
constexpr size_t WS_WQKV = 4 * MiB;
constexpr size_t WS_WO = 16 * MiB;
constexpr size_t WS_WUP = 20 * MiB;
constexpr size_t WS_WDN = 52 * MiB;
constexpr size_t WS_XN = 96 * MiB;
constexpr size_t WS_PG = WS_XN + (size_t)CH * D * 2;
constexpr size_t WS_ACT = WS_PG + (size_t)CH * D * 2;
constexpr size_t WS_CTL = 0, CTL_ZERO_BYTES = 65536;
constexpr size_t WS_STAT = 86 * MiB;
static_assert(WS_STAT + 2 * (size_t)CH * 64 <= WS_XN, "stat arrays");
constexpr size_t WS_END = WS_ACT + (size_t)CH * FF * 2;
static_assert(WS_XN >= WS_WDN + 32 * MiB && WS_END <= 1024 * MiB, "d_ws map");

constexpr int RING_BYTES = 131072;
constexpr int BIAS_OFF = RING_BYTES;
constexpr int MISC_OFF = RING_BYTES + 4096;
constexpr int LDS_BYTES = 147456;

#define GAS __attribute__((address_space(1)))
#define LAS __attribute__((address_space(3)))
typedef unsigned short bf16;
typedef unsigned v4u __attribute__((ext_vector_type(4)));
typedef unsigned v2u __attribute__((ext_vector_type(2)));
typedef float f32x4 __attribute__((ext_vector_type(4)));
typedef short bf16x8 __attribute__((ext_vector_type(8)));
typedef short s16x4 __attribute__((ext_vector_type(4)));
#define LDS_WAIT() asm volatile("s_waitcnt lgkmcnt(0)" ::: "memory")
__device__ __forceinline__ unsigned f2bf(float f) { unsigned u = __builtin_bit_cast(unsigned, f); return (u + 0x7fffu + ((u >> 16) & 1u)) >> 16; }
typedef float f32x2_t __attribute__((ext_vector_type(2))); typedef __bf16 bf16x2_t __attribute__((ext_vector_type(2)));
__device__ __forceinline__ unsigned pk2(float lo, float hi) { f32x2_t v = {lo, hi}; bf16x2_t b = __builtin_convertvector(v, bf16x2_t); return __builtin_bit_cast(unsigned, b); }
__device__ __forceinline__ float bf2f(unsigned short b) { return __builtin_bit_cast(float, (unsigned)b << 16); }
__device__ __forceinline__ float wave_sum(float v) {
#pragma unroll
    for (int o = 1; o < 64; o <<= 1) v += __shfl_xor(v, o);
    return v;
}

__device__ __forceinline__ void transpose_item(const float* W, int K, int N, bf16* WT, int row_off, const float* nscale, const float* kscale, LAS float* scr, int item, int lane) {
    const int nblk = N / 32, kb = item / nblk, nb = item % nblk, k0 = 64 * kb, n0 = 32 * nb;
#pragma unroll 8
    for (int i = 0; i < 32; ++i) { const int kk = 2 * i + (lane >> 5); scr[kk * 33 + (lane & 31)] = W[(size_t)(k0 + kk) * N + n0 + (lane & 31)]; }
    LDS_WAIT(); asm volatile("" ::: "memory");
    const int c = lane & 7;
    float ks[8];
#pragma unroll
    for (int e = 0; e < 8; ++e) ks[e] = kscale ? kscale[k0 + 8 * c + e] : 1.f;
#pragma unroll
    for (int j = 0; j < 4; ++j) { const int n = (lane >> 3) + 8 * j; const LAS float* s = scr + (8 * c) * 33 + n;
        const float sc = nscale ? nscale[n0 + n] : 1.f;
        v4u o; o.x = pk2(s[0 * 33] * sc * ks[0], s[1 * 33] * sc * ks[1]); o.y = pk2(s[2 * 33] * sc * ks[2], s[3 * 33] * sc * ks[3]); o.z = pk2(s[4 * 33] * sc * ks[4], s[5 * 33] * sc * ks[5]); o.w = pk2(s[6 * 33] * sc * ks[6], s[7 * 33] * sc * ks[7]);
        *(GAS v4u*)(WT + (size_t)(row_off + n0 + n) * K + k0 + 8 * c) = o; }
    LDS_WAIT(); asm volatile("" ::: "memory");
}

struct Ptrs {
    const float *x_in[2], *norm_mix, *pool_w, *pool_scale, *w_qkv, *rpb, *w_o, *norm_mlp, *w_up, *w_down, *norm_final;
    float* out; unsigned char* ws;
};

__device__ __forceinline__ void prologue(const Ptrs& P, LAS unsigned char* lds, int gw, int NGW, int wave, int lane) {
    LAS float* scr = (LAS float*)(lds + wave * 16384);
    bf16* WPOOL = (bf16*)(P.ws + WS_WPOOL); bf16* WQKV = (bf16*)(P.ws + WS_WQKV); bf16* WO = (bf16*)(P.ws + WS_WO); bf16* WUP = (bf16*)(P.ws + WS_WUP); bf16* WDN = (bf16*)(P.ws + WS_WDN);
    constexpr int I_POOL = (256 / 64) * (256 / 32), I_QKV = (D / 64) * (3 * D / 32), I_O = (D / 64) * (D / 32), I_UP = (D / 64) * (FF / 32), I_DN = (FF / 64) * (D / 32);
    constexpr int NITEMS = 8 * I_POOL + 2 * I_QKV + 2 * I_O + 4 * I_UP + 4 * I_DN;
    for (int it = gw; it < NITEMS; it += NGW) {
        int r = it;
        if (r < 8 * I_POOL) { const int mtx = r / I_POOL, j = mtx >> 2, g = mtx & 3; transpose_item(P.pool_w + (size_t)mtx * 65536, 256, 256, WPOOL + (size_t)j * 1024 * 256, g * 256, P.pool_scale + j * 1024 + g * 256, nullptr, scr, r % I_POOL, lane); continue; } r -= 8 * I_POOL;
        if (r < 2 * I_QKV) { const int j = r / I_QKV; transpose_item(P.w_qkv + (size_t)j * D * 3 * D, D, 3 * D, WQKV + (size_t)j * 3 * D * D, 0, nullptr, P.norm_mix + (2 * j + 1) * D, scr, r % I_QKV, lane); continue; } r -= 2 * I_QKV;
        if (r < 2 * I_O) { const int j = r / I_O; transpose_item(P.w_o + (size_t)j * D * D, D, D, WO + (size_t)j * D * D, 0, nullptr, nullptr, scr, r % I_O, lane); continue; } r -= 2 * I_O;
        if (r < 4 * I_UP) { const int j = r / I_UP; transpose_item(P.w_up + (size_t)j * D * FF, D, FF, WUP + (size_t)j * D * FF, 0, nullptr, P.norm_mlp + j * D, scr, r % I_UP, lane); continue; } r -= 4 * I_UP;
        { const int j = r / I_DN; transpose_item(P.w_down + (size_t)j * D * FF, FF, D, WDN + (size_t)j * D * FF, 0, nullptr, nullptr, scr, r % I_DN, lane); }
    }
}

__device__ __forceinline__ void norm_rows_bf16(const float* x, const float* gain, bf16* o, int gw, int NGW, int lane) {
    f32x4 g[4];
#pragma unroll
    for (int j = 0; j < 4; ++j) g[j] = *((const f32x4*)gain + lane + 64 * j);
    for (int m = gw; m < CH; m += NGW) {
        const GAS f32x4* xr = (const GAS f32x4*)(x + (size_t)m * D) + lane;
        f32x4 v[4]; float s = 0.f;
#pragma unroll
        for (int j = 0; j < 4; ++j) { v[j] = xr[64 * j]; s += (v[j].x * v[j].x + v[j].y * v[j].y) + (v[j].z * v[j].z + v[j].w * v[j].w); }
        const float r = 1.0f / sqrtf(wave_sum(s) * (1.f / D) + RMS_EPS);
        GAS v2u* o8 = (GAS v2u*)(o + (size_t)m * D) + lane;
#pragma unroll
        for (int j = 0; j < 4; ++j) { v2u w; w.x = pk2(v[j].x * r * g[j].x, v[j].y * r * g[j].y); w.y = pk2(v[j].z * r * g[j].z, v[j].w * r * g[j].w); o8[64 * j] = w; }
    }
}
__device__ __forceinline__ void norm_rows_f32_inplace(float* x, const float* gain, int nrows, int gw, int NGW, int lane) {
    f32x4 g[4];
#pragma unroll
    for (int j = 0; j < 4; ++j) g[j] = *((const f32x4*)gain + lane + 64 * j);
    for (int m = gw; m < nrows; m += NGW) {
        GAS f32x4* xr = (GAS f32x4*)(x + (size_t)m * D) + lane;
        f32x4 v[4]; float s = 0.f;
#pragma unroll
        for (int j = 0; j < 4; ++j) { v[j] = xr[64 * j]; s += (v[j].x * v[j].x + v[j].y * v[j].y) + (v[j].z * v[j].z + v[j].w * v[j].w); }
        const float r = 1.0f / sqrtf(wave_sum(s) * (1.f / D) + RMS_EPS);
#pragma unroll
        for (int j = 0; j < 4; ++j) xr[64 * j] = v[j] * r * g[j];
    }
}

constexpr int PT = 32, PROWS = 48;
typedef float f32x2v __attribute__((ext_vector_type(2)));
__device__ __forceinline__ f32x2v bfpair(unsigned u) { return (f32x2v){__builtin_bit_cast(float, u << 16), __builtin_bit_cast(float, u & 0xffff0000u)}; }
template <int W> __device__ __forceinline__ void pool_rows_interior(const LAS unsigned* hcol, GAS unsigned* po) {
    constexpr int HW = W / 2; constexpr float INV = 1.0f / (float)W;
    f32x2v s = {0.f, 0.f};
#pragma unroll
    for (int o = -HW; o < HW; ++o) s += bfpair(hcol[(8 + o) * 512]);
#pragma unroll
    for (int tt = 0; tt < PT; ++tt) {
        const f32x2v c = bfpair(hcol[(8 + tt) * 512]);
        const f32x2v p = s * INV - c;
        po[(size_t)tt * 128] = pk2(p.x, p.y);
        if (tt + 1 < PT) s += bfpair(hcol[(8 + tt + HW) * 512]) - bfpair(hcol[(8 + tt - HW) * 512]);
    }
}
__device__ __forceinline__ void pool_load_rows(f32x4 (&v)[6][4], const float* x, int m0, int seq_len, int wave, int lane) {
    const int sb = m0 / seq_len * seq_len, t0 = m0 - sb;
#pragma unroll
    for (int k = 0; k < 6; ++k) { const int t = min(max(t0 - 8 + wave + NWAVES * k, 0), seq_len - 1);
        const GAS f32x4* xr = (const GAS f32x4*)(x + (size_t)(sb + t) * D) + lane;
#pragma unroll
        for (int j = 0; j < 4; ++j) v[k][j] = xr[64 * j]; }
}
__device__ __forceinline__ void pool_phase(LAS unsigned char* lds, const float* x, const float* gain, bf16* Pg, int seq_len, int vcu, int G, int tid, int wave, int lane) {
    f32x4 g[4];
#pragma unroll
    for (int j = 0; j < 4; ++j) g[j] = *((const f32x4*)gain + lane + 64 * j);
    const int grp = wave >> 1, w = 2 << grp, hw = w >> 1;
    f32x4 v[6][4];
    if (vcu < CH / PT) pool_load_rows(v, x, vcu * PT, seq_len, wave, lane);
    for (int tile = vcu; tile < CH / PT; tile += G) {
        const int m0 = tile * PT;
        const int sb = m0 / seq_len * seq_len;
        const int t0 = m0 - sb;
#pragma unroll
        for (int k = 0; k < 6; ++k) { float s = 0.f;
#pragma unroll
            for (int j = 0; j < 4; ++j) s += (v[k][j].x * v[k][j].x + v[k][j].y * v[k][j].y) + (v[k][j].z * v[k][j].z + v[k][j].w * v[k][j].w);
            const float r = 1.0f / sqrtf(wave_sum(s) * (1.f / D) + RMS_EPS);
            LAS v2u* hr = (LAS v2u*)(lds + (wave + NWAVES * k) * 2048) + lane;
#pragma unroll
            for (int j = 0; j < 4; ++j) { v2u o; o.x = pk2(v[k][j].x * r * g[j].x, v[k][j].y * r * g[j].y); o.y = pk2(v[k][j].z * r * g[j].z, v[k][j].w * r * g[j].w); hr[64 * j] = o; } }
        __syncthreads();
        if (tile + G < CH / PT) { pool_load_rows(v, x, (tile + G) * PT, seq_len, wave, lane); __builtin_amdgcn_sched_barrier(0); }
        const LAS unsigned* hcol = (const LAS unsigned*)lds + tid;
        GAS unsigned* po = (GAS unsigned*)(Pg + (size_t)grp * CH * 256 + (size_t)m0 * 256) + (tid & 127);
        if (t0 >= 8 && t0 + PT + 8 <= seq_len) {
            switch (grp) { case 0: pool_rows_interior<2>(hcol, po); break; case 1: pool_rows_interior<4>(hcol, po); break; case 2: pool_rows_interior<8>(hcol, po); break; default: pool_rows_interior<16>(hcol, po); break; }
        } else {
        for (int tt = 0; tt < PT; ++tt) {
            const int t = t0 + tt;
            const int lo = max(t - hw, 0), hi = min(t + hw - 1, seq_len - 1);
            float s0 = 0.f, s1 = 0.f;
            for (int q = lo; q <= hi; ++q) { const unsigned u = hcol[(q - t0 + 8) * 512]; s0 += __builtin_bit_cast(float, u << 16); s1 += __builtin_bit_cast(float, u & 0xffff0000u); }
            const unsigned uc = hcol[(tt + 8) * 512];
            const float inv = 1.0f / (float)(hi - lo + 1);
            po[(size_t)tt * 128] = pk2(s0 * inv - __builtin_bit_cast(float, uc << 16), s1 * inv - __builtin_bit_cast(float, uc & 0xffff0000u));
        }
        }
        __syncthreads();
    }
}

#define RLX_AGENT __ATOMIC_RELAXED, __HIP_MEMORY_SCOPE_AGENT
#define XB_TMO      128
#define XB_XCNT(j)  (256  + 64 * (j))
#define XB_XSUB(j)  (1280 + 64 * (j))
#define XB_XGEN(j)  (2304 + 64 * (j))
#define XB_TOP      3328
#define XB_TOPGEN   3392
#define XCD_BAR_WORDS 3456
#define XB_SPIN_CAP (1u << 18)

__device__ __forceinline__ unsigned xb_ld(unsigned* p)              { return __hip_atomic_load(p, __ATOMIC_RELAXED, __HIP_MEMORY_SCOPE_AGENT); }
__device__ __forceinline__ unsigned xb_add(unsigned* p, unsigned v) { return __hip_atomic_fetch_add(p, v, __ATOMIC_RELAXED, __HIP_MEMORY_SCOPE_AGENT); }
__device__ __forceinline__ unsigned xb_xcc_id() { return (unsigned)__builtin_amdgcn_s_getreg((3 << 11) | 20) & 0xFu; }
#define XB_SPIN(cond, bar) do { unsigned _sp = 0; while (cond) { __builtin_amdgcn_s_sleep(1); \
    if ((++_sp & 255u) == 0u) { if (xb_ld(&(bar)[XB_TMO])) break; if (_sp > XB_SPIN_CAP) { atomicAdd(&(bar)[XB_TMO], 1u); break; } } } } while (0)

struct XcdBarrier {
    unsigned* bar; unsigned x;
    volatile LAS unsigned* st;
};

__device__ __forceinline__ XcdBarrier xcd_barrier_post(unsigned* bar, volatile LAS unsigned* st) {
    XcdBarrier b; b.bar = bar; b.x = xb_xcc_id(); b.st = st;
    if (threadIdx.x == 0) (void)xb_add(&bar[XB_XCNT(b.x)], 1u);
    return b;
}
__device__ __forceinline__ void xcd_barrier_complete(unsigned* bar, unsigned x, unsigned& nloc, unsigned& nx) {
    const unsigned G = gridDim.x * gridDim.y * gridDim.z;
    unsigned sum, cnt, mine, sp = 0u;
    for (;;) {
        sum = 0u; cnt = 0u; mine = 0u;
#pragma unroll
        for (unsigned j = 0; j < 16; ++j) { const unsigned c = xb_ld(&bar[XB_XCNT(j)]); sum += c; cnt += (c > 0u) ? 1u : 0u; mine = (j == x) ? c : mine; }
        if (sum == G) break;
        __builtin_amdgcn_s_sleep(1);
        if ((++sp & 255u) == 0u) { if (xb_ld(&bar[XB_TMO])) break; if (sp > XB_SPIN_CAP) { atomicAdd(&bar[XB_TMO], 1u); break; } }
    }
    nloc = mine > 0u ? mine : 1u; nx = cnt > 0u ? cnt : 1u;
}

__device__ __forceinline__ void xcd_barrier(const XcdBarrier& b) {
    asm volatile("s_waitcnt vmcnt(0)" ::: "memory");
    __syncthreads();
    if (threadIdx.x == 0) {
        unsigned* bar = b.bar;
        __builtin_amdgcn_s_waitcnt(0);
        unsigned nloc = b.st[0], nx = b.st[1];
        if (nloc == 0u) { xcd_barrier_complete(bar, b.x, nloc, nx); b.st[0] = nloc; b.st[1] = nx; }
        const unsigned old = xb_add(&bar[XB_XSUB(b.x)], 1u);
        const unsigned gen = old / nloc;
        if (old + 1u == (gen + 1u) * nloc) {
            __builtin_amdgcn_fence(__ATOMIC_RELEASE, "agent");
            asm volatile("s_waitcnt vmcnt(0)" ::: "memory");
            const unsigned og = xb_add(&bar[XB_TOP], 1u);
            const unsigned tg = og / nx;
            if (og + 1u == (tg + 1u) * nx) xb_add(&bar[XB_TOPGEN], 1u);
            else XB_SPIN(xb_ld(&bar[XB_TOPGEN]) == tg, bar);
            __builtin_amdgcn_fence(__ATOMIC_ACQUIRE, "agent");
            xb_add(&bar[XB_XGEN(b.x)], 1u);
            asm volatile("s_waitcnt vmcnt(0)" ::: "memory");
        } else {
            XB_SPIN(xb_ld(&bar[XB_XGEN(b.x)]) == gen, bar);
            __builtin_amdgcn_fence(__ATOMIC_ACQUIRE, "agent");
            asm volatile("s_waitcnt vmcnt(0)" ::: "memory");
        }
    }
    __syncthreads();
}


__device__ __forceinline__ unsigned cvtpk(float lo, float hi) { return pk2(lo, hi); }
__device__ __forceinline__ s16x4 vtr(const LAS unsigned char* p) { return __builtin_bit_cast(s16x4, __builtin_amdgcn_ds_read_tr16_b64_v4i16((LAS s16x4*)p)); }
__device__ __forceinline__ void attn_phase(LAS unsigned char* lds, bf16* Qb, const bf16* Kb, const bf16* Vb, const float* rpb_l, int seq_len, int G, int bx, int tid, int wave, int lane) {
    const int fr = lane & 15, fq = lane >> 4;
    const int rows = seq_len >> 6, rows_shift = (seq_len == 2048) ? 5 : 6;
    constexpr int NI = (CH / 64) * 8;
    int nx, xc, lc, per;
    if ((G & 7) == 0) { nx = G >> 3; xc = bx & 7; lc = bx >> 3; per = NI >> 3; } else { nx = G; xc = 0; lc = bx; per = NI; }
    LAS float* bias = (LAS float*)(lds + BIAS_OFF);
    const int qb = wave & 3, hh = wave >> 2;
    const int qc = (qb < 3) ? (8 + 16 * qb + fr) : (fr < 8 ? fr : 48 + fr);
    const int a0 = (qb < 3) ? qb : 0, a1 = (qb < 3) ? qb + 1 : 3;
    const int wst = min(max(qc - 8, 0), 48);
    const int q4 = (lane & 15) >> 2, p4 = lane & 3;
    float madd[2][4];
#pragma unroll
    for (int ai = 0; ai < 2; ++ai)
#pragma unroll
        for (int i = 0; i < 4; ++i) { const int kc = 16 * (ai ? a1 : a0) + 4 * fq + i; madd[ai][i] = ((kc >= wst) && (kc < wst + 16)) ? 0.f : -1.0e30f; }
    int voff[4];
#pragma unroll
    for (int i3 = 0; i3 < 4; ++i3) voff[i3] = (lane >> 4) * D + (((lane & 15) ^ (((lane >> 4) << 2) | i3)) * 8);
    if (lc >= per) return;
    int id = xc * per + lc;
    int r = id & (rows - 1), hp = (id >> rows_shift) & 7, tb = (id >> (rows_shift + 3)) * seq_len, r0 = min(max(r - 4, 0), rows - 8);
    bf16x8 qf0, qf1, kf[4][2][2];
    float bnext[2];
#define ATT_PREFETCH() do { \
        const int h_ = 2 * hp + hh; const size_t qo_ = (size_t)(tb + r * 64 + qc) * D + h_ * 64; \
        qf0 = *(const GAS bf16x8*)(Qb + qo_ + 8 * fq); qf1 = *(const GAS bf16x8*)(Qb + qo_ + 32 + 8 * fq); \
        const bf16* kb_ = Kb + ((size_t)(h_ * 8 + fq) * CH + (tb + r0 * 64 + fr)) * 8; \
        _Pragma("unroll") for (int kr = 0; kr < 4; ++kr) _Pragma("unroll") for (int ai = 0; ai < 2; ++ai) { const bf16* kp = kb_ + (kr * 64 + 16 * (ai ? a1 : a0)) * 8; kf[kr][ai][0] = *(const GAS bf16x8*)kp; kf[kr][ai][1] = *(const GAS bf16x8*)(kp + (size_t)4 * CH * 8); } \
        bnext[0] = rpb_l[hp * 930 + tid] * LOG2E; bnext[1] = (tid + 512 < 930) ? rpb_l[hp * 930 + tid + 512] * LOG2E : 0.f; } while (0)
#define ATT_BIAS_WRITE() do { bias[tid] = bnext[0]; if (tid + 512 < 930) bias[tid + 512] = bnext[1]; } while (0)
    ATT_PREFETCH();
    ATT_BIAS_WRITE();
    for (int loc = lc; loc < per; loc += nx) {
        const int h = 2 * hp + hh;
        const size_t qoff = (size_t)(tb + r * 64 + qc) * D + h * 64;
        const bf16* kbase = Kb + ((size_t)(h * 8 + fq) * CH + (tb + r0 * 64 + fr)) * 8;
        const int drb = r0 - r + 7;
        __syncthreads();
        {
            const int a = wave >> 1, ub = (wave & 1) * 2;
#pragma unroll
            for (int i = 0; i < 16; ++i) { const int kr = 2 * (ub + (i >> 3)) + (i & 1), cb = 16 * a + 4 * ((i & 7) >> 1);
                const bf16* src = Vb + (size_t)(tb + (r0 + kr) * 64 + cb) * D + hp * 128 + voff[i & 3];
                __builtin_amdgcn_global_load_lds((const unsigned*)src, (LAS unsigned*)(lds + (wave * 16 + i) * 1024), 16, 0, 0); }
        }
        f32x4 S[8][2];
        float mx = -3.0e38f;
        const LAS float* bptr[2][4];
#pragma unroll
        for (int ai = 0; ai < 2; ++ai)
#pragma unroll
            for (int i = 0; i < 4; ++i) { const int kc = 16 * (ai ? a1 : a0) + 4 * fq + i; bptr[ai][i] = bias + hh * 465 + drb * 31 + min(max(kc - qc + 15, 0), 30); }
#pragma unroll
        for (int kr = 0; kr < 8; ++kr) {
#pragma unroll
            for (int ai = 0; ai < 2; ++ai) {
                f32x4 z = {0.f, 0.f, 0.f, 0.f};
                z = __builtin_amdgcn_mfma_f32_16x16x32_bf16(kf[kr & 3][ai][0], qf0, z, 0, 0, 0);
                z = __builtin_amdgcn_mfma_f32_16x16x32_bf16(kf[kr & 3][ai][1], qf1, z, 0, 0, 0);
#pragma unroll
                for (int i = 0; i < 4; ++i) { z[i] = (z[i] + bptr[ai][i][kr * 31]) + madd[ai][i]; mx = fmaxf(mx, z[i]); }
                S[kr][ai] = z;
            }
            if (kr < 4) {
#pragma unroll
                for (int ai = 0; ai < 2; ++ai) { const bf16* kp = kbase + ((kr + 4) * 64 + 16 * (ai ? a1 : a0)) * 8; kf[kr & 3][ai][0] = *(const GAS bf16x8*)kp; kf[kr & 3][ai][1] = *(const GAS bf16x8*)(kp + (size_t)4 * CH * 8); }
            }
            __builtin_amdgcn_sched_barrier(0);
        }
        mx = fmaxf(mx, __shfl_xor(mx, 16)); mx = fmaxf(mx, __shfl_xor(mx, 32));
        float sum = 0.f;
#pragma unroll
        for (int kr = 0; kr < 8; ++kr)
#pragma unroll
            for (int ai = 0; ai < 2; ++ai)
#pragma unroll
                for (int i = 0; i < 4; ++i) { const float p = __builtin_amdgcn_exp2f(S[kr][ai][i] - mx); S[kr][ai][i] = p; sum += p; }
        sum += __shfl_xor(sum, 16); sum += __shfl_xor(sum, 32);
        bf16x8 pf[4][2];
#pragma unroll
        for (int u = 0; u < 4; ++u)
#pragma unroll
            for (int ai = 0; ai < 2; ++ai) { v4u pw; pw.x = cvtpk(S[2 * u][ai][0], S[2 * u][ai][1]); pw.y = cvtpk(S[2 * u][ai][2], S[2 * u][ai][3]); pw.z = cvtpk(S[2 * u + 1][ai][0], S[2 * u + 1][ai][1]); pw.w = cvtpk(S[2 * u + 1][ai][2], S[2 * u + 1][ai][3]);
                pf[u][ai] = __builtin_bit_cast(bf16x8, pw); }
        asm volatile("s_waitcnt vmcnt(0)" ::: "memory");
        __syncthreads();
        const int nloc = loc + nx; const bool has_next = nloc < per;
        const int r_cur = r, tb_cur = tb;
        if (has_next) { id = xc * per + nloc; r = id & (rows - 1); hp = (id >> rows_shift) & 7; tb = (id >> (rows_shift + 3)) * seq_len; r0 = min(max(r - 4, 0), rows - 8); ATT_PREFETCH(); }
        (void)r_cur; (void)tb_cur;
        f32x4 O[4];
#pragma unroll
        for (int c = 0; c < 4; ++c) O[c] = (f32x4){0.f, 0.f, 0.f, 0.f};
        const LAS unsigned char* vb[2][2][4];
#pragma unroll
        for (int ai = 0; ai < 2; ++ai)
#pragma unroll
            for (int t = 0; t < 2; ++t)
#pragma unroll
                for (int c = 0; c < 4; ++c) { const int rho = 8 * fq + 4 * t + q4, chn = 2 * (4 * hh + c) + (p4 >> 1);
                    vb[ai][t][c] = lds + (ai ? a1 : a0) * 32768 + 256 * rho + 16 * (chn ^ (((rho & 3) << 2) | ((rho >> 2) & 3))) + 8 * (p4 & 1); }
#pragma unroll
        for (int u = 0; u < 4; ++u) {
#pragma unroll
            for (int ai = 0; ai < 2; ++ai) {
#pragma unroll
                for (int c = 0; c < 4; ++c) {
                    const s16x4 v0 = vtr(vb[ai][0][c] + u * 8192), v1 = vtr(vb[ai][1][c] + u * 8192);
                    const bf16x8 vf = __builtin_shufflevector(v0, v1, 0, 1, 2, 3, 4, 5, 6, 7);
                    O[c] = __builtin_amdgcn_mfma_f32_16x16x32_bf16(vf, pf[u][ai], O[c], 0, 0, 0);
                }
            }
            __builtin_amdgcn_sched_barrier(0);
        }
        const float inv = 1.0f / sum;
#pragma unroll
        for (int c = 0; c < 4; ++c) { v2u w; w.x = cvtpk(O[c][0] * inv, O[c][1] * inv); w.y = cvtpk(O[c][2] * inv, O[c][3] * inv);
            *(GAS v2u*)(Qb + qoff + 16 * c + 4 * fq) = w; }
        if (has_next) ATT_BIAS_WRITE();
    }
    __syncthreads();
#undef ATT_PREFETCH
#undef ATT_BIAS_WRITE
}
enum { K_POOL = 1, K_GEMM_RES = 3, K_GEMM_QKV = 4, K_GEMM_UP = 5, K_ATTN = 6, K_FINAL = 7 };
enum { F_A_X = 1, F_A_IN = 2, F_AUX_X = 4, F_AUX_IN = 8 };
struct Ph { int kind, flags, N, K; const void* A; const void* B; void* C; const void* aux; float* st; float* stz; unsigned long long a_pn_stride, pad; };
constexpr int PPC = 19;
struct Args { Ptrs p; Ph tab[PPC]; };
__global__ void __launch_bounds__(NWAVES * 64, 2) fwd_megakernel(Args args) {
    extern __shared__ __attribute__((aligned(16))) unsigned char lds_raw[];
    cg::grid_group grid = cg::this_grid();
    LAS unsigned char* lds = (LAS unsigned char*)lds_raw;
    volatile LAS unsigned* MISC = (volatile LAS unsigned*)(lds + MISC_OFF);
    for (int u = threadIdx.x; u < 32; u += NWAVES * 64) MISC[u] = 0u;
    __syncthreads();
    const XcdBarrier bar = xcd_barrier_post((unsigned*)(args.p.ws + WS_CTL), MISC + 8);
    {
        const int tid = threadIdx.x, lane = tid & 63, wave = __builtin_amdgcn_readfirstlane(tid >> 6);
        const int G = gridDim.x, bx = blockIdx.x;
        const int vcu = (G % 8 == 0) ? (bx % 8) * (G / 8) + bx / 8 : bx;
        prologue(args.p, lds, vcu * NWAVES + wave, G * NWAVES, wave, lane);
    }
    grid.sync();

    int repflag = 0; (void)repflag;
    for (int ph = 0; ph < NCHUNK * PPC; ++ph) {
        int tid = threadIdx.x; asm volatile("" : "+v"(tid));
        int G = gridDim.x, bx = blockIdx.x; asm volatile("" : "+s"(G), "+s"(bx));
        const int lane = tid & 63, wave = __builtin_amdgcn_readfirstlane(tid >> 6);
        const int vcu = (G % 8 == 0) ? (bx % 8) * (G / 8) + bx / 8 : bx;
        const int gw = vcu * NWAVES + wave, NGW = G * NWAVES;
        const int ck = ph / PPC, idx = ph - ck * PPC;
        const Ph d = args.tab[idx];
        const int tok0 = ck * CH, grp = tok0 / GROUP_TOK, seq_len = grp ? 4096 : 2048;
        const float* xin = args.p.x_in[grp] + (size_t)(tok0 - grp * GROUP_TOK) * D;
        float* X = args.p.out + (size_t)tok0 * D;
        const void* A = (d.flags & F_A_X) ? (const void*)X : (d.flags & F_A_IN) ? (const void*)xin : d.A;
        const void* aux = (d.flags & F_AUX_X) ? (const void*)X : (d.flags & F_AUX_IN) ? (const void*)xin : d.aux;
        if (d.stz) for (int i = vcu * (NWAVES * 64) + tid; i < CH; i += G * NWAVES * 64) d.stz[i] = 0.f;
        switch (d.kind) {
        case K_POOL: pool_phase(lds, (const float*)A, (const float*)aux, (bf16*)d.C, seq_len, vcu, G, tid, wave, lane); break;
        case K_GEMM_RES: { pg8::Gemm g{(const bf16*)A, (const bf16*)d.B, CH, d.N, d.K, (size_t)d.a_pn_stride}; pg8::StaticOrder S; S.init(CH, d.N, G, bx);
            pg8::EpiRes E{(const float*)aux, X, (bf16*)d.C, d.st, D};
            pg8::gemm_phase<pg8::EpiRes, pg8::StaticOrder, PG8_ALIGN, PG8_SP2>(lds, g, S, E, tid); } break;
        case K_GEMM_QKV: { pg8::Gemm g{(const bf16*)A, (const bf16*)d.B, CH, d.N, d.K, 0}; pg8::StaticOrder S; S.init(CH, d.N, G, bx);
            pg8::EpiBf16<0, true> E{(bf16*)d.C, D, D, (size_t)CH * D, 0.125f * LOG2E, d.st};
            pg8::gemm_phase<pg8::EpiBf16<0, true>, pg8::StaticOrder, PG8_ALIGN, PG8_SP2>(lds, g, S, E, tid); } break;
        case K_GEMM_UP: { pg8::Gemm g{(const bf16*)A, (const bf16*)d.B, CH, d.N, d.K, 0}; pg8::StaticOrder S; S.init(CH, d.N, G, bx);
            pg8::EpiBf16<2, true> E{(bf16*)d.C, FF, 0, 0, 1.f, d.st};
            pg8::gemm_phase<pg8::EpiBf16<2, true>, pg8::StaticOrder, PG8_ALIGN, PG8_SP2>(lds, g, S, E, tid); } break;
        case K_ATTN: attn_phase(lds, (bf16*)d.C, (const bf16*)d.C + (size_t)CH * D, (const bf16*)d.C + 2 * (size_t)CH * D, (const float*)aux, seq_len, G, bx, tid, wave, lane); break;
        default: norm_rows_f32_inplace(X, (const float*)aux, CH, gw, NGW, lane); break;
        }
        if (d.kind != K_FINAL) xcd_barrier(bar);
#if defined(MK_REP)
        if (d.kind == MK_REP && !repflag) { repflag = 1; ph -= (MK_REP == K_ATTN) ? 2 : 1; } else if (d.kind == MK_REP) repflag = 0;
#endif
    }
}

extern "C" void kernel_launch(void* const* d_in, const int* in_sizes, int n_in, void* d_out, int out_size, void* d_ws, size_t ws_size, hipStream_t stream) {
    static int grid = 0;
    if (grid == 0) {
        if (n_in != 12 || in_sizes[0] != GROUP_TOK * D || in_sizes[1] != GROUP_TOK * D || out_size != NTOK * D || ws_size < WS_END) {
            fprintf(stderr, "kernel_launch: unexpected shapes (n_in %d, out %d, ws %zu < %zu); nothing launched\n", n_in, out_size, ws_size, (size_t)WS_END); grid = -1; return; }
        int dev = 0, cus = 0, per_cu = 0;
        if (hipGetDevice(&dev) != hipSuccess || hipDeviceGetAttribute(&cus, hipDeviceAttributeMultiprocessorCount, dev) != hipSuccess) { fprintf(stderr, "kernel_launch: device query failed\n"); grid = -1; return; }
        if (hipFuncSetAttribute((const void*)fwd_megakernel, hipFuncAttributeMaxDynamicSharedMemorySize, LDS_BYTES) != hipSuccess) { fprintf(stderr, "kernel_launch: hipFuncSetAttribute failed\n"); grid = -1; return; }
        if (hipOccupancyMaxActiveBlocksPerMultiprocessor(&per_cu, (const void*)fwd_megakernel, NWAVES * 64, LDS_BYTES) != hipSuccess || per_cu < 1) { fprintf(stderr, "kernel_launch: occupancy query gave %d\n", per_cu); per_cu = 1; }
        (void)hipGetLastError();
        grid = cus * per_cu;
    }
    if (grid < 0) return;
    if (hipMemsetAsync((char*)d_ws + WS_CTL, 0, CTL_ZERO_BYTES, stream) != hipSuccess) { fprintf(stderr, "kernel_launch: hipMemsetAsync failed\n"); return; }
    Args a{};
    Ptrs& p = a.p;
    p.x_in[0] = (const float*)d_in[0]; p.x_in[1] = (const float*)d_in[1]; p.norm_mix = (const float*)d_in[2]; p.pool_w = (const float*)d_in[3]; p.pool_scale = (const float*)d_in[4];
    p.w_qkv = (const float*)d_in[5]; p.rpb = (const float*)d_in[6]; p.w_o = (const float*)d_in[7]; p.norm_mlp = (const float*)d_in[8]; p.w_up = (const float*)d_in[9];
    p.w_down = (const float*)d_in[10]; p.norm_final = (const float*)d_in[11]; p.out = (float*)d_out; p.ws = (unsigned char*)d_ws;
    unsigned char* ws = (unsigned char*)d_ws;
    bf16* WPOOL = (bf16*)(ws + WS_WPOOL); bf16* WQKV = (bf16*)(ws + WS_WQKV); bf16* WO = (bf16*)(ws + WS_WO); bf16* WUP = (bf16*)(ws + WS_WUP); bf16* WDN = (bf16*)(ws + WS_WDN);
    bf16* XN = (bf16*)(ws + WS_XN); bf16* PG = (bf16*)(ws + WS_PG); bf16* QB = (bf16*)(ws + WS_ACT); bf16* HB = (bf16*)(ws + WS_ACT);
    float* SA = (float*)(ws + WS_STAT); float* SB = SA + (size_t)CH * 16;
    int n = 0;
    auto add = [&](int kind, int flags, int N, int K, const void* A, const void* B, void* C, const void* aux, float* st, float* stz, unsigned long long aps) {
        Ph& d = a.tab[n++]; d.kind = kind; d.flags = flags; d.N = N; d.K = K; d.A = A; d.B = B; d.C = C; d.aux = aux; d.st = st; d.stz = stz; d.a_pn_stride = aps; d.pad = 0; };
    for (int layer = 0; layer < DEPTH; ++layer) {
        const int j = layer >> 1;
        if ((layer & 1) == 0) {
            add(K_POOL, layer == 0 ? F_A_IN : F_A_X, 0, 0, nullptr, nullptr, PG, p.norm_mix + layer * D, nullptr, nullptr, 0);
            add(K_GEMM_RES, layer == 0 ? F_AUX_IN : F_AUX_X, D, 256, PG, WPOOL + (size_t)j * 1024 * 256, XN, nullptr, SA, nullptr, (unsigned long long)CH * 256 * 2);
        } else {
            add(K_GEMM_QKV, 0, 3 * D, D, XN, WQKV + (size_t)j * 3 * D * D, QB, nullptr, SB, nullptr, 0);
            add(K_ATTN, 0, 0, 0, nullptr, nullptr, QB, p.rpb + (size_t)j * NH * 15 * 31, nullptr, nullptr, 0);
            add(K_GEMM_RES, F_AUX_X, D, D, QB, WO + (size_t)j * D * D, XN, nullptr, SA, nullptr, 0);
        }
        add(K_GEMM_UP, 0, FF, D, XN, WUP + (size_t)layer * D * FF, HB, nullptr, SA, nullptr, 0);
        add(K_GEMM_RES, F_AUX_X, D, FF, HB, WDN + (size_t)layer * D * FF, (layer & 1) == 0 ? XN : nullptr, nullptr, SB, nullptr, 0);
    }
    add(K_FINAL, 0, 0, 0, nullptr, nullptr, nullptr, p.norm_final, nullptr, nullptr, 0);
    if (n != PPC) { fprintf(stderr, "kernel_launch: phase table has %d entries, expected %d\n", n, PPC); return; }
    void* kargs[] = {&a};
    hipError_t e = hipLaunchCooperativeKernel((const void*)fwd_megakernel, dim3(grid), dim3(NWAVES * 64), kargs, LDS_BYTES, stream);
    if (e != hipSuccess) fprintf(stderr, "kernel_launch: cooperative launch failed: %s (grid %d)\n", hipGetErrorString(e), grid);
}
```

```cpp
#include <hip/hip_runtime.h>
#include <hip/hip_cooperative_groups.h>
#include <cstdio>
#include <cstdint>
namespace cg = cooperative_groups;
namespace pg8 {
#define PG8_LAS __attribute__((address_space(3)))
typedef unsigned short bf16_t;
typedef short bf16x8 __attribute__((ext_vector_type(8)));
typedef float f32x4 __attribute__((ext_vector_type(4)));
typedef unsigned u32x4 __attribute__((ext_vector_type(4)));
constexpr int BM = 256, BK = 64, HALF = 128, HTB = HALF * BK * 2  , STAGE_BYTES = 8 * HTB, NXCD = 8, WGM = 8;

__host__ __device__ __forceinline__ int lds_byte(int r, int c) { const int st = (r >> 4) * 2 + (c >> 5), rr = r & 15, cc = c & 31, ob = rr * 64 + cc * 2; return st * 1024 + (ob ^ (((ob >> 9) & 1) << 5)); }
__host__ __device__ __forceinline__ void stage_rc(int b, int& R, int& C) { const int st = b / 1024, sb = b % 1024, swz = sb ^ (((sb >> 9) & 1) << 5); R = (st >> 1) * 16 + swz / 64; C = (st & 1) * 32 + (swz % 64) / 2; }
__host__ __device__ __forceinline__ int perm32(int rho) { const int n = rho >> 4, i = rho & 15; return 8 * (i >> 2) + 4 * n + (i & 3); }

struct Unit { int pm, pn; };
struct Gemm { const bf16_t* A; const bf16_t* Bt; int M, N, K; size_t a_pn_stride; };

struct StaticOrder {
    int nM, nN, nwg, G, c;
    __host__ __device__ void init(int M, int N, int G_, int c_) { nM = M / BM; nN = N / BM; nwg = nM * nN; G = G_; c = c_; }
    __host__ __device__ bool next(int i, Unit& u) const {
        const long L = (long)i * G + c; if (L >= nwg) return false;
        int wgid = (int)L; { const int q = nwg / NXCD, r = nwg % NXCD, xcd = wgid % NXCD, off = wgid / NXCD; wgid = (xcd < r ? xcd * (q + 1) : r * (q + 1) + (xcd - r) * q) + off; }
        const int nig = WGM * nN, gid = wgid / nig, fm = gid * WGM, gsz = (nM - fm) < WGM ? (nM - fm) : WGM;
        u.pm = fm + ((wgid % nig) % gsz); u.pn = (wgid % nig) / gsz; return true;
    }
    __device__ __forceinline__ void a_ready(const Unit&) const {}
    __device__ __forceinline__ void done(const Unit&) const {}
};

__device__ __forceinline__ unsigned cvt_pk_bf16(float lo, float hi) { unsigned r; asm volatile("v_cvt_pk_bf16_f32 %0, %1, %2" : "=v"(r) : "v"(lo), "v"(hi)); return r; }
typedef float f32x2 __attribute__((ext_vector_type(2)));
template <int ACT, bool RS> struct EpiBf16 {
    static constexpr bool PERM = true, AFTER_DRAIN = false;
    bf16_t* O; int ldc; int split_cols; size_t split_stride; float scale0; const float* st;
    __device__ __forceinline__ void operator()(const f32x4 (&acc)[2][2][4][2], const Unit& u, int wr, int wc, int fr, int fq) const {
        const int row0 = u.pm * BM + wr * 64 + fr; int colt = u.pn * BM; bf16_t* base = O;
        float sc = 1.f; bool kplane = false;
        if (split_cols) { const int t = colt / split_cols; base += (size_t)t * split_stride; colt -= t * split_cols; if (t == 0) sc = scale0; kplane = (t == 1); }
        const size_t kprows = split_stride / 1024;
        const int col0 = colt + wc * 32 + 8 * fq;
        f32x4 pv[2][4];
        if (RS) {
#pragma unroll
            for (int ai = 0; ai < 2; ++ai)
#pragma unroll
                for (int m = 0; m < 4; ++m) pv[ai][m] = *(const f32x4*)(st + (size_t)(row0 + ai * HALF + m * 16) * 16 + 4 * fq);
            __builtin_amdgcn_sched_barrier(0);
        }
#pragma unroll
        for (int ai = 0; ai < 2; ++ai)
#pragma unroll
            for (int m = 0; m < 4; ++m) { const int row = row0 + ai * HALF + m * 16; bf16_t* rowp = base + (size_t)row * ldc + col0;
                float f = sc;
                if (RS) { float ss = (pv[ai][m][0] + pv[ai][m][1]) + (pv[ai][m][2] + pv[ai][m][3]); ss += __shfl_xor(ss, 16); ss += __shfl_xor(ss, 32);
                    const float r = __builtin_amdgcn_rsqf(ss * (1.0f / 1024.0f) + 1e-6f); f *= (ACT == 2) ? r * r : r; }
#pragma unroll
                for (int bj = 0; bj < 2; ++bj) { f32x4 v0 = acc[ai][bj][m][0], v1 = acc[ai][bj][m][1];
                    if (ACT == 2) {
#pragma unroll
                        for (int e = 0; e < 4; ++e) { const float a = fmaxf(v0[e], 0.f), b = fmaxf(v1[e], 0.f); v0[e] = a * a; v1[e] = b * b; } }
                    v0 = v0 * f; v1 = v1 * f; u32x4 w; w.x = cvt_pk_bf16(v0[0], v0[1]); w.y = cvt_pk_bf16(v0[2], v0[3]); w.z = cvt_pk_bf16(v1[0], v1[1]); w.w = cvt_pk_bf16(v1[2], v1[3]);
                    if (kplane) *(u32x4*)(base + ((size_t)(((colt >> 6) + 2 * bj + (wc >> 1)) * 8 + (wc & 1) * 4 + fq) * kprows + row) * 8) = w;
                    else *(u32x4*)(rowp + bj * HALF) = w; } }
    }
};
struct EpiRes {
    static constexpr bool PERM = true, AFTER_DRAIN = false;
    const float* base; float* out; bf16_t* xn; float* st; int ldc;
    __device__ __forceinline__ void operator()(const f32x4 (&acc)[2][2][4][2], const Unit& u, int wr, int wc, int fr, int fq) const {
        const int col0 = u.pn * BM + wc * 32 + 8 * fq;
#pragma unroll
        for (int ai = 0; ai < 2; ++ai) {
            f32x4 bs[4][2][2];
#pragma unroll
            for (int m = 0; m < 4; ++m) { const size_t off = (size_t)(u.pm * BM + ai * HALF + wr * 64 + m * 16 + fr) * ldc + col0;
#pragma unroll
                for (int bj = 0; bj < 2; ++bj) { bs[m][bj][0] = *(const f32x4*)(base + off + bj * HALF); bs[m][bj][1] = *(const f32x4*)(base + off + bj * HALF + 4); } }
            __builtin_amdgcn_sched_barrier(0);
#pragma unroll
            for (int m = 0; m < 4; ++m) { const int row = u.pm * BM + ai * HALF + wr * 64 + m * 16 + fr; const size_t off = (size_t)row * ldc + col0; float ss = 0.f;
#pragma unroll
                for (int bj = 0; bj < 2; ++bj) {
                    const f32x4 o0 = bs[m][bj][0] + acc[ai][bj][m][0], o1 = bs[m][bj][1] + acc[ai][bj][m][1];
                    *(f32x4*)(out + off + bj * HALF) = o0; *(f32x4*)(out + off + bj * HALF + 4) = o1;
                    if (xn) { u32x4 w; w.x = cvt_pk_bf16(o0[0], o0[1]); w.y = cvt_pk_bf16(o0[2], o0[3]); w.z = cvt_pk_bf16(o1[0], o1[1]); w.w = cvt_pk_bf16(o1[2], o1[3]);
                        *(u32x4*)(xn + off + bj * HALF) = w;
                        ss += (o0[0] * o0[0] + o0[1] * o0[1]) + (o0[2] * o0[2] + o0[3] * o0[3]) + (o1[0] * o1[0] + o1[1] * o1[1]) + (o1[2] * o1[2] + o1[3] * o1[3]); } }
                if (xn) { ss += __shfl_xor(ss, 16); ss += __shfl_xor(ss, 32); if (fq == 0) st[(size_t)row * 16 + u.pn * 4 + wc] = ss; } }
            __builtin_amdgcn_sched_barrier(0);
        }
    }
};
template <class Epi, class Sched, bool ALIGN_EPI = false, bool SP2 = false>
__device__ __forceinline__ void gemm_phase(PG8_LAS unsigned char* lds, const Gemm g, const Sched& S, const Epi& E, const int tid_in) {
    const int tid = tid_in, wid = __builtin_amdgcn_readfirstlane(tid >> 6), lane = tid & 63, wr = wid >> 2, wc = wid & 3, fr = lane & 15, fq = lane >> 4;
    const int K = g.K, nt = K / BK;
    unsigned voffA[2], voffB[2];
#pragma unroll
    for (int i = 0; i < 2; ++i) { int R, C; stage_rc(tid * 16 + i * 8192, R, C); const int Rb = Epi::PERM ? ((R & ~31) + perm32(R & 31)) : R;
        voffA[i] = (unsigned)(R * K + C) * 2u; voffB[i] = (unsigned)(Rb * K + C) * 2u; }
    const size_t kstep = (size_t)(BK * 2);
    const size_t hstep = (size_t)HALF * K * 2;
    const size_t tstep = 2 * hstep;
    const unsigned ldsw = (unsigned)wid * 1024u;
    const int aoff = lds_byte(wr * 64 + fr, fq * 8), boff = lds_byte(wc * 32 + fr, fq * 8);
#define PG8_SA(b, h) (((b) * 2 + (h)) * HTB)
#define PG8_SB(b, h) ((4 + (b) * 2 + (h)) * HTB)
#define PG8_STAGE(bufoff, gbase, voff) do { _Pragma("unroll") for (int _i = 0; _i < 2; ++_i) \
        __builtin_amdgcn_global_load_lds((const unsigned*)((const char*)(gbase) + (voff)[_i]), (PG8_LAS unsigned*)(lds + (bufoff) + ldsw + _i * 8192), 16, 0, 0); } while (0)
#define PG8_LDA(dst, b, h) do { _Pragma("unroll") for (int m = 0; m < 4; ++m) _Pragma("unroll") for (int k = 0; k < 2; ++k) dst[m][k] = *(const PG8_LAS bf16x8*)(lds + PG8_SA(b, h) + aoff + m * 2048 + k * 1024); } while (0)
#define PG8_LDB(dst, b, h) do { _Pragma("unroll") for (int n = 0; n < 2; ++n) _Pragma("unroll") for (int k = 0; k < 2; ++k) dst[n][k] = *(const PG8_LAS bf16x8*)(lds + PG8_SB(b, h) + boff + n * 2048 + k * 1024); } while (0)
#define PG8_MMA(ai, bj, At, Bt) do { __builtin_amdgcn_s_setprio(1); _Pragma("unroll") for (int m = 0; m < 4; ++m) _Pragma("unroll") for (int n = 0; n < 2; ++n) _Pragma("unroll") for (int k = 0; k < 2; ++k) \
        acc[ai][bj][m][n] = __builtin_amdgcn_mfma_f32_16x16x32_bf16(Bt[n][k], At[m][k], acc[ai][bj][m][n], 0, 0, 0); __builtin_amdgcn_s_setprio(0); } while (0)
#define PG8_WAIT_V(n) asm volatile("s_waitcnt vmcnt(" #n ")" ::: "memory")
#define PG8_WAIT_L(n) asm volatile("s_waitcnt lgkmcnt(" #n ")" ::: "memory")
#define PG8_BAR __builtin_amdgcn_s_barrier()
#define PG8_SCHED __builtin_amdgcn_sched_barrier(0)
    Unit cur, nxt; int ui = 0;
    if (!S.next(0, cur)) return;
    f32x4 acc[2][2][4][2];
#pragma unroll
    for (int a = 0; a < 2; ++a)
#pragma unroll
        for (int b = 0; b < 2; ++b)
#pragma unroll
            for (int m = 0; m < 4; ++m)
#pragma unroll
                for (int n = 0; n < 2; ++n) acc[a][b][m][n] = (f32x4){0.f, 0.f, 0.f, 0.f};
    bf16x8 At[4][2], B0[2][2], B1[2][2];
    const char* cA = (const char*)g.A + (size_t)cur.pm * tstep + (size_t)cur.pn * g.a_pn_stride; const char* cB = (const char*)g.Bt + (size_t)cur.pn * tstep;
    S.a_ready(cur);
    if constexpr (SP2) {
        PG8_STAGE(PG8_SB(0, 0), cB, voffB); PG8_STAGE(PG8_SB(0, 1), cB + hstep, voffB); PG8_STAGE(PG8_SA(0, 0), cA, voffA); PG8_STAGE(PG8_SA(0, 1), cA + hstep, voffA);
        if (wr == 1) PG8_BAR;
        PG8_WAIT_V(2); PG8_BAR;
        PG8_STAGE(PG8_SB(1, 0), cB + kstep, voffB); PG8_STAGE(PG8_SA(1, 0), cA + kstep, voffA); PG8_STAGE(PG8_SB(1, 1), cB + hstep + kstep, voffB);
        PG8_WAIT_V(6); PG8_BAR;
    } else {
        PG8_STAGE(PG8_SB(0, 0), cB, voffB); PG8_STAGE(PG8_SA(0, 0), cA, voffA); PG8_STAGE(PG8_SB(0, 1), cB + hstep, voffB); PG8_STAGE(PG8_SA(0, 1), cA + hstep, voffA);
        if (wr == 1) PG8_BAR;
        PG8_WAIT_V(4); PG8_BAR;
        PG8_STAGE(PG8_SB(1, 0), cB + kstep, voffB); PG8_STAGE(PG8_SA(1, 0), cA + kstep, voffA); PG8_STAGE(PG8_SB(1, 1), cB + hstep + kstep, voffB);
        PG8_WAIT_V(6); PG8_BAR;
    }
    for (;;) {
        const bool has_next = S.next(ui + 1, nxt);
        const char* nA = has_next ? (const char*)g.A + (size_t)nxt.pm * tstep + (size_t)nxt.pn * g.a_pn_stride : cA; const char* nB = has_next ? (const char*)g.Bt + (size_t)nxt.pn * tstep : cB;
        for (int t = 0; t < nt; t += 2) {
            const bool last = (t == nt - 2);
            const char* a1 = cA + (size_t)(t + 1) * kstep;
            const char* a2 = last ? nA : cA + (size_t)(t + 2) * kstep; const char* b2 = last ? nB : cB + (size_t)(t + 2) * kstep;
            const char* a3 = a2 + kstep; const char* b3 = b2 + kstep;
            if (last && has_next) S.a_ready(nxt);
            if constexpr (SP2) {
            PG8_LDB(B0, 0, 0); PG8_LDB(B1, 0, 1); PG8_SCHED; PG8_LDA(At, 0, 0); PG8_STAGE(PG8_SA(1, 1), a1 + hstep, voffA);
            PG8_WAIT_V(8); PG8_WAIT_L(0); PG8_BAR; PG8_MMA(0, 0, At, B0); PG8_MMA(0, 1, At, B1); PG8_BAR; PG8_SCHED;
            PG8_LDA(At, 0, 1); PG8_STAGE(PG8_SB(0, 0), b2, voffB); PG8_STAGE(PG8_SB(0, 1), b2 + hstep, voffB); PG8_STAGE(PG8_SA(0, 0), a2, voffA);
            PG8_WAIT_V(8); PG8_WAIT_L(0); PG8_BAR; PG8_MMA(1, 0, At, B0); PG8_MMA(1, 1, At, B1); PG8_BAR; PG8_SCHED;
            PG8_LDB(B0, 1, 0); PG8_LDB(B1, 1, 1); PG8_SCHED; PG8_LDA(At, 1, 0); PG8_STAGE(PG8_SA(0, 1), a2 + hstep, voffA);
            PG8_WAIT_V(8); PG8_WAIT_L(0); PG8_BAR; PG8_MMA(0, 0, At, B0); PG8_MMA(0, 1, At, B1); PG8_BAR; PG8_SCHED;
            PG8_LDA(At, 1, 1); PG8_STAGE(PG8_SB(1, 0), b3, voffB); PG8_STAGE(PG8_SB(1, 1), b3 + hstep, voffB); PG8_STAGE(PG8_SA(1, 0), a3, voffA);
            PG8_WAIT_V(8); PG8_WAIT_L(0); PG8_BAR; PG8_MMA(1, 0, At, B0); PG8_MMA(1, 1, At, B1); PG8_BAR; PG8_SCHED;
            } else {
            PG8_LDB(B0, 0, 0); PG8_SCHED; PG8_LDA(At, 0, 0); PG8_STAGE(PG8_SA(1, 1), a1 + hstep, voffA);
            PG8_WAIT_L(8); PG8_BAR; PG8_WAIT_L(0); PG8_MMA(0, 0, At, B0); PG8_BAR; PG8_SCHED;
            PG8_LDB(B1, 0, 1); PG8_STAGE(PG8_SB(0, 0), b2, voffB);
            PG8_BAR; PG8_WAIT_L(0); PG8_MMA(0, 1, At, B1); PG8_BAR;
            PG8_LDA(At, 0, 1); PG8_STAGE(PG8_SA(0, 0), a2, voffA);
            PG8_BAR; PG8_WAIT_L(0); PG8_MMA(1, 0, At, B0); PG8_BAR; PG8_SCHED;
            PG8_STAGE(PG8_SB(0, 1), b2 + hstep, voffB);
            PG8_WAIT_V(6); PG8_BAR; PG8_MMA(1, 1, At, B1); PG8_BAR;
            PG8_LDB(B0, 1, 0); PG8_SCHED; PG8_LDA(At, 1, 0); PG8_STAGE(PG8_SA(0, 1), a2 + hstep, voffA);
            PG8_WAIT_L(8); PG8_BAR; PG8_WAIT_L(0); PG8_MMA(0, 0, At, B0); PG8_BAR; PG8_SCHED;
            PG8_LDB(B1, 1, 1); PG8_STAGE(PG8_SB(1, 0), b3, voffB);
            PG8_BAR; PG8_WAIT_L(0); PG8_MMA(0, 1, At, B1); PG8_BAR;
            PG8_LDA(At, 1, 1); PG8_STAGE(PG8_SA(1, 0), a3, voffA);
            PG8_BAR; PG8_WAIT_L(0); PG8_MMA(1, 0, At, B0); PG8_BAR; PG8_SCHED;
            PG8_STAGE(PG8_SB(1, 1), b3 + hstep, voffB);
            PG8_WAIT_V(6); PG8_BAR; PG8_MMA(1, 1, At, B1); PG8_BAR;
            }
        }
        if constexpr (ALIGN_EPI) { if (wr == 0) PG8_BAR; }
        if constexpr (!Epi::AFTER_DRAIN) { E(acc, cur, wr, wc, fr, fq); S.done(cur); }
        if (!has_next) break;
#pragma unroll
        for (int a = 0; a < 2; ++a)
#pragma unroll
            for (int b = 0; b < 2; ++b)
#pragma unroll
                for (int m = 0; m < 4; ++m)
#pragma unroll
                    for (int n = 0; n < 2; ++n) acc[a][b][m][n] = (f32x4){0.f, 0.f, 0.f, 0.f};
        cur = nxt; cA = nA; cB = nB; ++ui;
        if constexpr (ALIGN_EPI) { if (wr == 1) PG8_BAR; }
    }
    PG8_WAIT_V(0);
    if constexpr (!ALIGN_EPI) { if (wr == 0) PG8_BAR; }
    PG8_BAR;
    if constexpr (Epi::AFTER_DRAIN) { E.fused(acc, cur, wr, wc, fr, fq, lds, wid, lane); S.done(cur); }
#undef PG8_SA
#undef PG8_SB
#undef PG8_STAGE
#undef PG8_LDA
#undef PG8_LDB
#undef PG8_MMA
#undef PG8_WAIT_V
#undef PG8_WAIT_L
#undef PG8_BAR
#undef PG8_SCHED
}
}
#ifndef PG8_SP2
#define PG8_SP2 true
#endif
#ifndef PG8_ALIGN
#define PG8_ALIGN true
#endif

constexpr int NWAVES = 8;
constexpr int D = 1024, FF = 4096, NH = 16, HD = 64, DEPTH = 4;
constexpr int NTOK = 131072;
constexpr int GROUP_TOK = 65536;
#ifndef MK_CH
#define MK_CH 65536
#endif
constexpr int CH = MK_CH;
constexpr int NCHUNK = NTOK / CH;
constexpr float RMS_EPS = 1e-6f;
constexpr float LOG2E = 1.4426950408889634f;
static_assert(GROUP_TOK % CH == 0 && CH % 4096 == 0, "chunking");

constexpr size_t MiB = 1u << 20;
constexpr size_t WS_WPOOL = 2 * MiB;
constexpr size_t WS_WQKV = 4 * MiB;
constexpr size_t WS_WO = 16 * MiB;
constexpr size_t WS_WUP = 20 * MiB;
constexpr size_t WS_WDN = 52 * MiB;
constexpr size_t WS_XN = 96 * MiB;
constexpr size_t WS_PG = WS_XN + (size_t)CH * D * 2;
constexpr size_t WS_ACT = WS_PG + (size_t)CH * D * 2;
constexpr size_t WS_CTL = 0, CTL_ZERO_BYTES = 65536;
constexpr size_t WS_STAT = 86 * MiB;
static_assert(WS_STAT + 2 * (size_t)CH * 64 <= WS_XN, "stat arrays");
constexpr size_t WS_END = WS_ACT + (size_t)CH * FF * 2;
static_assert(WS_XN >= WS_WDN + 32 * MiB && WS_END <= 1024 * MiB, "d_ws map");

constexpr int RING_BYTES = 131072;
constexpr int BIAS_OFF = RING_BYTES;
constexpr int MISC_OFF = RING_BYTES + 4096;
constexpr int LDS_BYTES = 147456;

#define GAS __attribute__((address_space(1)))
#define LAS __attribute__((address_space(3)))
typedef unsigned short bf16;
typedef unsigned v4u __attribute__((ext_vector_type(4)));
typedef unsigned v2u __attribute__((ext_vector_type(2)));
typedef float f32x4 __attribute__((ext_vector_type(4)));
typedef short bf16x8 __attribute__((ext_vector_type(8)));
typedef short s16x4 __attribute__((ext_vector_type(4)));
#define LDS_WAIT() asm volatile("s_waitcnt lgkmcnt(0)" ::: "memory")
__device__ __forceinline__ unsigned f2bf(float f) { unsigned u = __builtin_bit_cast(unsigned, f); return (u + 0x7fffu + ((u >> 16) & 1u)) >> 16; }
typedef float f32x2_t __attribute__((ext_vector_type(2))); typedef __bf16 bf16x2_t __attribute__((ext_vector_type(2)));
__device__ __forceinline__ unsigned pk2(float lo, float hi) { f32x2_t v = {lo, hi}; bf16x2_t b = __builtin_convertvector(v, bf16x2_t); return __builtin_bit_cast(unsigned, b); }
__device__ __forceinline__ float bf2f(unsigned short b) { return __builtin_bit_cast(float, (unsigned)b << 16); }
__device__ __forceinline__ float wave_sum(float v) {
#pragma unroll
    for (int o = 1; o < 64; o <<= 1) v += __shfl_xor(v, o);
    return v;
}

__device__ __forceinline__ void transpose_item(const float* W, int K, int N, bf16* WT, int row_off, const float* nscale, const float* kscale, LAS float* scr, int item, int lane) {
    const int nblk = N / 32, kb = item / nblk, nb = item % nblk, k0 = 64 * kb, n0 = 32 * nb;
    float wv[32];
#pragma unroll
    for (int i = 0; i < 32; ++i) wv[i] = W[(size_t)(k0 + 2 * i + (lane >> 5)) * N + n0 + (lane & 31)];
#pragma unroll
    for (int i = 0; i < 32; ++i) scr[(2 * i + (lane >> 5)) * 33 + (lane & 31)] = wv[i];
    LDS_WAIT(); asm volatile("" ::: "memory");
    const int c = lane & 7;
    float ks[8];
#pragma unroll
    for (int e = 0; e < 8; ++e) ks[e] = kscale ? kscale[k0 + 8 * c + e] : 1.f;
#pragma unroll
    for (int j = 0; j < 4; ++j) { const int n = (lane >> 3) + 8 * j; const LAS float* s = scr + (8 * c) * 33 + n;
        const float sc = nscale ? nscale[n0 + n] : 1.f;
        v4u o; o.x = pk2(s[0 * 33] * sc * ks[0], s[1 * 33] * sc * ks[1]); o.y = pk2(s[2 * 33] * sc * ks[2], s[3 * 33] * sc * ks[3]); o.z = pk2(s[4 * 33] * sc * ks[4], s[5 * 33] * sc * ks[5]); o.w = pk2(s[6 * 33] * sc * ks[6], s[7 * 33] * sc * ks[7]);
        *(GAS v4u*)(WT + (size_t)(row_off + n0 + n) * K + k0 + 8 * c) = o; }
    LDS_WAIT(); asm volatile("" ::: "memory");
}

struct Ptrs {
    const float *x_in[2], *norm_mix, *pool_w, *pool_scale, *w_qkv, *rpb, *w_o, *norm_mlp, *w_up, *w_down, *norm_final;
    float* out; unsigned char* ws;
};

__device__ __forceinline__ void prologue(const Ptrs& P, LAS unsigned char* lds, int gw, int NGW, int wave, int lane) {
    LAS float* scr = (LAS float*)(lds + wave * 16384);
    bf16* WPOOL = (bf16*)(P.ws + WS_WPOOL); bf16* WQKV = (bf16*)(P.ws + WS_WQKV); bf16* WO = (bf16*)(P.ws + WS_WO); bf16* WUP = (bf16*)(P.ws + WS_WUP); bf16* WDN = (bf16*)(P.ws + WS_WDN);
    constexpr int I_POOL = (256 / 64) * (256 / 32), I_QKV = (D / 64) * (3 * D / 32), I_O = (D / 64) * (D / 32), I_UP = (D / 64) * (FF / 32), I_DN = (FF / 64) * (D / 32);
    constexpr int NITEMS = 8 * I_POOL + 2 * I_QKV + 2 * I_O + 4 * I_UP + 4 * I_DN;
    for (int it = gw; it < NITEMS; it += NGW) {
        int r = it;
        if (r < 8 * I_POOL) { const int mtx = r / I_POOL, j = mtx >> 2, g = mtx & 3; transpose_item(P.pool_w + (size_t)mtx * 65536, 256, 256, WPOOL + (size_t)j * 1024 * 256, g * 256, P.pool_scale + j * 1024 + g * 256, nullptr, scr, r % I_POOL, lane); continue; } r -= 8 * I_POOL;
        if (r < 2 * I_QKV) { const int j = r / I_QKV; transpose_item(P.w_qkv + (size_t)j * D * 3 * D, D, 3 * D, WQKV + (size_t)j * 3 * D * D, 0, nullptr, P.norm_mix + (2 * j + 1) * D, scr, r % I_QKV, lane); continue; } r -= 2 * I_QKV;
        if (r < 2 * I_O) { const int j = r / I_O; transpose_item(P.w_o + (size_t)j * D * D, D, D, WO + (size_t)j * D * D, 0, nullptr, nullptr, scr, r % I_O, lane); continue; } r -= 2 * I_O;
        if (r < 4 * I_UP) { const int j = r / I_UP; transpose_item(P.w_up + (size_t)j * D * FF, D, FF, WUP + (size_t)j * D * FF, 0, nullptr, P.norm_mlp + j * D, scr, r % I_UP, lane); continue; } r -= 4 * I_UP;
        { const int j = r / I_DN; transpose_item(P.w_down + (size_t)j * D * FF, FF, D, WDN + (size_t)j * D * FF, 0, nullptr, nullptr, scr, r % I_DN, lane); }
    }
}

__device__ __forceinline__ void norm_rows_f32_inplace(float* x, const float* gain, int nrows, int gw, int NGW, int lane) {
    f32x4 g[4];
#pragma unroll
    for (int j = 0; j < 4; ++j) g[j] = *((const f32x4*)gain + lane + 64 * j);
    for (int m = gw * 4; m < nrows; m += NGW * 4) {
        GAS f32x4* xr = (GAS f32x4*)(x + (size_t)m * D) + lane;
        f32x4 v[4][4];
#pragma unroll
        for (int r = 0; r < 4; ++r)
#pragma unroll
            for (int j = 0; j < 4; ++j) v[r][j] = xr[r * 256 + 64 * j];
        __builtin_amdgcn_sched_barrier(0);
#pragma unroll
        for (int r = 0; r < 4; ++r) { float s = 0.f;
#pragma unroll
            for (int j = 0; j < 4; ++j) s += (v[r][j].x * v[r][j].x + v[r][j].y * v[r][j].y) + (v[r][j].z * v[r][j].z + v[r][j].w * v[r][j].w);
            const float rr = 1.0f / sqrtf(wave_sum(s) * (1.f / D) + RMS_EPS);
#pragma unroll
            for (int j = 0; j < 4; ++j) xr[r * 256 + 64 * j] = v[r][j] * rr * g[j]; }
    }
}

constexpr int PT = 32, PROWS = 48;
typedef float f32x2v __attribute__((ext_vector_type(2)));
__device__ __forceinline__ f32x2v bfpair(unsigned u) { return (f32x2v){__builtin_bit_cast(float, u << 16), __builtin_bit_cast(float, u & 0xffff0000u)}; }
template <int W> __device__ __forceinline__ void pool_rows_interior(const LAS unsigned* hcol, GAS unsigned* po) {
    constexpr int HW = W / 2; constexpr float INV = 1.0f / (float)W;
    f32x2v s = {0.f, 0.f};
#pragma unroll
    for (int o = -HW; o < HW; ++o) s += bfpair(hcol[(8 + o) * 512]);
#pragma unroll
    for (int tt = 0; tt < PT; ++tt) {
        const f32x2v c = bfpair(hcol[(8 + tt) * 512]);
        const f32x2v p = s * INV - c;
        po[(size_t)tt * 128] = pk2(p.x, p.y);
        if (tt + 1 < PT) s += bfpair(hcol[(8 + tt + HW) * 512]) - bfpair(hcol[(8 + tt - HW) * 512]);
    }
}
__device__ __forceinline__ void pool_load_rows(f32x4 (&v)[6][4], const float* x, int m0, int seq_len, int wave, int lane) {
    const int sb = m0 / seq_len * seq_len, t0 = m0 - sb;
#pragma unroll
    for (int k = 0; k < 6; ++k) { const int t = min(max(t0 - 8 + wave + NWAVES * k, 0), seq_len - 1);
        const GAS f32x4* xr = (const GAS f32x4*)(x + (size_t)(sb + t) * D) + lane;
#pragma unroll
        for (int j = 0; j < 4; ++j) v[k][j] = xr[64 * j]; }
}
__device__ __forceinline__ void pool_phase(LAS unsigned char* lds, const float* x, const float* gain, bf16* Pg, int seq_len, int vcu, int G, int tid, int wave, int lane) {
    f32x4 g[4];
#pragma unroll
    for (int j = 0; j < 4; ++j) g[j] = *((const f32x4*)gain + lane + 64 * j);
    const int grp = wave >> 1, w = 2 << grp, hw = w >> 1;
    f32x4 v[6][4];
    if (vcu < CH / PT) pool_load_rows(v, x, vcu * PT, seq_len, wave, lane);
    for (int tile = vcu; tile < CH / PT; tile += G) {
        const int m0 = tile * PT;
        const int sb = m0 / seq_len * seq_len;
        const int t0 = m0 - sb;
#pragma unroll
        for (int k = 0; k < 6; ++k) { float s = 0.f;
#pragma unroll
            for (int j = 0; j < 4; ++j) s += (v[k][j].x * v[k][j].x + v[k][j].y * v[k][j].y) + (v[k][j].z * v[k][j].z + v[k][j].w * v[k][j].w);
            const float r = 1.0f / sqrtf(wave_sum(s) * (1.f / D) + RMS_EPS);
            LAS v2u* hr = (LAS v2u*)(lds + (wave + NWAVES * k) * 2048) + lane;
#pragma unroll
            for (int j = 0; j < 4; ++j) { v2u o; o.x = pk2(v[k][j].x * r * g[j].x, v[k][j].y * r * g[j].y); o.y = pk2(v[k][j].z * r * g[j].z, v[k][j].w * r * g[j].w); hr[64 * j] = o; } }
        __syncthreads();
        if (tile + G < CH / PT) { pool_load_rows(v, x, (tile + G) * PT, seq_len, wave, lane); __builtin_amdgcn_sched_barrier(0); }
        const LAS unsigned* hcol = (const LAS unsigned*)lds + tid;
        GAS unsigned* po = (GAS unsigned*)(Pg + (size_t)grp * CH * 256 + (size_t)m0 * 256) + (tid & 127);
        if (t0 >= 8 && t0 + PT + 8 <= seq_len) {
            switch (grp) { case 0: pool_rows_interior<2>(hcol, po); break; case 1: pool_rows_interior<4>(hcol, po); break; case 2: pool_rows_interior<8>(hcol, po); break; default: pool_rows_interior<16>(hcol, po); break; }
        } else {
        for (int tt = 0; tt < PT; ++tt) {
            const int t = t0 + tt;
            const int lo = max(t - hw, 0), hi = min(t + hw - 1, seq_len - 1);
            float s0 = 0.f, s1 = 0.f;
            for (int q = lo; q <= hi; ++q) { const unsigned u = hcol[(q - t0 + 8) * 512]; s0 += __builtin_bit_cast(float, u << 16); s1 += __builtin_bit_cast(float, u & 0xffff0000u); }
            const unsigned uc = hcol[(tt + 8) * 512];
            const float inv = 1.0f / (float)(hi - lo + 1);
            po[(size_t)tt * 128] = pk2(s0 * inv - __builtin_bit_cast(float, uc << 16), s1 * inv - __builtin_bit_cast(float, uc & 0xffff0000u));
        }
        }
        __syncthreads();
    }
}

#define RLX_AGENT __ATOMIC_RELAXED, __HIP_MEMORY_SCOPE_AGENT
#define XB_TMO      128
#define XB_XCNT(j)  (256  + 64 * (j))
#define XB_XSUB(j)  (1280 + 64 * (j))
#define XB_XGEN(j)  (2304 + 64 * (j))
#define XB_TOP      3328
#define XB_TOPGEN   3392
#define XCD_BAR_WORDS 3456
#define XB_SPIN_CAP (1u << 18)

__device__ __forceinline__ unsigned xb_ld(unsigned* p)              { return __hip_atomic_load(p, __ATOMIC_RELAXED, __HIP_MEMORY_SCOPE_AGENT); }
__device__ __forceinline__ unsigned xb_add(unsigned* p, unsigned v) { return __hip_atomic_fetch_add(p, v, __ATOMIC_RELAXED, __HIP_MEMORY_SCOPE_AGENT); }
__device__ __forceinline__ unsigned xb_xcc_id() { return (unsigned)__builtin_amdgcn_s_getreg((3 << 11) | 20) & 0xFu; }
#define XB_SPIN(cond, bar) do { unsigned _sp = 0; while (cond) { __builtin_amdgcn_s_sleep(1); \
    if ((++_sp & 255u) == 0u) { if (xb_ld(&(bar)[XB_TMO])) break; if (_sp > XB_SPIN_CAP) { atomicAdd(&(bar)[XB_TMO], 1u); break; } } } } while (0)

struct XcdBarrier {
    unsigned* bar; unsigned x;
    volatile LAS unsigned* st;
};

__device__ __forceinline__ XcdBarrier xcd_barrier_post(unsigned* bar, volatile LAS unsigned* st) {
    XcdBarrier b; b.bar = bar; b.x = xb_xcc_id(); b.st = st;
    if (threadIdx.x == 0) (void)xb_add(&bar[XB_XCNT(b.x)], 1u);
    return b;
}
__device__ __forceinline__ void xcd_barrier_complete(unsigned* bar, unsigned x, unsigned& nloc, unsigned& nx) {
    const unsigned G = gridDim.x * gridDim.y * gridDim.z;
    unsigned sum, cnt, mine, sp = 0u;
    for (;;) {
        sum = 0u; cnt = 0u; mine = 0u;
#pragma unroll
        for (unsigned j = 0; j < 16; ++j) { const unsigned c = xb_ld(&bar[XB_XCNT(j)]); sum += c; cnt += (c > 0u) ? 1u : 0u; mine = (j == x) ? c : mine; }
        if (sum == G) break;
        __builtin_amdgcn_s_sleep(1);
        if ((++sp & 255u) == 0u) { if (xb_ld(&bar[XB_TMO])) break; if (sp > XB_SPIN_CAP) { atomicAdd(&bar[XB_TMO], 1u); break; } }
    }
    nloc = mine > 0u ? mine : 1u; nx = cnt > 0u ? cnt : 1u;
}

__device__ __forceinline__ void xcd_barrier(const XcdBarrier& b) {
    asm volatile("s_waitcnt vmcnt(0)" ::: "memory");
    __syncthreads();
    if (threadIdx.x == 0) {
        unsigned* bar = b.bar;
        __builtin_amdgcn_s_waitcnt(0);
        unsigned nloc = b.st[0], nx = b.st[1];
        if (nloc == 0u) { xcd_barrier_complete(bar, b.x, nloc, nx); b.st[0] = nloc; b.st[1] = nx; }
        const unsigned old = xb_add(&bar[XB_XSUB(b.x)], 1u);
        const unsigned gen = old / nloc;
        if (old + 1u == (gen + 1u) * nloc) {
            __builtin_amdgcn_fence(__ATOMIC_RELEASE, "agent");
            asm volatile("s_waitcnt vmcnt(0)" ::: "memory");
            const unsigned og = xb_add(&bar[XB_TOP], 1u);
            const unsigned tg = og / nx;
            if (og + 1u == (tg + 1u) * nx) xb_add(&bar[XB_TOPGEN], 1u);
            else XB_SPIN(xb_ld(&bar[XB_TOPGEN]) == tg, bar);
            __builtin_amdgcn_fence(__ATOMIC_ACQUIRE, "agent");
            xb_add(&bar[XB_XGEN(b.x)], 1u);
            asm volatile("s_waitcnt vmcnt(0)" ::: "memory");
        } else {
            XB_SPIN(xb_ld(&bar[XB_XGEN(b.x)]) == gen, bar);
            __builtin_amdgcn_fence(__ATOMIC_ACQUIRE, "agent");
            asm volatile("s_waitcnt vmcnt(0)" ::: "memory");
        }
    }
    __syncthreads();
}


__device__ __forceinline__ unsigned cvtpk(float lo, float hi) { return pk2(lo, hi); }
__device__ __forceinline__ s16x4 vtr(const LAS unsigned char* p) { return __builtin_bit_cast(s16x4, __builtin_amdgcn_ds_read_tr16_b64_v4i16((LAS s16x4*)p)); }
__device__ __forceinline__ void attn_phase(LAS unsigned char* lds, bf16* Qb, const bf16* Kb, const bf16* Vb, const float* rpb_l, int seq_len, int G, int bx, int tid, int wave, int lane) {
    const int fr = lane & 15, fq = lane >> 4;
    const int rows = seq_len >> 6, rows_shift = (seq_len == 2048) ? 5 : 6;
    constexpr int NI = (CH / 64) * 8;
    int nx, xc, lc, per;
    if ((G & 7) == 0) { nx = G >> 3; xc = bx & 7; lc = bx >> 3; per = NI >> 3; } else { nx = G; xc = 0; lc = bx; per = NI; }
    LAS float* bias = (LAS float*)(lds + BIAS_OFF);
    const int qb = wave & 3, hh = wave >> 2;
    const int qc = (qb < 3) ? (8 + 16 * qb + fr) : (fr < 8 ? fr : 48 + fr);
    const int a0 = (qb < 3) ? qb : 0, a1 = (qb < 3) ? qb + 1 : 3;
    const int wst = min(max(qc - 8, 0), 48);
    const int q4 = (lane & 15) >> 2, p4 = lane & 3;
    float madd[2][4];
#pragma unroll
    for (int ai = 0; ai < 2; ++ai)
#pragma unroll
        for (int i = 0; i < 4; ++i) { const int kc = 16 * (ai ? a1 : a0) + 4 * fq + i; madd[ai][i] = ((kc >= wst) && (kc < wst + 16)) ? 0.f : -1.0e30f; }
    int voff[4];
#pragma unroll
    for (int i3 = 0; i3 < 4; ++i3) voff[i3] = (lane >> 4) * D + (((lane & 15) ^ (((lane >> 4) << 2) | i3)) * 8);
    if (lc >= per) return;
    int id = xc * per + lc;
    int r = id & (rows - 1), hp = (id >> rows_shift) & 7, tb = (id >> (rows_shift + 3)) * seq_len, r0 = min(max(r - 4, 0), rows - 8);
    bf16x8 qf0, qf1, kf[4][2][2];
    float bnext[2];
#define ATT_PREFETCH() do { \
        const int h_ = 2 * hp + hh; const size_t qo_ = (size_t)(tb + r * 64 + qc) * D + h_ * 64; \
        qf0 = *(const GAS bf16x8*)(Qb + qo_ + 8 * fq); qf1 = *(const GAS bf16x8*)(Qb + qo_ + 32 + 8 * fq); \
        const bf16* kb_ = Kb + ((size_t)(h_ * 8 + fq) * CH + (tb + r0 * 64 + fr)) * 8; \
        _Pragma("unroll") for (int kr = 0; kr < 4; ++kr) _Pragma("unroll") for (int ai = 0; ai < 2; ++ai) { const bf16* kp = kb_ + (kr * 64 + 16 * (ai ? a1 : a0)) * 8; kf[kr][ai][0] = *(const GAS bf16x8*)kp; kf[kr][ai][1] = *(const GAS bf16x8*)(kp + (size_t)4 * CH * 8); } \
        bnext[0] = rpb_l[hp * 930 + tid] * LOG2E; bnext[1] = (tid + 512 < 930) ? rpb_l[hp * 930 + tid + 512] * LOG2E : 0.f; } while (0)
#define ATT_BIAS_WRITE() do { bias[tid] = bnext[0]; if (tid + 512 < 930) bias[tid + 512] = bnext[1]; } while (0)
    ATT_PREFETCH();
    ATT_BIAS_WRITE();
    for (int loc = lc; loc < per; loc += nx) {
        const int h = 2 * hp + hh;
        const size_t qoff = (size_t)(tb + r * 64 + qc) * D + h * 64;
        const bf16* kbase = Kb + ((size_t)(h * 8 + fq) * CH + (tb + r0 * 64 + fr)) * 8;
        const int drb = r0 - r + 7;
        __syncthreads();
        {
            const int a = wave >> 1, ub = (wave & 1) * 2;
#pragma unroll
            for (int i = 0; i < 16; ++i) { const int kr = 2 * (ub + (i >> 3)) + (i & 1), cb = 16 * a + 4 * ((i & 7) >> 1);
                const bf16* src = Vb + (size_t)(tb + (r0 + kr) * 64 + cb) * D + hp * 128 + voff[i & 3];
                __builtin_amdgcn_global_load_lds((const unsigned*)src, (LAS unsigned*)(lds + (wave * 16 + i) * 1024), 16, 0, 0); }
        }
        f32x4 S[8][2];
        float mx = -3.0e38f;
        const LAS float* bptr[2][4];
#pragma unroll
        for (int ai = 0; ai < 2; ++ai)
#pragma unroll
            for (int i = 0; i < 4; ++i) { const int kc = 16 * (ai ? a1 : a0) + 4 * fq + i; bptr[ai][i] = bias + hh * 465 + drb * 31 + min(max(kc - qc + 15, 0), 30); }
#pragma unroll
        for (int kr = 0; kr < 8; ++kr) {
#pragma unroll
            for (int ai = 0; ai < 2; ++ai) {
                f32x4 z = {0.f, 0.f, 0.f, 0.f};
                z = __builtin_amdgcn_mfma_f32_16x16x32_bf16(kf[kr & 3][ai][0], qf0, z, 0, 0, 0);
                z = __builtin_amdgcn_mfma_f32_16x16x32_bf16(kf[kr & 3][ai][1], qf1, z, 0, 0, 0);
#pragma unroll
                for (int i = 0; i < 4; ++i) { z[i] = (z[i] + bptr[ai][i][kr * 31]) + madd[ai][i]; mx = fmaxf(mx, z[i]); }
                S[kr][ai] = z;
            }
            if (kr < 4) {
#pragma unroll
                for (int ai = 0; ai < 2; ++ai) { const bf16* kp = kbase + ((kr + 4) * 64 + 16 * (ai ? a1 : a0)) * 8; kf[kr & 3][ai][0] = *(const GAS bf16x8*)kp; kf[kr & 3][ai][1] = *(const GAS bf16x8*)(kp + (size_t)4 * CH * 8); }
            }
            __builtin_amdgcn_sched_barrier(0);
        }
        mx = fmaxf(mx, __shfl_xor(mx, 16)); mx = fmaxf(mx, __shfl_xor(mx, 32));
        float sum = 0.f;
#pragma unroll
        for (int kr = 0; kr < 8; ++kr)
#pragma unroll
            for (int ai = 0; ai < 2; ++ai)
#pragma unroll
                for (int i = 0; i < 4; ++i) { const float p = __builtin_amdgcn_exp2f(S[kr][ai][i] - mx); S[kr][ai][i] = p; sum += p; }
        sum += __shfl_xor(sum, 16); sum += __shfl_xor(sum, 32);
        bf16x8 pf[4][2];
#pragma unroll
        for (int u = 0; u < 4; ++u)
#pragma unroll
            for (int ai = 0; ai < 2; ++ai) { v4u pw; pw.x = cvtpk(S[2 * u][ai][0], S[2 * u][ai][1]); pw.y = cvtpk(S[2 * u][ai][2], S[2 * u][ai][3]); pw.z = cvtpk(S[2 * u + 1][ai][0], S[2 * u + 1][ai][1]); pw.w = cvtpk(S[2 * u + 1][ai][2], S[2 * u + 1][ai][3]);
                pf[u][ai] = __builtin_bit_cast(bf16x8, pw); }
        asm volatile("s_waitcnt vmcnt(0)" ::: "memory");
        __syncthreads();
        const int nloc = loc + nx; const bool has_next = nloc < per;
        const int r_cur = r, tb_cur = tb;
        if (has_next) { id = xc * per + nloc; r = id & (rows - 1); hp = (id >> rows_shift) & 7; tb = (id >> (rows_shift + 3)) * seq_len; r0 = min(max(r - 4, 0), rows - 8); ATT_PREFETCH(); }
        (void)r_cur; (void)tb_cur;
        f32x4 O[4];
#pragma unroll
        for (int c = 0; c < 4; ++c) O[c] = (f32x4){0.f, 0.f, 0.f, 0.f};
        const LAS unsigned char* vb[2][2][4];
#pragma unroll
        for (int ai = 0; ai < 2; ++ai)
#pragma unroll
            for (int t = 0; t < 2; ++t)
#pragma unroll
                for (int c = 0; c < 4; ++c) { const int rho = 8 * fq + 4 * t + q4, chn = 2 * (4 * hh + c) + (p4 >> 1);
                    vb[ai][t][c] = lds + (ai ? a1 : a0) * 32768 + 256 * rho + 16 * (chn ^ (((rho & 3) << 2) | ((rho >> 2) & 3))) + 8 * (p4 & 1); }
#pragma unroll
        for (int u = 0; u < 4; ++u) {
#pragma unroll
            for (int ai = 0; ai < 2; ++ai) {
#pragma unroll
                for (int c = 0; c < 4; ++c) {
                    const s16x4 v0 = vtr(vb[ai][0][c] + u * 8192), v1 = vtr(vb[ai][1][c] + u * 8192);
                    const bf16x8 vf = __builtin_shufflevector(v0, v1, 0, 1, 2, 3, 4, 5, 6, 7);
                    O[c] = __builtin_amdgcn_mfma_f32_16x16x32_bf16(vf, pf[u][ai], O[c], 0, 0, 0);
                }
            }
            __builtin_amdgcn_sched_barrier(0);
        }
        const float inv = 1.0f / sum;
#pragma unroll
        for (int c = 0; c < 4; ++c) { v2u w; w.x = cvtpk(O[c][0] * inv, O[c][1] * inv); w.y = cvtpk(O[c][2] * inv, O[c][3] * inv);
            *(GAS v2u*)(Qb + qoff + 16 * c + 4 * fq) = w; }
        if (has_next) ATT_BIAS_WRITE();
    }
    __syncthreads();
#undef ATT_PREFETCH
#undef ATT_BIAS_WRITE
}
enum { K_POOL = 1, K_GEMM_RES = 3, K_GEMM_QKV = 4, K_GEMM_UP = 5, K_ATTN = 6, K_FINAL = 7 };
enum { F_A_X = 1, F_A_IN = 2, F_AUX_X = 4, F_AUX_IN = 8 };
struct Ph { int kind, flags, N, K; const void* A; const void* B; void* C; const void* aux; float* st; float* stz; unsigned long long a_pn_stride, pad; };
constexpr int PPC = 19;
struct Args { Ptrs p; Ph tab[PPC]; };
__global__ void __launch_bounds__(NWAVES * 64, 2) fwd_megakernel(Args args) {
    extern __shared__ __attribute__((aligned(16))) unsigned char lds_raw[];
    cg::grid_group grid = cg::this_grid();
    LAS unsigned char* lds = (LAS unsigned char*)lds_raw;
    volatile LAS unsigned* MISC = (volatile LAS unsigned*)(lds + MISC_OFF);
    for (int u = threadIdx.x; u < 32; u += NWAVES * 64) MISC[u] = 0u;
    __syncthreads();
    const XcdBarrier bar = xcd_barrier_post((unsigned*)(args.p.ws + WS_CTL), MISC + 8);
    {
        const int tid = threadIdx.x, lane = tid & 63, wave = __builtin_amdgcn_readfirstlane(tid >> 6);
        const int G = gridDim.x, bx = blockIdx.x;
        const int vcu = (G % 8 == 0) ? (bx % 8) * (G / 8) + bx / 8 : bx;
        prologue(args.p, lds, vcu * NWAVES + wave, G * NWAVES, wave, lane);
    }
    grid.sync();

    int repflag = 0; (void)repflag;
    for (int ph = 0; ph < NCHUNK * PPC; ++ph) {
        int tid = threadIdx.x; asm volatile("" : "+v"(tid));
        int G = gridDim.x, bx = blockIdx.x; asm volatile("" : "+s"(G), "+s"(bx));
        const int lane = tid & 63, wave = __builtin_amdgcn_readfirstlane(tid >> 6);
        const int vcu = (G % 8 == 0) ? (bx % 8) * (G / 8) + bx / 8 : bx;
        const int gw = vcu * NWAVES + wave, NGW = G * NWAVES;
        const int ck = ph / PPC, idx = ph - ck * PPC;
        const Ph d = args.tab[idx];
        const int tok0 = ck * CH, grp = tok0 / GROUP_TOK, seq_len = grp ? 4096 : 2048;
        const float* xin = args.p.x_in[grp] + (size_t)(tok0 - grp * GROUP_TOK) * D;
        float* X = args.p.out + (size_t)tok0 * D;
        const void* A = (d.flags & F_A_X) ? (const void*)X : (d.flags & F_A_IN) ? (const void*)xin : d.A;
        const void* aux = (d.flags & F_AUX_X) ? (const void*)X : (d.flags & F_AUX_IN) ? (const void*)xin : d.aux;
        if (d.stz) for (int i = vcu * (NWAVES * 64) + tid; i < CH; i += G * NWAVES * 64) d.stz[i] = 0.f;
        switch (d.kind) {
        case K_POOL: pool_phase(lds, (const float*)A, (const float*)aux, (bf16*)d.C, seq_len, vcu, G, tid, wave, lane); break;
        case K_GEMM_RES: { pg8::Gemm g{(const bf16*)A, (const bf16*)d.B, CH, d.N, d.K, (size_t)d.a_pn_stride}; pg8::StaticOrder S; S.init(CH, d.N, G, bx);
            pg8::EpiRes E{(const float*)aux, X, (bf16*)d.C, d.st, D};
            pg8::gemm_phase<pg8::EpiRes, pg8::StaticOrder, PG8_ALIGN, PG8_SP2>(lds, g, S, E, tid); } break;
        case K_GEMM_QKV: { pg8::Gemm g{(const bf16*)A, (const bf16*)d.B, CH, d.N, d.K, 0}; pg8::StaticOrder S; S.init(CH, d.N, G, bx);
            pg8::EpiBf16<0, true> E{(bf16*)d.C, D, D, (size_t)CH * D, 0.125f * LOG2E, d.st};
            pg8::gemm_phase<pg8::EpiBf16<0, true>, pg8::StaticOrder, PG8_ALIGN, PG8_SP2>(lds, g, S, E, tid); } break;
        case K_GEMM_UP: { pg8::Gemm g{(const bf16*)A, (const bf16*)d.B, CH, d.N, d.K, 0}; pg8::StaticOrder S; S.init(CH, d.N, G, bx);
            pg8::EpiBf16<2, true> E{(bf16*)d.C, FF, 0, 0, 1.f, d.st};
            pg8::gemm_phase<pg8::EpiBf16<2, true>, pg8::StaticOrder, PG8_ALIGN, PG8_SP2>(lds, g, S, E, tid); } break;
        case K_ATTN: attn_phase(lds, (bf16*)d.C, (const bf16*)d.C + (size_t)CH * D, (const bf16*)d.C + 2 * (size_t)CH * D, (const float*)aux, seq_len, G, bx, tid, wave, lane); break;
        default: norm_rows_f32_inplace(X, (const float*)aux, CH, gw, NGW, lane); break;
        }
        if (d.kind != K_FINAL) xcd_barrier(bar);
#if defined(MK_REP)
        if (d.kind == MK_REP && !repflag) { repflag = 1; ph -= (MK_REP == K_ATTN) ? 2 : 1; } else if (d.kind == MK_REP) repflag = 0;
#endif
    }
}

extern "C" void kernel_launch(void* const* d_in, const int* in_sizes, int n_in, void* d_out, int out_size, void* d_ws, size_t ws_size, hipStream_t stream) {
    static int grid = 0;
    if (grid == 0) {
        if (n_in != 12 || in_sizes[0] != GROUP_TOK * D || in_sizes[1] != GROUP_TOK * D || out_size != NTOK * D || ws_size < WS_END) {
            fprintf(stderr, "kernel_launch: unexpected shapes (n_in %d, out %d, ws %zu < %zu); nothing launched\n", n_in, out_size, ws_size, (size_t)WS_END); grid = -1; return; }
        int dev = 0, cus = 0, per_cu = 0;
        if (hipGetDevice(&dev) != hipSuccess || hipDeviceGetAttribute(&cus, hipDeviceAttributeMultiprocessorCount, dev) != hipSuccess) { fprintf(stderr, "kernel_launch: device query failed\n"); grid = -1; return; }
        if (hipFuncSetAttribute((const void*)fwd_megakernel, hipFuncAttributeMaxDynamicSharedMemorySize, LDS_BYTES) != hipSuccess) { fprintf(stderr, "kernel_launch: hipFuncSetAttribute failed\n"); grid = -1; return; }
        if (hipOccupancyMaxActiveBlocksPerMultiprocessor(&per_cu, (const void*)fwd_megakernel, NWAVES * 64, LDS_BYTES) != hipSuccess || per_cu < 1) { fprintf(stderr, "kernel_launch: occupancy query gave %d\n", per_cu); per_cu = 1; }
        (void)hipGetLastError();
        grid = cus * per_cu;
    }
    if (grid < 0) return;
    if (hipMemsetAsync((char*)d_ws + WS_CTL, 0, CTL_ZERO_BYTES, stream) != hipSuccess) { fprintf(stderr, "kernel_launch: hipMemsetAsync failed\n"); return; }
    Args a{};
    Ptrs& p = a.p;
    p.x_in[0] = (const float*)d_in[0]; p.x_in[1] = (const float*)d_in[1]; p.norm_mix = (const float*)d_in[2]; p.pool_w = (const float*)d_in[3]; p.pool_scale = (const float*)d_in[4];
    p.w_qkv = (const float*)d_in[5]; p.rpb = (const float*)d_in[6]; p.w_o = (const float*)d_in[7]; p.norm_mlp = (const float*)d_in[8]; p.w_up = (const float*)d_in[9];
    p.w_down = (const float*)d_in[10]; p.norm_final = (const float*)d_in[11]; p.out = (float*)d_out; p.ws = (unsigned char*)d_ws;
    unsigned char* ws = (unsigned char*)d_ws;
    bf16* WPOOL = (bf16*)(ws + WS_WPOOL); bf16* WQKV = (bf16*)(ws + WS_WQKV); bf16* WO = (bf16*)(ws + WS_WO); bf16* WUP = (bf16*)(ws + WS_WUP); bf16* WDN = (bf16*)(ws + WS_WDN);
    bf16* XN = (bf16*)(ws + WS_XN); bf16* PG = (bf16*)(ws + WS_PG); bf16* QB = (bf16*)(ws + WS_ACT); bf16* HB = (bf16*)(ws + WS_ACT);
    float* SA = (float*)(ws + WS_STAT); float* SB = SA + (size_t)CH * 16;
    int n = 0;
    auto add = [&](int kind, int flags, int N, int K, const void* A, const void* B, void* C, const void* aux, float* st, float* stz, unsigned long long aps) {
        Ph& d = a.tab[n++]; d.kind = kind; d.flags = flags; d.N = N; d.K = K; d.A = A; d.B = B; d.C = C; d.aux = aux; d.st = st; d.stz = stz; d.a_pn_stride = aps; d.pad = 0; };
    for (int layer = 0; layer < DEPTH; ++layer) {
        const int j = layer >> 1;
        if ((layer & 1) == 0) {
            add(K_POOL, layer == 0 ? F_A_IN : F_A_X, 0, 0, nullptr, nullptr, PG, p.norm_mix + layer * D, nullptr, nullptr, 0);
            add(K_GEMM_RES, layer == 0 ? F_AUX_IN : F_AUX_X, D, 256, PG, WPOOL + (size_t)j * 1024 * 256, XN, nullptr, SA, nullptr, (unsigned long long)CH * 256 * 2);
        } else {
            add(K_GEMM_QKV, 0, 3 * D, D, XN, WQKV + (size_t)j * 3 * D * D, QB, nullptr, SB, nullptr, 0);
            add(K_ATTN, 0, 0, 0, nullptr, nullptr, QB, p.rpb + (size_t)j * NH * 15 * 31, nullptr, nullptr, 0);
            add(K_GEMM_RES, F_AUX_X, D, D, QB, WO + (size_t)j * D * D, XN, nullptr, SA, nullptr, 0);
        }
        add(K_GEMM_UP, 0, FF, D, XN, WUP + (size_t)layer * D * FF, HB, nullptr, SA, nullptr, 0);
        add(K_GEMM_RES, F_AUX_X, D, FF, HB, WDN + (size_t)layer * D * FF, (layer & 1) == 0 ? XN : nullptr, nullptr, SB, nullptr, 0);
    }
    add(K_FINAL, 0, 0, 0, nullptr, nullptr, nullptr, p.norm_final, nullptr, nullptr, 0);
    if (n != PPC) { fprintf(stderr, "kernel_launch: phase table has %d entries, expected %d\n", n, PPC); return; }
    void* kargs[] = {&a};
    hipError_t e = hipLaunchCooperativeKernel((const void*)fwd_megakernel, dim3(grid), dim3(NWAVES * 64), kargs, LDS_BYTES, stream);
    if (e != hipSuccess) fprintf(stderr, "kernel_launch: cooperative launch failed: %s (grid %d)\n", hipGetErrorString(e), grid);
}
```

```cpp
#include <hip/hip_runtime.h>
#include <hip/hip_cooperative_groups.h>
#include <cstdio>
#include <cstdint>
namespace cg = cooperative_groups;
namespace pg8 {
#define PG8_LAS __attribute__((address_space(3)))
typedef unsigned short bf16_t;
typedef short bf16x8 __attribute__((ext_vector_type(8)));
typedef float f32x4 __attribute__((ext_vector_type(4)));
typedef unsigned u32x4 __attribute__((ext_vector_type(4)));
constexpr int BM = 256, BK = 64, HALF = 128, HTB = HALF * BK * 2  , STAGE_BYTES = 8 * HTB, NXCD = 8, WGM = 8;

__host__ __device__ __forceinline__ int lds_byte(int r, int c) { const int st = (r >> 4) * 2 + (c >> 5), rr = r & 15, cc = c & 31, ob = rr * 64 + cc * 2; return st * 1024 + (ob ^ (((ob >> 9) & 1) << 5)); }
__host__ __device__ __forceinline__ void stage_rc(int b, int& R, int& C) { const int st = b / 1024, sb = b % 1024, swz = sb ^ (((sb >> 9) & 1) << 5); R = (st >> 1) * 16 + swz / 64; C = (st & 1) * 32 + (swz % 64) / 2; }
__host__ __device__ __forceinline__ int perm32(int rho) { const int n = rho >> 4, i = rho & 15; return 8 * (i >> 2) + 4 * n + (i & 3); }

struct Unit { int pm, pn; };
struct Gemm { const bf16_t* A; const bf16_t* Bt; int M, N, K; size_t a_pn_stride; };

struct StaticOrder {
    int nM, nN, nwg, G, c;
    __host__ __device__ void init(int M, int N, int G_, int c_) { nM = M / BM; nN = N / BM; nwg = nM * nN; G = G_; c = c_; }
    __host__ __device__ bool next(int i, Unit& u) const {
        const long L = (long)i * G + c; if (L >= nwg) return false;
        int wgid = (int)L; { const int q = nwg / NXCD, r = nwg % NXCD, xcd = wgid % NXCD, off = wgid / NXCD; wgid = (xcd < r ? xcd * (q + 1) : r * (q + 1) + (xcd - r) * q) + off; }
        const int nig = WGM * nN, gid = wgid / nig, fm = gid * WGM, gsz = (nM - fm) < WGM ? (nM - fm) : WGM;
        u.pm = fm + ((wgid % nig) % gsz); u.pn = (wgid % nig) / gsz; return true;
    }
    __device__ __forceinline__ void a_ready(const Unit&) const {}
    __device__ __forceinline__ void done(const Unit&) const {}
};

__device__ __forceinline__ unsigned cvt_pk_bf16(float lo, float hi) { unsigned r; asm volatile("v_cvt_pk_bf16_f32 %0, %1, %2" : "=v"(r) : "v"(lo), "v"(hi)); return r; }
typedef float f32x2 __attribute__((ext_vector_type(2)));
template <int ACT, bool RS> struct EpiBf16 {
    static constexpr bool PERM = true, AFTER_DRAIN = false;
    bf16_t* O; int ldc; int split_cols; size_t split_stride; float scale0; const float* st;
    __device__ __forceinline__ void operator()(const f32x4 (&acc)[2][2][4][2], const Unit& u, int wr, int wc, int fr, int fq) const {
        const int row0 = u.pm * BM + wr * 64 + fr; int colt = u.pn * BM; bf16_t* base = O;
        float sc = 1.f; bool kplane = false;
        if (split_cols) { const int t = colt / split_cols; base += (size_t)t * split_stride; colt -= t * split_cols; if (t == 0) sc = scale0; kplane = (t == 1); }
        const size_t kprows = split_stride / 1024;
        const int col0 = colt + wc * 32 + 8 * fq;
        f32x4 pv[2][4];
        if (RS) {
#pragma unroll
            for (int ai = 0; ai < 2; ++ai)
#pragma unroll
                for (int m = 0; m < 4; ++m) pv[ai][m] = *(const f32x4*)(st + (size_t)(row0 + ai * HALF + m * 16) * 16 + 4 * fq);
            __builtin_amdgcn_sched_barrier(0);
        }
#pragma unroll
        for (int ai = 0; ai < 2; ++ai)
#pragma unroll
            for (int m = 0; m < 4; ++m) { const int row = row0 + ai * HALF + m * 16; bf16_t* rowp = base + (size_t)row * ldc + col0;
                float f = sc;
                if (RS) { float ss = (pv[ai][m][0] + pv[ai][m][1]) + (pv[ai][m][2] + pv[ai][m][3]); ss += __shfl_xor(ss, 16); ss += __shfl_xor(ss, 32);
                    const float r = __builtin_amdgcn_rsqf(ss * (1.0f / 1024.0f) + 1e-6f); f *= (ACT == 2) ? r * r : r; }
#pragma unroll
                for (int bj = 0; bj < 2; ++bj) { f32x4 v0 = acc[ai][bj][m][0], v1 = acc[ai][bj][m][1];
                    if (ACT == 2) {
#pragma unroll
                        for (int e = 0; e < 4; ++e) { const float a = fmaxf(v0[e], 0.f), b = fmaxf(v1[e], 0.f); v0[e] = a * a; v1[e] = b * b; } }
                    v0 = v0 * f; v1 = v1 * f; u32x4 w; w.x = cvt_pk_bf16(v0[0], v0[1]); w.y = cvt_pk_bf16(v0[2], v0[3]); w.z = cvt_pk_bf16(v1[0], v1[1]); w.w = cvt_pk_bf16(v1[2], v1[3]);
                    if (kplane) *(u32x4*)(base + ((size_t)(((colt >> 6) + 2 * bj + (wc >> 1)) * 8 + (wc & 1) * 4 + fq) * kprows + row) * 8) = w;
                    else *(u32x4*)(rowp + bj * HALF) = w; } }
    }
};
struct EpiRes {
    static constexpr bool PERM = true, AFTER_DRAIN = false;
    const float* base; float* out; bf16_t* xn; float* st; int ldc; const float* rs;
    __device__ __forceinline__ void operator()(const f32x4 (&acc)[2][2][4][2], const Unit& u, int wr, int wc, int fr, int fq) const {
        const int col0 = u.pn * BM + wc * 32 + 8 * fq;
#pragma unroll
        for (int ai = 0; ai < 2; ++ai) {
            f32x4 rp[4];
            if (rs) {
#pragma unroll
                for (int m = 0; m < 4; ++m) rp[m] = *(const f32x4*)(rs + (size_t)(u.pm * BM + ai * HALF + wr * 64 + m * 16 + fr) * 16 + 4 * fq);
            }
            f32x4 bs[4][2][2];
#pragma unroll
            for (int m = 0; m < 4; ++m) { const size_t off = (size_t)(u.pm * BM + ai * HALF + wr * 64 + m * 16 + fr) * ldc + col0;
#pragma unroll
                for (int bj = 0; bj < 2; ++bj) { bs[m][bj][0] = *(const f32x4*)(base + off + bj * HALF); bs[m][bj][1] = *(const f32x4*)(base + off + bj * HALF + 4); } }
            __builtin_amdgcn_sched_barrier(0);
#pragma unroll
            for (int m = 0; m < 4; ++m) { const int row = u.pm * BM + ai * HALF + wr * 64 + m * 16 + fr; const size_t off = (size_t)row * ldc + col0; float ss = 0.f;
                float f = 1.f;
                if (rs) { float q = (rp[m][0] + rp[m][1]) + (rp[m][2] + rp[m][3]); q += __shfl_xor(q, 16); q += __shfl_xor(q, 32); const float r = __builtin_amdgcn_rsqf(q * (1.0f / 1024.0f) + 1e-6f); f = r * r; }
#pragma unroll
                for (int bj = 0; bj < 2; ++bj) {
                    const f32x4 o0 = bs[m][bj][0] + acc[ai][bj][m][0] * f, o1 = bs[m][bj][1] + acc[ai][bj][m][1] * f;
                    *(f32x4*)(out + off + bj * HALF) = o0; *(f32x4*)(out + off + bj * HALF + 4) = o1;
                    if (xn) { u32x4 w; w.x = cvt_pk_bf16(o0[0], o0[1]); w.y = cvt_pk_bf16(o0[2], o0[3]); w.z = cvt_pk_bf16(o1[0], o1[1]); w.w = cvt_pk_bf16(o1[2], o1[3]);
                        *(u32x4*)(xn + off + bj * HALF) = w;
                        ss += (o0[0] * o0[0] + o0[1] * o0[1]) + (o0[2] * o0[2] + o0[3] * o0[3]) + (o1[0] * o1[0] + o1[1] * o1[1]) + (o1[2] * o1[2] + o1[3] * o1[3]); } }
                if (xn) { ss += __shfl_xor(ss, 16); ss += __shfl_xor(ss, 32); if (fq == 0) st[(size_t)row * 16 + u.pn * 4 + wc] = ss; } }
            __builtin_amdgcn_sched_barrier(0);
        }
    }
};
template <class Epi, class Sched, bool ALIGN_EPI = false, bool SP2 = false>
__device__ __forceinline__ void gemm_phase(PG8_LAS unsigned char* lds, const Gemm g, const Sched& S, const Epi& E, const int tid_in) {
    const int tid = tid_in, wid = __builtin_amdgcn_readfirstlane(tid >> 6), lane = tid & 63, wr = wid >> 2, wc = wid & 3, fr = lane & 15, fq = lane >> 4;
    const int K = g.K, nt = K / BK;
    unsigned voffA[2], voffB[2];
#pragma unroll
    for (int i = 0; i < 2; ++i) { int R, C; stage_rc(tid * 16 + i * 8192, R, C); const int Rb = Epi::PERM ? ((R & ~31) + perm32(R & 31)) : R;
        voffA[i] = (unsigned)(R * K + C) * 2u; voffB[i] = (unsigned)(Rb * K + C) * 2u; }
    const size_t kstep = (size_t)(BK * 2);
    const size_t hstep = (size_t)HALF * K * 2;
    const size_t tstep = 2 * hstep;
    const unsigned ldsw = (unsigned)wid * 1024u;
    const int aoff = lds_byte(wr * 64 + fr, fq * 8), boff = lds_byte(wc * 32 + fr, fq * 8);
#define PG8_SA(b, h) (((b) * 2 + (h)) * HTB)
#define PG8_SB(b, h) ((4 + (b) * 2 + (h)) * HTB)
#define PG8_STAGE(bufoff, gbase, voff) do { _Pragma("unroll") for (int _i = 0; _i < 2; ++_i) \
        __builtin_amdgcn_global_load_lds((const unsigned*)((const char*)(gbase) + (voff)[_i]), (PG8_LAS unsigned*)(lds + (bufoff) + ldsw + _i * 8192), 16, 0, 0); } while (0)
#define PG8_LDA(dst, b, h) do { _Pragma("unroll") for (int m = 0; m < 4; ++m) _Pragma("unroll") for (int k = 0; k < 2; ++k) dst[m][k] = *(const PG8_LAS bf16x8*)(lds + PG8_SA(b, h) + aoff + m * 2048 + k * 1024); } while (0)
#define PG8_LDB(dst, b, h) do { _Pragma("unroll") for (int n = 0; n < 2; ++n) _Pragma("unroll") for (int k = 0; k < 2; ++k) dst[n][k] = *(const PG8_LAS bf16x8*)(lds + PG8_SB(b, h) + boff + n * 2048 + k * 1024); } while (0)
#define PG8_MMA(ai, bj, At, Bt) do { __builtin_amdgcn_s_setprio(1); _Pragma("unroll") for (int m = 0; m < 4; ++m) _Pragma("unroll") for (int n = 0; n < 2; ++n) _Pragma("unroll") for (int k = 0; k < 2; ++k) \
        acc[ai][bj][m][n] = __builtin_amdgcn_mfma_f32_16x16x32_bf16(Bt[n][k], At[m][k], acc[ai][bj][m][n], 0, 0, 0); __builtin_amdgcn_s_setprio(0); } while (0)
#define PG8_WAIT_V(n) asm volatile("s_waitcnt vmcnt(" #n ")" ::: "memory")
#define PG8_WAIT_L(n) asm volatile("s_waitcnt lgkmcnt(" #n ")" ::: "memory")
#define PG8_BAR __builtin_amdgcn_s_barrier()
#define PG8_SCHED __builtin_amdgcn_sched_barrier(0)
    Unit cur, nxt; int ui = 0;
    if (!S.next(0, cur)) return;
    f32x4 acc[2][2][4][2];
#pragma unroll
    for (int a = 0; a < 2; ++a)
#pragma unroll
        for (int b = 0; b < 2; ++b)
#pragma unroll
            for (int m = 0; m < 4; ++m)
#pragma unroll
                for (int n = 0; n < 2; ++n) acc[a][b][m][n] = (f32x4){0.f, 0.f, 0.f, 0.f};
    bf16x8 At[4][2], B0[2][2], B1[2][2];
    const char* cA = (const char*)g.A + (size_t)cur.pm * tstep + (size_t)cur.pn * g.a_pn_stride; const char* cB = (const char*)g.Bt + (size_t)cur.pn * tstep;
    S.a_ready(cur);
    if constexpr (SP2) {
        PG8_STAGE(PG8_SB(0, 0), cB, voffB); PG8_STAGE(PG8_SB(0, 1), cB + hstep, voffB); PG8_STAGE(PG8_SA(0, 0), cA, voffA); PG8_STAGE(PG8_SA(0, 1), cA + hstep, voffA);
        if (wr == 1) PG8_BAR;
        PG8_WAIT_V(2); PG8_BAR;
        PG8_STAGE(PG8_SB(1, 0), cB + kstep, voffB); PG8_STAGE(PG8_SA(1, 0), cA + kstep, voffA); PG8_STAGE(PG8_SB(1, 1), cB + hstep + kstep, voffB);
        PG8_WAIT_V(6); PG8_BAR;
    } else {
        PG8_STAGE(PG8_SB(0, 0), cB, voffB); PG8_STAGE(PG8_SA(0, 0), cA, voffA); PG8_STAGE(PG8_SB(0, 1), cB + hstep, voffB); PG8_STAGE(PG8_SA(0, 1), cA + hstep, voffA);
        if (wr == 1) PG8_BAR;
        PG8_WAIT_V(4); PG8_BAR;
        PG8_STAGE(PG8_SB(1, 0), cB + kstep, voffB); PG8_STAGE(PG8_SA(1, 0), cA + kstep, voffA); PG8_STAGE(PG8_SB(1, 1), cB + hstep + kstep, voffB);
        PG8_WAIT_V(6); PG8_BAR;
    }
    for (;;) {
        const bool has_next = S.next(ui + 1, nxt);
        const char* nA = has_next ? (const char*)g.A + (size_t)nxt.pm * tstep + (size_t)nxt.pn * g.a_pn_stride : cA; const char* nB = has_next ? (const char*)g.Bt + (size_t)nxt.pn * tstep : cB;
        for (int t = 0; t < nt; t += 2) {
            const bool last = (t == nt - 2);
            const char* a1 = cA + (size_t)(t + 1) * kstep;
            const char* a2 = last ? nA : cA + (size_t)(t + 2) * kstep; const char* b2 = last ? nB : cB + (size_t)(t + 2) * kstep;
            const char* a3 = a2 + kstep; const char* b3 = b2 + kstep;
            if (last && has_next) S.a_ready(nxt);
            if constexpr (SP2) {
            PG8_LDB(B0, 0, 0); PG8_LDB(B1, 0, 1); PG8_SCHED; PG8_LDA(At, 0, 0); PG8_STAGE(PG8_SA(1, 1), a1 + hstep, voffA);
            PG8_WAIT_V(8); PG8_WAIT_L(0); PG8_BAR; PG8_MMA(0, 0, At, B0); PG8_MMA(0, 1, At, B1); PG8_BAR; PG8_SCHED;
            PG8_LDA(At, 0, 1); PG8_STAGE(PG8_SB(0, 0), b2, voffB); PG8_STAGE(PG8_SB(0, 1), b2 + hstep, voffB); PG8_STAGE(PG8_SA(0, 0), a2, voffA);
            PG8_WAIT_V(8); PG8_WAIT_L(0); PG8_BAR; PG8_MMA(1, 0, At, B0); PG8_MMA(1, 1, At, B1); PG8_BAR; PG8_SCHED;
            PG8_LDB(B0, 1, 0); PG8_LDB(B1, 1, 1); PG8_SCHED; PG8_LDA(At, 1, 0); PG8_STAGE(PG8_SA(0, 1), a2 + hstep, voffA);
            PG8_WAIT_V(8); PG8_WAIT_L(0); PG8_BAR; PG8_MMA(0, 0, At, B0); PG8_MMA(0, 1, At, B1); PG8_BAR; PG8_SCHED;
            PG8_LDA(At, 1, 1); PG8_STAGE(PG8_SB(1, 0), b3, voffB); PG8_STAGE(PG8_SB(1, 1), b3 + hstep, voffB); PG8_STAGE(PG8_SA(1, 0), a3, voffA);
            PG8_WAIT_V(8); PG8_WAIT_L(0); PG8_BAR; PG8_MMA(1, 0, At, B0); PG8_MMA(1, 1, At, B1); PG8_BAR; PG8_SCHED;
            } else {
            PG8_LDB(B0, 0, 0); PG8_SCHED; PG8_LDA(At, 0, 0); PG8_STAGE(PG8_SA(1, 1), a1 + hstep, voffA);
            PG8_WAIT_L(8); PG8_BAR; PG8_WAIT_L(0); PG8_MMA(0, 0, At, B0); PG8_BAR; PG8_SCHED;
            PG8_LDB(B1, 0, 1); PG8_STAGE(PG8_SB(0, 0), b2, voffB);
            PG8_BAR; PG8_WAIT_L(0); PG8_MMA(0, 1, At, B1); PG8_BAR;
            PG8_LDA(At, 0, 1); PG8_STAGE(PG8_SA(0, 0), a2, voffA);
            PG8_BAR; PG8_WAIT_L(0); PG8_MMA(1, 0, At, B0); PG8_BAR; PG8_SCHED;
            PG8_STAGE(PG8_SB(0, 1), b2 + hstep, voffB);
            PG8_WAIT_V(6); PG8_BAR; PG8_MMA(1, 1, At, B1); PG8_BAR;
            PG8_LDB(B0, 1, 0); PG8_SCHED; PG8_LDA(At, 1, 0); PG8_STAGE(PG8_SA(0, 1), a2 + hstep, voffA);
            PG8_WAIT_L(8); PG8_BAR; PG8_WAIT_L(0); PG8_MMA(0, 0, At, B0); PG8_BAR; PG8_SCHED;
            PG8_LDB(B1, 1, 1); PG8_STAGE(PG8_SB(1, 0), b3, voffB);
            PG8_BAR; PG8_WAIT_L(0); PG8_MMA(0, 1, At, B1); PG8_BAR;
            PG8_LDA(At, 1, 1); PG8_STAGE(PG8_SA(1, 0), a3, voffA);
            PG8_BAR; PG8_WAIT_L(0); PG8_MMA(1, 0, At, B0); PG8_BAR; PG8_SCHED;
            PG8_STAGE(PG8_SB(1, 1), b3 + hstep, voffB);
            PG8_WAIT_V(6); PG8_BAR; PG8_MMA(1, 1, At, B1); PG8_BAR;
            }
        }
        if constexpr (ALIGN_EPI) { if (wr == 0) PG8_BAR; }
        if constexpr (!Epi::AFTER_DRAIN) { E(acc, cur, wr, wc, fr, fq); S.done(cur); }
        if (!has_next) break;
#pragma unroll
        for (int a = 0; a < 2; ++a)
#pragma unroll
            for (int b = 0; b < 2; ++b)
#pragma unroll
                for (int m = 0; m < 4; ++m)
#pragma unroll
                    for (int n = 0; n < 2; ++n) acc[a][b][m][n] = (f32x4){0.f, 0.f, 0.f, 0.f};
        cur = nxt; cA = nA; cB = nB; ++ui;
        if constexpr (ALIGN_EPI) { if (wr == 1) PG8_BAR; }
    }
    PG8_WAIT_V(0);
    if constexpr (!ALIGN_EPI) { if (wr == 0) PG8_BAR; }
    PG8_BAR;
    if constexpr (Epi::AFTER_DRAIN) { E.fused(acc, cur, wr, wc, fr, fq, lds, wid, lane); S.done(cur); }
#undef PG8_SA
#undef PG8_SB
#undef PG8_STAGE
#undef PG8_LDA
#undef PG8_LDB
#undef PG8_MMA
#undef PG8_WAIT_V
#undef PG8_WAIT_L
#undef PG8_BAR
#undef PG8_SCHED
}
}
#ifndef PG8_SP2
#define PG8_SP2 true
#endif
#ifndef PG8_ALIGN
#define PG8_ALIGN true
#endif

constexpr int NWAVES = 8;
constexpr int D = 1024, FF = 4096, NH = 16, HD = 64, DEPTH = 4;
constexpr int NTOK = 131072;
constexpr int GROUP_TOK = 65536;
#ifndef MK_CH
#define MK_CH 65536
#endif
constexpr int CH = MK_CH;
constexpr int NCHUNK = NTOK / CH;
constexpr float RMS_EPS = 1e-6f;
constexpr float LOG2E = 1.4426950408889634f;
static_assert(GROUP_TOK % CH == 0 && CH % 4096 == 0, "chunking");

constexpr size_t MiB = 1u << 20;
constexpr size_t WS_WPOOL = 2 * MiB;
constexpr size_t WS_WQKV = 4 * MiB;
constexpr size_t WS_WO = 16 * MiB;
constexpr size_t WS_WUP = 20 * MiB;
constexpr size_t WS_WDN = 52 * MiB;
constexpr size_t WS_XN = 96 * MiB;
constexpr size_t WS_PG = WS_XN + (size_t)CH * D * 2;
constexpr size_t WS_ACT = WS_PG + (size_t)CH * D * 2;
constexpr size_t WS_CTL = 0, CTL_ZERO_BYTES = 65536;
constexpr size_t WS_STAT = 86 * MiB;
static_assert(WS_STAT + 2 * (size_t)CH * 64 <= WS_XN, "stat arrays");
constexpr size_t WS_END = WS_ACT + (size_t)CH * FF * 2;
static_assert(WS_XN >= WS_WDN + 32 * MiB && WS_END <= 1024 * MiB, "d_ws map");

constexpr int RING_BYTES = 131072;
constexpr int BIAS_OFF = RING_BYTES;
constexpr int MISC_OFF = RING_BYTES + 4096;
constexpr int LDS_BYTES = 147456;

#define GAS __attribute__((address_space(1)))
#define LAS __attribute__((address_space(3)))
typedef unsigned short bf16;
typedef unsigned v4u __attribute__((ext_vector_type(4)));
typedef unsigned v2u __attribute__((ext_vector_type(2)));
typedef float f32x4 __attribute__((ext_vector_type(4)));
typedef short bf16x8 __attribute__((ext_vector_type(8)));
typedef short s16x4 __attribute__((ext_vector_type(4)));
#define LDS_WAIT() asm volatile("s_waitcnt lgkmcnt(0)" ::: "memory")
typedef float f32x2_t __attribute__((ext_vector_type(2))); typedef __bf16 bf16x2_t __attribute__((ext_vector_type(2)));
__device__ __forceinline__ unsigned pk2(float lo, float hi) { f32x2_t v = {lo, hi}; bf16x2_t b = __builtin_convertvector(v, bf16x2_t); return __builtin_bit_cast(unsigned, b); }
__device__ __forceinline__ float wave_sum(float v) {
#pragma unroll
    for (int o = 1; o < 64; o <<= 1) v += __shfl_xor(v, o);
    return v;
}

__device__ __forceinline__ void transpose_item(const float* W, int K, int N, bf16* WT, int row_off, const float* nscale, const float* kscale, LAS float* scr, int item, int lane) {
    const int nblk = N / 32, kb = item / nblk, nb = item % nblk, k0 = 64 * kb, n0 = 32 * nb;
    float wv[32];
#pragma unroll
    for (int i = 0; i < 32; ++i) wv[i] = W[(size_t)(k0 + 2 * i + (lane >> 5)) * N + n0 + (lane & 31)];
#pragma unroll
    for (int i = 0; i < 32; ++i) scr[(2 * i + (lane >> 5)) * 33 + (lane & 31)] = wv[i];
    LDS_WAIT(); asm volatile("" ::: "memory");
    const int c = lane & 7;
    float ks[8];
#pragma unroll
    for (int e = 0; e < 8; ++e) ks[e] = kscale ? kscale[k0 + 8 * c + e] : 1.f;
#pragma unroll
    for (int j = 0; j < 4; ++j) { const int n = (lane >> 3) + 8 * j; const LAS float* s = scr + (8 * c) * 33 + n;
        const float sc = nscale ? nscale[n0 + n] : 1.f;
        v4u o; o.x = pk2(s[0 * 33] * sc * ks[0], s[1 * 33] * sc * ks[1]); o.y = pk2(s[2 * 33] * sc * ks[2], s[3 * 33] * sc * ks[3]); o.z = pk2(s[4 * 33] * sc * ks[4], s[5 * 33] * sc * ks[5]); o.w = pk2(s[6 * 33] * sc * ks[6], s[7 * 33] * sc * ks[7]);
        *(GAS v4u*)(WT + (size_t)(row_off + n0 + n) * K + k0 + 8 * c) = o; }
    LDS_WAIT(); asm volatile("" ::: "memory");
}

struct Ptrs {
    const float *x_in[2], *norm_mix, *pool_w, *pool_scale, *w_qkv, *rpb, *w_o, *norm_mlp, *w_up, *w_down, *norm_final;
    float* out; unsigned char* ws;
};

__device__ __forceinline__ void prologue(const Ptrs& P, LAS unsigned char* lds, int gw, int NGW, int wave, int lane) {
    LAS float* scr = (LAS float*)(lds + wave * 16384);
    bf16* WPOOL = (bf16*)(P.ws + WS_WPOOL); bf16* WQKV = (bf16*)(P.ws + WS_WQKV); bf16* WO = (bf16*)(P.ws + WS_WO); bf16* WUP = (bf16*)(P.ws + WS_WUP); bf16* WDN = (bf16*)(P.ws + WS_WDN);
    constexpr int I_POOL = (256 / 64) * (256 / 32), I_QKV = (D / 64) * (3 * D / 32), I_O = (D / 64) * (D / 32), I_UP = (D / 64) * (FF / 32), I_DN = (FF / 64) * (D / 32);
    constexpr int NITEMS = 8 * I_POOL + 2 * I_QKV + 2 * I_O + 4 * I_UP + 4 * I_DN;
    for (int it = gw; it < NITEMS; it += NGW) {
        int r = it;
        if (r < 8 * I_POOL) { const int mtx = r / I_POOL, j = mtx >> 2, g = mtx & 3; transpose_item(P.pool_w + (size_t)mtx * 65536, 256, 256, WPOOL + (size_t)j * 1024 * 256, g * 256, P.pool_scale + j * 1024 + g * 256, nullptr, scr, r % I_POOL, lane); continue; } r -= 8 * I_POOL;
        if (r < 2 * I_QKV) { const int j = r / I_QKV; transpose_item(P.w_qkv + (size_t)j * D * 3 * D, D, 3 * D, WQKV + (size_t)j * 3 * D * D, 0, nullptr, P.norm_mix + (2 * j + 1) * D, scr, r % I_QKV, lane); continue; } r -= 2 * I_QKV;
        if (r < 2 * I_O) { const int j = r / I_O; transpose_item(P.w_o + (size_t)j * D * D, D, D, WO + (size_t)j * D * D, 0, nullptr, nullptr, scr, r % I_O, lane); continue; } r -= 2 * I_O;
        if (r < 4 * I_UP) { const int j = r / I_UP; transpose_item(P.w_up + (size_t)j * D * FF, D, FF, WUP + (size_t)j * D * FF, 0, nullptr, P.norm_mlp + j * D, scr, r % I_UP, lane); continue; } r -= 4 * I_UP;
        { const int j = r / I_DN; transpose_item(P.w_down + (size_t)j * D * FF, FF, D, WDN + (size_t)j * D * FF, 0, nullptr, nullptr, scr, r % I_DN, lane); }
    }
}

__device__ __forceinline__ void norm_rows_f32_inplace(float* x, const float* gain, int nrows, int gw, int NGW, int lane) {
    f32x4 g[4];
#pragma unroll
    for (int j = 0; j < 4; ++j) g[j] = *((const f32x4*)gain + lane + 64 * j);
    for (int m = gw * 4; m < nrows; m += NGW * 4) {
        GAS f32x4* xr = (GAS f32x4*)(x + (size_t)m * D) + lane;
        f32x4 v[4][4];
#pragma unroll
        for (int r = 0; r < 4; ++r)
#pragma unroll
            for (int j = 0; j < 4; ++j) v[r][j] = xr[r * 256 + 64 * j];
        __builtin_amdgcn_sched_barrier(0);
#pragma unroll
        for (int r = 0; r < 4; ++r) { float s = 0.f;
#pragma unroll
            for (int j = 0; j < 4; ++j) s += (v[r][j].x * v[r][j].x + v[r][j].y * v[r][j].y) + (v[r][j].z * v[r][j].z + v[r][j].w * v[r][j].w);
            const float rr = 1.0f / sqrtf(wave_sum(s) * (1.f / D) + RMS_EPS);
#pragma unroll
            for (int j = 0; j < 4; ++j) xr[r * 256 + 64 * j] = v[r][j] * rr * g[j]; }
    }
}

constexpr int PT = 32, PROWS = 48;
typedef float f32x2v __attribute__((ext_vector_type(2)));
__device__ __forceinline__ f32x2v bfpair(unsigned u) { return (f32x2v){__builtin_bit_cast(float, u << 16), __builtin_bit_cast(float, u & 0xffff0000u)}; }
template <int W> __device__ __forceinline__ void pool_rows_interior(const LAS unsigned* hcol, GAS unsigned* po) {
    constexpr int HW = W / 2; constexpr float INV = 1.0f / (float)W;
    f32x2v s = {0.f, 0.f};
#pragma unroll
    for (int o = -HW; o < HW; ++o) s += bfpair(hcol[(8 + o) * 512]);
#pragma unroll
    for (int tt = 0; tt < PT; ++tt) {
        const f32x2v c = bfpair(hcol[(8 + tt) * 512]);
        const f32x2v p = s * INV - c;
        po[(size_t)tt * 128] = pk2(p.x, p.y);
        if (tt + 1 < PT) s += bfpair(hcol[(8 + tt + HW) * 512]) - bfpair(hcol[(8 + tt - HW) * 512]);
    }
}
__device__ __forceinline__ void pool_load_rows(f32x4 (&v)[6][4], const float* x, int m0, int seq_len, int wave, int lane) {
    const int sb = m0 / seq_len * seq_len, t0 = m0 - sb;
#pragma unroll
    for (int k = 0; k < 6; ++k) { const int t = min(max(t0 - 8 + wave + NWAVES * k, 0), seq_len - 1);
        const GAS f32x4* xr = (const GAS f32x4*)(x + (size_t)(sb + t) * D) + lane;
#pragma unroll
        for (int j = 0; j < 4; ++j) v[k][j] = xr[64 * j]; }
}
__device__ __forceinline__ void pool_phase(LAS unsigned char* lds, const float* x, const float* gain, bf16* Pg, int seq_len, int vcu, int G, int tid, int wave, int lane) {
    f32x4 g[4];
#pragma unroll
    for (int j = 0; j < 4; ++j) g[j] = *((const f32x4*)gain + lane + 64 * j);
    const int grp = wave >> 1, w = 2 << grp, hw = w >> 1;
    f32x4 v[6][4];
    if (vcu < CH / PT) pool_load_rows(v, x, vcu * PT, seq_len, wave, lane);
    for (int tile = vcu; tile < CH / PT; tile += G) {
        const int m0 = tile * PT;
        const int sb = m0 / seq_len * seq_len;
        const int t0 = m0 - sb;
#pragma unroll
        for (int k = 0; k < 6; ++k) { float s = 0.f;
#pragma unroll
            for (int j = 0; j < 4; ++j) s += (v[k][j].x * v[k][j].x + v[k][j].y * v[k][j].y) + (v[k][j].z * v[k][j].z + v[k][j].w * v[k][j].w);
            const float r = 1.0f / sqrtf(wave_sum(s) * (1.f / D) + RMS_EPS);
            LAS v2u* hr = (LAS v2u*)(lds + (wave + NWAVES * k) * 2048) + lane;
#pragma unroll
            for (int j = 0; j < 4; ++j) { v2u o; o.x = pk2(v[k][j].x * r * g[j].x, v[k][j].y * r * g[j].y); o.y = pk2(v[k][j].z * r * g[j].z, v[k][j].w * r * g[j].w); hr[64 * j] = o; } }
        __syncthreads();
        if (tile + G < CH / PT) { pool_load_rows(v, x, (tile + G) * PT, seq_len, wave, lane); __builtin_amdgcn_sched_barrier(0); }
        const LAS unsigned* hcol = (const LAS unsigned*)lds + tid;
        GAS unsigned* po = (GAS unsigned*)(Pg + (size_t)grp * CH * 256 + (size_t)m0 * 256) + (tid & 127);
        if (t0 >= 8 && t0 + PT + 8 <= seq_len) {
            switch (grp) { case 0: pool_rows_interior<2>(hcol, po); break; case 1: pool_rows_interior<4>(hcol, po); break; case 2: pool_rows_interior<8>(hcol, po); break; default: pool_rows_interior<16>(hcol, po); break; }
        } else {
        for (int tt = 0; tt < PT; ++tt) {
            const int t = t0 + tt;
            const int lo = max(t - hw, 0), hi = min(t + hw - 1, seq_len - 1);
            float s0 = 0.f, s1 = 0.f;
            for (int q = lo; q <= hi; ++q) { const unsigned u = hcol[(q - t0 + 8) * 512]; s0 += __builtin_bit_cast(float, u << 16); s1 += __builtin_bit_cast(float, u & 0xffff0000u); }
            const unsigned uc = hcol[(tt + 8) * 512];
            const float inv = 1.0f / (float)(hi - lo + 1);
            po[(size_t)tt * 128] = pk2(s0 * inv - __builtin_bit_cast(float, uc << 16), s1 * inv - __builtin_bit_cast(float, uc & 0xffff0000u));
        }
        }
        __syncthreads();
    }
}

#define RLX_AGENT __ATOMIC_RELAXED, __HIP_MEMORY_SCOPE_AGENT
#define XB_TMO      128
#define XB_XCNT(j)  (256  + 64 * (j))
#define XB_XSUB(j)  (1280 + 64 * (j))
#define XB_XGEN(j)  (2304 + 64 * (j))
#define XB_TOP      3328
#define XB_TOPGEN   3392
#define XCD_BAR_WORDS 3456
#define XB_SPIN_CAP (1u << 18)

__device__ __forceinline__ unsigned xb_ld(unsigned* p)              { return __hip_atomic_load(p, __ATOMIC_RELAXED, __HIP_MEMORY_SCOPE_AGENT); }
__device__ __forceinline__ unsigned xb_add(unsigned* p, unsigned v) { return __hip_atomic_fetch_add(p, v, __ATOMIC_RELAXED, __HIP_MEMORY_SCOPE_AGENT); }
__device__ __forceinline__ unsigned xb_xcc_id() { return (unsigned)__builtin_amdgcn_s_getreg((3 << 11) | 20) & 0xFu; }
#define XB_SPIN(cond, bar) do { unsigned _sp = 0; while (cond) { __builtin_amdgcn_s_sleep(1); \
    if ((++_sp & 255u) == 0u) { if (xb_ld(&(bar)[XB_TMO])) break; if (_sp > XB_SPIN_CAP) { atomicAdd(&(bar)[XB_TMO], 1u); break; } } } } while (0)

struct XcdBarrier {
    unsigned* bar; unsigned x;
    volatile LAS unsigned* st;
};

__device__ __forceinline__ XcdBarrier xcd_barrier_post(unsigned* bar, volatile LAS unsigned* st) {
    XcdBarrier b; b.bar = bar; b.x = xb_xcc_id(); b.st = st;
    if (threadIdx.x == 0) (void)xb_add(&bar[XB_XCNT(b.x)], 1u);
    return b;
}
__device__ __forceinline__ void xcd_barrier_complete(unsigned* bar, unsigned x, unsigned& nloc, unsigned& nx) {
    const unsigned G = gridDim.x * gridDim.y * gridDim.z;
    unsigned sum, cnt, mine, sp = 0u;
    for (;;) {
        sum = 0u; cnt = 0u; mine = 0u;
#pragma unroll
        for (unsigned j = 0; j < 16; ++j) { const unsigned c = xb_ld(&bar[XB_XCNT(j)]); sum += c; cnt += (c > 0u) ? 1u : 0u; mine = (j == x) ? c : mine; }
        if (sum == G) break;
        __builtin_amdgcn_s_sleep(1);
        if ((++sp & 255u) == 0u) { if (xb_ld(&bar[XB_TMO])) break; if (sp > XB_SPIN_CAP) { atomicAdd(&bar[XB_TMO], 1u); break; } }
    }
    nloc = mine > 0u ? mine : 1u; nx = cnt > 0u ? cnt : 1u;
}

__device__ __forceinline__ void xcd_barrier(const XcdBarrier& b) {
    asm volatile("s_waitcnt vmcnt(0)" ::: "memory");
    __syncthreads();
    if (threadIdx.x == 0) {
        unsigned* bar = b.bar;
        __builtin_amdgcn_s_waitcnt(0);
        unsigned nloc = b.st[0], nx = b.st[1];
        if (nloc == 0u) { xcd_barrier_complete(bar, b.x, nloc, nx); b.st[0] = nloc; b.st[1] = nx; }
        const unsigned old = xb_add(&bar[XB_XSUB(b.x)], 1u);
        const unsigned gen = old / nloc;
        if (old + 1u == (gen + 1u) * nloc) {
            __builtin_amdgcn_fence(__ATOMIC_RELEASE, "agent");
            asm volatile("s_waitcnt vmcnt(0)" ::: "memory");
            const unsigned og = xb_add(&bar[XB_TOP], 1u);
            const unsigned tg = og / nx;
            if (og + 1u == (tg + 1u) * nx) xb_add(&bar[XB_TOPGEN], 1u);
            else XB_SPIN(xb_ld(&bar[XB_TOPGEN]) == tg, bar);
            __builtin_amdgcn_fence(__ATOMIC_ACQUIRE, "agent");
            xb_add(&bar[XB_XGEN(b.x)], 1u);
            asm volatile("s_waitcnt vmcnt(0)" ::: "memory");
        } else {
            XB_SPIN(xb_ld(&bar[XB_XGEN(b.x)]) == gen, bar);
            __builtin_amdgcn_fence(__ATOMIC_ACQUIRE, "agent");
            asm volatile("s_waitcnt vmcnt(0)" ::: "memory");
        }
    }
    __syncthreads();
}


__device__ __forceinline__ unsigned cvtpk(float lo, float hi) { return pk2(lo, hi); }
__device__ __forceinline__ s16x4 vtr(const LAS unsigned char* p) { return __builtin_bit_cast(s16x4, __builtin_amdgcn_ds_read_tr16_b64_v4i16((LAS s16x4*)p)); }
__device__ __forceinline__ void attn_phase(LAS unsigned char* lds, bf16* Qb, const bf16* Kb, const bf16* Vb, const float* rpb_l, int seq_len, int G, int bx, int tid, int wave, int lane) {
    const int fr = lane & 15, fq = lane >> 4;
    const int rows = seq_len >> 6, rows_shift = (seq_len == 2048) ? 5 : 6;
    constexpr int NI = (CH / 64) * 8;
    int nx, xc, lc, per;
    if ((G & 7) == 0) { nx = G >> 3; xc = bx & 7; lc = bx >> 3; per = NI >> 3; } else { nx = G; xc = 0; lc = bx; per = NI; }
    LAS float* bias = (LAS float*)(lds + BIAS_OFF);
    const int qb = wave & 3, hh = wave >> 2;
    const int qc = (qb < 3) ? (8 + 16 * qb + fr) : (fr < 8 ? fr : 48 + fr);
    const int a0 = (qb < 3) ? qb : 0, a1 = (qb < 3) ? qb + 1 : 3;
    const int wst = min(max(qc - 8, 0), 48);
    const int q4 = (lane & 15) >> 2, p4 = lane & 3;
    float madd[2][4];
#pragma unroll
    for (int ai = 0; ai < 2; ++ai)
#pragma unroll
        for (int i = 0; i < 4; ++i) { const int kc = 16 * (ai ? a1 : a0) + 4 * fq + i; madd[ai][i] = ((kc >= wst) && (kc < wst + 16)) ? 0.f : -1.0e30f; }
    int voff[4];
#pragma unroll
    for (int i3 = 0; i3 < 4; ++i3) voff[i3] = (lane >> 4) * D + (((lane & 15) ^ (((lane >> 4) << 2) | i3)) * 8);
    if (lc >= per) return;
    int id = xc * per + lc;
    int r = id & (rows - 1), hp = (id >> rows_shift) & 7, tb = (id >> (rows_shift + 3)) * seq_len, r0 = min(max(r - 4, 0), rows - 8);
    bf16x8 qf0, qf1, kf[4][2][2];
    float bnext[2];
#define ATT_PREFETCH() do { \
        const int h_ = 2 * hp + hh; const size_t qo_ = (size_t)(tb + r * 64 + qc) * D + h_ * 64; \
        qf0 = *(const GAS bf16x8*)(Qb + qo_ + 8 * fq); qf1 = *(const GAS bf16x8*)(Qb + qo_ + 32 + 8 * fq); \
        const bf16* kb_ = Kb + ((size_t)(h_ * 8 + fq) * CH + (tb + r0 * 64 + fr)) * 8; \
        _Pragma("unroll") for (int kr = 0; kr < 4; ++kr) _Pragma("unroll") for (int ai = 0; ai < 2; ++ai) { const bf16* kp = kb_ + (kr * 64 + 16 * (ai ? a1 : a0)) * 8; kf[kr][ai][0] = *(const GAS bf16x8*)kp; kf[kr][ai][1] = *(const GAS bf16x8*)(kp + (size_t)4 * CH * 8); } \
        bnext[0] = rpb_l[hp * 930 + tid] * LOG2E; bnext[1] = (tid + 512 < 930) ? rpb_l[hp * 930 + tid + 512] * LOG2E : 0.f; } while (0)
#define ATT_BIAS_WRITE() do { bias[tid] = bnext[0]; if (tid + 512 < 930) bias[tid + 512] = bnext[1]; } while (0)
    ATT_PREFETCH();
    ATT_BIAS_WRITE();
    for (int loc = lc; loc < per; loc += nx) {
        const int h = 2 * hp + hh;
        const size_t qoff = (size_t)(tb + r * 64 + qc) * D + h * 64;
        const bf16* kbase = Kb + ((size_t)(h * 8 + fq) * CH + (tb + r0 * 64 + fr)) * 8;
        const int drb = r0 - r + 7;
        __syncthreads();
        {
            const int a = wave >> 1, ub = (wave & 1) * 2;
#pragma unroll
            for (int i = 0; i < 16; ++i) { const int kr = 2 * (ub + (i >> 3)) + (i & 1), cb = 16 * a + 4 * ((i & 7) >> 1);
                const bf16* src = Vb + (size_t)(tb + (r0 + kr) * 64 + cb) * D + hp * 128 + voff[i & 3];
                __builtin_amdgcn_global_load_lds((const unsigned*)src, (LAS unsigned*)(lds + (wave * 16 + i) * 1024), 16, 0, 0); }
        }
        f32x4 S[8][2];
        float mx = -3.0e38f;
        const LAS float* bptr[2][4];
#pragma unroll
        for (int ai = 0; ai < 2; ++ai)
#pragma unroll
            for (int i = 0; i < 4; ++i) { const int kc = 16 * (ai ? a1 : a0) + 4 * fq + i; bptr[ai][i] = bias + hh * 465 + drb * 31 + min(max(kc - qc + 15, 0), 30); }
#pragma unroll
        for (int kr = 0; kr < 8; ++kr) {
#pragma unroll
            for (int ai = 0; ai < 2; ++ai) {
                f32x4 z = {0.f, 0.f, 0.f, 0.f};
                z = __builtin_amdgcn_mfma_f32_16x16x32_bf16(kf[kr & 3][ai][0], qf0, z, 0, 0, 0);
                z = __builtin_amdgcn_mfma_f32_16x16x32_bf16(kf[kr & 3][ai][1], qf1, z, 0, 0, 0);
#pragma unroll
                for (int i = 0; i < 4; ++i) { z[i] = (z[i] + bptr[ai][i][kr * 31]) + madd[ai][i]; mx = fmaxf(mx, z[i]); }
                S[kr][ai] = z;
            }
            if (kr < 4) {
#pragma unroll
                for (int ai = 0; ai < 2; ++ai) { const bf16* kp = kbase + ((kr + 4) * 64 + 16 * (ai ? a1 : a0)) * 8; kf[kr & 3][ai][0] = *(const GAS bf16x8*)kp; kf[kr & 3][ai][1] = *(const GAS bf16x8*)(kp + (size_t)4 * CH * 8); }
            }
            __builtin_amdgcn_sched_barrier(0);
        }
        mx = fmaxf(mx, __shfl_xor(mx, 16)); mx = fmaxf(mx, __shfl_xor(mx, 32));
        float sum = 0.f;
#pragma unroll
        for (int kr = 0; kr < 8; ++kr)
#pragma unroll
            for (int ai = 0; ai < 2; ++ai)
#pragma unroll
                for (int i = 0; i < 4; ++i) { const float p = __builtin_amdgcn_exp2f(S[kr][ai][i] - mx); S[kr][ai][i] = p; sum += p; }
        sum += __shfl_xor(sum, 16); sum += __shfl_xor(sum, 32);
        bf16x8 pf[4][2];
#pragma unroll
        for (int u = 0; u < 4; ++u)
#pragma unroll
            for (int ai = 0; ai < 2; ++ai) { v4u pw; pw.x = cvtpk(S[2 * u][ai][0], S[2 * u][ai][1]); pw.y = cvtpk(S[2 * u][ai][2], S[2 * u][ai][3]); pw.z = cvtpk(S[2 * u + 1][ai][0], S[2 * u + 1][ai][1]); pw.w = cvtpk(S[2 * u + 1][ai][2], S[2 * u + 1][ai][3]);
                pf[u][ai] = __builtin_bit_cast(bf16x8, pw); }
        asm volatile("s_waitcnt vmcnt(0)" ::: "memory");
        __syncthreads();
        const int nloc = loc + nx; const bool has_next = nloc < per;
        const int r_cur = r, tb_cur = tb;
        if (has_next) { id = xc * per + nloc; r = id & (rows - 1); hp = (id >> rows_shift) & 7; tb = (id >> (rows_shift + 3)) * seq_len; r0 = min(max(r - 4, 0), rows - 8); ATT_PREFETCH(); }
        (void)r_cur; (void)tb_cur;
        f32x4 O[4];
#pragma unroll
        for (int c = 0; c < 4; ++c) O[c] = (f32x4){0.f, 0.f, 0.f, 0.f};
        const LAS unsigned char* vb[2][2][4];
#pragma unroll
        for (int ai = 0; ai < 2; ++ai)
#pragma unroll
            for (int t = 0; t < 2; ++t)
#pragma unroll
                for (int c = 0; c < 4; ++c) { const int rho = 8 * fq + 4 * t + q4, chn = 2 * (4 * hh + c) + (p4 >> 1);
                    vb[ai][t][c] = lds + (ai ? a1 : a0) * 32768 + 256 * rho + 16 * (chn ^ (((rho & 3) << 2) | ((rho >> 2) & 3))) + 8 * (p4 & 1); }
#pragma unroll
        for (int u = 0; u < 4; ++u) {
#pragma unroll
            for (int ai = 0; ai < 2; ++ai) {
#pragma unroll
                for (int c = 0; c < 4; ++c) {
                    const s16x4 v0 = vtr(vb[ai][0][c] + u * 8192), v1 = vtr(vb[ai][1][c] + u * 8192);
                    const bf16x8 vf = __builtin_shufflevector(v0, v1, 0, 1, 2, 3, 4, 5, 6, 7);
                    O[c] = __builtin_amdgcn_mfma_f32_16x16x32_bf16(vf, pf[u][ai], O[c], 0, 0, 0);
                }
            }
            __builtin_amdgcn_sched_barrier(0);
        }
        const float inv = 1.0f / sum;
#pragma unroll
        for (int c = 0; c < 4; ++c) { v2u w; w.x = cvtpk(O[c][0] * inv, O[c][1] * inv); w.y = cvtpk(O[c][2] * inv, O[c][3] * inv);
            *(GAS v2u*)(Qb + qoff + 16 * c + 4 * fq) = w; }
        if (has_next) ATT_BIAS_WRITE();
    }
    __syncthreads();
#undef ATT_PREFETCH
#undef ATT_BIAS_WRITE
}
enum { K_POOL = 1, K_GEMM_RES = 3, K_GEMM_QKV = 4, K_GEMM_UP = 5, K_ATTN = 6, K_FINAL = 7 };
enum { F_A_X = 1, F_A_IN = 2, F_AUX_X = 4, F_AUX_IN = 8 };
struct Ph { int kind, flags, N, K; const void* A; const void* B; void* C; const void* aux; float* st; float* rs; unsigned long long a_pn_stride, pad; };
constexpr int PPC = 19;
struct Args { Ptrs p; Ph tab[PPC]; };
__global__ void __launch_bounds__(NWAVES * 64, 2) fwd_megakernel(Args args) {
    extern __shared__ __attribute__((aligned(16))) unsigned char lds_raw[];
    cg::grid_group grid = cg::this_grid();
    LAS unsigned char* lds = (LAS unsigned char*)lds_raw;
    volatile LAS unsigned* MISC = (volatile LAS unsigned*)(lds + MISC_OFF);
    for (int u = threadIdx.x; u < 32; u += NWAVES * 64) MISC[u] = 0u;
    __syncthreads();
    const XcdBarrier bar = xcd_barrier_post((unsigned*)(args.p.ws + WS_CTL), MISC + 8);
    {
        const int tid = threadIdx.x, lane = tid & 63, wave = __builtin_amdgcn_readfirstlane(tid >> 6);
        const int G = gridDim.x, bx = blockIdx.x;
        const int vcu = (G % 8 == 0) ? (bx % 8) * (G / 8) + bx / 8 : bx;
        prologue(args.p, lds, vcu * NWAVES + wave, G * NWAVES, wave, lane);
    }
    grid.sync();

    for (int ph = 0; ph < NCHUNK * PPC; ++ph) {
        int tid = threadIdx.x; asm volatile("" : "+v"(tid));
        int G = gridDim.x, bx = blockIdx.x; asm volatile("" : "+s"(G), "+s"(bx));
        const int lane = tid & 63, wave = __builtin_amdgcn_readfirstlane(tid >> 6);
        const int vcu = (G % 8 == 0) ? (bx % 8) * (G / 8) + bx / 8 : bx;
        const int gw = vcu * NWAVES + wave, NGW = G * NWAVES;
        const int ck = ph / PPC, idx = ph - ck * PPC;
        const Ph d = args.tab[idx];
        const int tok0 = ck * CH, grp = tok0 / GROUP_TOK, seq_len = grp ? 4096 : 2048;
        const float* xin = args.p.x_in[grp] + (size_t)(tok0 - grp * GROUP_TOK) * D;
        float* X = args.p.out + (size_t)tok0 * D;
        const void* A = (d.flags & F_A_X) ? (const void*)X : (d.flags & F_A_IN) ? (const void*)xin : d.A;
        const void* aux = (d.flags & F_AUX_X) ? (const void*)X : (d.flags & F_AUX_IN) ? (const void*)xin : d.aux;
        switch (d.kind) {
        case K_POOL: pool_phase(lds, (const float*)A, (const float*)aux, (bf16*)d.C, seq_len, vcu, G, tid, wave, lane); break;
        case K_GEMM_RES: { pg8::Gemm g{(const bf16*)A, (const bf16*)d.B, CH, d.N, d.K, (size_t)d.a_pn_stride}; pg8::StaticOrder S; S.init(CH, d.N, G, bx);
            pg8::EpiRes E{(const float*)aux, X, (bf16*)d.C, d.st, D, d.rs};
            pg8::gemm_phase<pg8::EpiRes, pg8::StaticOrder, PG8_ALIGN, PG8_SP2>(lds, g, S, E, tid); } break;
        case K_GEMM_QKV: { pg8::Gemm g{(const bf16*)A, (const bf16*)d.B, CH, d.N, d.K, 0}; pg8::StaticOrder S; S.init(CH, d.N, G, bx);
            pg8::EpiBf16<0, true> E{(bf16*)d.C, D, D, (size_t)CH * D, 0.125f * LOG2E, d.st};
            pg8::gemm_phase<pg8::EpiBf16<0, true>, pg8::StaticOrder, PG8_ALIGN, PG8_SP2>(lds, g, S, E, tid); } break;
        case K_GEMM_UP: { pg8::Gemm g{(const bf16*)A, (const bf16*)d.B, CH, d.N, d.K, 0}; pg8::StaticOrder S; S.init(CH, d.N, G, bx);
            pg8::EpiBf16<2, false> E{(bf16*)d.C, FF, 0, 0, 1.f, nullptr};
            pg8::gemm_phase<pg8::EpiBf16<2, false>, pg8::StaticOrder, PG8_ALIGN, PG8_SP2>(lds, g, S, E, tid); } break;
        case K_ATTN: attn_phase(lds, (bf16*)d.C, (const bf16*)d.C + (size_t)CH * D, (const bf16*)d.C + 2 * (size_t)CH * D, (const float*)aux, seq_len, G, bx, tid, wave, lane); break;
        default: norm_rows_f32_inplace(X, (const float*)aux, CH, gw, NGW, lane); break;
        }
        if (d.kind != K_FINAL) xcd_barrier(bar);
    }
}

extern "C" void kernel_launch(void* const* d_in, const int* in_sizes, int n_in, void* d_out, int out_size, void* d_ws, size_t ws_size, hipStream_t stream) {
    static int grid = 0;
    if (grid == 0) {
        if (n_in != 12 || in_sizes[0] != GROUP_TOK * D || in_sizes[1] != GROUP_TOK * D || out_size != NTOK * D || ws_size < WS_END) {
            fprintf(stderr, "kernel_launch: unexpected shapes (n_in %d, out %d, ws %zu < %zu); nothing launched\n", n_in, out_size, ws_size, (size_t)WS_END); grid = -1; return; }
        int dev = 0, cus = 0, per_cu = 0;
        if (hipGetDevice(&dev) != hipSuccess || hipDeviceGetAttribute(&cus, hipDeviceAttributeMultiprocessorCount, dev) != hipSuccess) { fprintf(stderr, "kernel_launch: device query failed\n"); grid = -1; return; }
        if (hipFuncSetAttribute((const void*)fwd_megakernel, hipFuncAttributeMaxDynamicSharedMemorySize, LDS_BYTES) != hipSuccess) { fprintf(stderr, "kernel_launch: hipFuncSetAttribute failed\n"); grid = -1; return; }
        if (hipOccupancyMaxActiveBlocksPerMultiprocessor(&per_cu, (const void*)fwd_megakernel, NWAVES * 64, LDS_BYTES) != hipSuccess || per_cu < 1) { fprintf(stderr, "kernel_launch: occupancy query gave %d\n", per_cu); per_cu = 1; }
        (void)hipGetLastError();
        grid = cus * per_cu;
    }
    if (grid < 0) return;
    if (hipMemsetAsync((char*)d_ws + WS_CTL, 0, CTL_ZERO_BYTES, stream) != hipSuccess) { fprintf(stderr, "kernel_launch: hipMemsetAsync failed\n"); return; }
    Args a{};
    Ptrs& p = a.p;
    p.x_in[0] = (const float*)d_in[0]; p.x_in[1] = (const float*)d_in[1]; p.norm_mix = (const float*)d_in[2]; p.pool_w = (const float*)d_in[3]; p.pool_scale = (const float*)d_in[4];
    p.w_qkv = (const float*)d_in[5]; p.rpb = (const float*)d_in[6]; p.w_o = (const float*)d_in[7]; p.norm_mlp = (const float*)d_in[8]; p.w_up = (const float*)d_in[9];
    p.w_down = (const float*)d_in[10]; p.norm_final = (const float*)d_in[11]; p.out = (float*)d_out; p.ws = (unsigned char*)d_ws;
    unsigned char* ws = (unsigned char*)d_ws;
    bf16* WPOOL = (bf16*)(ws + WS_WPOOL); bf16* WQKV = (bf16*)(ws + WS_WQKV); bf16* WO = (bf16*)(ws + WS_WO); bf16* WUP = (bf16*)(ws + WS_WUP); bf16* WDN = (bf16*)(ws + WS_WDN);
    bf16* XN = (bf16*)(ws + WS_XN); bf16* PG = (bf16*)(ws + WS_PG); bf16* QB = (bf16*)(ws + WS_ACT); bf16* HB = (bf16*)(ws + WS_ACT);
    float* SA = (float*)(ws + WS_STAT); float* SB = SA + (size_t)CH * 16;
    int n = 0;
    auto add = [&](int kind, int flags, int N, int K, const void* A, const void* B, void* C, const void* aux, float* st, float* rs, unsigned long long aps) {
        Ph& d = a.tab[n++]; d.kind = kind; d.flags = flags; d.N = N; d.K = K; d.A = A; d.B = B; d.C = C; d.aux = aux; d.st = st; d.rs = rs; d.a_pn_stride = aps; d.pad = 0; };
    for (int layer = 0; layer < DEPTH; ++layer) {
        const int j = layer >> 1;
        if ((layer & 1) == 0) {
            add(K_POOL, layer == 0 ? F_A_IN : F_A_X, 0, 0, nullptr, nullptr, PG, p.norm_mix + layer * D, nullptr, nullptr, 0);
            add(K_GEMM_RES, layer == 0 ? F_AUX_IN : F_AUX_X, D, 256, PG, WPOOL + (size_t)j * 1024 * 256, XN, nullptr, SA, nullptr, (unsigned long long)CH * 256 * 2);
        } else {
            add(K_GEMM_QKV, 0, 3 * D, D, XN, WQKV + (size_t)j * 3 * D * D, QB, nullptr, SB, nullptr, 0);
            add(K_ATTN, 0, 0, 0, nullptr, nullptr, QB, p.rpb + (size_t)j * NH * 15 * 31, nullptr, nullptr, 0);
            add(K_GEMM_RES, F_AUX_X, D, D, QB, WO + (size_t)j * D * D, XN, nullptr, SA, nullptr, 0);
        }
        add(K_GEMM_UP, 0, FF, D, XN, WUP + (size_t)layer * D * FF, HB, nullptr, SA, nullptr, 0);
        add(K_GEMM_RES, F_AUX_X, D, FF, HB, WDN + (size_t)layer * D * FF, (layer & 1) == 0 ? XN : nullptr, nullptr, SB, SA, 0);
    }
    add(K_FINAL, 0, 0, 0, nullptr, nullptr, nullptr, p.norm_final, nullptr, nullptr, 0);
    if (n != PPC) { fprintf(stderr, "kernel_launch: phase table has %d entries, expected %d\n", n, PPC); return; }
    void* kargs[] = {&a};
    hipError_t e = hipLaunchCooperativeKernel((const void*)fwd_megakernel, dim3(grid), dim3(NWAVES * 64), kargs, LDS_BYTES, stream);
    if (e != hipSuccess) fprintf(stderr, "kernel_launch: cooperative launch failed: %s (grid %d)\n", hipGetErrorString(e), grid);
}
```

```cpp
#include <hip/hip_runtime.h>
#include <hip/hip_cooperative_groups.h>
#include <cstdio>
#include <cstdint>
namespace cg = cooperative_groups;
namespace pg8 {
#define PG8_LAS __attribute__((address_space(3)))
typedef unsigned short bf16_t;
typedef short bf16x8 __attribute__((ext_vector_type(8)));
typedef float f32x4 __attribute__((ext_vector_type(4)));
typedef unsigned u32x4 __attribute__((ext_vector_type(4)));
constexpr int BM = 256, BK = 64, HALF = 128, HTB = HALF * BK * 2  , STAGE_BYTES = 8 * HTB, NXCD = 8, WGM = 8;

__host__ __device__ __forceinline__ int lds_byte(int r, int c) { const int st = (r >> 4) * 2 + (c >> 5), rr = r & 15, cc = c & 31, ob = rr * 64 + cc * 2; return st * 1024 + (ob ^ (((ob >> 9) & 1) << 5)); }
__host__ __device__ __forceinline__ void stage_rc(int b, int& R, int& C) { const int st = b / 1024, sb = b % 1024, swz = sb ^ (((sb >> 9) & 1) << 5); R = (st >> 1) * 16 + swz / 64; C = (st & 1) * 32 + (swz % 64) / 2; }
__host__ __device__ __forceinline__ int perm32(int rho) { const int n = rho >> 4, i = rho & 15; return 8 * (i >> 2) + 4 * n + (i & 3); }

struct Unit { int pm, pn; };
struct Gemm { const bf16_t* A; const bf16_t* Bt; int M, N, K; size_t a_pn_stride; };

struct StaticOrder {
    int nM, nN, nwg, G, c;
    __host__ __device__ void init(int M, int N, int G_, int c_) { nM = M / BM; nN = N / BM; nwg = nM * nN; G = G_; c = c_; }
    __host__ __device__ bool next(int i, Unit& u) const {
        const long L = (long)i * G + c; if (L >= nwg) return false;
        int wgid = (int)L; { const int q = nwg / NXCD, r = nwg % NXCD, xcd = wgid % NXCD, off = wgid / NXCD; wgid = (xcd < r ? xcd * (q + 1) : r * (q + 1) + (xcd - r) * q) + off; }
        const int nig = WGM * nN, gid = wgid / nig, fm = gid * WGM, gsz = (nM - fm) < WGM ? (nM - fm) : WGM;
        u.pm = fm + ((wgid % nig) % gsz); u.pn = (wgid % nig) / gsz; return true;
    }
    __device__ __forceinline__ void a_ready(const Unit&) const {}
    __device__ __forceinline__ void done(const Unit&) const {}
};

__device__ __forceinline__ unsigned cvt_pk_bf16(float lo, float hi) { unsigned r; asm volatile("v_cvt_pk_bf16_f32 %0, %1, %2" : "=v"(r) : "v"(lo), "v"(hi)); return r; }
typedef float f32x2 __attribute__((ext_vector_type(2)));
template <int ACT, bool RS> struct EpiBf16 {
    static constexpr bool PERM = true, AFTER_DRAIN = false;
    bf16_t* O; int ldc; int split_cols; size_t split_stride; float scale0; const float* st;
    __device__ __forceinline__ void operator()(const f32x4 (&acc)[2][2][4][2], const Unit& u, int wr, int wc, int fr, int fq) const {
        const int row0 = u.pm * BM + wr * 64 + fr; int colt = u.pn * BM; bf16_t* base = O;
        float sc = 1.f; bool kplane = false;
        if (split_cols) { const int t = colt / split_cols; base += (size_t)t * split_stride; colt -= t * split_cols; if (t == 0) sc = scale0; kplane = (t == 1); }
        const size_t kprows = split_stride / 1024;
        const int col0 = colt + wc * 32 + 8 * fq;
        f32x4 pv[2][4];
        if (RS) {
#pragma unroll
            for (int ai = 0; ai < 2; ++ai)
#pragma unroll
                for (int m = 0; m < 4; ++m) pv[ai][m] = *(const f32x4*)(st + (size_t)(row0 + ai * HALF + m * 16) * 16 + 4 * fq);
            __builtin_amdgcn_sched_barrier(0);
        }
#pragma unroll
        for (int ai = 0; ai < 2; ++ai)
#pragma unroll
            for (int m = 0; m < 4; ++m) { const int row = row0 + ai * HALF + m * 16; bf16_t* rowp = base + (size_t)row * ldc + col0;
                float f = sc;
                if (RS) { float ss = (pv[ai][m][0] + pv[ai][m][1]) + (pv[ai][m][2] + pv[ai][m][3]); ss += __shfl_xor(ss, 16); ss += __shfl_xor(ss, 32);
                    const float r = __builtin_amdgcn_rsqf(ss * (1.0f / 1024.0f) + 1e-6f); f *= (ACT == 2) ? r * r : r; }
#pragma unroll
                for (int bj = 0; bj < 2; ++bj) { f32x4 v0 = acc[ai][bj][m][0], v1 = acc[ai][bj][m][1];
                    if (ACT == 2) {
#pragma unroll
                        for (int e = 0; e < 4; ++e) { const float a = fmaxf(v0[e], 0.f), b = fmaxf(v1[e], 0.f); v0[e] = a * a; v1[e] = b * b; } }
                    v0 = v0 * f; v1 = v1 * f; u32x4 w; w.x = cvt_pk_bf16(v0[0], v0[1]); w.y = cvt_pk_bf16(v0[2], v0[3]); w.z = cvt_pk_bf16(v1[0], v1[1]); w.w = cvt_pk_bf16(v1[2], v1[3]);
                    if (kplane) *(u32x4*)(base + ((size_t)(((colt >> 6) + 2 * bj + (wc >> 1)) * 8 + (wc & 1) * 4 + fq) * kprows + row) * 8) = w;
                    else *(u32x4*)(rowp + bj * HALF) = w; } }
    }
};
struct EpiRes {
    static constexpr bool PERM = true, AFTER_DRAIN = false;
    const float* base; float* out; bf16_t* xn; float* st; int ldc; const float* rs;
    __device__ __forceinline__ void operator()(const f32x4 (&acc)[2][2][4][2], const Unit& u, int wr, int wc, int fr, int fq) const {
        const int col0 = u.pn * BM + wc * 32 + 8 * fq;
#pragma unroll
        for (int ai = 0; ai < 2; ++ai) {
            f32x4 rp[4];
            if (rs) {
#pragma unroll
                for (int m = 0; m < 4; ++m) rp[m] = *(const f32x4*)(rs + (size_t)(u.pm * BM + ai * HALF + wr * 64 + m * 16 + fr) * 16 + 4 * fq);
            }
            f32x4 bs[4][2][2];
#pragma unroll
            for (int m = 0; m < 4; ++m) { const size_t off = (size_t)(u.pm * BM + ai * HALF + wr * 64 + m * 16 + fr) * ldc + col0;
#pragma unroll
                for (int bj = 0; bj < 2; ++bj) { bs[m][bj][0] = *(const f32x4*)(base + off + bj * HALF); bs[m][bj][1] = *(const f32x4*)(base + off + bj * HALF + 4); } }
            __builtin_amdgcn_sched_barrier(0);
#pragma unroll
            for (int m = 0; m < 4; ++m) { const int row = u.pm * BM + ai * HALF + wr * 64 + m * 16 + fr; const size_t off = (size_t)row * ldc + col0; float ss = 0.f;
                float f = 1.f;
                if (rs) { float q = (rp[m][0] + rp[m][1]) + (rp[m][2] + rp[m][3]); q += __shfl_xor(q, 16); q += __shfl_xor(q, 32); const float r = __builtin_amdgcn_rsqf(q * (1.0f / 1024.0f) + 1e-6f); f = r * r; }
#pragma unroll
                for (int bj = 0; bj < 2; ++bj) {
                    const f32x4 o0 = bs[m][bj][0] + acc[ai][bj][m][0] * f, o1 = bs[m][bj][1] + acc[ai][bj][m][1] * f;
                    *(f32x4*)(out + off + bj * HALF) = o0; *(f32x4*)(out + off + bj * HALF + 4) = o1;
                    if (xn) { u32x4 w; w.x = cvt_pk_bf16(o0[0], o0[1]); w.y = cvt_pk_bf16(o0[2], o0[3]); w.z = cvt_pk_bf16(o1[0], o1[1]); w.w = cvt_pk_bf16(o1[2], o1[3]);
                        *(u32x4*)(xn + off + bj * HALF) = w;
                        ss += (o0[0] * o0[0] + o0[1] * o0[1]) + (o0[2] * o0[2] + o0[3] * o0[3]) + (o1[0] * o1[0] + o1[1] * o1[1]) + (o1[2] * o1[2] + o1[3] * o1[3]); } }
                if (xn) { ss += __shfl_xor(ss, 16); ss += __shfl_xor(ss, 32); if (fq == 0) st[(size_t)row * 16 + u.pn * 4 + wc] = ss; } }
            __builtin_amdgcn_sched_barrier(0);
        }
    }
};
template <class Epi, class Sched, bool ALIGN_EPI = false, bool SP2 = false>
__device__ __forceinline__ void gemm_phase(PG8_LAS unsigned char* lds, const Gemm g, const Sched& S, const Epi& E, const int tid_in) {
    const int tid = tid_in, wid = __builtin_amdgcn_readfirstlane(tid >> 6), lane = tid & 63, wr = wid >> 2, wc = wid & 3, fr = lane & 15, fq = lane >> 4;
    const int K = g.K, nt = K / BK;
    unsigned voffA[2], voffB[2];
#pragma unroll
    for (int i = 0; i < 2; ++i) { int R, C; stage_rc(tid * 16 + i * 8192, R, C); const int Rb = Epi::PERM ? ((R & ~31) + perm32(R & 31)) : R;
        voffA[i] = (unsigned)(R * K + C) * 2u; voffB[i] = (unsigned)(Rb * K + C) * 2u; }
    const size_t kstep = (size_t)(BK * 2);
    const size_t hstep = (size_t)HALF * K * 2;
    const size_t tstep = 2 * hstep;
    const unsigned ldsw = (unsigned)wid * 1024u;
    const int aoff = lds_byte(wr * 64 + fr, fq * 8), boff = lds_byte(wc * 32 + fr, fq * 8);
#define PG8_SA(b, h) (((b) * 2 + (h)) * HTB)
#define PG8_SB(b, h) ((4 + (b) * 2 + (h)) * HTB)
#define PG8_STAGE(bufoff, gbase, voff) do { _Pragma("unroll") for (int _i = 0; _i < 2; ++_i) \
        __builtin_amdgcn_global_load_lds((const unsigned*)((const char*)(gbase) + (voff)[_i]), (PG8_LAS unsigned*)(lds + (bufoff) + ldsw + _i * 8192), 16, 0, 0); } while (0)
#define PG8_LDA(dst, b, h) do { _Pragma("unroll") for (int m = 0; m < 4; ++m) _Pragma("unroll") for (int k = 0; k < 2; ++k) dst[m][k] = *(const PG8_LAS bf16x8*)(lds + PG8_SA(b, h) + aoff + m * 2048 + k * 1024); } while (0)
#define PG8_LDB(dst, b, h) do { _Pragma("unroll") for (int n = 0; n < 2; ++n) _Pragma("unroll") for (int k = 0; k < 2; ++k) dst[n][k] = *(const PG8_LAS bf16x8*)(lds + PG8_SB(b, h) + boff + n * 2048 + k * 1024); } while (0)
#define PG8_MMA(ai, bj, At, Bt) do { __builtin_amdgcn_s_setprio(1); _Pragma("unroll") for (int m = 0; m < 4; ++m) _Pragma("unroll") for (int n = 0; n < 2; ++n) _Pragma("unroll") for (int k = 0; k < 2; ++k) \
        acc[ai][bj][m][n] = __builtin_amdgcn_mfma_f32_16x16x32_bf16(Bt[n][k], At[m][k], acc[ai][bj][m][n], 0, 0, 0); __builtin_amdgcn_s_setprio(0); } while (0)
#define PG8_WAIT_V(n) asm volatile("s_waitcnt vmcnt(" #n ")" ::: "memory")
#define PG8_WAIT_L(n) asm volatile("s_waitcnt lgkmcnt(" #n ")" ::: "memory")
#define PG8_BAR __builtin_amdgcn_s_barrier()
#define PG8_SCHED __builtin_amdgcn_sched_barrier(0)
    Unit cur, nxt; int ui = 0;
    if (!S.next(0, cur)) return;
    f32x4 acc[2][2][4][2];
#pragma unroll
    for (int a = 0; a < 2; ++a)
#pragma unroll
        for (int b = 0; b < 2; ++b)
#pragma unroll
            for (int m = 0; m < 4; ++m)
#pragma unroll
                for (int n = 0; n < 2; ++n) acc[a][b][m][n] = (f32x4){0.f, 0.f, 0.f, 0.f};
    bf16x8 At[4][2], B0[2][2], B1[2][2];
    const char* cA = (const char*)g.A + (size_t)cur.pm * tstep + (size_t)cur.pn * g.a_pn_stride; const char* cB = (const char*)g.Bt + (size_t)cur.pn * tstep;
    S.a_ready(cur);
    if constexpr (SP2) {
        PG8_STAGE(PG8_SB(0, 0), cB, voffB); PG8_STAGE(PG8_SB(0, 1), cB + hstep, voffB); PG8_STAGE(PG8_SA(0, 0), cA, voffA); PG8_STAGE(PG8_SA(0, 1), cA + hstep, voffA);
        if (wr == 1) PG8_BAR;
        PG8_WAIT_V(2); PG8_BAR;
        PG8_STAGE(PG8_SB(1, 0), cB + kstep, voffB); PG8_STAGE(PG8_SA(1, 0), cA + kstep, voffA); PG8_STAGE(PG8_SB(1, 1), cB + hstep + kstep, voffB);
        PG8_WAIT_V(6); PG8_BAR;
    } else {
        PG8_STAGE(PG8_SB(0, 0), cB, voffB); PG8_STAGE(PG8_SA(0, 0), cA, voffA); PG8_STAGE(PG8_SB(0, 1), cB + hstep, voffB); PG8_STAGE(PG8_SA(0, 1), cA + hstep, voffA);
        if (wr == 1) PG8_BAR;
        PG8_WAIT_V(4); PG8_BAR;
        PG8_STAGE(PG8_SB(1, 0), cB + kstep, voffB); PG8_STAGE(PG8_SA(1, 0), cA + kstep, voffA); PG8_STAGE(PG8_SB(1, 1), cB + hstep + kstep, voffB);
        PG8_WAIT_V(6); PG8_BAR;
    }
    for (;;) {
        const bool has_next = S.next(ui + 1, nxt);
        const char* nA = has_next ? (const char*)g.A + (size_t)nxt.pm * tstep + (size_t)nxt.pn * g.a_pn_stride : cA; const char* nB = has_next ? (const char*)g.Bt + (size_t)nxt.pn * tstep : cB;
        for (int t = 0; t < nt; t += 2) {
            const bool last = (t == nt - 2);
            const char* a1 = cA + (size_t)(t + 1) * kstep;
            const char* a2 = last ? nA : cA + (size_t)(t + 2) * kstep; const char* b2 = last ? nB : cB + (size_t)(t + 2) * kstep;
            const char* a3 = a2 + kstep; const char* b3 = b2 + kstep;
            if (last && has_next) S.a_ready(nxt);
            if constexpr (SP2) {
            PG8_LDB(B0, 0, 0); PG8_LDB(B1, 0, 1); PG8_SCHED; PG8_LDA(At, 0, 0); PG8_STAGE(PG8_SA(1, 1), a1 + hstep, voffA);
            PG8_WAIT_V(8); PG8_WAIT_L(0); PG8_BAR; PG8_MMA(0, 0, At, B0); PG8_MMA(0, 1, At, B1); PG8_BAR; PG8_SCHED;
            PG8_LDA(At, 0, 1); PG8_STAGE(PG8_SB(0, 0), b2, voffB); PG8_STAGE(PG8_SB(0, 1), b2 + hstep, voffB); PG8_STAGE(PG8_SA(0, 0), a2, voffA);
            PG8_WAIT_V(8); PG8_WAIT_L(0); PG8_BAR; PG8_MMA(1, 0, At, B0); PG8_MMA(1, 1, At, B1); PG8_BAR; PG8_SCHED;
            PG8_LDB(B0, 1, 0); PG8_LDB(B1, 1, 1); PG8_SCHED; PG8_LDA(At, 1, 0); PG8_STAGE(PG8_SA(0, 1), a2 + hstep, voffA);
            PG8_WAIT_V(8); PG8_WAIT_L(0); PG8_BAR; PG8_MMA(0, 0, At, B0); PG8_MMA(0, 1, At, B1); PG8_BAR; PG8_SCHED;
            PG8_LDA(At, 1, 1); PG8_STAGE(PG8_SB(1, 0), b3, voffB); PG8_STAGE(PG8_SB(1, 1), b3 + hstep, voffB); PG8_STAGE(PG8_SA(1, 0), a3, voffA);
            PG8_WAIT_V(8); PG8_WAIT_L(0); PG8_BAR; PG8_MMA(1, 0, At, B0); PG8_MMA(1, 1, At, B1); PG8_BAR; PG8_SCHED;
            } else {
            PG8_LDB(B0, 0, 0); PG8_SCHED; PG8_LDA(At, 0, 0); PG8_STAGE(PG8_SA(1, 1), a1 + hstep, voffA);
            PG8_WAIT_L(8); PG8_BAR; PG8_WAIT_L(0); PG8_MMA(0, 0, At, B0); PG8_BAR; PG8_SCHED;
            PG8_LDB(B1, 0, 1); PG8_STAGE(PG8_SB(0, 0), b2, voffB);
            PG8_BAR; PG8_WAIT_L(0); PG8_MMA(0, 1, At, B1); PG8_BAR;
            PG8_LDA(At, 0, 1); PG8_STAGE(PG8_SA(0, 0), a2, voffA);
            PG8_BAR; PG8_WAIT_L(0); PG8_MMA(1, 0, At, B0); PG8_BAR; PG8_SCHED;
            PG8_STAGE(PG8_SB(0, 1), b2 + hstep, voffB);
            PG8_WAIT_V(6); PG8_BAR; PG8_MMA(1, 1, At, B1); PG8_BAR;
            PG8_LDB(B0, 1, 0); PG8_SCHED; PG8_LDA(At, 1, 0); PG8_STAGE(PG8_SA(0, 1), a2 + hstep, voffA);
            PG8_WAIT_L(8); PG8_BAR; PG8_WAIT_L(0); PG8_MMA(0, 0, At, B0); PG8_BAR; PG8_SCHED;
            PG8_LDB(B1, 1, 1); PG8_STAGE(PG8_SB(1, 0), b3, voffB);
            PG8_BAR; PG8_WAIT_L(0); PG8_MMA(0, 1, At, B1); PG8_BAR;
            PG8_LDA(At, 1, 1); PG8_STAGE(PG8_SA(1, 0), a3, voffA);
            PG8_BAR; PG8_WAIT_L(0); PG8_MMA(1, 0, At, B0); PG8_BAR; PG8_SCHED;
            PG8_STAGE(PG8_SB(1, 1), b3 + hstep, voffB);
            PG8_WAIT_V(6); PG8_BAR; PG8_MMA(1, 1, At, B1); PG8_BAR;
            }
        }
        if constexpr (ALIGN_EPI) { if (wr == 0) PG8_BAR; }
        if constexpr (!Epi::AFTER_DRAIN) { E(acc, cur, wr, wc, fr, fq); S.done(cur); }
        if (!has_next) break;
#pragma unroll
        for (int a = 0; a < 2; ++a)
#pragma unroll
            for (int b = 0; b < 2; ++b)
#pragma unroll
                for (int m = 0; m < 4; ++m)
#pragma unroll
                    for (int n = 0; n < 2; ++n) acc[a][b][m][n] = (f32x4){0.f, 0.f, 0.f, 0.f};
        cur = nxt; cA = nA; cB = nB; ++ui;
        if constexpr (ALIGN_EPI) { if (wr == 1) PG8_BAR; }
    }
    PG8_WAIT_V(0);
    if constexpr (!ALIGN_EPI) { if (wr == 0) PG8_BAR; }
    PG8_BAR;
    if constexpr (Epi::AFTER_DRAIN) { E.fused(acc, cur, wr, wc, fr, fq, lds, wid, lane); S.done(cur); }
#undef PG8_SA
#undef PG8_SB
#undef PG8_STAGE
#undef PG8_LDA
#undef PG8_LDB
#undef PG8_MMA
#undef PG8_WAIT_V
#undef PG8_WAIT_L
#undef PG8_BAR
#undef PG8_SCHED
}
}
#ifndef PG8_SP2
#define PG8_SP2 true
#endif
#ifndef PG8_ALIGN
#define PG8_ALIGN true
#endif

constexpr int NWAVES = 8;
constexpr int D = 1024, FF = 4096, NH = 16, HD = 64, DEPTH = 4;
constexpr int NTOK = 131072;
constexpr int GROUP_TOK = 65536;
#ifndef MK_CH
#define MK_CH 65536
#endif
constexpr int CH = MK_CH;
constexpr int NCHUNK = NTOK / CH;
constexpr float RMS_EPS = 1e-6f;
constexpr float LOG2E = 1.4426950408889634f;
static_assert(GROUP_TOK % CH == 0 && CH % 4096 == 0, "chunking");

constexpr size_t MiB = 1u << 20;
constexpr size_t WS_WPOOL = 2 * MiB;
constexpr size_t WS_WQKV = 4 * MiB;
constexpr size_t WS_WO = 16 * MiB;
constexpr size_t WS_WUP = 20 * MiB;
constexpr size_t WS_WDN = 52 * MiB;
constexpr size_t WS_XN = 96 * MiB;
constexpr size_t WS_PG = WS_XN + (size_t)CH * D * 2;
constexpr size_t WS_ACT = WS_PG + (size_t)CH * D * 2;
constexpr size_t WS_CTL = 0, CTL_ZERO_BYTES = 65536;
constexpr size_t WS_STAT = 86 * MiB;
static_assert(WS_STAT + 2 * (size_t)CH * 64 <= WS_XN, "stat arrays");
constexpr size_t WS_END = WS_ACT + (size_t)CH * FF * 2;
static_assert(WS_XN >= WS_WDN + 32 * MiB && WS_END <= 1024 * MiB, "d_ws map");

constexpr int RING_BYTES = 131072;
constexpr int BIAS_OFF = RING_BYTES;
constexpr int MISC_OFF = RING_BYTES + 4096;
constexpr int LDS_BYTES = 147456;

#define GAS __attribute__((address_space(1)))
#define LAS __attribute__((address_space(3)))
typedef unsigned short bf16;
typedef unsigned v4u __attribute__((ext_vector_type(4)));
typedef unsigned v2u __attribute__((ext_vector_type(2)));
typedef float f32x4 __attribute__((ext_vector_type(4)));
typedef short bf16x8 __attribute__((ext_vector_type(8)));
typedef short s16x4 __attribute__((ext_vector_type(4)));
#define LDS_WAIT() asm volatile("s_waitcnt lgkmcnt(0)" ::: "memory")
typedef float f32x2_t __attribute__((ext_vector_type(2))); typedef __bf16 bf16x2_t __attribute__((ext_vector_type(2)));
__device__ __forceinline__ unsigned pk2(float lo, float hi) { f32x2_t v = {lo, hi}; bf16x2_t b = __builtin_convertvector(v, bf16x2_t); return __builtin_bit_cast(unsigned, b); }
__device__ __forceinline__ float wave_sum(float v) {
#pragma unroll
    for (int o = 1; o < 64; o <<= 1) v += __shfl_xor(v, o);
    return v;
}

__device__ __forceinline__ void transpose_item(const float* W, int K, int N, bf16* WT, int row_off, const float* nscale, const float* kscale, LAS float* scr, int item, int lane) {
    const int nblk = N / 32, kb = item / nblk, nb = item % nblk, k0 = 64 * kb, n0 = 32 * nb;
    float wv[32];
#pragma unroll
    for (int i = 0; i < 32; ++i) wv[i] = W[(size_t)(k0 + 2 * i + (lane >> 5)) * N + n0 + (lane & 31)];
#pragma unroll
    for (int i = 0; i < 32; ++i) scr[(2 * i + (lane >> 5)) * 33 + (lane & 31)] = wv[i];
    LDS_WAIT(); asm volatile("" ::: "memory");
    const int c = lane & 7;
    float ks[8];
#pragma unroll
    for (int e = 0; e < 8; ++e) ks[e] = kscale ? kscale[k0 + 8 * c + e] : 1.f;
#pragma unroll
    for (int j = 0; j < 4; ++j) { const int n = (lane >> 3) + 8 * j; const LAS float* s = scr + (8 * c) * 33 + n;
        const float sc = nscale ? nscale[n0 + n] : 1.f;
        v4u o; o.x = pk2(s[0 * 33] * sc * ks[0], s[1 * 33] * sc * ks[1]); o.y = pk2(s[2 * 33] * sc * ks[2], s[3 * 33] * sc * ks[3]); o.z = pk2(s[4 * 33] * sc * ks[4], s[5 * 33] * sc * ks[5]); o.w = pk2(s[6 * 33] * sc * ks[6], s[7 * 33] * sc * ks[7]);
        *(GAS v4u*)(WT + (size_t)(row_off + n0 + n) * K + k0 + 8 * c) = o; }
    LDS_WAIT(); asm volatile("" ::: "memory");
}

struct Ptrs {
    const float *x_in[2], *norm_mix, *pool_w, *pool_scale, *w_qkv, *rpb, *w_o, *norm_mlp, *w_up, *w_down, *norm_final;
    float* out; unsigned char* ws;
};

__device__ __forceinline__ void prologue(const Ptrs& P, LAS unsigned char* lds, int gw, int NGW, int wave, int lane) {
    LAS float* scr = (LAS float*)(lds + wave * 16384);
    bf16* WPOOL = (bf16*)(P.ws + WS_WPOOL); bf16* WQKV = (bf16*)(P.ws + WS_WQKV); bf16* WO = (bf16*)(P.ws + WS_WO); bf16* WUP = (bf16*)(P.ws + WS_WUP); bf16* WDN = (bf16*)(P.ws + WS_WDN);
    constexpr int I_POOL = (256 / 64) * (256 / 32), I_QKV = (D / 64) * (3 * D / 32), I_O = (D / 64) * (D / 32), I_UP = (D / 64) * (FF / 32), I_DN = (FF / 64) * (D / 32);
    constexpr int NITEMS = 8 * I_POOL + 2 * I_QKV + 2 * I_O + 4 * I_UP + 4 * I_DN;
    for (int it = gw; it < NITEMS; it += NGW) {
        int r = it;
        if (r < 8 * I_POOL) { const int mtx = r / I_POOL, j = mtx >> 2, g = mtx & 3; transpose_item(P.pool_w + (size_t)mtx * 65536, 256, 256, WPOOL + (size_t)j * 1024 * 256, g * 256, P.pool_scale + j * 1024 + g * 256, nullptr, scr, r % I_POOL, lane); continue; } r -= 8 * I_POOL;
        if (r < 2 * I_QKV) { const int j = r / I_QKV; transpose_item(P.w_qkv + (size_t)j * D * 3 * D, D, 3 * D, WQKV + (size_t)j * 3 * D * D, 0, nullptr, P.norm_mix + (2 * j + 1) * D, scr, r % I_QKV, lane); continue; } r -= 2 * I_QKV;
        if (r < 2 * I_O) { const int j = r / I_O; transpose_item(P.w_o + (size_t)j * D * D, D, D, WO + (size_t)j * D * D, 0, nullptr, nullptr, scr, r % I_O, lane); continue; } r -= 2 * I_O;
        if (r < 4 * I_UP) { const int j = r / I_UP; transpose_item(P.w_up + (size_t)j * D * FF, D, FF, WUP + (size_t)j * D * FF, 0, nullptr, P.norm_mlp + j * D, scr, r % I_UP, lane); continue; } r -= 4 * I_UP;
        { const int j = r / I_DN; transpose_item(P.w_down + (size_t)j * D * FF, FF, D, WDN + (size_t)j * D * FF, 0, nullptr, nullptr, scr, r % I_DN, lane); }
    }
}

__device__ __forceinline__ void norm_rows_f32_inplace(float* x, const float* gain, int nrows, int gw, int NGW, int lane) {
    f32x4 g[4];
#pragma unroll
    for (int j = 0; j < 4; ++j) g[j] = *((const f32x4*)gain + lane + 64 * j);
    for (int m = gw * 4; m < nrows; m += NGW * 4) {
        GAS f32x4* xr = (GAS f32x4*)(x + (size_t)m * D) + lane;
        f32x4 v[4][4];
#pragma unroll
        for (int r = 0; r < 4; ++r)
#pragma unroll
            for (int j = 0; j < 4; ++j) v[r][j] = xr[r * 256 + 64 * j];
        __builtin_amdgcn_sched_barrier(0);
#pragma unroll
        for (int r = 0; r < 4; ++r) { float s = 0.f;
#pragma unroll
            for (int j = 0; j < 4; ++j) s += (v[r][j].x * v[r][j].x + v[r][j].y * v[r][j].y) + (v[r][j].z * v[r][j].z + v[r][j].w * v[r][j].w);
            const float rr = 1.0f / sqrtf(wave_sum(s) * (1.f / D) + RMS_EPS);
#pragma unroll
            for (int j = 0; j < 4; ++j) xr[r * 256 + 64 * j] = v[r][j] * rr * g[j]; }
    }
}

constexpr int PT = 32, PROWS = 48;
typedef float f32x2v __attribute__((ext_vector_type(2)));
__device__ __forceinline__ f32x2v bfpair(unsigned u) { return (f32x2v){__builtin_bit_cast(float, u << 16), __builtin_bit_cast(float, u & 0xffff0000u)}; }
struct f32x8 { f32x4 lo, hi; };
__device__ __forceinline__ f32x8 bf8(const v4u u) { f32x8 r; r.lo = (f32x4){__builtin_bit_cast(float, u.x << 16), __builtin_bit_cast(float, u.x & 0xffff0000u), __builtin_bit_cast(float, u.y << 16), __builtin_bit_cast(float, u.y & 0xffff0000u)};
    r.hi = (f32x4){__builtin_bit_cast(float, u.z << 16), __builtin_bit_cast(float, u.z & 0xffff0000u), __builtin_bit_cast(float, u.w << 16), __builtin_bit_cast(float, u.w & 0xffff0000u)}; return r; }
__device__ __forceinline__ v4u pack8(const f32x4 a, const f32x4 b) { v4u o; o.x = pk2(a[0], a[1]); o.y = pk2(a[2], a[3]); o.z = pk2(b[0], b[1]); o.w = pk2(b[2], b[3]); return o; }
template <int W> __device__ __forceinline__ void pool_rows_interior(const LAS v4u* hrow, GAS v4u* po) {
    constexpr int HW = W / 2; constexpr float INV = 1.0f / (float)W;
    f32x4 sl = {0.f, 0.f, 0.f, 0.f}, sh = {0.f, 0.f, 0.f, 0.f};
#pragma unroll
    for (int o = -HW; o < HW; ++o) { const f32x8 h = bf8(hrow[(8 + o) * 128]); sl += h.lo; sh += h.hi; }
    __builtin_amdgcn_sched_barrier(0);
#pragma unroll
    for (int i = 0; i < 8; ++i) {
        const f32x8 c = bf8(hrow[(8 + i) * 128]);
        po[(size_t)i * 32] = pack8(sl * INV - c.lo, sh * INV - c.hi);
        if (i + 1 < 8) { const f32x8 a = bf8(hrow[(8 + i + HW) * 128]), b = bf8(hrow[(8 + i - HW) * 128]); sl += a.lo - b.lo; sh += a.hi - b.hi; }
        __builtin_amdgcn_sched_barrier(0);
    }
}
__device__ __forceinline__ void pool_load_rows(f32x4 (&v)[6][4], const float* x, int m0, int seq_len, int wave, int lane) {
    const int sb = m0 / seq_len * seq_len, t0 = m0 - sb;
#pragma unroll
    for (int k = 0; k < 6; ++k) { const int t = min(max(t0 - 8 + wave + NWAVES * k, 0), seq_len - 1);
        const GAS f32x4* xr = (const GAS f32x4*)(x + (size_t)(sb + t) * D) + lane;
#pragma unroll
        for (int j = 0; j < 4; ++j) v[k][j] = xr[64 * j]; }
}
__device__ __forceinline__ void pool_phase(LAS unsigned char* lds, const float* x, const float* gain, bf16* Pg, int seq_len, int vcu, int G, int tid, int wave, int lane) {
    f32x4 v[6][4];
    if (vcu < CH / PT) pool_load_rows(v, x, vcu * PT, seq_len, wave, lane);
    for (int tile = vcu; tile < CH / PT; tile += G) {
        const int m0 = tile * PT;
        const int sb = m0 / seq_len * seq_len;
        const int t0 = m0 - sb;
        f32x4 g[4];
#pragma unroll
        for (int j = 0; j < 4; ++j) g[j] = *((const GAS f32x4*)gain + lane + 64 * j);
#pragma unroll
        for (int k = 0; k < 6; ++k) { float s = 0.f;
#pragma unroll
            for (int j = 0; j < 4; ++j) s += (v[k][j].x * v[k][j].x + v[k][j].y * v[k][j].y) + (v[k][j].z * v[k][j].z + v[k][j].w * v[k][j].w);
            const float r = 1.0f / sqrtf(wave_sum(s) * (1.f / D) + RMS_EPS);
            LAS v2u* hr = (LAS v2u*)(lds + (wave + NWAVES * k) * 2048) + lane;
#pragma unroll
            for (int j = 0; j < 4; ++j) { v2u o; o.x = pk2(v[k][j].x * r * g[j].x, v[k][j].y * r * g[j].y); o.y = pk2(v[k][j].z * r * g[j].z, v[k][j].w * r * g[j].w); hr[64 * j] = o; } }
        __syncthreads();
        if (tile + G < CH / PT) { pool_load_rows(v, x, (tile + G) * PT, seq_len, wave, lane); __builtin_amdgcn_sched_barrier(0); }
        {
            const int pg = wave & 3, part = (lane >> 5) + 2 * (wave >> 2), oc = lane & 31, pw = 2 << pg, phw = pw >> 1;
            const LAS v4u* hrow = (const LAS v4u*)(lds + (8 * part) * 2048 + pg * 512 + oc * 16);
            GAS v4u* po = (GAS v4u*)(Pg + ((size_t)pg * CH + m0 + 8 * part) * 256 + oc * 8);
            if (t0 >= 8 && t0 + PT + 8 <= seq_len) {
                switch (pg) { case 0: pool_rows_interior<2>(hrow, po); break; case 1: pool_rows_interior<4>(hrow, po); break; case 2: pool_rows_interior<8>(hrow, po); break; default: pool_rows_interior<16>(hrow, po); break; }
            } else {
                for (int i = 0; i < 8; ++i) {
                    const int t = t0 + 8 * part + i;
                    const int lo = max(t - phw, 0), hi = min(t + phw - 1, seq_len - 1);
                    f32x4 sl = {0.f, 0.f, 0.f, 0.f}, sh = {0.f, 0.f, 0.f, 0.f};
                    for (int q = lo; q <= hi; ++q) { const f32x8 h = bf8(hrow[(8 + q - t + i) * 128]); sl += h.lo; sh += h.hi; }
                    const f32x8 c = bf8(hrow[(8 + i) * 128]);
                    const float inv = 1.0f / (float)(hi - lo + 1);
                    po[(size_t)i * 32] = pack8(sl * inv - c.lo, sh * inv - c.hi);
                }
            }
        }
        __syncthreads();
    }
}

#define RLX_AGENT __ATOMIC_RELAXED, __HIP_MEMORY_SCOPE_AGENT
#define XB_TMO      128
#define XB_XCNT(j)  (256  + 64 * (j))
#define XB_XSUB(j)  (1280 + 64 * (j))
#define XB_XGEN(j)  (2304 + 64 * (j))
#define XB_TOP      3328
#define XB_TOPGEN   3392
#define XCD_BAR_WORDS 3456
#define XB_SPIN_CAP (1u << 18)

__device__ __forceinline__ unsigned xb_ld(unsigned* p)              { return __hip_atomic_load(p, __ATOMIC_RELAXED, __HIP_MEMORY_SCOPE_AGENT); }
__device__ __forceinline__ unsigned xb_add(unsigned* p, unsigned v) { return __hip_atomic_fetch_add(p, v, __ATOMIC_RELAXED, __HIP_MEMORY_SCOPE_AGENT); }
__device__ __forceinline__ unsigned xb_xcc_id() { return (unsigned)__builtin_amdgcn_s_getreg((3 << 11) | 20) & 0xFu; }
#define XB_SPIN(cond, bar) do { unsigned _sp = 0; while (cond) { __builtin_amdgcn_s_sleep(1); \
    if ((++_sp & 255u) == 0u) { if (xb_ld(&(bar)[XB_TMO])) break; if (_sp > XB_SPIN_CAP) { atomicAdd(&(bar)[XB_TMO], 1u); break; } } } } while (0)

struct XcdBarrier {
    unsigned* bar; unsigned x;
    volatile LAS unsigned* st;
};

__device__ __forceinline__ XcdBarrier xcd_barrier_post(unsigned* bar, volatile LAS unsigned* st) {
    XcdBarrier b; b.bar = bar; b.x = xb_xcc_id(); b.st = st;
    if (threadIdx.x == 0) (void)xb_add(&bar[XB_XCNT(b.x)], 1u);
    return b;
}
__device__ __forceinline__ void xcd_barrier_complete(unsigned* bar, unsigned x, unsigned& nloc, unsigned& nx) {
    const unsigned G = gridDim.x * gridDim.y * gridDim.z;
    unsigned sum, cnt, mine, sp = 0u;
    for (;;) {
        sum = 0u; cnt = 0u; mine = 0u;
#pragma unroll
        for (unsigned j = 0; j < 16; ++j) { const unsigned c = xb_ld(&bar[XB_XCNT(j)]); sum += c; cnt += (c > 0u) ? 1u : 0u; mine = (j == x) ? c : mine; }
        if (sum == G) break;
        __builtin_amdgcn_s_sleep(1);
        if ((++sp & 255u) == 0u) { if (xb_ld(&bar[XB_TMO])) break; if (sp > XB_SPIN_CAP) { atomicAdd(&bar[XB_TMO], 1u); break; } }
    }
    nloc = mine > 0u ? mine : 1u; nx = cnt > 0u ? cnt : 1u;
}

__device__ __forceinline__ void xcd_barrier(const XcdBarrier& b) {
    asm volatile("s_waitcnt vmcnt(0)" ::: "memory");
    __syncthreads();
    if (threadIdx.x == 0) {
        unsigned* bar = b.bar;
        __builtin_amdgcn_s_waitcnt(0);
        unsigned nloc = b.st[0], nx = b.st[1];
        if (nloc == 0u) { xcd_barrier_complete(bar, b.x, nloc, nx); b.st[0] = nloc; b.st[1] = nx; }
        const unsigned old = xb_add(&bar[XB_XSUB(b.x)], 1u);
        const unsigned gen = old / nloc;
        if (old + 1u == (gen + 1u) * nloc) {
            __builtin_amdgcn_fence(__ATOMIC_RELEASE, "agent");
            asm volatile("s_waitcnt vmcnt(0)" ::: "memory");
            const unsigned og = xb_add(&bar[XB_TOP], 1u);
            const unsigned tg = og / nx;
            if (og + 1u == (tg + 1u) * nx) xb_add(&bar[XB_TOPGEN], 1u);
            else XB_SPIN(xb_ld(&bar[XB_TOPGEN]) == tg, bar);
            __builtin_amdgcn_fence(__ATOMIC_ACQUIRE, "agent");
            xb_add(&bar[XB_XGEN(b.x)], 1u);
            asm volatile("s_waitcnt vmcnt(0)" ::: "memory");
        } else {
            XB_SPIN(xb_ld(&bar[XB_XGEN(b.x)]) == gen, bar);
            __builtin_amdgcn_fence(__ATOMIC_ACQUIRE, "agent");
            asm volatile("s_waitcnt vmcnt(0)" ::: "memory");
        }
    }
    __syncthreads();
}


__device__ __forceinline__ unsigned cvtpk(float lo, float hi) { return pk2(lo, hi); }
__device__ __forceinline__ s16x4 vtr(const LAS unsigned char* p) { return __builtin_bit_cast(s16x4, __builtin_amdgcn_ds_read_tr16_b64_v4i16((LAS s16x4*)p)); }
__device__ __forceinline__ void attn_phase(LAS unsigned char* lds, bf16* Qb, const bf16* Kb, const bf16* Vb, const float* rpb_l, int seq_len, int G, int bx, int tid, int wave, int lane) {
    const int fr = lane & 15, fq = lane >> 4;
    const int rows = seq_len >> 6, rows_shift = (seq_len == 2048) ? 5 : 6;
    constexpr int NI = (CH / 64) * 8;
    int nx, xc, lc, per;
    if ((G & 7) == 0) { nx = G >> 3; xc = bx & 7; lc = bx >> 3; per = NI >> 3; } else { nx = G; xc = 0; lc = bx; per = NI; }
    LAS float* bias = (LAS float*)(lds + BIAS_OFF);
    const int qb = wave & 3, hh = wave >> 2;
    const int qc = (qb < 3) ? (8 + 16 * qb + fr) : (fr < 8 ? fr : 48 + fr);
    const int a0 = (qb < 3) ? qb : 0, a1 = (qb < 3) ? qb + 1 : 3;
    const int wst = min(max(qc - 8, 0), 48);
    const int q4 = (lane & 15) >> 2, p4 = lane & 3;
    float madd[2][4];
#pragma unroll
    for (int ai = 0; ai < 2; ++ai)
#pragma unroll
        for (int i = 0; i < 4; ++i) { const int kc = 16 * (ai ? a1 : a0) + 4 * fq + i; madd[ai][i] = ((kc >= wst) && (kc < wst + 16)) ? 0.f : -1.0e30f; }
    int voff[4];
#pragma unroll
    for (int i3 = 0; i3 < 4; ++i3) voff[i3] = (lane >> 4) * D + (((lane & 15) ^ (((lane >> 4) << 2) | i3)) * 8);
    if (lc >= per) return;
    int id = xc * per + lc;
    int r = id & (rows - 1), hp = (id >> rows_shift) & 7, tb = (id >> (rows_shift + 3)) * seq_len, r0 = min(max(r - 4, 0), rows - 8);
    bf16x8 qf0, qf1, kf[4][2][2];
    float bnext[2];
#define ATT_PREFETCH() do { \
        const int h_ = 2 * hp + hh; const size_t qo_ = (size_t)(tb + r * 64 + qc) * D + h_ * 64; \
        qf0 = *(const GAS bf16x8*)(Qb + qo_ + 8 * fq); qf1 = *(const GAS bf16x8*)(Qb + qo_ + 32 + 8 * fq); \
        const bf16* kb_ = Kb + ((size_t)(h_ * 8 + fq) * CH + (tb + r0 * 64 + fr)) * 8; \
        _Pragma("unroll") for (int kr = 0; kr < 4; ++kr) _Pragma("unroll") for (int ai = 0; ai < 2; ++ai) { const bf16* kp = kb_ + (kr * 64 + 16 * (ai ? a1 : a0)) * 8; kf[kr][ai][0] = *(const GAS bf16x8*)kp; kf[kr][ai][1] = *(const GAS bf16x8*)(kp + (size_t)4 * CH * 8); } \
        bnext[0] = rpb_l[hp * 930 + tid] * LOG2E; bnext[1] = (tid + 512 < 930) ? rpb_l[hp * 930 + tid + 512] * LOG2E : 0.f; } while (0)
#define ATT_BIAS_WRITE() do { bias[tid] = bnext[0]; if (tid + 512 < 930) bias[tid + 512] = bnext[1]; } while (0)
    ATT_PREFETCH();
    ATT_BIAS_WRITE();
    for (int loc = lc; loc < per; loc += nx) {
        const int h = 2 * hp + hh;
        const size_t qoff = (size_t)(tb + r * 64 + qc) * D + h * 64;
        const bf16* kbase = Kb + ((size_t)(h * 8 + fq) * CH + (tb + r0 * 64 + fr)) * 8;
        const int drb = r0 - r + 7;
        __syncthreads();
        {
            const int a = wave >> 1, ub = (wave & 1) * 2;
#pragma unroll
            for (int i = 0; i < 16; ++i) { const int kr = 2 * (ub + (i >> 3)) + (i & 1), cb = 16 * a + 4 * ((i & 7) >> 1);
                const bf16* src = Vb + (size_t)(tb + (r0 + kr) * 64 + cb) * D + hp * 128 + voff[i & 3];
                __builtin_amdgcn_global_load_lds((const unsigned*)src, (LAS unsigned*)(lds + (wave * 16 + i) * 1024), 16, 0, 0); }
        }
        f32x4 S[8][2];
        float mx = -3.0e38f;
        const LAS float* bptr[2][4];
#pragma unroll
        for (int ai = 0; ai < 2; ++ai)
#pragma unroll
            for (int i = 0; i < 4; ++i) { const int kc = 16 * (ai ? a1 : a0) + 4 * fq + i; bptr[ai][i] = bias + hh * 465 + drb * 31 + min(max(kc - qc + 15, 0), 30); }
#pragma unroll
        for (int kr = 0; kr < 8; ++kr) {
#pragma unroll
            for (int ai = 0; ai < 2; ++ai) {
                f32x4 z = {0.f, 0.f, 0.f, 0.f};
                z = __builtin_amdgcn_mfma_f32_16x16x32_bf16(kf[kr & 3][ai][0], qf0, z, 0, 0, 0);
                z = __builtin_amdgcn_mfma_f32_16x16x32_bf16(kf[kr & 3][ai][1], qf1, z, 0, 0, 0);
#pragma unroll
                for (int i = 0; i < 4; ++i) { z[i] = (z[i] + bptr[ai][i][kr * 31]) + madd[ai][i]; mx = fmaxf(mx, z[i]); }
                S[kr][ai] = z;
            }
            if (kr < 4) {
#pragma unroll
                for (int ai = 0; ai < 2; ++ai) { const bf16* kp = kbase + ((kr + 4) * 64 + 16 * (ai ? a1 : a0)) * 8; kf[kr & 3][ai][0] = *(const GAS bf16x8*)kp; kf[kr & 3][ai][1] = *(const GAS bf16x8*)(kp + (size_t)4 * CH * 8); }
            }
            __builtin_amdgcn_sched_barrier(0);
        }
        mx = fmaxf(mx, __shfl_xor(mx, 16)); mx = fmaxf(mx, __shfl_xor(mx, 32));
        float sum = 0.f;
#pragma unroll
        for (int kr = 0; kr < 8; ++kr)
#pragma unroll
            for (int ai = 0; ai < 2; ++ai)
#pragma unroll
                for (int i = 0; i < 4; ++i) { const float p = __builtin_amdgcn_exp2f(S[kr][ai][i] - mx); S[kr][ai][i] = p; sum += p; }
        sum += __shfl_xor(sum, 16); sum += __shfl_xor(sum, 32);
        bf16x8 pf[4][2];
#pragma unroll
        for (int u = 0; u < 4; ++u)
#pragma unroll
            for (int ai = 0; ai < 2; ++ai) { v4u pw; pw.x = cvtpk(S[2 * u][ai][0], S[2 * u][ai][1]); pw.y = cvtpk(S[2 * u][ai][2], S[2 * u][ai][3]); pw.z = cvtpk(S[2 * u + 1][ai][0], S[2 * u + 1][ai][1]); pw.w = cvtpk(S[2 * u + 1][ai][2], S[2 * u + 1][ai][3]);
                pf[u][ai] = __builtin_bit_cast(bf16x8, pw); }
        asm volatile("s_waitcnt vmcnt(0)" ::: "memory");
        __syncthreads();
        const int nloc = loc + nx; const bool has_next = nloc < per;
        const int r_cur = r, tb_cur = tb;
        if (has_next) { id = xc * per + nloc; r = id & (rows - 1); hp = (id >> rows_shift) & 7; tb = (id >> (rows_shift + 3)) * seq_len; r0 = min(max(r - 4, 0), rows - 8); ATT_PREFETCH(); }
        (void)r_cur; (void)tb_cur;
        f32x4 O[4];
#pragma unroll
        for (int c = 0; c < 4; ++c) O[c] = (f32x4){0.f, 0.f, 0.f, 0.f};
        const LAS unsigned char* vb[2][2][4];
#pragma unroll
        for (int ai = 0; ai < 2; ++ai)
#pragma unroll
            for (int t = 0; t < 2; ++t)
#pragma unroll
                for (int c = 0; c < 4; ++c) { const int rho = 8 * fq + 4 * t + q4, chn = 2 * (4 * hh + c) + (p4 >> 1);
                    vb[ai][t][c] = lds + (ai ? a1 : a0) * 32768 + 256 * rho + 16 * (chn ^ (((rho & 3) << 2) | ((rho >> 2) & 3))) + 8 * (p4 & 1); }
#pragma unroll
        for (int u = 0; u < 4; ++u) {
#pragma unroll
            for (int ai = 0; ai < 2; ++ai) {
#pragma unroll
                for (int c = 0; c < 4; ++c) {
                    const s16x4 v0 = vtr(vb[ai][0][c] + u * 8192), v1 = vtr(vb[ai][1][c] + u * 8192);
                    const bf16x8 vf = __builtin_shufflevector(v0, v1, 0, 1, 2, 3, 4, 5, 6, 7);
                    O[c] = __builtin_amdgcn_mfma_f32_16x16x32_bf16(vf, pf[u][ai], O[c], 0, 0, 0);
                }
            }
            __builtin_amdgcn_sched_barrier(0);
        }
        const float inv = 1.0f / sum;
#pragma unroll
        for (int c = 0; c < 4; ++c) { v2u w; w.x = cvtpk(O[c][0] * inv, O[c][1] * inv); w.y = cvtpk(O[c][2] * inv, O[c][3] * inv);
            *(GAS v2u*)(Qb + qoff + 16 * c + 4 * fq) = w; }
        if (has_next) ATT_BIAS_WRITE();
    }
    __syncthreads();
#undef ATT_PREFETCH
#undef ATT_BIAS_WRITE
}
enum { K_POOL = 1, K_GEMM_RES = 3, K_GEMM_QKV = 4, K_GEMM_UP = 5, K_ATTN = 6, K_FINAL = 7 };
enum { F_A_X = 1, F_A_IN = 2, F_AUX_X = 4, F_AUX_IN = 8 };
struct Ph { int kind, flags, N, K; const void* A; const void* B; void* C; const void* aux; float* st; float* rs; unsigned long long a_pn_stride, pad; };
constexpr int PPC = 19;
struct Args { Ptrs p; Ph tab[PPC]; };
__global__ void __launch_bounds__(NWAVES * 64, 2) fwd_megakernel(Args args) {
    extern __shared__ __attribute__((aligned(16))) unsigned char lds_raw[];
    cg::grid_group grid = cg::this_grid();
    LAS unsigned char* lds = (LAS unsigned char*)lds_raw;
    volatile LAS unsigned* MISC = (volatile LAS unsigned*)(lds + MISC_OFF);
    for (int u = threadIdx.x; u < 32; u += NWAVES * 64) MISC[u] = 0u;
    __syncthreads();
    const XcdBarrier bar = xcd_barrier_post((unsigned*)(args.p.ws + WS_CTL), MISC + 8);
    {
        const int tid = threadIdx.x, lane = tid & 63, wave = __builtin_amdgcn_readfirstlane(tid >> 6);
        const int G = gridDim.x, bx = blockIdx.x;
        const int vcu = (G % 8 == 0) ? (bx % 8) * (G / 8) + bx / 8 : bx;
        prologue(args.p, lds, vcu * NWAVES + wave, G * NWAVES, wave, lane);
    }
    grid.sync();

    for (int ph = 0; ph < NCHUNK * PPC; ++ph) {
        int tid = threadIdx.x; asm volatile("" : "+v"(tid));
        int G = gridDim.x, bx = blockIdx.x; asm volatile("" : "+s"(G), "+s"(bx));
        const int lane = tid & 63, wave = __builtin_amdgcn_readfirstlane(tid >> 6);
        const int vcu = (G % 8 == 0) ? (bx % 8) * (G / 8) + bx / 8 : bx;
        const int gw = vcu * NWAVES + wave, NGW = G * NWAVES;
        const int ck = ph / PPC, idx = ph - ck * PPC;
        const Ph d = args.tab[idx];
        const int tok0 = ck * CH, grp = tok0 / GROUP_TOK, seq_len = grp ? 4096 : 2048;
        const float* xin = args.p.x_in[grp] + (size_t)(tok0 - grp * GROUP_TOK) * D;
        float* X = args.p.out + (size_t)tok0 * D;
        const void* A = (d.flags & F_A_X) ? (const void*)X : (d.flags & F_A_IN) ? (const void*)xin : d.A;
        const void* aux = (d.flags & F_AUX_X) ? (const void*)X : (d.flags & F_AUX_IN) ? (const void*)xin : d.aux;
        switch (d.kind) {
        case K_POOL: { int tid2 = threadIdx.x; asm volatile("" : "+v"(tid2));
            pool_phase(lds, (const float*)A, (const float*)aux, (bf16*)d.C, seq_len, vcu, G, tid2, __builtin_amdgcn_readfirstlane(tid2 >> 6), tid2 & 63); } break;
        case K_GEMM_RES: { pg8::Gemm g{(const bf16*)A, (const bf16*)d.B, CH, d.N, d.K, (size_t)d.a_pn_stride}; pg8::StaticOrder S; S.init(CH, d.N, G, bx);
            pg8::EpiRes E{(const float*)aux, X, (bf16*)d.C, d.st, D, d.rs};
            pg8::gemm_phase<pg8::EpiRes, pg8::StaticOrder, PG8_ALIGN, PG8_SP2>(lds, g, S, E, tid); } break;
        case K_GEMM_QKV: { pg8::Gemm g{(const bf16*)A, (const bf16*)d.B, CH, d.N, d.K, 0}; pg8::StaticOrder S; S.init(CH, d.N, G, bx);
            pg8::EpiBf16<0, true> E{(bf16*)d.C, D, D, (size_t)CH * D, 0.125f * LOG2E, d.st};
            pg8::gemm_phase<pg8::EpiBf16<0, true>, pg8::StaticOrder, PG8_ALIGN, PG8_SP2>(lds, g, S, E, tid); } break;
        case K_GEMM_UP: { pg8::Gemm g{(const bf16*)A, (const bf16*)d.B, CH, d.N, d.K, 0}; pg8::StaticOrder S; S.init(CH, d.N, G, bx);
            pg8::EpiBf16<2, false> E{(bf16*)d.C, FF, 0, 0, 1.f, nullptr};
            pg8::gemm_phase<pg8::EpiBf16<2, false>, pg8::StaticOrder, PG8_ALIGN, PG8_SP2>(lds, g, S, E, tid); } break;
        case K_ATTN: attn_phase(lds, (bf16*)d.C, (const bf16*)d.C + (size_t)CH * D, (const bf16*)d.C + 2 * (size_t)CH * D, (const float*)aux, seq_len, G, bx, tid, wave, lane); break;
        default: norm_rows_f32_inplace(X, (const float*)aux, CH, gw, NGW, lane); break;
        }
        if (d.kind != K_FINAL) xcd_barrier(bar);
    }
}

extern "C" void kernel_launch(void* const* d_in, const int* in_sizes, int n_in, void* d_out, int out_size, void* d_ws, size_t ws_size, hipStream_t stream) {
    static int grid = 0;
    if (grid == 0) {
        if (n_in != 12 || in_sizes[0] != GROUP_TOK * D || in_sizes[1] != GROUP_TOK * D || out_size != NTOK * D || ws_size < WS_END) {
            fprintf(stderr, "kernel_launch: unexpected shapes (n_in %d, out %d, ws %zu < %zu); nothing launched\n", n_in, out_size, ws_size, (size_t)WS_END); grid = -1; return; }
        int dev = 0, cus = 0, per_cu = 0;
        if (hipGetDevice(&dev) != hipSuccess || hipDeviceGetAttribute(&cus, hipDeviceAttributeMultiprocessorCount, dev) != hipSuccess) { fprintf(stderr, "kernel_launch: device query failed\n"); grid = -1; return; }
        if (hipFuncSetAttribute((const void*)fwd_megakernel, hipFuncAttributeMaxDynamicSharedMemorySize, LDS_BYTES) != hipSuccess) { fprintf(stderr, "kernel_launch: hipFuncSetAttribute failed\n"); grid = -1; return; }
        if (hipOccupancyMaxActiveBlocksPerMultiprocessor(&per_cu, (const void*)fwd_megakernel, NWAVES * 64, LDS_BYTES) != hipSuccess || per_cu < 1) { fprintf(stderr, "kernel_launch: occupancy query gave %d\n", per_cu); per_cu = 1; }
        (void)hipGetLastError();
        grid = cus * per_cu;
    }
    if (grid < 0) return;
    if (hipMemsetAsync((char*)d_ws + WS_CTL, 0, CTL_ZERO_BYTES, stream) != hipSuccess) { fprintf(stderr, "kernel_launch: hipMemsetAsync failed\n"); return; }
    Args a{};
    Ptrs& p = a.p;
    p.x_in[0] = (const float*)d_in[0]; p.x_in[1] = (const float*)d_in[1]; p.norm_mix = (const float*)d_in[2]; p.pool_w = (const float*)d_in[3]; p.pool_scale = (const float*)d_in[4];
    p.w_qkv = (const float*)d_in[5]; p.rpb = (const float*)d_in[6]; p.w_o = (const float*)d_in[7]; p.norm_mlp = (const float*)d_in[8]; p.w_up = (const float*)d_in[9];
    p.w_down = (const float*)d_in[10]; p.norm_final = (const float*)d_in[11]; p.out = (float*)d_out; p.ws = (unsigned char*)d_ws;
    unsigned char* ws = (unsigned char*)d_ws;
    bf16* WPOOL = (bf16*)(ws + WS_WPOOL); bf16* WQKV = (bf16*)(ws + WS_WQKV); bf16* WO = (bf16*)(ws + WS_WO); bf16* WUP = (bf16*)(ws + WS_WUP); bf16* WDN = (bf16*)(ws + WS_WDN);
    bf16* XN = (bf16*)(ws + WS_XN); bf16* PG = (bf16*)(ws + WS_PG); bf16* QB = (bf16*)(ws + WS_ACT); bf16* HB = (bf16*)(ws + WS_ACT);
    float* SA = (float*)(ws + WS_STAT); float* SB = SA + (size_t)CH * 16;
    int n = 0;
    auto add = [&](int kind, int flags, int N, int K, const void* A, const void* B, void* C, const void* aux, float* st, float* rs, unsigned long long aps) {
        Ph& d = a.tab[n++]; d.kind = kind; d.flags = flags; d.N = N; d.K = K; d.A = A; d.B = B; d.C = C; d.aux = aux; d.st = st; d.rs = rs; d.a_pn_stride = aps; d.pad = 0; };
    for (int layer = 0; layer < DEPTH; ++layer) {
        const int j = layer >> 1;
        if ((layer & 1) == 0) {
            add(K_POOL, layer == 0 ? F_A_IN : F_A_X, 0, 0, nullptr, nullptr, PG, p.norm_mix + layer * D, nullptr, nullptr, 0);
            add(K_GEMM_RES, layer == 0 ? F_AUX_IN : F_AUX_X, D, 256, PG, WPOOL + (size_t)j * 1024 * 256, XN, nullptr, SA, nullptr, (unsigned long long)CH * 256 * 2);
        } else {
            add(K_GEMM_QKV, 0, 3 * D, D, XN, WQKV + (size_t)j * 3 * D * D, QB, nullptr, SB, nullptr, 0);
            add(K_ATTN, 0, 0, 0, nullptr, nullptr, QB, p.rpb + (size_t)j * NH * 15 * 31, nullptr, nullptr, 0);
            add(K_GEMM_RES, F_AUX_X, D, D, QB, WO + (size_t)j * D * D, XN, nullptr, SA, nullptr, 0);
        }
        add(K_GEMM_UP, 0, FF, D, XN, WUP + (size_t)layer * D * FF, HB, nullptr, SA, nullptr, 0);
        add(K_GEMM_RES, F_AUX_X, D, FF, HB, WDN + (size_t)layer * D * FF, (layer & 1) == 0 ? XN : nullptr, nullptr, SB, SA, 0);
    }
    add(K_FINAL, 0, 0, 0, nullptr, nullptr, nullptr, p.norm_final, nullptr, nullptr, 0);
    if (n != PPC) { fprintf(stderr, "kernel_launch: phase table has %d entries, expected %d\n", n, PPC); return; }
    void* kargs[] = {&a};
    hipError_t e = hipLaunchCooperativeKernel((const void*)fwd_megakernel, dim3(grid), dim3(NWAVES * 64), kargs, LDS_BYTES, stream);
    if (e != hipSuccess) fprintf(stderr, "kernel_launch: cooperative launch failed: %s (grid %d)\n", hipGetErrorString(e), grid);
}
```

```cpp
#include <hip/hip_runtime.h>
#include <hip/hip_cooperative_groups.h>
#include <cstdio>
#include <cstdint>
namespace cg = cooperative_groups;
namespace pg8 {
#define PG8_LAS __attribute__((address_space(3)))
typedef unsigned short bf16_t;
typedef short bf16x8 __attribute__((ext_vector_type(8)));
typedef float f32x4 __attribute__((ext_vector_type(4)));
typedef unsigned u32x4 __attribute__((ext_vector_type(4)));
constexpr int BM = 256, BK = 64, HALF = 128, HTB = HALF * BK * 2  , STAGE_BYTES = 8 * HTB, NXCD = 8, WGM = 8;

__host__ __device__ __forceinline__ int lds_byte(int r, int c) { const int st = (r >> 4) * 2 + (c >> 5), rr = r & 15, cc = c & 31, ob = rr * 64 + cc * 2; return st * 1024 + (ob ^ (((ob >> 9) & 1) << 5)); }
__host__ __device__ __forceinline__ void stage_rc(int b, int& R, int& C) { const int st = b / 1024, sb = b % 1024, swz = sb ^ (((sb >> 9) & 1) << 5); R = (st >> 1) * 16 + swz / 64; C = (st & 1) * 32 + (swz % 64) / 2; }
__host__ __device__ __forceinline__ int perm32(int rho) { const int n = rho >> 4, i = rho & 15; return 8 * (i >> 2) + 4 * n + (i & 3); }

struct Unit { int pm, pn; };
struct Gemm { const bf16_t* A; const bf16_t* Bt; int M, N, K; size_t a_pn_stride; int a_tiled; };

struct StaticOrder {
    int nM, nN, nwg, G, c;
    __host__ __device__ void init(int M, int N, int G_, int c_) { nM = M / BM; nN = N / BM; nwg = nM * nN; G = G_; c = c_; }
    __host__ __device__ bool next(int i, Unit& u) const {
        const long L = (long)i * G + c; if (L >= nwg) return false;
        int wgid = (int)L; { const int q = nwg / NXCD, r = nwg % NXCD, xcd = wgid % NXCD, off = wgid / NXCD; wgid = (xcd < r ? xcd * (q + 1) : r * (q + 1) + (xcd - r) * q) + off; }
        const int nig = WGM * nN, gid = wgid / nig, fm = gid * WGM, gsz = (nM - fm) < WGM ? (nM - fm) : WGM;
        u.pm = fm + ((wgid % nig) % gsz); u.pn = (wgid % nig) / gsz; return true;
    }
    __device__ __forceinline__ void a_ready(const Unit&) const {}
    __device__ __forceinline__ void done(const Unit&) const {}
};

__device__ __forceinline__ unsigned cvt_pk_bf16(float lo, float hi) { unsigned r; asm volatile("v_cvt_pk_bf16_f32 %0, %1, %2" : "=v"(r) : "v"(lo), "v"(hi)); return r; }
typedef float f32x2 __attribute__((ext_vector_type(2)));
template <int ACT, bool RS> struct EpiBf16 {
    static constexpr bool PERM = true, AFTER_DRAIN = false;
    bf16_t* O; int ldc; int split_cols; size_t split_stride; float scale0; const float* st; int tiled;
    __device__ __forceinline__ void operator()(const f32x4 (&acc)[2][2][4][2], const Unit& u, int wr, int wc, int fr, int fq) const {
        const int row0 = u.pm * BM + wr * 64 + fr; int colt = u.pn * BM; bf16_t* base = O;
        float sc = 1.f; bool kplane = false;
        if (split_cols) { const int t = colt / split_cols; base += (size_t)t * split_stride; colt -= t * split_cols; if (t == 0) sc = scale0; kplane = (t == 1); }
        const size_t kprows = split_stride / 1024;
        const int col0 = colt + wc * 32 + 8 * fq;
        f32x4 pv[2][4];
        if (RS) {
#pragma unroll
            for (int ai = 0; ai < 2; ++ai)
#pragma unroll
                for (int m = 0; m < 4; ++m) pv[ai][m] = *(const f32x4*)(st + (size_t)(row0 + ai * HALF + m * 16) * 16 + 4 * fq);
            __builtin_amdgcn_sched_barrier(0);
        }
#pragma unroll
        for (int ai = 0; ai < 2; ++ai)
#pragma unroll
            for (int m = 0; m < 4; ++m) { const int row = row0 + ai * HALF + m * 16; bf16_t* rowp = base + (size_t)row * ldc + col0;
                float f = sc;
                if (RS) { float ss = (pv[ai][m][0] + pv[ai][m][1]) + (pv[ai][m][2] + pv[ai][m][3]); ss += __shfl_xor(ss, 16); ss += __shfl_xor(ss, 32);
                    const float r = __builtin_amdgcn_rsqf(ss * (1.0f / 1024.0f) + 1e-6f); f *= (ACT == 2) ? r * r : r; }
#pragma unroll
                for (int bj = 0; bj < 2; ++bj) { f32x4 v0 = acc[ai][bj][m][0], v1 = acc[ai][bj][m][1];
                    if (ACT == 2) {
#pragma unroll
                        for (int e = 0; e < 4; ++e) { const float a = fmaxf(v0[e], 0.f), b = fmaxf(v1[e], 0.f); v0[e] = a * a; v1[e] = b * b; } }
                    v0 = v0 * f; v1 = v1 * f; u32x4 w; w.x = cvt_pk_bf16(v0[0], v0[1]); w.y = cvt_pk_bf16(v0[2], v0[3]); w.z = cvt_pk_bf16(v1[0], v1[1]); w.w = cvt_pk_bf16(v1[2], v1[3]);
                    if (kplane) *(u32x4*)(base + ((size_t)(((colt >> 6) + 2 * bj + (wc >> 1)) * 8 + (wc & 1) * 4 + fq) * kprows + row) * 8) = w;
                    else if (tiled) { const int r_ = row & 255, c_ = col0 + bj * HALF;
                        *(u32x4*)((char*)base + ((size_t)(((row >> 8) * 2 + (r_ >> 7)) * (ldc >> 6) + (c_ >> 6)) << 14) + lds_byte(r_ & 127, c_ & 63)) = w; }
                    else *(u32x4*)(rowp + bj * HALF) = w; } }
    }
};
struct EpiRes {
    static constexpr bool PERM = true, AFTER_DRAIN = false;
    const float* base; float* out; bf16_t* xn; float* st; int ldc; const float* rs;
    __device__ __forceinline__ void operator()(const f32x4 (&acc)[2][2][4][2], const Unit& u, int wr, int wc, int fr, int fq) const {
        const int col0 = u.pn * BM + wc * 32 + 8 * fq;
#pragma unroll
        for (int ai = 0; ai < 2; ++ai) {
            f32x4 rp[4];
            if (rs) {
#pragma unroll
                for (int m = 0; m < 4; ++m) rp[m] = *(const f32x4*)(rs + (size_t)(u.pm * BM + ai * HALF + wr * 64 + m * 16 + fr) * 16 + 4 * fq);
            }
            f32x4 bs[4][2][2];
#pragma unroll
            for (int m = 0; m < 4; ++m) { const size_t off = (size_t)(u.pm * BM + ai * HALF + wr * 64 + m * 16 + fr) * ldc + col0;
#pragma unroll
                for (int bj = 0; bj < 2; ++bj) { bs[m][bj][0] = *(const f32x4*)(base + off + bj * HALF); bs[m][bj][1] = *(const f32x4*)(base + off + bj * HALF + 4); } }
            __builtin_amdgcn_sched_barrier(0);
#pragma unroll
            for (int m = 0; m < 4; ++m) { const int row = u.pm * BM + ai * HALF + wr * 64 + m * 16 + fr; const size_t off = (size_t)row * ldc + col0; float ss = 0.f;
                float f = 1.f;
                if (rs) { float q = (rp[m][0] + rp[m][1]) + (rp[m][2] + rp[m][3]); q += __shfl_xor(q, 16); q += __shfl_xor(q, 32); const float r = __builtin_amdgcn_rsqf(q * (1.0f / 1024.0f) + 1e-6f); f = r * r; }
#pragma unroll
                for (int bj = 0; bj < 2; ++bj) {
                    const f32x4 o0 = bs[m][bj][0] + acc[ai][bj][m][0] * f, o1 = bs[m][bj][1] + acc[ai][bj][m][1] * f;
                    *(f32x4*)(out + off + bj * HALF) = o0; *(f32x4*)(out + off + bj * HALF + 4) = o1;
                    if (xn) { u32x4 w; w.x = cvt_pk_bf16(o0[0], o0[1]); w.y = cvt_pk_bf16(o0[2], o0[3]); w.z = cvt_pk_bf16(o1[0], o1[1]); w.w = cvt_pk_bf16(o1[2], o1[3]);
                        { const int c_ = col0 + bj * HALF;
                          *(u32x4*)((char*)xn + ((size_t)((u.pm * 2 + ai) * (ldc >> 6) + (c_ >> 6)) << 14) + lds_byte(wr * 64 + m * 16 + fr, c_ & 63)) = w; }
                        ss += (o0[0] * o0[0] + o0[1] * o0[1]) + (o0[2] * o0[2] + o0[3] * o0[3]) + (o1[0] * o1[0] + o1[1] * o1[1]) + (o1[2] * o1[2] + o1[3] * o1[3]); } }
                if (xn) { ss += __shfl_xor(ss, 16); ss += __shfl_xor(ss, 32); if (fq == 0) st[(size_t)row * 16 + u.pn * 4 + wc] = ss; } }
            __builtin_amdgcn_sched_barrier(0);
        }
    }
};
template <class Epi, class Sched, bool ALIGN_EPI = false, bool SP2 = false>
__device__ __forceinline__ void gemm_phase(PG8_LAS unsigned char* lds, const Gemm g, const Sched& S, const Epi& E, const int tid_in) {
    const int tid = tid_in, wid = __builtin_amdgcn_readfirstlane(tid >> 6), lane = tid & 63, wr = wid >> 2, wc = wid & 3, fr = lane & 15, fq = lane >> 4;
    const int K = g.K, nt = K / BK;
    unsigned voffA[2], voffB[2];
#pragma unroll
    for (int i = 0; i < 2; ++i) { int R, C; stage_rc(tid * 16 + i * 8192, R, C); const int Rb = Epi::PERM ? ((R & ~31) + perm32(R & 31)) : R;
        voffA[i] = g.a_tiled ? (unsigned)(tid * 16 + i * 8192) : (unsigned)(R * K + C) * 2u; voffB[i] = (unsigned)(Rb * K + C) * 2u; }
    const size_t kstep = (size_t)(BK * 2);
    const size_t hstep = (size_t)HALF * K * 2;
    const size_t tstep = 2 * hstep;
    const size_t kstepA = g.a_tiled ? (size_t)16384 : kstep, hstepA = g.a_tiled ? (size_t)nt * 16384 : hstep, tstepA = 2 * hstepA;
    const unsigned ldsw = (unsigned)wid * 1024u;
    const int aoff = lds_byte(wr * 64 + fr, fq * 8), boff = lds_byte(wc * 32 + fr, fq * 8);
#define PG8_SA(b, h) (((b) * 2 + (h)) * HTB)
#define PG8_SB(b, h) ((4 + (b) * 2 + (h)) * HTB)
#define PG8_STAGE(bufoff, gbase, voff) do { _Pragma("unroll") for (int _i = 0; _i < 2; ++_i) \
        __builtin_amdgcn_global_load_lds((const unsigned*)((const char*)(gbase) + (voff)[_i]), (PG8_LAS unsigned*)(lds + (bufoff) + ldsw + _i * 8192), 16, 0, 0); } while (0)
#define PG8_LDA(dst, b, h) do { _Pragma("unroll") for (int m = 0; m < 4; ++m) _Pragma("unroll") for (int k = 0; k < 2; ++k) dst[m][k] = *(const PG8_LAS bf16x8*)(lds + PG8_SA(b, h) + aoff + m * 2048 + k * 1024); } while (0)
#define PG8_LDB(dst, b, h) do { _Pragma("unroll") for (int n = 0; n < 2; ++n) _Pragma("unroll") for (int k = 0; k < 2; ++k) dst[n][k] = *(const PG8_LAS bf16x8*)(lds + PG8_SB(b, h) + boff + n * 2048 + k * 1024); } while (0)
#define PG8_MMA(ai, bj, At, Bt) do { __builtin_amdgcn_s_setprio(1); _Pragma("unroll") for (int m = 0; m < 4; ++m) _Pragma("unroll") for (int n = 0; n < 2; ++n) _Pragma("unroll") for (int k = 0; k < 2; ++k) \
        acc[ai][bj][m][n] = __builtin_amdgcn_mfma_f32_16x16x32_bf16(Bt[n][k], At[m][k], acc[ai][bj][m][n], 0, 0, 0); __builtin_amdgcn_s_setprio(0); } while (0)
#define PG8_WAIT_V(n) asm volatile("s_waitcnt vmcnt(" #n ")" ::: "memory")
#define PG8_WAIT_L(n) asm volatile("s_waitcnt lgkmcnt(" #n ")" ::: "memory")
#define PG8_BAR __builtin_amdgcn_s_barrier()
#define PG8_SCHED __builtin_amdgcn_sched_barrier(0)
    Unit cur, nxt; int ui = 0;
    if (!S.next(0, cur)) return;
    f32x4 acc[2][2][4][2];
#pragma unroll
    for (int a = 0; a < 2; ++a)
#pragma unroll
        for (int b = 0; b < 2; ++b)
#pragma unroll
            for (int m = 0; m < 4; ++m)
#pragma unroll
                for (int n = 0; n < 2; ++n) acc[a][b][m][n] = (f32x4){0.f, 0.f, 0.f, 0.f};
    bf16x8 At[4][2], B0[2][2], B1[2][2];
    const char* cA = (const char*)g.A + (size_t)cur.pm * tstepA + (size_t)cur.pn * g.a_pn_stride; const char* cB = (const char*)g.Bt + (size_t)cur.pn * tstep;
    S.a_ready(cur);
    if constexpr (SP2) {
        PG8_STAGE(PG8_SB(0, 0), cB, voffB); PG8_STAGE(PG8_SB(0, 1), cB + hstep, voffB); PG8_STAGE(PG8_SA(0, 0), cA, voffA); PG8_STAGE(PG8_SA(0, 1), cA + hstepA, voffA);
        if (wr == 1) PG8_BAR;
        PG8_WAIT_V(2); PG8_BAR;
        PG8_STAGE(PG8_SB(1, 0), cB + kstep, voffB); PG8_STAGE(PG8_SA(1, 0), cA + kstepA, voffA); PG8_STAGE(PG8_SB(1, 1), cB + hstep + kstep, voffB);
        PG8_WAIT_V(6); PG8_BAR;
    } else {
        PG8_STAGE(PG8_SB(0, 0), cB, voffB); PG8_STAGE(PG8_SA(0, 0), cA, voffA); PG8_STAGE(PG8_SB(0, 1), cB + hstep, voffB); PG8_STAGE(PG8_SA(0, 1), cA + hstepA, voffA);
        if (wr == 1) PG8_BAR;
        PG8_WAIT_V(4); PG8_BAR;
        PG8_STAGE(PG8_SB(1, 0), cB + kstep, voffB); PG8_STAGE(PG8_SA(1, 0), cA + kstepA, voffA); PG8_STAGE(PG8_SB(1, 1), cB + hstep + kstep, voffB);
        PG8_WAIT_V(6); PG8_BAR;
    }
    for (;;) {
        const bool has_next = S.next(ui + 1, nxt);
        const char* nA = has_next ? (const char*)g.A + (size_t)nxt.pm * tstepA + (size_t)nxt.pn * g.a_pn_stride : cA; const char* nB = has_next ? (const char*)g.Bt + (size_t)nxt.pn * tstep : cB;
        for (int t = 0; t < nt; t += 2) {
            const bool last = (t == nt - 2);
            const char* a1 = cA + (size_t)(t + 1) * kstepA;
            const char* a2 = last ? nA : cA + (size_t)(t + 2) * kstepA; const char* b2 = last ? nB : cB + (size_t)(t + 2) * kstep;
            const char* a3 = a2 + kstepA; const char* b3 = b2 + kstep;
            if (last && has_next) S.a_ready(nxt);
            if constexpr (SP2) {
            PG8_LDB(B0, 0, 0); PG8_LDB(B1, 0, 1); PG8_SCHED; PG8_LDA(At, 0, 0); PG8_STAGE(PG8_SA(1, 1), a1 + hstepA, voffA);
            PG8_WAIT_V(8); PG8_WAIT_L(0); PG8_BAR; PG8_MMA(0, 0, At, B0); PG8_MMA(0, 1, At, B1); PG8_BAR; PG8_SCHED;
            PG8_LDA(At, 0, 1); PG8_STAGE(PG8_SB(0, 0), b2, voffB); PG8_STAGE(PG8_SB(0, 1), b2 + hstep, voffB); PG8_STAGE(PG8_SA(0, 0), a2, voffA);
            PG8_WAIT_V(8); PG8_WAIT_L(0); PG8_BAR; PG8_MMA(1, 0, At, B0); PG8_MMA(1, 1, At, B1); PG8_BAR; PG8_SCHED;
            PG8_LDB(B0, 1, 0); PG8_LDB(B1, 1, 1); PG8_SCHED; PG8_LDA(At, 1, 0); PG8_STAGE(PG8_SA(0, 1), a2 + hstepA, voffA);
            PG8_WAIT_V(8); PG8_WAIT_L(0); PG8_BAR; PG8_MMA(0, 0, At, B0); PG8_MMA(0, 1, At, B1); PG8_BAR; PG8_SCHED;
            PG8_LDA(At, 1, 1); PG8_STAGE(PG8_SB(1, 0), b3, voffB); PG8_STAGE(PG8_SB(1, 1), b3 + hstep, voffB); PG8_STAGE(PG8_SA(1, 0), a3, voffA);
            PG8_WAIT_V(8); PG8_WAIT_L(0); PG8_BAR; PG8_MMA(1, 0, At, B0); PG8_MMA(1, 1, At, B1); PG8_BAR; PG8_SCHED;
            } else {
            PG8_LDB(B0, 0, 0); PG8_SCHED; PG8_LDA(At, 0, 0); PG8_STAGE(PG8_SA(1, 1), a1 + hstepA, voffA);
            PG8_WAIT_L(8); PG8_BAR; PG8_WAIT_L(0); PG8_MMA(0, 0, At, B0); PG8_BAR; PG8_SCHED;
            PG8_LDB(B1, 0, 1); PG8_STAGE(PG8_SB(0, 0), b2, voffB);
            PG8_BAR; PG8_WAIT_L(0); PG8_MMA(0, 1, At, B1); PG8_BAR;
            PG8_LDA(At, 0, 1); PG8_STAGE(PG8_SA(0, 0), a2, voffA);
            PG8_BAR; PG8_WAIT_L(0); PG8_MMA(1, 0, At, B0); PG8_BAR; PG8_SCHED;
            PG8_STAGE(PG8_SB(0, 1), b2 + hstep, voffB);
            PG8_WAIT_V(6); PG8_BAR; PG8_MMA(1, 1, At, B1); PG8_BAR;
            PG8_LDB(B0, 1, 0); PG8_SCHED; PG8_LDA(At, 1, 0); PG8_STAGE(PG8_SA(0, 1), a2 + hstepA, voffA);
            PG8_WAIT_L(8); PG8_BAR; PG8_WAIT_L(0); PG8_MMA(0, 0, At, B0); PG8_BAR; PG8_SCHED;
            PG8_LDB(B1, 1, 1); PG8_STAGE(PG8_SB(1, 0), b3, voffB);
            PG8_BAR; PG8_WAIT_L(0); PG8_MMA(0, 1, At, B1); PG8_BAR;
            PG8_LDA(At, 1, 1); PG8_STAGE(PG8_SA(1, 0), a3, voffA);
            PG8_BAR; PG8_WAIT_L(0); PG8_MMA(1, 0, At, B0); PG8_BAR; PG8_SCHED;
            PG8_STAGE(PG8_SB(1, 1), b3 + hstep, voffB);
            PG8_WAIT_V(6); PG8_BAR; PG8_MMA(1, 1, At, B1); PG8_BAR;
            }
        }
        if constexpr (ALIGN_EPI) { if (wr == 0) PG8_BAR; }
        if constexpr (!Epi::AFTER_DRAIN) { E(acc, cur, wr, wc, fr, fq); S.done(cur); }
        if (!has_next) break;
#pragma unroll
        for (int a = 0; a < 2; ++a)
#pragma unroll
            for (int b = 0; b < 2; ++b)
#pragma unroll
                for (int m = 0; m < 4; ++m)
#pragma unroll
                    for (int n = 0; n < 2; ++n) acc[a][b][m][n] = (f32x4){0.f, 0.f, 0.f, 0.f};
        cur = nxt; cA = nA; cB = nB; ++ui;
        if constexpr (ALIGN_EPI) { if (wr == 1) PG8_BAR; }
    }
    PG8_WAIT_V(0);
    if constexpr (!ALIGN_EPI) { if (wr == 0) PG8_BAR; }
    PG8_BAR;
    if constexpr (Epi::AFTER_DRAIN) { E.fused(acc, cur, wr, wc, fr, fq, lds, wid, lane); S.done(cur); }
#undef PG8_SA
#undef PG8_SB
#undef PG8_STAGE
#undef PG8_LDA
#undef PG8_LDB
#undef PG8_MMA
#undef PG8_WAIT_V
#undef PG8_WAIT_L
#undef PG8_BAR
#undef PG8_SCHED
}
}
#ifndef PG8_SP2
#define PG8_SP2 true
#endif
#ifndef PG8_ALIGN
#define PG8_ALIGN true
#endif

constexpr int NWAVES = 8;
constexpr int D = 1024, FF = 4096, NH = 16, HD = 64, DEPTH = 4;
constexpr int NTOK = 131072;
constexpr int GROUP_TOK = 65536;
#ifndef MK_CH
#define MK_CH 65536
#endif
constexpr int CH = MK_CH;
constexpr int NCHUNK = NTOK / CH;
constexpr float RMS_EPS = 1e-6f;
constexpr float LOG2E = 1.4426950408889634f;
static_assert(GROUP_TOK % CH == 0 && CH % 4096 == 0, "chunking");

constexpr size_t MiB = 1u << 20;
constexpr size_t WS_WPOOL = 2 * MiB;
constexpr size_t WS_WQKV = 4 * MiB;
constexpr size_t WS_WO = 16 * MiB;
constexpr size_t WS_WUP = 20 * MiB;
constexpr size_t WS_WDN = 52 * MiB;
constexpr size_t WS_XN = 96 * MiB;
constexpr size_t WS_PG = WS_XN + (size_t)CH * D * 2;
constexpr size_t WS_ACT = WS_PG + (size_t)CH * D * 2;
constexpr size_t WS_CTL = 0, CTL_ZERO_BYTES = 65536;
constexpr size_t WS_STAT = 86 * MiB;
static_assert(WS_STAT + 2 * (size_t)CH * 64 <= WS_XN, "stat arrays");
constexpr size_t WS_END = WS_ACT + (size_t)CH * FF * 2;
static_assert(WS_XN >= WS_WDN + 32 * MiB && WS_END <= 1024 * MiB, "d_ws map");

constexpr int RING_BYTES = 131072;
constexpr int BIAS_OFF = RING_BYTES;
constexpr int MISC_OFF = RING_BYTES + 4096;
constexpr int LDS_BYTES = 147456;

#define GAS __attribute__((address_space(1)))
#define LAS __attribute__((address_space(3)))
typedef unsigned short bf16;
typedef unsigned v4u __attribute__((ext_vector_type(4)));
typedef unsigned v2u __attribute__((ext_vector_type(2)));
typedef float f32x4 __attribute__((ext_vector_type(4)));
typedef short bf16x8 __attribute__((ext_vector_type(8)));
typedef short s16x4 __attribute__((ext_vector_type(4)));
#define LDS_WAIT() asm volatile("s_waitcnt lgkmcnt(0)" ::: "memory")
typedef float f32x2_t __attribute__((ext_vector_type(2))); typedef __bf16 bf16x2_t __attribute__((ext_vector_type(2)));
__device__ __forceinline__ unsigned pk2(float lo, float hi) { f32x2_t v = {lo, hi}; bf16x2_t b = __builtin_convertvector(v, bf16x2_t); return __builtin_bit_cast(unsigned, b); }
__device__ __forceinline__ float wave_sum(float v) {
#pragma unroll
    for (int o = 1; o < 64; o <<= 1) v += __shfl_xor(v, o);
    return v;
}

__device__ __forceinline__ void transpose_item(const float* W, int K, int N, bf16* WT, int row_off, const float* nscale, const float* kscale, LAS float* scr, int item, int lane) {
    const int nblk = N / 32, kb = item / nblk, nb = item % nblk, k0 = 64 * kb, n0 = 32 * nb;
    float wv[32];
#pragma unroll
    for (int i = 0; i < 32; ++i) wv[i] = W[(size_t)(k0 + 2 * i + (lane >> 5)) * N + n0 + (lane & 31)];
#pragma unroll
    for (int i = 0; i < 32; ++i) scr[(2 * i + (lane >> 5)) * 33 + (lane & 31)] = wv[i];
    LDS_WAIT(); asm volatile("" ::: "memory");
    const int c = lane & 7;
    float ks[8];
#pragma unroll
    for (int e = 0; e < 8; ++e) ks[e] = kscale ? kscale[k0 + 8 * c + e] : 1.f;
#pragma unroll
    for (int j = 0; j < 4; ++j) { const int n = (lane >> 3) + 8 * j; const LAS float* s = scr + (8 * c) * 33 + n;
        const float sc = nscale ? nscale[n0 + n] : 1.f;
        v4u o; o.x = pk2(s[0 * 33] * sc * ks[0], s[1 * 33] * sc * ks[1]); o.y = pk2(s[2 * 33] * sc * ks[2], s[3 * 33] * sc * ks[3]); o.z = pk2(s[4 * 33] * sc * ks[4], s[5 * 33] * sc * ks[5]); o.w = pk2(s[6 * 33] * sc * ks[6], s[7 * 33] * sc * ks[7]);
        *(GAS v4u*)(WT + (size_t)(row_off + n0 + n) * K + k0 + 8 * c) = o; }
    LDS_WAIT(); asm volatile("" ::: "memory");
}

struct Ptrs {
    const float *x_in[2], *norm_mix, *pool_w, *pool_scale, *w_qkv, *rpb, *w_o, *norm_mlp, *w_up, *w_down, *norm_final;
    float* out; unsigned char* ws;
};

__device__ __forceinline__ void prologue(const Ptrs& P, LAS unsigned char* lds, int gw, int NGW, int wave, int lane) {
    LAS float* scr = (LAS float*)(lds + wave * 16384);
    bf16* WPOOL = (bf16*)(P.ws + WS_WPOOL); bf16* WQKV = (bf16*)(P.ws + WS_WQKV); bf16* WO = (bf16*)(P.ws + WS_WO); bf16* WUP = (bf16*)(P.ws + WS_WUP); bf16* WDN = (bf16*)(P.ws + WS_WDN);
    constexpr int I_POOL = (256 / 64) * (256 / 32), I_QKV = (D / 64) * (3 * D / 32), I_O = (D / 64) * (D / 32), I_UP = (D / 64) * (FF / 32), I_DN = (FF / 64) * (D / 32);
    constexpr int NITEMS = 8 * I_POOL + 2 * I_QKV + 2 * I_O + 4 * I_UP + 4 * I_DN;
    for (int it = gw; it < NITEMS; it += NGW) {
        int r = it;
        if (r < 8 * I_POOL) { const int mtx = r / I_POOL, j = mtx >> 2, g = mtx & 3; transpose_item(P.pool_w + (size_t)mtx * 65536, 256, 256, WPOOL + (size_t)j * 1024 * 256, g * 256, P.pool_scale + j * 1024 + g * 256, nullptr, scr, r % I_POOL, lane); continue; } r -= 8 * I_POOL;
        if (r < 2 * I_QKV) { const int j = r / I_QKV; transpose_item(P.w_qkv + (size_t)j * D * 3 * D, D, 3 * D, WQKV + (size_t)j * 3 * D * D, 0, nullptr, P.norm_mix + (2 * j + 1) * D, scr, r % I_QKV, lane); continue; } r -= 2 * I_QKV;
        if (r < 2 * I_O) { const int j = r / I_O; transpose_item(P.w_o + (size_t)j * D * D, D, D, WO + (size_t)j * D * D, 0, nullptr, nullptr, scr, r % I_O, lane); continue; } r -= 2 * I_O;
        if (r < 4 * I_UP) { const int j = r / I_UP; transpose_item(P.w_up + (size_t)j * D * FF, D, FF, WUP + (size_t)j * D * FF, 0, nullptr, P.norm_mlp + j * D, scr, r % I_UP, lane); continue; } r -= 4 * I_UP;
        { const int j = r / I_DN; transpose_item(P.w_down + (size_t)j * D * FF, FF, D, WDN + (size_t)j * D * FF, 0, nullptr, nullptr, scr, r % I_DN, lane); }
    }
}

__device__ __forceinline__ void norm_rows_f32_inplace(float* x, const float* gain, int nrows, int gw, int NGW, int lane) {
    f32x4 g[4];
#pragma unroll
    for (int j = 0; j < 4; ++j) g[j] = *((const f32x4*)gain + lane + 64 * j);
    for (int m = gw * 4; m < nrows; m += NGW * 4) {
        GAS f32x4* xr = (GAS f32x4*)(x + (size_t)m * D) + lane;
        f32x4 v[4][4];
#pragma unroll
        for (int r = 0; r < 4; ++r)
#pragma unroll
            for (int j = 0; j < 4; ++j) v[r][j] = xr[r * 256 + 64 * j];
        __builtin_amdgcn_sched_barrier(0);
#pragma unroll
        for (int r = 0; r < 4; ++r) { float s = 0.f;
#pragma unroll
            for (int j = 0; j < 4; ++j) s += (v[r][j].x * v[r][j].x + v[r][j].y * v[r][j].y) + (v[r][j].z * v[r][j].z + v[r][j].w * v[r][j].w);
            const float rr = 1.0f / sqrtf(wave_sum(s) * (1.f / D) + RMS_EPS);
#pragma unroll
            for (int j = 0; j < 4; ++j) xr[r * 256 + 64 * j] = v[r][j] * rr * g[j]; }
    }
}

constexpr int PT = 32, PROWS = 48;
typedef float f32x2v __attribute__((ext_vector_type(2)));
__device__ __forceinline__ f32x2v bfpair(unsigned u) { return (f32x2v){__builtin_bit_cast(float, u << 16), __builtin_bit_cast(float, u & 0xffff0000u)}; }
struct f32x8 { f32x4 lo, hi; };
__device__ __forceinline__ f32x8 bf8(const v4u u) { f32x8 r; r.lo = (f32x4){__builtin_bit_cast(float, u.x << 16), __builtin_bit_cast(float, u.x & 0xffff0000u), __builtin_bit_cast(float, u.y << 16), __builtin_bit_cast(float, u.y & 0xffff0000u)};
    r.hi = (f32x4){__builtin_bit_cast(float, u.z << 16), __builtin_bit_cast(float, u.z & 0xffff0000u), __builtin_bit_cast(float, u.w << 16), __builtin_bit_cast(float, u.w & 0xffff0000u)}; return r; }
__device__ __forceinline__ v4u pack8(const f32x4 a, const f32x4 b) { v4u o; o.x = pk2(a[0], a[1]); o.y = pk2(a[2], a[3]); o.z = pk2(b[0], b[1]); o.w = pk2(b[2], b[3]); return o; }
template <int W> __device__ __forceinline__ void pool_rows_interior(const LAS v4u* hrow, GAS v4u* po) {
    constexpr int HW = W / 2; constexpr float INV = 1.0f / (float)W;
    f32x4 sl = {0.f, 0.f, 0.f, 0.f}, sh = {0.f, 0.f, 0.f, 0.f};
#pragma unroll
    for (int o = -HW; o < HW; ++o) { const f32x8 h = bf8(hrow[(8 + o) * 128]); sl += h.lo; sh += h.hi; }
    __builtin_amdgcn_sched_barrier(0);
#pragma unroll
    for (int i = 0; i < 8; ++i) {
        const f32x8 c = bf8(hrow[(8 + i) * 128]);
        po[(size_t)i * 32] = pack8(sl * INV - c.lo, sh * INV - c.hi);
        if (i + 1 < 8) { const f32x8 a = bf8(hrow[(8 + i + HW) * 128]), b = bf8(hrow[(8 + i - HW) * 128]); sl += a.lo - b.lo; sh += a.hi - b.hi; }
        __builtin_amdgcn_sched_barrier(0);
    }
}
__device__ __forceinline__ void pool_load_rows(f32x4 (&v)[6][4], const float* x, int m0, int seq_len, int wave, int lane) {
    const int sb = m0 / seq_len * seq_len, t0 = m0 - sb;
#pragma unroll
    for (int k = 0; k < 6; ++k) { const int t = min(max(t0 - 8 + wave + NWAVES * k, 0), seq_len - 1);
        const GAS f32x4* xr = (const GAS f32x4*)(x + (size_t)(sb + t) * D) + lane;
#pragma unroll
        for (int j = 0; j < 4; ++j) v[k][j] = xr[64 * j]; }
}
__device__ __forceinline__ void pool_phase(LAS unsigned char* lds, const float* x, const float* gain, bf16* Pg, int seq_len, int vcu, int G, int tid, int wave, int lane) {
    f32x4 v[6][4];
    if (vcu < CH / PT) pool_load_rows(v, x, vcu * PT, seq_len, wave, lane);
    for (int tile = vcu; tile < CH / PT; tile += G) {
        const int m0 = tile * PT;
        const int sb = m0 / seq_len * seq_len;
        const int t0 = m0 - sb;
        f32x4 g[4];
#pragma unroll
        for (int j = 0; j < 4; ++j) g[j] = *((const GAS f32x4*)gain + lane + 64 * j);
#pragma unroll
        for (int k = 0; k < 6; ++k) { float s = 0.f;
#pragma unroll
            for (int j = 0; j < 4; ++j) s += (v[k][j].x * v[k][j].x + v[k][j].y * v[k][j].y) + (v[k][j].z * v[k][j].z + v[k][j].w * v[k][j].w);
            const float r = 1.0f / sqrtf(wave_sum(s) * (1.f / D) + RMS_EPS);
            LAS v2u* hr = (LAS v2u*)(lds + (wave + NWAVES * k) * 2048) + lane;
#pragma unroll
            for (int j = 0; j < 4; ++j) { v2u o; o.x = pk2(v[k][j].x * r * g[j].x, v[k][j].y * r * g[j].y); o.y = pk2(v[k][j].z * r * g[j].z, v[k][j].w * r * g[j].w); hr[64 * j] = o; } }
        __syncthreads();
        if (tile + G < CH / PT) { pool_load_rows(v, x, (tile + G) * PT, seq_len, wave, lane); __builtin_amdgcn_sched_barrier(0); }
        {
            const int pg = wave & 3, part = (lane >> 5) + 2 * (wave >> 2), oc = lane & 31, pw = 2 << pg, phw = pw >> 1;
            const LAS v4u* hrow = (const LAS v4u*)(lds + (8 * part) * 2048 + pg * 512 + oc * 16);
            GAS v4u* po = (GAS v4u*)(Pg + ((size_t)pg * CH + m0 + 8 * part) * 256 + oc * 8);
            if (t0 >= 8 && t0 + PT + 8 <= seq_len) {
                switch (pg) { case 0: pool_rows_interior<2>(hrow, po); break; case 1: pool_rows_interior<4>(hrow, po); break; case 2: pool_rows_interior<8>(hrow, po); break; default: pool_rows_interior<16>(hrow, po); break; }
            } else {
                for (int i = 0; i < 8; ++i) {
                    const int t = t0 + 8 * part + i;
                    const int lo = max(t - phw, 0), hi = min(t + phw - 1, seq_len - 1);
                    f32x4 sl = {0.f, 0.f, 0.f, 0.f}, sh = {0.f, 0.f, 0.f, 0.f};
                    for (int q = lo; q <= hi; ++q) { const f32x8 h = bf8(hrow[(8 + q - t + i) * 128]); sl += h.lo; sh += h.hi; }
                    const f32x8 c = bf8(hrow[(8 + i) * 128]);
                    const float inv = 1.0f / (float)(hi - lo + 1);
                    po[(size_t)i * 32] = pack8(sl * inv - c.lo, sh * inv - c.hi);
                }
            }
        }
        __syncthreads();
    }
}

#define RLX_AGENT __ATOMIC_RELAXED, __HIP_MEMORY_SCOPE_AGENT
#define XB_TMO      128
#define XB_XCNT(j)  (256  + 64 * (j))
#define XB_XSUB(j)  (1280 + 64 * (j))
#define XB_XGEN(j)  (2304 + 64 * (j))
#define XB_TOP      3328
#define XB_TOPGEN   3392
#define XCD_BAR_WORDS 3456
#define XB_SPIN_CAP (1u << 18)

__device__ __forceinline__ unsigned xb_ld(unsigned* p)              { return __hip_atomic_load(p, __ATOMIC_RELAXED, __HIP_MEMORY_SCOPE_AGENT); }
__device__ __forceinline__ unsigned xb_add(unsigned* p, unsigned v) { return __hip_atomic_fetch_add(p, v, __ATOMIC_RELAXED, __HIP_MEMORY_SCOPE_AGENT); }
__device__ __forceinline__ unsigned xb_xcc_id() { return (unsigned)__builtin_amdgcn_s_getreg((3 << 11) | 20) & 0xFu; }
#define XB_SPIN(cond, bar) do { unsigned _sp = 0; while (cond) { __builtin_amdgcn_s_sleep(1); \
    if ((++_sp & 255u) == 0u) { if (xb_ld(&(bar)[XB_TMO])) break; if (_sp > XB_SPIN_CAP) { atomicAdd(&(bar)[XB_TMO], 1u); break; } } } } while (0)

struct XcdBarrier {
    unsigned* bar; unsigned x;
    volatile LAS unsigned* st;
};

__device__ __forceinline__ XcdBarrier xcd_barrier_post(unsigned* bar, volatile LAS unsigned* st) {
    XcdBarrier b; b.bar = bar; b.x = xb_xcc_id(); b.st = st;
    if (threadIdx.x == 0) (void)xb_add(&bar[XB_XCNT(b.x)], 1u);
    return b;
}
__device__ __forceinline__ void xcd_barrier_complete(unsigned* bar, unsigned x, unsigned& nloc, unsigned& nx) {
    const unsigned G = gridDim.x * gridDim.y * gridDim.z;
    unsigned sum, cnt, mine, sp = 0u;
    for (;;) {
        sum = 0u; cnt = 0u; mine = 0u;
#pragma unroll
        for (unsigned j = 0; j < 16; ++j) { const unsigned c = xb_ld(&bar[XB_XCNT(j)]); sum += c; cnt += (c > 0u) ? 1u : 0u; mine = (j == x) ? c : mine; }
        if (sum == G) break;
        __builtin_amdgcn_s_sleep(1);
        if ((++sp & 255u) == 0u) { if (xb_ld(&bar[XB_TMO])) break; if (sp > XB_SPIN_CAP) { atomicAdd(&bar[XB_TMO], 1u); break; } }
    }
    nloc = mine > 0u ? mine : 1u; nx = cnt > 0u ? cnt : 1u;
}

__device__ __forceinline__ void xcd_barrier(const XcdBarrier& b) {
    asm volatile("s_waitcnt vmcnt(0)" ::: "memory");
    __syncthreads();
    if (threadIdx.x == 0) {
        unsigned* bar = b.bar;
        __builtin_amdgcn_s_waitcnt(0);
        unsigned nloc = b.st[0], nx = b.st[1];
        if (nloc == 0u) { xcd_barrier_complete(bar, b.x, nloc, nx); b.st[0] = nloc; b.st[1] = nx; }
        const unsigned old = xb_add(&bar[XB_XSUB(b.x)], 1u);
        const unsigned gen = old / nloc;
        if (old + 1u == (gen + 1u) * nloc) {
            __builtin_amdgcn_fence(__ATOMIC_RELEASE, "agent");
            asm volatile("s_waitcnt vmcnt(0)" ::: "memory");
            const unsigned og = xb_add(&bar[XB_TOP], 1u);
            const unsigned tg = og / nx;
            if (og + 1u == (tg + 1u) * nx) xb_add(&bar[XB_TOPGEN], 1u);
            else XB_SPIN(xb_ld(&bar[XB_TOPGEN]) == tg, bar);
            __builtin_amdgcn_fence(__ATOMIC_ACQUIRE, "agent");
            xb_add(&bar[XB_XGEN(b.x)], 1u);
            asm volatile("s_waitcnt vmcnt(0)" ::: "memory");
        } else {
            XB_SPIN(xb_ld(&bar[XB_XGEN(b.x)]) == gen, bar);
            __builtin_amdgcn_fence(__ATOMIC_ACQUIRE, "agent");
            asm volatile("s_waitcnt vmcnt(0)" ::: "memory");
        }
    }
    __syncthreads();
}


__device__ __forceinline__ unsigned cvtpk(float lo, float hi) { return pk2(lo, hi); }
__device__ __forceinline__ s16x4 vtr(const LAS unsigned char* p) { return __builtin_bit_cast(s16x4, __builtin_amdgcn_ds_read_tr16_b64_v4i16((LAS s16x4*)p)); }
__device__ __forceinline__ void attn_phase(LAS unsigned char* lds, bf16* Qb, const bf16* Kb, const bf16* Vb, const float* rpb_l, int seq_len, int G, int bx, int tid, int wave, int lane) {
    const int fr = lane & 15, fq = lane >> 4;
    const int rows = seq_len >> 6, rows_shift = (seq_len == 2048) ? 5 : 6;
    constexpr int NI = (CH / 64) * 8;
    int nx, xc, lc, per;
    if ((G & 7) == 0) { nx = G >> 3; xc = bx & 7; lc = bx >> 3; per = NI >> 3; } else { nx = G; xc = 0; lc = bx; per = NI; }
    LAS float* bias = (LAS float*)(lds + BIAS_OFF);
    const int qb = wave & 3, hh = wave >> 2;
    const int qc = (qb < 3) ? (8 + 16 * qb + fr) : (fr < 8 ? fr : 48 + fr);
    const int a0 = (qb < 3) ? qb : 0, a1 = (qb < 3) ? qb + 1 : 3;
    const int wst = min(max(qc - 8, 0), 48);
    const int q4 = (lane & 15) >> 2, p4 = lane & 3;
    float madd[2][4];
#pragma unroll
    for (int ai = 0; ai < 2; ++ai)
#pragma unroll
        for (int i = 0; i < 4; ++i) { const int kc = 16 * (ai ? a1 : a0) + 4 * fq + i; madd[ai][i] = ((kc >= wst) && (kc < wst + 16)) ? 0.f : -1.0e30f; }
    int voff[4];
#pragma unroll
    for (int i3 = 0; i3 < 4; ++i3) voff[i3] = (lane >> 4) * D + (((lane & 15) ^ (((lane >> 4) << 2) | i3)) * 8);
    if (lc >= per) return;
    int id = xc * per + lc;
    int r = id & (rows - 1), hp = (id >> rows_shift) & 7, tb = (id >> (rows_shift + 3)) * seq_len, r0 = min(max(r - 4, 0), rows - 8);
    bf16x8 qf0, qf1, kf[4][2][2];
    float bnext[2];
#define ATT_PREFETCH() do { \
        const int h_ = 2 * hp + hh; const size_t qo_ = (size_t)(tb + r * 64 + qc) * D + h_ * 64; \
        qf0 = *(const GAS bf16x8*)(Qb + qo_ + 8 * fq); qf1 = *(const GAS bf16x8*)(Qb + qo_ + 32 + 8 * fq); \
        const bf16* kb_ = Kb + ((size_t)(h_ * 8 + fq) * CH + (tb + r0 * 64 + fr)) * 8; \
        _Pragma("unroll") for (int kr = 0; kr < 4; ++kr) _Pragma("unroll") for (int ai = 0; ai < 2; ++ai) { const bf16* kp = kb_ + (kr * 64 + 16 * (ai ? a1 : a0)) * 8; kf[kr][ai][0] = *(const GAS bf16x8*)kp; kf[kr][ai][1] = *(const GAS bf16x8*)(kp + (size_t)4 * CH * 8); } \
        bnext[0] = rpb_l[hp * 930 + tid] * LOG2E; bnext[1] = (tid + 512 < 930) ? rpb_l[hp * 930 + tid + 512] * LOG2E : 0.f; } while (0)
#define ATT_BIAS_WRITE() do { bias[tid] = bnext[0]; if (tid + 512 < 930) bias[tid + 512] = bnext[1]; } while (0)
    ATT_PREFETCH();
    ATT_BIAS_WRITE();
    for (int loc = lc; loc < per; loc += nx) {
        const int h = 2 * hp + hh;
        const size_t qoff = (size_t)(tb + r * 64 + qc) * D + h * 64;
        const bf16* kbase = Kb + ((size_t)(h * 8 + fq) * CH + (tb + r0 * 64 + fr)) * 8;
        const int drb = r0 - r + 7;
        __syncthreads();
        {
            const int a = wave >> 1, ub = (wave & 1) * 2;
#pragma unroll
            for (int i = 0; i < 16; ++i) { const int kr = 2 * (ub + (i >> 3)) + (i & 1), cb = 16 * a + 4 * ((i & 7) >> 1);
                const bf16* src = Vb + (size_t)(tb + (r0 + kr) * 64 + cb) * D + hp * 128 + voff[i & 3];
                __builtin_amdgcn_global_load_lds((const unsigned*)src, (LAS unsigned*)(lds + (wave * 16 + i) * 1024), 16, 0, 0); }
        }
        f32x4 S[8][2];
        float mx = -3.0e38f;
        const LAS float* bptr[2][4];
#pragma unroll
        for (int ai = 0; ai < 2; ++ai)
#pragma unroll
            for (int i = 0; i < 4; ++i) { const int kc = 16 * (ai ? a1 : a0) + 4 * fq + i; bptr[ai][i] = bias + hh * 465 + drb * 31 + min(max(kc - qc + 15, 0), 30); }
#pragma unroll
        for (int kr = 0; kr < 8; ++kr) {
#pragma unroll
            for (int ai = 0; ai < 2; ++ai) {
                f32x4 z = {0.f, 0.f, 0.f, 0.f};
                z = __builtin_amdgcn_mfma_f32_16x16x32_bf16(kf[kr & 3][ai][0], qf0, z, 0, 0, 0);
                z = __builtin_amdgcn_mfma_f32_16x16x32_bf16(kf[kr & 3][ai][1], qf1, z, 0, 0, 0);
#pragma unroll
                for (int i = 0; i < 4; ++i) { z[i] = (z[i] + bptr[ai][i][kr * 31]) + madd[ai][i]; mx = fmaxf(mx, z[i]); }
                S[kr][ai] = z;
            }
            if (kr < 4) {
#pragma unroll
                for (int ai = 0; ai < 2; ++ai) { const bf16* kp = kbase + ((kr + 4) * 64 + 16 * (ai ? a1 : a0)) * 8; kf[kr & 3][ai][0] = *(const GAS bf16x8*)kp; kf[kr & 3][ai][1] = *(const GAS bf16x8*)(kp + (size_t)4 * CH * 8); }
            }
            __builtin_amdgcn_sched_barrier(0);
        }
        mx = fmaxf(mx, __shfl_xor(mx, 16)); mx = fmaxf(mx, __shfl_xor(mx, 32));
        float sum = 0.f;
#pragma unroll
        for (int kr = 0; kr < 8; ++kr)
#pragma unroll
            for (int ai = 0; ai < 2; ++ai)
#pragma unroll
                for (int i = 0; i < 4; ++i) { const float p = __builtin_amdgcn_exp2f(S[kr][ai][i] - mx); S[kr][ai][i] = p; sum += p; }
        sum += __shfl_xor(sum, 16); sum += __shfl_xor(sum, 32);
        bf16x8 pf[4][2];
#pragma unroll
        for (int u = 0; u < 4; ++u)
#pragma unroll
            for (int ai = 0; ai < 2; ++ai) { v4u pw; pw.x = cvtpk(S[2 * u][ai][0], S[2 * u][ai][1]); pw.y = cvtpk(S[2 * u][ai][2], S[2 * u][ai][3]); pw.z = cvtpk(S[2 * u + 1][ai][0], S[2 * u + 1][ai][1]); pw.w = cvtpk(S[2 * u + 1][ai][2], S[2 * u + 1][ai][3]);
                pf[u][ai] = __builtin_bit_cast(bf16x8, pw); }
        asm volatile("s_waitcnt vmcnt(0)" ::: "memory");
        __syncthreads();
        const int nloc = loc + nx; const bool has_next = nloc < per;
        const int r_cur = r, tb_cur = tb;
        if (has_next) { id = xc * per + nloc; r = id & (rows - 1); hp = (id >> rows_shift) & 7; tb = (id >> (rows_shift + 3)) * seq_len; r0 = min(max(r - 4, 0), rows - 8); ATT_PREFETCH(); }
        (void)r_cur; (void)tb_cur;
        f32x4 O[4];
#pragma unroll
        for (int c = 0; c < 4; ++c) O[c] = (f32x4){0.f, 0.f, 0.f, 0.f};
        const LAS unsigned char* vb[2][2][4];
#pragma unroll
        for (int ai = 0; ai < 2; ++ai)
#pragma unroll
            for (int t = 0; t < 2; ++t)
#pragma unroll
                for (int c = 0; c < 4; ++c) { const int rho = 8 * fq + 4 * t + q4, chn = 2 * (4 * hh + c) + (p4 >> 1);
                    vb[ai][t][c] = lds + (ai ? a1 : a0) * 32768 + 256 * rho + 16 * (chn ^ (((rho & 3) << 2) | ((rho >> 2) & 3))) + 8 * (p4 & 1); }
#pragma unroll
        for (int u = 0; u < 4; ++u) {
#pragma unroll
            for (int ai = 0; ai < 2; ++ai) {
#pragma unroll
                for (int c = 0; c < 4; ++c) {
                    const s16x4 v0 = vtr(vb[ai][0][c] + u * 8192), v1 = vtr(vb[ai][1][c] + u * 8192);
                    const bf16x8 vf = __builtin_shufflevector(v0, v1, 0, 1, 2, 3, 4, 5, 6, 7);
                    O[c] = __builtin_amdgcn_mfma_f32_16x16x32_bf16(vf, pf[u][ai], O[c], 0, 0, 0);
                }
            }
            __builtin_amdgcn_sched_barrier(0);
        }
        const float inv = 1.0f / sum;
#pragma unroll
        for (int c = 0; c < 4; ++c) { v2u w; w.x = cvtpk(O[c][0] * inv, O[c][1] * inv); w.y = cvtpk(O[c][2] * inv, O[c][3] * inv);
            *(GAS v2u*)(Qb + qoff + 16 * c + 4 * fq) = w; }
        if (has_next) ATT_BIAS_WRITE();
    }
    __syncthreads();
#undef ATT_PREFETCH
#undef ATT_BIAS_WRITE
}
enum { K_POOL = 1, K_GEMM_RES = 3, K_GEMM_QKV = 4, K_GEMM_UP = 5, K_ATTN = 6, K_FINAL = 7 };
enum { F_A_X = 1, F_A_IN = 2, F_AUX_X = 4, F_AUX_IN = 8 };
struct Ph { int kind, flags, N, K; const void* A; const void* B; void* C; const void* aux; float* st; float* rs; unsigned long long a_pn_stride, pad; };
constexpr int PPC = 19;
struct Args { Ptrs p; Ph tab[PPC]; };
__global__ void __launch_bounds__(NWAVES * 64, 2) fwd_megakernel(Args args) {
    extern __shared__ __attribute__((aligned(16))) unsigned char lds_raw[];
    cg::grid_group grid = cg::this_grid();
    LAS unsigned char* lds = (LAS unsigned char*)lds_raw;
    volatile LAS unsigned* MISC = (volatile LAS unsigned*)(lds + MISC_OFF);
    for (int u = threadIdx.x; u < 32; u += NWAVES * 64) MISC[u] = 0u;
    __syncthreads();
    const XcdBarrier bar = xcd_barrier_post((unsigned*)(args.p.ws + WS_CTL), MISC + 8);
    {
        const int tid = threadIdx.x, lane = tid & 63, wave = __builtin_amdgcn_readfirstlane(tid >> 6);
        const int G = gridDim.x, bx = blockIdx.x;
        const int vcu = (G % 8 == 0) ? (bx % 8) * (G / 8) + bx / 8 : bx;
        prologue(args.p, lds, vcu * NWAVES + wave, G * NWAVES, wave, lane);
    }
    grid.sync();

    for (int ph = 0; ph < NCHUNK * PPC; ++ph) {
        int tid = threadIdx.x; asm volatile("" : "+v"(tid));
        int G = gridDim.x, bx = blockIdx.x; asm volatile("" : "+s"(G), "+s"(bx));
        const int lane = tid & 63, wave = __builtin_amdgcn_readfirstlane(tid >> 6);
        const int vcu = (G % 8 == 0) ? (bx % 8) * (G / 8) + bx / 8 : bx;
        const int gw = vcu * NWAVES + wave, NGW = G * NWAVES;
        const int ck = ph / PPC, idx = ph - ck * PPC;
        const Ph d = args.tab[idx];
        const int tok0 = ck * CH, grp = tok0 / GROUP_TOK, seq_len = grp ? 4096 : 2048;
        const float* xin = args.p.x_in[grp] + (size_t)(tok0 - grp * GROUP_TOK) * D;
        float* X = args.p.out + (size_t)tok0 * D;
        const void* A = (d.flags & F_A_X) ? (const void*)X : (d.flags & F_A_IN) ? (const void*)xin : d.A;
        const void* aux = (d.flags & F_AUX_X) ? (const void*)X : (d.flags & F_AUX_IN) ? (const void*)xin : d.aux;
#define KIND_IS(x) ([&]() { int kd_ = d.kind; asm volatile("" : "+s"(kd_)); return kd_ == (x); }())
        if (0) {}
        else if (KIND_IS(K_POOL)) { { int tid2 = threadIdx.x; asm volatile("" : "+v"(tid2));
            pool_phase(lds, (const float*)A, (const float*)aux, (bf16*)d.C, seq_len, vcu, G, tid2, __builtin_amdgcn_readfirstlane(tid2 >> 6), tid2 & 63); } }
        else if (KIND_IS(K_GEMM_RES)) { pg8::Gemm g{(const bf16*)A, (const bf16*)d.B, CH, d.N, d.K, (size_t)d.a_pn_stride, d.K == FF  }; pg8::StaticOrder S; S.init(CH, d.N, G, bx);
            pg8::EpiRes E{(const float*)aux, X, (bf16*)d.C, d.st, D, d.rs};
            pg8::gemm_phase<pg8::EpiRes, pg8::StaticOrder, PG8_ALIGN, PG8_SP2>(lds, g, S, E, tid); }
        else if (KIND_IS(K_GEMM_QKV)) { pg8::Gemm g{(const bf16*)A, (const bf16*)d.B, CH, d.N, d.K, 0, 1  }; pg8::StaticOrder S; S.init(CH, d.N, G, bx);
            pg8::EpiBf16<0, true> E{(bf16*)d.C, D, D, (size_t)CH * D, 0.125f * LOG2E, d.st, 0};
            pg8::gemm_phase<pg8::EpiBf16<0, true>, pg8::StaticOrder, PG8_ALIGN, PG8_SP2>(lds, g, S, E, tid); }
        else if (KIND_IS(K_GEMM_UP)) { pg8::Gemm g{(const bf16*)A, (const bf16*)d.B, CH, d.N, d.K, 0, 1  }; pg8::StaticOrder S; S.init(CH, d.N, G, bx);
            pg8::EpiBf16<2, false> E{(bf16*)d.C, FF, 0, 0, 1.f, nullptr, 1};
            pg8::gemm_phase<pg8::EpiBf16<2, false>, pg8::StaticOrder, PG8_ALIGN, PG8_SP2>(lds, g, S, E, tid); }
        else if (KIND_IS(K_ATTN)) { attn_phase(lds, (bf16*)d.C, (const bf16*)d.C + (size_t)CH * D, (const bf16*)d.C + 2 * (size_t)CH * D, (const float*)aux, seq_len, G, bx, tid, wave, lane); }
        else { norm_rows_f32_inplace(X, (const float*)aux, CH, gw, NGW, lane); }
#undef KIND_IS
        if (d.kind != K_FINAL) xcd_barrier(bar);
    }
}

extern "C" void kernel_launch(void* const* d_in, const int* in_sizes, int n_in, void* d_out, int out_size, void* d_ws, size_t ws_size, hipStream_t stream) {
    static int grid = 0;
    if (grid == 0) {
        if (n_in != 12 || in_sizes[0] != GROUP_TOK * D || in_sizes[1] != GROUP_TOK * D || out_size != NTOK * D || ws_size < WS_END) {
            fprintf(stderr, "kernel_launch: unexpected shapes (n_in %d, out %d, ws %zu < %zu); nothing launched\n", n_in, out_size, ws_size, (size_t)WS_END); grid = -1; return; }
        int dev = 0, cus = 0, per_cu = 0;
        if (hipGetDevice(&dev) != hipSuccess || hipDeviceGetAttribute(&cus, hipDeviceAttributeMultiprocessorCount, dev) != hipSuccess) { fprintf(stderr, "kernel_launch: device query failed\n"); grid = -1; return; }
        if (hipFuncSetAttribute((const void*)fwd_megakernel, hipFuncAttributeMaxDynamicSharedMemorySize, LDS_BYTES) != hipSuccess) { fprintf(stderr, "kernel_launch: hipFuncSetAttribute failed\n"); grid = -1; return; }
        if (hipOccupancyMaxActiveBlocksPerMultiprocessor(&per_cu, (const void*)fwd_megakernel, NWAVES * 64, LDS_BYTES) != hipSuccess || per_cu < 1) { fprintf(stderr, "kernel_launch: occupancy query gave %d\n", per_cu); per_cu = 1; }
        (void)hipGetLastError();
        grid = cus * per_cu;
    }
    if (grid < 0) return;
    if (hipMemsetAsync((char*)d_ws + WS_CTL, 0, CTL_ZERO_BYTES, stream) != hipSuccess) { fprintf(stderr, "kernel_launch: hipMemsetAsync failed\n"); return; }
    Args a{};
    Ptrs& p = a.p;
    p.x_in[0] = (const float*)d_in[0]; p.x_in[1] = (const float*)d_in[1]; p.norm_mix = (const float*)d_in[2]; p.pool_w = (const float*)d_in[3]; p.pool_scale = (const float*)d_in[4];
    p.w_qkv = (const float*)d_in[5]; p.rpb = (const float*)d_in[6]; p.w_o = (const float*)d_in[7]; p.norm_mlp = (const float*)d_in[8]; p.w_up = (const float*)d_in[9];
    p.w_down = (const float*)d_in[10]; p.norm_final = (const float*)d_in[11]; p.out = (float*)d_out; p.ws = (unsigned char*)d_ws;
    unsigned char* ws = (unsigned char*)d_ws;
    bf16* WPOOL = (bf16*)(ws + WS_WPOOL); bf16* WQKV = (bf16*)(ws + WS_WQKV); bf16* WO = (bf16*)(ws + WS_WO); bf16* WUP = (bf16*)(ws + WS_WUP); bf16* WDN = (bf16*)(ws + WS_WDN);
    bf16* XN = (bf16*)(ws + WS_XN); bf16* PG = (bf16*)(ws + WS_PG); bf16* QB = (bf16*)(ws + WS_ACT); bf16* HB = (bf16*)(ws + WS_ACT);
    float* SA = (float*)(ws + WS_STAT); float* SB = SA + (size_t)CH * 16;
    int n = 0;
    auto add = [&](int kind, int flags, int N, int K, const void* A, const void* B, void* C, const void* aux, float* st, float* rs, unsigned long long aps) {
        Ph& d = a.tab[n++]; d.kind = kind; d.flags = flags; d.N = N; d.K = K; d.A = A; d.B = B; d.C = C; d.aux = aux; d.st = st; d.rs = rs; d.a_pn_stride = aps; d.pad = 0; };
    for (int layer = 0; layer < DEPTH; ++layer) {
        const int j = layer >> 1;
        if ((layer & 1) == 0) {
            add(K_POOL, layer == 0 ? F_A_IN : F_A_X, 0, 0, nullptr, nullptr, PG, p.norm_mix + layer * D, nullptr, nullptr, 0);
            add(K_GEMM_RES, layer == 0 ? F_AUX_IN : F_AUX_X, D, 256, PG, WPOOL + (size_t)j * 1024 * 256, XN, nullptr, SA, nullptr, (unsigned long long)CH * 256 * 2);
        } else {
            add(K_GEMM_QKV, 0, 3 * D, D, XN, WQKV + (size_t)j * 3 * D * D, QB, nullptr, SB, nullptr, 0);
            add(K_ATTN, 0, 0, 0, nullptr, nullptr, QB, p.rpb + (size_t)j * NH * 15 * 31, nullptr, nullptr, 0);
            add(K_GEMM_RES, F_AUX_X, D, D, QB, WO + (size_t)j * D * D, XN, nullptr, SA, nullptr, 0);
        }
        add(K_GEMM_UP, 0, FF, D, XN, WUP + (size_t)layer * D * FF, HB, nullptr, SA, nullptr, 0);
        add(K_GEMM_RES, F_AUX_X, D, FF, HB, WDN + (size_t)layer * D * FF, (layer & 1) == 0 ? XN : nullptr, nullptr, SB, SA, 0);
    }
    add(K_FINAL, 0, 0, 0, nullptr, nullptr, nullptr, p.norm_final, nullptr, nullptr, 0);
    if (n != PPC) { fprintf(stderr, "kernel_launch: phase table has %d entries, expected %d\n", n, PPC); return; }
    void* kargs[] = {&a};
    hipError_t e = hipLaunchCooperativeKernel((const void*)fwd_megakernel, dim3(grid), dim3(NWAVES * 64), kargs, LDS_BYTES, stream);
    if (e != hipSuccess) fprintf(stderr, "kernel_launch: cooperative launch failed: %s (grid %d)\n", hipGetErrorString(e), grid);
}
```

```cpp
#include <hip/hip_runtime.h>
#include <hip/hip_cooperative_groups.h>
#include <cstdio>
#include <cstdint>
namespace cg = cooperative_groups;
namespace pg8 {
#define PG8_LAS __attribute__((address_space(3)))
typedef unsigned short bf16_t;
typedef short bf16x8 __attribute__((ext_vector_type(8)));
typedef float f32x4 __attribute__((ext_vector_type(4)));
typedef unsigned u32x4 __attribute__((ext_vector_type(4)));
constexpr int BM = 256, BK = 64, HALF = 128, HTB = HALF * BK * 2  , STAGE_BYTES = 8 * HTB, NXCD = 8, WGM = 8;

__host__ __device__ __forceinline__ int lds_byte(int r, int c) { const int st = (r >> 4) * 2 + (c >> 5), rr = r & 15, cc = c & 31, ob = rr * 64 + cc * 2; return st * 1024 + (ob ^ (((ob >> 9) & 1) << 5)); }
__host__ __device__ __forceinline__ void stage_rc(int b, int& R, int& C) { const int st = b / 1024, sb = b % 1024, swz = sb ^ (((sb >> 9) & 1) << 5); R = (st >> 1) * 16 + swz / 64; C = (st & 1) * 32 + (swz % 64) / 2; }
__host__ __device__ __forceinline__ int perm32(int rho) { const int n = rho >> 4, i = rho & 15; return 8 * (i >> 2) + 4 * n + (i & 3); }

struct Unit { int pm, pn; };
struct Gemm { const bf16_t* A; const bf16_t* Bt; int M, N, K; size_t a_pn_stride; int a_tiled; };

struct StaticOrder {
    int nM, nN, nwg, G, c;
    __host__ __device__ void init(int M, int N, int G_, int c_) { nM = M / BM; nN = N / BM; nwg = nM * nN; G = G_; c = c_; }
    __host__ __device__ bool next(int i, Unit& u) const {
        const long L = (long)i * G + c; if (L >= nwg) return false;
        int wgid = (int)L; { const int q = nwg / NXCD, r = nwg % NXCD, xcd = wgid % NXCD, off = wgid / NXCD; wgid = (xcd < r ? xcd * (q + 1) : r * (q + 1) + (xcd - r) * q) + off; }
        const int nig = WGM * nN, gid = wgid / nig, fm = gid * WGM, gsz = (nM - fm) < WGM ? (nM - fm) : WGM;
        u.pm = fm + ((wgid % nig) % gsz); u.pn = (wgid % nig) / gsz; return true;
    }
    __device__ __forceinline__ void a_ready(const Unit&) const {}
    __device__ __forceinline__ void done(const Unit&) const {}
};

__device__ __forceinline__ unsigned cvt_pk_bf16(float lo, float hi) { unsigned r; asm volatile("v_cvt_pk_bf16_f32 %0, %1, %2" : "=v"(r) : "v"(lo), "v"(hi)); return r; }
typedef float f32x2 __attribute__((ext_vector_type(2)));
template <int ACT, bool RS> struct EpiBf16 {
    static constexpr bool PERM = true, AFTER_DRAIN = false;
    bf16_t* O; int ldc; int split_cols; size_t split_stride; float scale0; const float* st; int tiled;
    __device__ __forceinline__ void operator()(const f32x4 (&acc)[2][2][4][2], const Unit& u, int wr, int wc, int fr, int fq) const {
        const int row0 = u.pm * BM + wr * 64 + fr; int colt = u.pn * BM; bf16_t* base = O;
        float sc = 1.f; bool kplane = false;
        if (split_cols) { const int t = colt / split_cols; base += (size_t)t * split_stride; colt -= t * split_cols; if (t == 0) sc = scale0; kplane = (t == 1); }
        const size_t kprows = split_stride / 1024;
        const int col0 = colt + wc * 32 + 8 * fq;
        f32x4 pv[2][4];
        if (RS) {
#pragma unroll
            for (int ai = 0; ai < 2; ++ai)
#pragma unroll
                for (int m = 0; m < 4; ++m) pv[ai][m] = *(const f32x4*)(st + (size_t)(row0 + ai * HALF + m * 16) * 16 + 4 * fq);
            __builtin_amdgcn_sched_barrier(0);
        }
#pragma unroll
        for (int ai = 0; ai < 2; ++ai)
#pragma unroll
            for (int m = 0; m < 4; ++m) { const int row = row0 + ai * HALF + m * 16; bf16_t* rowp = base + (size_t)row * ldc + col0;
                float f = sc;
                if (RS) { float ss = (pv[ai][m][0] + pv[ai][m][1]) + (pv[ai][m][2] + pv[ai][m][3]); ss += __shfl_xor(ss, 16); ss += __shfl_xor(ss, 32);
                    const float r = __builtin_amdgcn_rsqf(ss * (1.0f / 1024.0f) + 1e-6f); f *= (ACT == 2) ? r * r : r; }
#pragma unroll
                for (int bj = 0; bj < 2; ++bj) { f32x4 v0 = acc[ai][bj][m][0], v1 = acc[ai][bj][m][1];
                    if (ACT == 2) {
#pragma unroll
                        for (int e = 0; e < 4; ++e) { const float a = fmaxf(v0[e], 0.f), b = fmaxf(v1[e], 0.f); v0[e] = a * a; v1[e] = b * b; } }
                    v0 = v0 * f; v1 = v1 * f; u32x4 w; w.x = cvt_pk_bf16(v0[0], v0[1]); w.y = cvt_pk_bf16(v0[2], v0[3]); w.z = cvt_pk_bf16(v1[0], v1[1]); w.w = cvt_pk_bf16(v1[2], v1[3]);
                    if (kplane) *(u32x4*)(base + ((size_t)(((colt >> 6) + 2 * bj + (wc >> 1)) * 8 + (wc & 1) * 4 + fq) * kprows + row) * 8) = w;
                    else if (tiled) { const int r_ = row & 255, c_ = col0 + bj * HALF;
                        *(u32x4*)((char*)base + ((size_t)(((row >> 8) * 2 + (r_ >> 7)) * (ldc >> 6) + (c_ >> 6)) << 14) + lds_byte(r_ & 127, c_ & 63)) = w; }
                    else *(u32x4*)(rowp + bj * HALF) = w; } }
    }
};
struct EpiRes {
    static constexpr bool PERM = true, AFTER_DRAIN = false;
    const float* base; float* out; bf16_t* xn; float* st; int ldc; const float* rs;
    __device__ __forceinline__ void operator()(const f32x4 (&acc)[2][2][4][2], const Unit& u, int wr, int wc, int fr, int fq) const {
        const int col0 = u.pn * BM + wc * 32 + 8 * fq;
#pragma unroll
        for (int ai = 0; ai < 2; ++ai) {
            f32x4 rp[4];
            if (rs) {
#pragma unroll
                for (int m = 0; m < 4; ++m) rp[m] = *(const f32x4*)(rs + (size_t)(u.pm * BM + ai * HALF + wr * 64 + m * 16 + fr) * 16 + 4 * fq);
            }
            f32x4 bs[4][2][2];
#pragma unroll
            for (int m = 0; m < 4; ++m) { const size_t off = (size_t)(u.pm * BM + ai * HALF + wr * 64 + m * 16 + fr) * ldc + col0;
#pragma unroll
                for (int bj = 0; bj < 2; ++bj) { bs[m][bj][0] = *(const f32x4*)(base + off + bj * HALF); bs[m][bj][1] = *(const f32x4*)(base + off + bj * HALF + 4); } }
            __builtin_amdgcn_sched_barrier(0);
#pragma unroll
            for (int m = 0; m < 4; ++m) { const int row = u.pm * BM + ai * HALF + wr * 64 + m * 16 + fr; const size_t off = (size_t)row * ldc + col0; float ss = 0.f;
                float f = 1.f;
                if (rs) { float q = (rp[m][0] + rp[m][1]) + (rp[m][2] + rp[m][3]); q += __shfl_xor(q, 16); q += __shfl_xor(q, 32); const float r = __builtin_amdgcn_rsqf(q * (1.0f / 1024.0f) + 1e-6f); f = r * r; }
#pragma unroll
                for (int bj = 0; bj < 2; ++bj) {
                    const f32x4 o0 = bs[m][bj][0] + acc[ai][bj][m][0] * f, o1 = bs[m][bj][1] + acc[ai][bj][m][1] * f;
                    *(f32x4*)(out + off + bj * HALF) = o0; *(f32x4*)(out + off + bj * HALF + 4) = o1;
                    if (xn) { u32x4 w; w.x = cvt_pk_bf16(o0[0], o0[1]); w.y = cvt_pk_bf16(o0[2], o0[3]); w.z = cvt_pk_bf16(o1[0], o1[1]); w.w = cvt_pk_bf16(o1[2], o1[3]);
                        { const int c_ = col0 + bj * HALF;
                          *(u32x4*)((char*)xn + ((size_t)((u.pm * 2 + ai) * (ldc >> 6) + (c_ >> 6)) << 14) + lds_byte(wr * 64 + m * 16 + fr, c_ & 63)) = w; }
                        ss += (o0[0] * o0[0] + o0[1] * o0[1]) + (o0[2] * o0[2] + o0[3] * o0[3]) + (o1[0] * o1[0] + o1[1] * o1[1]) + (o1[2] * o1[2] + o1[3] * o1[3]); } }
                if (xn) { ss += __shfl_xor(ss, 16); ss += __shfl_xor(ss, 32); if (fq == 0) st[(size_t)row * 16 + u.pn * 4 + wc] = ss; } }
            __builtin_amdgcn_sched_barrier(0);
        }
    }
};
template <class Epi, class Sched, bool ALIGN_EPI = false, bool SP2 = false>
__device__ __forceinline__ void gemm_phase(PG8_LAS unsigned char* lds, const Gemm g, const Sched& S, const Epi& E, const int tid_in) {
    const int tid = tid_in, wid = __builtin_amdgcn_readfirstlane(tid >> 6), lane = tid & 63, wr = wid >> 2, wc = wid & 3, fr = lane & 15, fq = lane >> 4;
    const int K = g.K, nt = K / BK;
    unsigned voffA[2], voffB[2];
#pragma unroll
    for (int i = 0; i < 2; ++i) { int R, C; stage_rc(tid * 16 + i * 8192, R, C); const int Rb = Epi::PERM ? ((R & ~31) + perm32(R & 31)) : R;
        voffA[i] = g.a_tiled ? (unsigned)(tid * 16 + i * 8192) : (unsigned)(R * K + C) * 2u; voffB[i] = (unsigned)(tid * 16 + i * 8192); (void)Rb; }
    const size_t kstep = (size_t)(BK * 2);
    const size_t hstep = (size_t)HALF * K * 2;
    const size_t tstep = 2 * hstep;
    const size_t kstepB = 16384, hstepB = (size_t)nt * 16384, tstepB = 2 * hstepB;
    const size_t kstepA = g.a_tiled ? (size_t)16384 : kstep, hstepA = g.a_tiled ? (size_t)nt * 16384 : hstep, tstepA = 2 * hstepA;
    const unsigned ldsw = (unsigned)wid * 1024u;
    const int aoff = lds_byte(wr * 64 + fr, fq * 8), boff = lds_byte(wc * 32 + fr, fq * 8);
#define PG8_SA(b, h) (((b) * 2 + (h)) * HTB)
#define PG8_SB(b, h) ((4 + (b) * 2 + (h)) * HTB)
#define PG8_STAGE(bufoff, gbase, voff) do { _Pragma("unroll") for (int _i = 0; _i < 2; ++_i) \
        __builtin_amdgcn_global_load_lds((const unsigned*)((const char*)(gbase) + (voff)[_i]), (PG8_LAS unsigned*)(lds + (bufoff) + ldsw + _i * 8192), 16, 0, 0); } while (0)
#define PG8_LDA(dst, b, h) do { _Pragma("unroll") for (int m = 0; m < 4; ++m) _Pragma("unroll") for (int k = 0; k < 2; ++k) dst[m][k] = *(const PG8_LAS bf16x8*)(lds + PG8_SA(b, h) + aoff + m * 2048 + k * 1024); } while (0)
#define PG8_LDB(dst, b, h) do { _Pragma("unroll") for (int n = 0; n < 2; ++n) _Pragma("unroll") for (int k = 0; k < 2; ++k) dst[n][k] = *(const PG8_LAS bf16x8*)(lds + PG8_SB(b, h) + boff + n * 2048 + k * 1024); } while (0)
#define PG8_MMA(ai, bj, At, Bt) do { __builtin_amdgcn_s_setprio(1); _Pragma("unroll") for (int m = 0; m < 4; ++m) _Pragma("unroll") for (int n = 0; n < 2; ++n) _Pragma("unroll") for (int k = 0; k < 2; ++k) \
        acc[ai][bj][m][n] = __builtin_amdgcn_mfma_f32_16x16x32_bf16(Bt[n][k], At[m][k], acc[ai][bj][m][n], 0, 0, 0); __builtin_amdgcn_s_setprio(0); } while (0)
#define PG8_WAIT_V(n) asm volatile("s_waitcnt vmcnt(" #n ")" ::: "memory")
#define PG8_WAIT_L(n) asm volatile("s_waitcnt lgkmcnt(" #n ")" ::: "memory")
#define PG8_BAR __builtin_amdgcn_s_barrier()
#define PG8_SCHED __builtin_amdgcn_sched_barrier(0)
    Unit cur, nxt; int ui = 0;
    if (!S.next(0, cur)) return;
    f32x4 acc[2][2][4][2];
#pragma unroll
    for (int a = 0; a < 2; ++a)
#pragma unroll
        for (int b = 0; b < 2; ++b)
#pragma unroll
            for (int m = 0; m < 4; ++m)
#pragma unroll
                for (int n = 0; n < 2; ++n) acc[a][b][m][n] = (f32x4){0.f, 0.f, 0.f, 0.f};
    bf16x8 At[4][2], B0[2][2], B1[2][2];
    const char* cA = (const char*)g.A + (size_t)cur.pm * tstepA + (size_t)cur.pn * g.a_pn_stride; const char* cB = (const char*)g.Bt + (size_t)cur.pn * tstepB;
    S.a_ready(cur);
    if constexpr (SP2) {
        PG8_STAGE(PG8_SB(0, 0), cB, voffB); PG8_STAGE(PG8_SB(0, 1), cB + hstepB, voffB); PG8_STAGE(PG8_SA(0, 0), cA, voffA); PG8_STAGE(PG8_SA(0, 1), cA + hstepA, voffA);
        if (wr == 1) PG8_BAR;
        PG8_WAIT_V(2); PG8_BAR;
        PG8_STAGE(PG8_SB(1, 0), cB + kstepB, voffB); PG8_STAGE(PG8_SA(1, 0), cA + kstepA, voffA); PG8_STAGE(PG8_SB(1, 1), cB + hstepB + kstepB, voffB);
        PG8_WAIT_V(6); PG8_BAR;
    } else {
        PG8_STAGE(PG8_SB(0, 0), cB, voffB); PG8_STAGE(PG8_SA(0, 0), cA, voffA); PG8_STAGE(PG8_SB(0, 1), cB + hstepB, voffB); PG8_STAGE(PG8_SA(0, 1), cA + hstepA, voffA);
        if (wr == 1) PG8_BAR;
        PG8_WAIT_V(4); PG8_BAR;
        PG8_STAGE(PG8_SB(1, 0), cB + kstepB, voffB); PG8_STAGE(PG8_SA(1, 0), cA + kstepA, voffA); PG8_STAGE(PG8_SB(1, 1), cB + hstepB + kstepB, voffB);
        PG8_WAIT_V(6); PG8_BAR;
    }
    for (;;) {
        const bool has_next = S.next(ui + 1, nxt);
        const char* nA = has_next ? (const char*)g.A + (size_t)nxt.pm * tstepA + (size_t)nxt.pn * g.a_pn_stride : cA; const char* nB = has_next ? (const char*)g.Bt + (size_t)nxt.pn * tstepB : cB;
        for (int t = 0; t < nt; t += 2) {
            const bool last = (t == nt - 2);
            const char* a1 = cA + (size_t)(t + 1) * kstepA;
            const char* a2 = last ? nA : cA + (size_t)(t + 2) * kstepA; const char* b2 = last ? nB : cB + (size_t)(t + 2) * kstepB;
            const char* a3 = a2 + kstepA; const char* b3 = b2 + kstepB;
            if (last && has_next) S.a_ready(nxt);
            if constexpr (SP2) {
            PG8_LDB(B0, 0, 0); PG8_LDB(B1, 0, 1); PG8_SCHED; PG8_LDA(At, 0, 0); PG8_STAGE(PG8_SA(1, 1), a1 + hstepA, voffA);
            PG8_WAIT_V(8); PG8_WAIT_L(0); PG8_BAR; PG8_MMA(0, 0, At, B0); PG8_MMA(0, 1, At, B1); PG8_BAR; PG8_SCHED;
            PG8_LDA(At, 0, 1); PG8_STAGE(PG8_SB(0, 0), b2, voffB); PG8_STAGE(PG8_SB(0, 1), b2 + hstepB, voffB); PG8_STAGE(PG8_SA(0, 0), a2, voffA);
            PG8_WAIT_V(8); PG8_WAIT_L(0); PG8_BAR; PG8_MMA(1, 0, At, B0); PG8_MMA(1, 1, At, B1); PG8_BAR; PG8_SCHED;
            PG8_LDB(B0, 1, 0); PG8_LDB(B1, 1, 1); PG8_SCHED; PG8_LDA(At, 1, 0); PG8_STAGE(PG8_SA(0, 1), a2 + hstepA, voffA);
            PG8_WAIT_V(8); PG8_WAIT_L(0); PG8_BAR; PG8_MMA(0, 0, At, B0); PG8_MMA(0, 1, At, B1); PG8_BAR; PG8_SCHED;
            PG8_LDA(At, 1, 1); PG8_STAGE(PG8_SB(1, 0), b3, voffB); PG8_STAGE(PG8_SB(1, 1), b3 + hstepB, voffB); PG8_STAGE(PG8_SA(1, 0), a3, voffA);
            PG8_WAIT_V(8); PG8_WAIT_L(0); PG8_BAR; PG8_MMA(1, 0, At, B0); PG8_MMA(1, 1, At, B1); PG8_BAR; PG8_SCHED;
            } else {
            PG8_LDB(B0, 0, 0); PG8_SCHED; PG8_LDA(At, 0, 0); PG8_STAGE(PG8_SA(1, 1), a1 + hstepA, voffA);
            PG8_WAIT_L(8); PG8_BAR; PG8_WAIT_L(0); PG8_MMA(0, 0, At, B0); PG8_BAR; PG8_SCHED;
            PG8_LDB(B1, 0, 1); PG8_STAGE(PG8_SB(0, 0), b2, voffB);
            PG8_BAR; PG8_WAIT_L(0); PG8_MMA(0, 1, At, B1); PG8_BAR;
            PG8_LDA(At, 0, 1); PG8_STAGE(PG8_SA(0, 0), a2, voffA);
            PG8_BAR; PG8_WAIT_L(0); PG8_MMA(1, 0, At, B0); PG8_BAR; PG8_SCHED;
            PG8_STAGE(PG8_SB(0, 1), b2 + hstepB, voffB);
            PG8_WAIT_V(6); PG8_BAR; PG8_MMA(1, 1, At, B1); PG8_BAR;
            PG8_LDB(B0, 1, 0); PG8_SCHED; PG8_LDA(At, 1, 0); PG8_STAGE(PG8_SA(0, 1), a2 + hstepA, voffA);
            PG8_WAIT_L(8); PG8_BAR; PG8_WAIT_L(0); PG8_MMA(0, 0, At, B0); PG8_BAR; PG8_SCHED;
            PG8_LDB(B1, 1, 1); PG8_STAGE(PG8_SB(1, 0), b3, voffB);
            PG8_BAR; PG8_WAIT_L(0); PG8_MMA(0, 1, At, B1); PG8_BAR;
            PG8_LDA(At, 1, 1); PG8_STAGE(PG8_SA(1, 0), a3, voffA);
            PG8_BAR; PG8_WAIT_L(0); PG8_MMA(1, 0, At, B0); PG8_BAR; PG8_SCHED;
            PG8_STAGE(PG8_SB(1, 1), b3 + hstepB, voffB);
            PG8_WAIT_V(6); PG8_BAR; PG8_MMA(1, 1, At, B1); PG8_BAR;
            }
        }
        if constexpr (ALIGN_EPI) { if (wr == 0) PG8_BAR; }
        if constexpr (!Epi::AFTER_DRAIN) { E(acc, cur, wr, wc, fr, fq); S.done(cur); }
        if (!has_next) break;
#pragma unroll
        for (int a = 0; a < 2; ++a)
#pragma unroll
            for (int b = 0; b < 2; ++b)
#pragma unroll
                for (int m = 0; m < 4; ++m)
#pragma unroll
                    for (int n = 0; n < 2; ++n) acc[a][b][m][n] = (f32x4){0.f, 0.f, 0.f, 0.f};
        cur = nxt; cA = nA; cB = nB; ++ui;
        if constexpr (ALIGN_EPI) { if (wr == 1) PG8_BAR; }
    }
    PG8_WAIT_V(0);
    if constexpr (!ALIGN_EPI) { if (wr == 0) PG8_BAR; }
    PG8_BAR;
    if constexpr (Epi::AFTER_DRAIN) { E.fused(acc, cur, wr, wc, fr, fq, lds, wid, lane); S.done(cur); }
#undef PG8_SA
#undef PG8_SB
#undef PG8_STAGE
#undef PG8_LDA
#undef PG8_LDB
#undef PG8_MMA
#undef PG8_WAIT_V
#undef PG8_WAIT_L
#undef PG8_BAR
#undef PG8_SCHED
}
}
#ifndef PG8_SP2
#define PG8_SP2 true
#endif
#ifndef PG8_ALIGN
#define PG8_ALIGN true
#endif

constexpr int NWAVES = 8;
constexpr int D = 1024, FF = 4096, NH = 16, HD = 64, DEPTH = 4;
constexpr int NTOK = 131072;
constexpr int GROUP_TOK = 65536;
#ifndef MK_CH
#define MK_CH 65536
#endif
constexpr int CH = MK_CH;
constexpr int NCHUNK = NTOK / CH;
constexpr float RMS_EPS = 1e-6f;
constexpr float LOG2E = 1.4426950408889634f;
static_assert(GROUP_TOK % CH == 0 && CH % 4096 == 0, "chunking");

constexpr size_t MiB = 1u << 20;
constexpr size_t WS_WPOOL = 2 * MiB;
constexpr size_t WS_WQKV = 4 * MiB;
constexpr size_t WS_WO = 16 * MiB;
constexpr size_t WS_WUP = 20 * MiB;
constexpr size_t WS_WDN = 52 * MiB;
constexpr size_t WS_XN = 96 * MiB;
constexpr size_t WS_PG = WS_XN + (size_t)CH * D * 2;
constexpr size_t WS_ACT = WS_PG + (size_t)CH * D * 2;
constexpr size_t WS_CTL = 0, CTL_ZERO_BYTES = 65536;
constexpr size_t WS_STAT = 86 * MiB;
static_assert(WS_STAT + 2 * (size_t)CH * 64 <= WS_XN, "stat arrays");
constexpr size_t WS_END = WS_ACT + (size_t)CH * FF * 2;
static_assert(WS_XN >= WS_WDN + 32 * MiB && WS_END <= 1024 * MiB, "d_ws map");

constexpr int RING_BYTES = 131072;
constexpr int BIAS_OFF = RING_BYTES;
constexpr int MISC_OFF = RING_BYTES + 4096;
constexpr int LDS_BYTES = 147456;

#define GAS __attribute__((address_space(1)))
#define LAS __attribute__((address_space(3)))
typedef unsigned short bf16;
typedef unsigned v4u __attribute__((ext_vector_type(4)));
typedef unsigned v2u __attribute__((ext_vector_type(2)));
typedef float f32x4 __attribute__((ext_vector_type(4)));
typedef short bf16x8 __attribute__((ext_vector_type(8)));
typedef short s16x4 __attribute__((ext_vector_type(4)));
#define LDS_WAIT() asm volatile("s_waitcnt lgkmcnt(0)" ::: "memory")
typedef float f32x2_t __attribute__((ext_vector_type(2))); typedef __bf16 bf16x2_t __attribute__((ext_vector_type(2)));
__device__ __forceinline__ unsigned pk2(float lo, float hi) { f32x2_t v = {lo, hi}; bf16x2_t b = __builtin_convertvector(v, bf16x2_t); return __builtin_bit_cast(unsigned, b); }
__device__ __forceinline__ float wave_sum(float v) {
#pragma unroll
    for (int o = 1; o < 64; o <<= 1) v += __shfl_xor(v, o);
    return v;
}

__device__ __forceinline__ void transpose_item(const float* W, int K, int N, bf16* WT, int row_off, const float* nscale, const float* kscale, LAS float* scr, int item, int lane) {
    const int nblk = N / 32, kb = item / nblk, nb = item % nblk, k0 = 64 * kb, n0 = 32 * nb;
    float wv[32];
#pragma unroll
    for (int i = 0; i < 32; ++i) wv[i] = W[(size_t)(k0 + 2 * i + (lane >> 5)) * N + n0 + (lane & 31)];
#pragma unroll
    for (int i = 0; i < 32; ++i) scr[(2 * i + (lane >> 5)) * 33 + (lane & 31)] = wv[i];
    LDS_WAIT(); asm volatile("" ::: "memory");
    const int c = lane & 7;
    float ks[8];
#pragma unroll
    for (int e = 0; e < 8; ++e) ks[e] = kscale ? kscale[k0 + 8 * c + e] : 1.f;
#pragma unroll
    for (int j = 0; j < 4; ++j) { const int n = (lane >> 3) + 8 * j; const LAS float* s = scr + (8 * c) * 33 + n;
        const float sc = nscale ? nscale[n0 + n] : 1.f;
        v4u o; o.x = pk2(s[0 * 33] * sc * ks[0], s[1 * 33] * sc * ks[1]); o.y = pk2(s[2 * 33] * sc * ks[2], s[3 * 33] * sc * ks[3]); o.z = pk2(s[4 * 33] * sc * ks[4], s[5 * 33] * sc * ks[5]); o.w = pk2(s[6 * 33] * sc * ks[6], s[7 * 33] * sc * ks[7]);
        { const int ng = row_off + n0 + n, nr = ng & 127, cc = nr & 31, slot = (((cc >> 2) & 1) << 4) | ((cc >> 3) << 2) | (cc & 3), kk = k0 + 8 * c;
          *(GAS v4u*)((GAS char*)WT + ((size_t)(((ng >> 8) * 2 + ((ng >> 7) & 1)) * (K >> 6) + (kk >> 6)) << 14) + pg8::lds_byte((nr & ~31) + slot, kk & 63)) = o; } }
    LDS_WAIT(); asm volatile("" ::: "memory");
}

struct Ptrs {
    const float *x_in[2], *norm_mix, *pool_w, *pool_scale, *w_qkv, *rpb, *w_o, *norm_mlp, *w_up, *w_down, *norm_final;
    float* out; unsigned char* ws;
};

__device__ __forceinline__ void prologue(const Ptrs& P, LAS unsigned char* lds, int gw, int NGW, int wave, int lane) {
    LAS float* scr = (LAS float*)(lds + wave * 16384);
    bf16* WPOOL = (bf16*)(P.ws + WS_WPOOL); bf16* WQKV = (bf16*)(P.ws + WS_WQKV); bf16* WO = (bf16*)(P.ws + WS_WO); bf16* WUP = (bf16*)(P.ws + WS_WUP); bf16* WDN = (bf16*)(P.ws + WS_WDN);
    constexpr int I_POOL = (256 / 64) * (256 / 32), I_QKV = (D / 64) * (3 * D / 32), I_O = (D / 64) * (D / 32), I_UP = (D / 64) * (FF / 32), I_DN = (FF / 64) * (D / 32);
    constexpr int NITEMS = 8 * I_POOL + 2 * I_QKV + 2 * I_O + 4 * I_UP + 4 * I_DN;
    for (int it = gw; it < NITEMS; it += NGW) {
        int r = it;
        if (r < 8 * I_POOL) { const int mtx = r / I_POOL, j = mtx >> 2, g = mtx & 3; transpose_item(P.pool_w + (size_t)mtx * 65536, 256, 256, WPOOL + (size_t)j * 1024 * 256, g * 256, P.pool_scale + j * 1024 + g * 256, nullptr, scr, r % I_POOL, lane); continue; } r -= 8 * I_POOL;
        if (r < 2 * I_QKV) { const int j = r / I_QKV; transpose_item(P.w_qkv + (size_t)j * D * 3 * D, D, 3 * D, WQKV + (size_t)j * 3 * D * D, 0, nullptr, P.norm_mix + (2 * j + 1) * D, scr, r % I_QKV, lane); continue; } r -= 2 * I_QKV;
        if (r < 2 * I_O) { const int j = r / I_O; transpose_item(P.w_o + (size_t)j * D * D, D, D, WO + (size_t)j * D * D, 0, nullptr, nullptr, scr, r % I_O, lane); continue; } r -= 2 * I_O;
        if (r < 4 * I_UP) { const int j = r / I_UP; transpose_item(P.w_up + (size_t)j * D * FF, D, FF, WUP + (size_t)j * D * FF, 0, nullptr, P.norm_mlp + j * D, scr, r % I_UP, lane); continue; } r -= 4 * I_UP;
        { const int j = r / I_DN; transpose_item(P.w_down + (size_t)j * D * FF, FF, D, WDN + (size_t)j * D * FF, 0, nullptr, nullptr, scr, r % I_DN, lane); }
    }
}

__device__ __forceinline__ void norm_rows_f32_inplace(float* x, const float* gain, int nrows, int gw, int NGW, int lane) {
    f32x4 g[4];
#pragma unroll
    for (int j = 0; j < 4; ++j) g[j] = *((const f32x4*)gain + lane + 64 * j);
    for (int m = gw * 4; m < nrows; m += NGW * 4) {
        GAS f32x4* xr = (GAS f32x4*)(x + (size_t)m * D) + lane;
        f32x4 v[4][4];
#pragma unroll
        for (int r = 0; r < 4; ++r)
#pragma unroll
            for (int j = 0; j < 4; ++j) v[r][j] = xr[r * 256 + 64 * j];
        __builtin_amdgcn_sched_barrier(0);
#pragma unroll
        for (int r = 0; r < 4; ++r) { float s = 0.f;
#pragma unroll
            for (int j = 0; j < 4; ++j) s += (v[r][j].x * v[r][j].x + v[r][j].y * v[r][j].y) + (v[r][j].z * v[r][j].z + v[r][j].w * v[r][j].w);
            const float rr = 1.0f / sqrtf(wave_sum(s) * (1.f / D) + RMS_EPS);
#pragma unroll
            for (int j = 0; j < 4; ++j) xr[r * 256 + 64 * j] = v[r][j] * rr * g[j]; }
    }
}

constexpr int PT = 32, PROWS = 48;
typedef float f32x2v __attribute__((ext_vector_type(2)));
__device__ __forceinline__ f32x2v bfpair(unsigned u) { return (f32x2v){__builtin_bit_cast(float, u << 16), __builtin_bit_cast(float, u & 0xffff0000u)}; }
struct f32x8 { f32x4 lo, hi; };
__device__ __forceinline__ f32x8 bf8(const v4u u) { f32x8 r; r.lo = (f32x4){__builtin_bit_cast(float, u.x << 16), __builtin_bit_cast(float, u.x & 0xffff0000u), __builtin_bit_cast(float, u.y << 16), __builtin_bit_cast(float, u.y & 0xffff0000u)};
    r.hi = (f32x4){__builtin_bit_cast(float, u.z << 16), __builtin_bit_cast(float, u.z & 0xffff0000u), __builtin_bit_cast(float, u.w << 16), __builtin_bit_cast(float, u.w & 0xffff0000u)}; return r; }
__device__ __forceinline__ v4u pack8(const f32x4 a, const f32x4 b) { v4u o; o.x = pk2(a[0], a[1]); o.y = pk2(a[2], a[3]); o.z = pk2(b[0], b[1]); o.w = pk2(b[2], b[3]); return o; }
template <int W> __device__ __forceinline__ void pool_rows_interior(const LAS v4u* hrow, GAS v4u* po) {
    constexpr int HW = W / 2; constexpr float INV = 1.0f / (float)W;
    f32x4 sl = {0.f, 0.f, 0.f, 0.f}, sh = {0.f, 0.f, 0.f, 0.f};
#pragma unroll
    for (int o = -HW; o < HW; ++o) { const f32x8 h = bf8(hrow[(8 + o) * 128]); sl += h.lo; sh += h.hi; }
    __builtin_amdgcn_sched_barrier(0);
#pragma unroll
    for (int i = 0; i < 8; ++i) {
        const f32x8 c = bf8(hrow[(8 + i) * 128]);
        po[(size_t)i * 32] = pack8(sl * INV - c.lo, sh * INV - c.hi);
        if (i + 1 < 8) { const f32x8 a = bf8(hrow[(8 + i + HW) * 128]), b = bf8(hrow[(8 + i - HW) * 128]); sl += a.lo - b.lo; sh += a.hi - b.hi; }
        __builtin_amdgcn_sched_barrier(0);
    }
}
__device__ __forceinline__ void pool_load_rows(f32x4 (&v)[6][4], const float* x, int m0, int seq_len, int wave, int lane) {
    const int sb = m0 / seq_len * seq_len, t0 = m0 - sb;
#pragma unroll
    for (int k = 0; k < 6; ++k) { const int t = min(max(t0 - 8 + wave + NWAVES * k, 0), seq_len - 1);
        const GAS f32x4* xr = (const GAS f32x4*)(x + (size_t)(sb + t) * D) + lane;
#pragma unroll
        for (int j = 0; j < 4; ++j) v[k][j] = xr[64 * j]; }
}
__device__ __forceinline__ void pool_phase(LAS unsigned char* lds, const float* x, const float* gain, bf16* Pg, int seq_len, int vcu, int G, int tid, int wave, int lane) {
    f32x4 v[6][4];
    if (vcu < CH / PT) pool_load_rows(v, x, vcu * PT, seq_len, wave, lane);
    for (int tile = vcu; tile < CH / PT; tile += G) {
        const int m0 = tile * PT;
        const int sb = m0 / seq_len * seq_len;
        const int t0 = m0 - sb;
        f32x4 g[4];
#pragma unroll
        for (int j = 0; j < 4; ++j) g[j] = *((const GAS f32x4*)gain + lane + 64 * j);
#pragma unroll
        for (int k = 0; k < 6; ++k) { float s = 0.f;
#pragma unroll
            for (int j = 0; j < 4; ++j) s += (v[k][j].x * v[k][j].x + v[k][j].y * v[k][j].y) + (v[k][j].z * v[k][j].z + v[k][j].w * v[k][j].w);
            const float r = 1.0f / sqrtf(wave_sum(s) * (1.f / D) + RMS_EPS);
            LAS v2u* hr = (LAS v2u*)(lds + (wave + NWAVES * k) * 2048) + lane;
#pragma unroll
            for (int j = 0; j < 4; ++j) { v2u o; o.x = pk2(v[k][j].x * r * g[j].x, v[k][j].y * r * g[j].y); o.y = pk2(v[k][j].z * r * g[j].z, v[k][j].w * r * g[j].w); hr[64 * j] = o; } }
        __syncthreads();
        if (tile + G < CH / PT) { pool_load_rows(v, x, (tile + G) * PT, seq_len, wave, lane); __builtin_amdgcn_sched_barrier(0); }
        {
            const int pg = wave & 3, part = (lane >> 5) + 2 * (wave >> 2), oc = lane & 31, pw = 2 << pg, phw = pw >> 1;
            const LAS v4u* hrow = (const LAS v4u*)(lds + (8 * part) * 2048 + pg * 512 + oc * 16);
            GAS v4u* po = (GAS v4u*)(Pg + ((size_t)pg * CH + m0 + 8 * part) * 256 + oc * 8);
            if (t0 >= 8 && t0 + PT + 8 <= seq_len) {
                switch (pg) { case 0: pool_rows_interior<2>(hrow, po); break; case 1: pool_rows_interior<4>(hrow, po); break; case 2: pool_rows_interior<8>(hrow, po); break; default: pool_rows_interior<16>(hrow, po); break; }
            } else {
                for (int i = 0; i < 8; ++i) {
                    const int t = t0 + 8 * part + i;
                    const int lo = max(t - phw, 0), hi = min(t + phw - 1, seq_len - 1);
                    f32x4 sl = {0.f, 0.f, 0.f, 0.f}, sh = {0.f, 0.f, 0.f, 0.f};
                    for (int q = lo; q <= hi; ++q) { const f32x8 h = bf8(hrow[(8 + q - t + i) * 128]); sl += h.lo; sh += h.hi; }
                    const f32x8 c = bf8(hrow[(8 + i) * 128]);
                    const float inv = 1.0f / (float)(hi - lo + 1);
                    po[(size_t)i * 32] = pack8(sl * inv - c.lo, sh * inv - c.hi);
                }
            }
        }
        __syncthreads();
    }
}

#define RLX_AGENT __ATOMIC_RELAXED, __HIP_MEMORY_SCOPE_AGENT
#define XB_TMO      128
#define XB_XCNT(j)  (256  + 64 * (j))
#define XB_XSUB(j)  (1280 + 64 * (j))
#define XB_XGEN(j)  (2304 + 64 * (j))
#define XB_TOP      3328
#define XB_TOPGEN   3392
#define XCD_BAR_WORDS 3456
#define XB_SPIN_CAP (1u << 18)

__device__ __forceinline__ unsigned xb_ld(unsigned* p)              { return __hip_atomic_load(p, __ATOMIC_RELAXED, __HIP_MEMORY_SCOPE_AGENT); }
__device__ __forceinline__ unsigned xb_add(unsigned* p, unsigned v) { return __hip_atomic_fetch_add(p, v, __ATOMIC_RELAXED, __HIP_MEMORY_SCOPE_AGENT); }
__device__ __forceinline__ unsigned xb_xcc_id() { return (unsigned)__builtin_amdgcn_s_getreg((3 << 11) | 20) & 0xFu; }
#define XB_SPIN(cond, bar) do { unsigned _sp = 0; while (cond) { __builtin_amdgcn_s_sleep(1); \
    if ((++_sp & 255u) == 0u) { if (xb_ld(&(bar)[XB_TMO])) break; if (_sp > XB_SPIN_CAP) { atomicAdd(&(bar)[XB_TMO], 1u); break; } } } } while (0)

struct XcdBarrier {
    unsigned* bar; unsigned x;
    volatile LAS unsigned* st;
};

__device__ __forceinline__ XcdBarrier xcd_barrier_post(unsigned* bar, volatile LAS unsigned* st) {
    XcdBarrier b; b.bar = bar; b.x = xb_xcc_id(); b.st = st;
    if (threadIdx.x == 0) (void)xb_add(&bar[XB_XCNT(b.x)], 1u);
    return b;
}
__device__ __forceinline__ void xcd_barrier_complete(unsigned* bar, unsigned x, unsigned& nloc, unsigned& nx) {
    const unsigned G = gridDim.x * gridDim.y * gridDim.z;
    unsigned sum, cnt, mine, sp = 0u;
    for (;;) {
        sum = 0u; cnt = 0u; mine = 0u;
#pragma unroll
        for (unsigned j = 0; j < 16; ++j) { const unsigned c = xb_ld(&bar[XB_XCNT(j)]); sum += c; cnt += (c > 0u) ? 1u : 0u; mine = (j == x) ? c : mine; }
        if (sum == G) break;
        __builtin_amdgcn_s_sleep(1);
        if ((++sp & 255u) == 0u) { if (xb_ld(&bar[XB_TMO])) break; if (sp > XB_SPIN_CAP) { atomicAdd(&bar[XB_TMO], 1u); break; } }
    }
    nloc = mine > 0u ? mine : 1u; nx = cnt > 0u ? cnt : 1u;
}

__device__ __forceinline__ void xcd_barrier(const XcdBarrier& b) {
    asm volatile("s_waitcnt vmcnt(0)" ::: "memory");
    __syncthreads();
    if (threadIdx.x == 0) {
        unsigned* bar = b.bar;
        __builtin_amdgcn_s_waitcnt(0);
        unsigned nloc = b.st[0], nx = b.st[1];
        if (nloc == 0u) { xcd_barrier_complete(bar, b.x, nloc, nx); b.st[0] = nloc; b.st[1] = nx; }
        const unsigned old = xb_add(&bar[XB_XSUB(b.x)], 1u);
        const unsigned gen = old / nloc;
        if (old + 1u == (gen + 1u) * nloc) {
            __builtin_amdgcn_fence(__ATOMIC_RELEASE, "agent");
            asm volatile("s_waitcnt vmcnt(0)" ::: "memory");
            const unsigned og = xb_add(&bar[XB_TOP], 1u);
            const unsigned tg = og / nx;
            if (og + 1u == (tg + 1u) * nx) xb_add(&bar[XB_TOPGEN], 1u);
            else XB_SPIN(xb_ld(&bar[XB_TOPGEN]) == tg, bar);
            __builtin_amdgcn_fence(__ATOMIC_ACQUIRE, "agent");
            xb_add(&bar[XB_XGEN(b.x)], 1u);
            asm volatile("s_waitcnt vmcnt(0)" ::: "memory");
        } else {
            XB_SPIN(xb_ld(&bar[XB_XGEN(b.x)]) == gen, bar);
            __builtin_amdgcn_fence(__ATOMIC_ACQUIRE, "agent");
            asm volatile("s_waitcnt vmcnt(0)" ::: "memory");
        }
    }
    __syncthreads();
}


__device__ __forceinline__ unsigned cvtpk(float lo, float hi) { return pk2(lo, hi); }
__device__ __forceinline__ s16x4 vtr(const LAS unsigned char* p) { return __builtin_bit_cast(s16x4, __builtin_amdgcn_ds_read_tr16_b64_v4i16((LAS s16x4*)p)); }
__device__ __forceinline__ void attn_phase(LAS unsigned char* lds, bf16* Qb, const bf16* Kb, const bf16* Vb, const float* rpb_l, int seq_len, int G, int bx, int tid, int wave, int lane) {
    const int fr = lane & 15, fq = lane >> 4;
    const int rows = seq_len >> 6, rows_shift = (seq_len == 2048) ? 5 : 6;
    constexpr int NI = (CH / 64) * 8;
    int nx, xc, lc, per;
    if ((G & 7) == 0) { nx = G >> 3; xc = bx & 7; lc = bx >> 3; per = NI >> 3; } else { nx = G; xc = 0; lc = bx; per = NI; }
    LAS float* bias = (LAS float*)(lds + BIAS_OFF);
    const int qb = wave & 3, hh = wave >> 2;
    const int qc = (qb < 3) ? (8 + 16 * qb + fr) : (fr < 8 ? fr : 48 + fr);
    const int a0 = (qb < 3) ? qb : 0, a1 = (qb < 3) ? qb + 1 : 3;
    const int wst = min(max(qc - 8, 0), 48);
    const int q4 = (lane & 15) >> 2, p4 = lane & 3;
    float madd[2][4];
#pragma unroll
    for (int ai = 0; ai < 2; ++ai)
#pragma unroll
        for (int i = 0; i < 4; ++i) { const int kc = 16 * (ai ? a1 : a0) + 4 * fq + i; madd[ai][i] = ((kc >= wst) && (kc < wst + 16)) ? 0.f : -1.0e30f; }
    int voff[4];
#pragma unroll
    for (int i3 = 0; i3 < 4; ++i3) voff[i3] = (lane >> 4) * D + (((lane & 15) ^ (((lane >> 4) << 2) | i3)) * 8);
    if (lc >= per) return;
    int id = xc * per + lc;
    int r = id & (rows - 1), hp = (id >> rows_shift) & 7, tb = (id >> (rows_shift + 3)) * seq_len, r0 = min(max(r - 4, 0), rows - 8);
    bf16x8 qf0, qf1, kf[4][2][2];
    float bnext[2];
#define ATT_PREFETCH() do { \
        const int h_ = 2 * hp + hh; const size_t qo_ = (size_t)(tb + r * 64 + qc) * D + h_ * 64; \
        qf0 = *(const GAS bf16x8*)(Qb + qo_ + 8 * fq); qf1 = *(const GAS bf16x8*)(Qb + qo_ + 32 + 8 * fq); \
        const bf16* kb_ = Kb + ((size_t)(h_ * 8 + fq) * CH + (tb + r0 * 64 + fr)) * 8; \
        _Pragma("unroll") for (int kr = 0; kr < 4; ++kr) _Pragma("unroll") for (int ai = 0; ai < 2; ++ai) { const bf16* kp = kb_ + (kr * 64 + 16 * (ai ? a1 : a0)) * 8; kf[kr][ai][0] = *(const GAS bf16x8*)kp; kf[kr][ai][1] = *(const GAS bf16x8*)(kp + (size_t)4 * CH * 8); } \
        bnext[0] = rpb_l[hp * 930 + tid] * LOG2E; bnext[1] = (tid + 512 < 930) ? rpb_l[hp * 930 + tid + 512] * LOG2E : 0.f; } while (0)
#define ATT_BIAS_WRITE() do { bias[tid] = bnext[0]; if (tid + 512 < 930) bias[tid + 512] = bnext[1]; } while (0)
    ATT_PREFETCH();
    ATT_BIAS_WRITE();
    for (int loc = lc; loc < per; loc += nx) {
        const int h = 2 * hp + hh;
        const size_t qoff = (size_t)(tb + r * 64 + qc) * D + h * 64;
        const bf16* kbase = Kb + ((size_t)(h * 8 + fq) * CH + (tb + r0 * 64 + fr)) * 8;
        const int drb = r0 - r + 7;
        __syncthreads();
        {
            const int a = wave >> 1, ub = (wave & 1) * 2;
#pragma unroll
            for (int i = 0; i < 16; ++i) { const int kr = 2 * (ub + (i >> 3)) + (i & 1), cb = 16 * a + 4 * ((i & 7) >> 1);
                const bf16* src = Vb + (size_t)(tb + (r0 + kr) * 64 + cb) * D + hp * 128 + voff[i & 3];
                __builtin_amdgcn_global_load_lds((const unsigned*)src, (LAS unsigned*)(lds + (wave * 16 + i) * 1024), 16, 0, 0); }
        }
        f32x4 S[8][2];
        float mx = -3.0e38f;
        const LAS float* bptr[2][4];
#pragma unroll
        for (int ai = 0; ai < 2; ++ai)
#pragma unroll
            for (int i = 0; i < 4; ++i) { const int kc = 16 * (ai ? a1 : a0) + 4 * fq + i; bptr[ai][i] = bias + hh * 465 + drb * 31 + min(max(kc - qc + 15, 0), 30); }
#pragma unroll
        for (int kr = 0; kr < 8; ++kr) {
#pragma unroll
            for (int ai = 0; ai < 2; ++ai) {
                f32x4 z = {0.f, 0.f, 0.f, 0.f};
                z = __builtin_amdgcn_mfma_f32_16x16x32_bf16(kf[kr & 3][ai][0], qf0, z, 0, 0, 0);
                z = __builtin_amdgcn_mfma_f32_16x16x32_bf16(kf[kr & 3][ai][1], qf1, z, 0, 0, 0);
#pragma unroll
                for (int i = 0; i < 4; ++i) { z[i] = (z[i] + bptr[ai][i][kr * 31]) + madd[ai][i]; mx = fmaxf(mx, z[i]); }
                S[kr][ai] = z;
            }
            if (kr < 4) {
#pragma unroll
                for (int ai = 0; ai < 2; ++ai) { const bf16* kp = kbase + ((kr + 4) * 64 + 16 * (ai ? a1 : a0)) * 8; kf[kr & 3][ai][0] = *(const GAS bf16x8*)kp; kf[kr & 3][ai][1] = *(const GAS bf16x8*)(kp + (size_t)4 * CH * 8); }
            }
            __builtin_amdgcn_sched_barrier(0);
        }
        mx = fmaxf(mx, __shfl_xor(mx, 16)); mx = fmaxf(mx, __shfl_xor(mx, 32));
        float sum = 0.f;
#pragma unroll
        for (int kr = 0; kr < 8; ++kr)
#pragma unroll
            for (int ai = 0; ai < 2; ++ai)
#pragma unroll
                for (int i = 0; i < 4; ++i) { const float p = __builtin_amdgcn_exp2f(S[kr][ai][i] - mx); S[kr][ai][i] = p; sum += p; }
        sum += __shfl_xor(sum, 16); sum += __shfl_xor(sum, 32);
        bf16x8 pf[4][2];
#pragma unroll
        for (int u = 0; u < 4; ++u)
#pragma unroll
            for (int ai = 0; ai < 2; ++ai) { v4u pw; pw.x = cvtpk(S[2 * u][ai][0], S[2 * u][ai][1]); pw.y = cvtpk(S[2 * u][ai][2], S[2 * u][ai][3]); pw.z = cvtpk(S[2 * u + 1][ai][0], S[2 * u + 1][ai][1]); pw.w = cvtpk(S[2 * u + 1][ai][2], S[2 * u + 1][ai][3]);
                pf[u][ai] = __builtin_bit_cast(bf16x8, pw); }
        asm volatile("s_waitcnt vmcnt(0)" ::: "memory");
        __syncthreads();
        const int nloc = loc + nx; const bool has_next = nloc < per;
        const int r_cur = r, tb_cur = tb;
        if (has_next) { id = xc * per + nloc; r = id & (rows - 1); hp = (id >> rows_shift) & 7; tb = (id >> (rows_shift + 3)) * seq_len; r0 = min(max(r - 4, 0), rows - 8); ATT_PREFETCH(); }
        (void)r_cur; (void)tb_cur;
        f32x4 O[4];
#pragma unroll
        for (int c = 0; c < 4; ++c) O[c] = (f32x4){0.f, 0.f, 0.f, 0.f};
        const LAS unsigned char* vb[2][2][4];
#pragma unroll
        for (int ai = 0; ai < 2; ++ai)
#pragma unroll
            for (int t = 0; t < 2; ++t)
#pragma unroll
                for (int c = 0; c < 4; ++c) { const int rho = 8 * fq + 4 * t + q4, chn = 2 * (4 * hh + c) + (p4 >> 1);
                    vb[ai][t][c] = lds + (ai ? a1 : a0) * 32768 + 256 * rho + 16 * (chn ^ (((rho & 3) << 2) | ((rho >> 2) & 3))) + 8 * (p4 & 1); }
#pragma unroll
        for (int u = 0; u < 4; ++u) {
#pragma unroll
            for (int ai = 0; ai < 2; ++ai) {
#pragma unroll
                for (int c = 0; c < 4; ++c) {
                    const s16x4 v0 = vtr(vb[ai][0][c] + u * 8192), v1 = vtr(vb[ai][1][c] + u * 8192);
                    const bf16x8 vf = __builtin_shufflevector(v0, v1, 0, 1, 2, 3, 4, 5, 6, 7);
                    O[c] = __builtin_amdgcn_mfma_f32_16x16x32_bf16(vf, pf[u][ai], O[c], 0, 0, 0);
                }
            }
            __builtin_amdgcn_sched_barrier(0);
        }
        const float inv = 1.0f / sum;
#pragma unroll
        for (int c = 0; c < 4; ++c) { v2u w; w.x = cvtpk(O[c][0] * inv, O[c][1] * inv); w.y = cvtpk(O[c][2] * inv, O[c][3] * inv);
            *(GAS v2u*)(Qb + qoff + 16 * c + 4 * fq) = w; }
        if (has_next) ATT_BIAS_WRITE();
    }
    __syncthreads();
#undef ATT_PREFETCH
#undef ATT_BIAS_WRITE
}
enum { K_POOL = 1, K_GEMM_RES = 3, K_GEMM_QKV = 4, K_GEMM_UP = 5, K_ATTN = 6, K_FINAL = 7 };
enum { F_A_X = 1, F_A_IN = 2, F_AUX_X = 4, F_AUX_IN = 8 };
struct Ph { int kind, flags, N, K; const void* A; const void* B; void* C; const void* aux; float* st; float* rs; unsigned long long a_pn_stride, pad; };
constexpr int PPC = 19;
struct Args { Ptrs p; Ph tab[PPC]; };
__global__ void __launch_bounds__(NWAVES * 64, 2) fwd_megakernel(Args args) {
    extern __shared__ __attribute__((aligned(16))) unsigned char lds_raw[];
    cg::grid_group grid = cg::this_grid();
    LAS unsigned char* lds = (LAS unsigned char*)lds_raw;
    volatile LAS unsigned* MISC = (volatile LAS unsigned*)(lds + MISC_OFF);
    for (int u = threadIdx.x; u < 32; u += NWAVES * 64) MISC[u] = 0u;
    __syncthreads();
    const XcdBarrier bar = xcd_barrier_post((unsigned*)(args.p.ws + WS_CTL), MISC + 8);
    {
        const int tid = threadIdx.x, lane = tid & 63, wave = __builtin_amdgcn_readfirstlane(tid >> 6);
        const int G = gridDim.x, bx = blockIdx.x;
        const int vcu = (G % 8 == 0) ? (bx % 8) * (G / 8) + bx / 8 : bx;
        prologue(args.p, lds, vcu * NWAVES + wave, G * NWAVES, wave, lane);
    }
    grid.sync();

    for (int ph = 0; ph < NCHUNK * PPC; ++ph) {
        int tid = threadIdx.x; asm volatile("" : "+v"(tid));
        int G = gridDim.x, bx = blockIdx.x; asm volatile("" : "+s"(G), "+s"(bx));
        const int lane = tid & 63, wave = __builtin_amdgcn_readfirstlane(tid >> 6);
        const int vcu = (G % 8 == 0) ? (bx % 8) * (G / 8) + bx / 8 : bx;
        const int gw = vcu * NWAVES + wave, NGW = G * NWAVES;
        const int ck = ph / PPC, idx = ph - ck * PPC;
        const Ph d = args.tab[idx];
        const int tok0 = ck * CH, grp = tok0 / GROUP_TOK, seq_len = grp ? 4096 : 2048;
        const float* xin = args.p.x_in[grp] + (size_t)(tok0 - grp * GROUP_TOK) * D;
        float* X = args.p.out + (size_t)tok0 * D;
        const void* A = (d.flags & F_A_X) ? (const void*)X : (d.flags & F_A_IN) ? (const void*)xin : d.A;
        const void* aux = (d.flags & F_AUX_X) ? (const void*)X : (d.flags & F_AUX_IN) ? (const void*)xin : d.aux;
#define KIND_IS(x) ([&]() { int kd_ = d.kind; asm volatile("" : "+s"(kd_)); return kd_ == (x); }())
        if (0) {}
        else if (KIND_IS(K_POOL)) { { int tid2 = threadIdx.x; asm volatile("" : "+v"(tid2));
            pool_phase(lds, (const float*)A, (const float*)aux, (bf16*)d.C, seq_len, vcu, G, tid2, __builtin_amdgcn_readfirstlane(tid2 >> 6), tid2 & 63); } }
        else if (KIND_IS(K_GEMM_RES)) { pg8::Gemm g{(const bf16*)A, (const bf16*)d.B, CH, d.N, d.K, (size_t)d.a_pn_stride, d.K == FF  }; pg8::StaticOrder S; S.init(CH, d.N, G, bx);
            pg8::EpiRes E{(const float*)aux, X, (bf16*)d.C, d.st, D, d.rs};
            pg8::gemm_phase<pg8::EpiRes, pg8::StaticOrder, PG8_ALIGN, PG8_SP2>(lds, g, S, E, tid); }
        else if (KIND_IS(K_GEMM_QKV)) { pg8::Gemm g{(const bf16*)A, (const bf16*)d.B, CH, d.N, d.K, 0, 1  }; pg8::StaticOrder S; S.init(CH, d.N, G, bx);
            pg8::EpiBf16<0, true> E{(bf16*)d.C, D, D, (size_t)CH * D, 0.125f * LOG2E, d.st, 0};
            pg8::gemm_phase<pg8::EpiBf16<0, true>, pg8::StaticOrder, PG8_ALIGN, PG8_SP2>(lds, g, S, E, tid); }
        else if (KIND_IS(K_GEMM_UP)) { pg8::Gemm g{(const bf16*)A, (const bf16*)d.B, CH, d.N, d.K, 0, 1  }; pg8::StaticOrder S; S.init(CH, d.N, G, bx);
            pg8::EpiBf16<2, false> E{(bf16*)d.C, FF, 0, 0, 1.f, nullptr, 1};
            pg8::gemm_phase<pg8::EpiBf16<2, false>, pg8::StaticOrder, PG8_ALIGN, PG8_SP2>(lds, g, S, E, tid); }
        else if (KIND_IS(K_ATTN)) { attn_phase(lds, (bf16*)d.C, (const bf16*)d.C + (size_t)CH * D, (const bf16*)d.C + 2 * (size_t)CH * D, (const float*)aux, seq_len, G, bx, tid, wave, lane); }
        else { norm_rows_f32_inplace(X, (const float*)aux, CH, gw, NGW, lane); }
#undef KIND_IS
        if (d.kind != K_FINAL) xcd_barrier(bar);
    }
}

extern "C" void kernel_launch(void* const* d_in, const int* in_sizes, int n_in, void* d_out, int out_size, void* d_ws, size_t ws_size, hipStream_t stream) {
    static int grid = 0;
    if (grid == 0) {
        if (n_in != 12 || in_sizes[0] != GROUP_TOK * D || in_sizes[1] != GROUP_TOK * D || out_size != NTOK * D || ws_size < WS_END) {
            fprintf(stderr, "kernel_launch: unexpected shapes (n_in %d, out %d, ws %zu < %zu); nothing launched\n", n_in, out_size, ws_size, (size_t)WS_END); grid = -1; return; }
        int dev = 0, cus = 0, per_cu = 0;
        if (hipGetDevice(&dev) != hipSuccess || hipDeviceGetAttribute(&cus, hipDeviceAttributeMultiprocessorCount, dev) != hipSuccess) { fprintf(stderr, "kernel_launch: device query failed\n"); grid = -1; return; }
        if (hipFuncSetAttribute((const void*)fwd_megakernel, hipFuncAttributeMaxDynamicSharedMemorySize, LDS_BYTES) != hipSuccess) { fprintf(stderr, "kernel_launch: hipFuncSetAttribute failed\n"); grid = -1; return; }
        if (hipOccupancyMaxActiveBlocksPerMultiprocessor(&per_cu, (const void*)fwd_megakernel, NWAVES * 64, LDS_BYTES) != hipSuccess || per_cu < 1) { fprintf(stderr, "kernel_launch: occupancy query gave %d\n", per_cu); per_cu = 1; }
        (void)hipGetLastError();
        grid = cus * per_cu;
    }
    if (grid < 0) return;
    if (hipMemsetAsync((char*)d_ws + WS_CTL, 0, CTL_ZERO_BYTES, stream) != hipSuccess) { fprintf(stderr, "kernel_launch: hipMemsetAsync failed\n"); return; }
    Args a{};
    Ptrs& p = a.p;
    p.x_in[0] = (const float*)d_in[0]; p.x_in[1] = (const float*)d_in[1]; p.norm_mix = (const float*)d_in[2]; p.pool_w = (const float*)d_in[3]; p.pool_scale = (const float*)d_in[4];
    p.w_qkv = (const float*)d_in[5]; p.rpb = (const float*)d_in[6]; p.w_o = (const float*)d_in[7]; p.norm_mlp = (const float*)d_in[8]; p.w_up = (const float*)d_in[9];
    p.w_down = (const float*)d_in[10]; p.norm_final = (const float*)d_in[11]; p.out = (float*)d_out; p.ws = (unsigned char*)d_ws;
    unsigned char* ws = (unsigned char*)d_ws;
    bf16* WPOOL = (bf16*)(ws + WS_WPOOL); bf16* WQKV = (bf16*)(ws + WS_WQKV); bf16* WO = (bf16*)(ws + WS_WO); bf16* WUP = (bf16*)(ws + WS_WUP); bf16* WDN = (bf16*)(ws + WS_WDN);
    bf16* XN = (bf16*)(ws + WS_XN); bf16* PG = (bf16*)(ws + WS_PG); bf16* QB = (bf16*)(ws + WS_ACT); bf16* HB = (bf16*)(ws + WS_ACT);
    float* SA = (float*)(ws + WS_STAT); float* SB = SA + (size_t)CH * 16;
    int n = 0;
    auto add = [&](int kind, int flags, int N, int K, const void* A, const void* B, void* C, const void* aux, float* st, float* rs, unsigned long long aps) {
        Ph& d = a.tab[n++]; d.kind = kind; d.flags = flags; d.N = N; d.K = K; d.A = A; d.B = B; d.C = C; d.aux = aux; d.st = st; d.rs = rs; d.a_pn_stride = aps; d.pad = 0; };
    for (int layer = 0; layer < DEPTH; ++layer) {
        const int j = layer >> 1;
        if ((layer & 1) == 0) {
            add(K_POOL, layer == 0 ? F_A_IN : F_A_X, 0, 0, nullptr, nullptr, PG, p.norm_mix + layer * D, nullptr, nullptr, 0);
            add(K_GEMM_RES, layer == 0 ? F_AUX_IN : F_AUX_X, D, 256, PG, WPOOL + (size_t)j * 1024 * 256, XN, nullptr, SA, nullptr, (unsigned long long)CH * 256 * 2);
        } else {
            add(K_GEMM_QKV, 0, 3 * D, D, XN, WQKV + (size_t)j * 3 * D * D, QB, nullptr, SB, nullptr, 0);
            add(K_ATTN, 0, 0, 0, nullptr, nullptr, QB, p.rpb + (size_t)j * NH * 15 * 31, nullptr, nullptr, 0);
            add(K_GEMM_RES, F_AUX_X, D, D, QB, WO + (size_t)j * D * D, XN, nullptr, SA, nullptr, 0);
        }
        add(K_GEMM_UP, 0, FF, D, XN, WUP + (size_t)layer * D * FF, HB, nullptr, SA, nullptr, 0);
        add(K_GEMM_RES, F_AUX_X, D, FF, HB, WDN + (size_t)layer * D * FF, (layer & 1) == 0 ? XN : nullptr, nullptr, SB, SA, 0);
    }
    add(K_FINAL, 0, 0, 0, nullptr, nullptr, nullptr, p.norm_final, nullptr, nullptr, 0);
    if (n != PPC) { fprintf(stderr, "kernel_launch: phase table has %d entries, expected %d\n", n, PPC); return; }
    void* kargs[] = {&a};
    hipError_t e = hipLaunchCooperativeKernel((const void*)fwd_megakernel, dim3(grid), dim3(NWAVES * 64), kargs, LDS_BYTES, stream);
    if (e != hipSuccess) fprintf(stderr, "kernel_launch: cooperative launch failed: %s (grid %d)\n", hipGetErrorString(e), grid);
}
```

```cpp
#include <hip/hip_runtime.h>
#include <hip/hip_cooperative_groups.h>
#include <cstdio>
#include <cstdint>
namespace cg = cooperative_groups;
namespace pg8 {
#define PG8_LAS __attribute__((address_space(3)))
typedef unsigned short bf16_t;
typedef short bf16x8 __attribute__((ext_vector_type(8)));
typedef float f32x4 __attribute__((ext_vector_type(4)));
typedef unsigned u32x4 __attribute__((ext_vector_type(4)));
constexpr int BM = 256, BK = 64, HALF = 128, HTB = HALF * BK * 2  , STAGE_BYTES = 8 * HTB, NXCD = 8, WGM = 8;

__host__ __device__ __forceinline__ int lds_byte(int r, int c) { const int st = (r >> 4) * 2 + (c >> 5), rr = r & 15, cc = c & 31, ob = rr * 64 + cc * 2; return st * 1024 + (ob ^ (((ob >> 9) & 1) << 5)); }
__host__ __device__ __forceinline__ void stage_rc(int b, int& R, int& C) { const int st = b / 1024, sb = b % 1024, swz = sb ^ (((sb >> 9) & 1) << 5); R = (st >> 1) * 16 + swz / 64; C = (st & 1) * 32 + (swz % 64) / 2; }
__host__ __device__ __forceinline__ int perm32(int rho) { const int n = rho >> 4, i = rho & 15; return 8 * (i >> 2) + 4 * n + (i & 3); }

struct Unit { int pm, pn; };
struct Gemm { const bf16_t* A; const bf16_t* Bt; int M, N, K; size_t a_pn_stride; int a_tiled; };

struct StaticOrder {
    int nM, nN, nwg, G, c;
    __host__ __device__ void init(int M, int N, int G_, int c_) { nM = M / BM; nN = N / BM; nwg = nM * nN; G = G_; c = c_; }
    __host__ __device__ bool next(int i, Unit& u) const {
        const long L = (long)i * G + c; if (L >= nwg) return false;
        int wgid = (int)L; { const int q = nwg / NXCD, r = nwg % NXCD, xcd = wgid % NXCD, off = wgid / NXCD; wgid = (xcd < r ? xcd * (q + 1) : r * (q + 1) + (xcd - r) * q) + off; }
        const int nig = WGM * nN, gid = wgid / nig, fm = gid * WGM, gsz = (nM - fm) < WGM ? (nM - fm) : WGM;
        u.pm = fm + ((wgid % nig) % gsz); u.pn = (wgid % nig) / gsz; return true;
    }
    __device__ __forceinline__ void a_ready(const Unit&) const {}
    __device__ __forceinline__ void done(const Unit&) const {}
};

__device__ __forceinline__ unsigned cvt_pk_bf16(float lo, float hi) { unsigned r; asm volatile("v_cvt_pk_bf16_f32 %0, %1, %2" : "=v"(r) : "v"(lo), "v"(hi)); return r; }
typedef float f32x2 __attribute__((ext_vector_type(2)));
template <int ACT, bool RS> struct EpiBf16 {
    static constexpr bool PERM = true, AFTER_DRAIN = false;
    bf16_t* O; int ldc; int split_cols; size_t split_stride; float scale0; const float* st; int tiled;
    __device__ __forceinline__ void operator()(const f32x4 (&acc)[2][2][4][2], const Unit& u, int wr, int wc, int fr, int fq) const {
        const int row0 = u.pm * BM + wr * 64 + fr; int colt = u.pn * BM; bf16_t* base = O;
        float sc = 1.f; bool kplane = false;
        if (split_cols) { const int t = colt / split_cols; base += (size_t)t * split_stride; colt -= t * split_cols; if (t == 0) sc = scale0; kplane = (t == 1); }
        const size_t kprows = split_stride / 1024;
        const int col0 = colt + wc * 32 + 8 * fq;
        f32x4 pv[2][4];
        if (RS) {
#pragma unroll
            for (int ai = 0; ai < 2; ++ai)
#pragma unroll
                for (int m = 0; m < 4; ++m) pv[ai][m] = *(const f32x4*)(st + (size_t)(row0 + ai * HALF + m * 16) * 16 + 4 * fq);
            __builtin_amdgcn_sched_barrier(0);
        }
#pragma unroll
        for (int ai = 0; ai < 2; ++ai)
#pragma unroll
            for (int m = 0; m < 4; ++m) { const int row = row0 + ai * HALF + m * 16; bf16_t* rowp = base + (size_t)row * ldc + col0;
                float f = sc;
                if (RS) { float ss = (pv[ai][m][0] + pv[ai][m][1]) + (pv[ai][m][2] + pv[ai][m][3]); ss += __shfl_xor(ss, 16); ss += __shfl_xor(ss, 32);
                    const float r = __builtin_amdgcn_rsqf(ss * (1.0f / 1024.0f) + 1e-6f); f *= (ACT == 2) ? r * r : r; }
#pragma unroll
                for (int bj = 0; bj < 2; ++bj) { f32x4 v0 = acc[ai][bj][m][0], v1 = acc[ai][bj][m][1];
                    if (ACT == 2) {
#pragma unroll
                        for (int e = 0; e < 4; ++e) { const float a = fmaxf(v0[e], 0.f), b = fmaxf(v1[e], 0.f); v0[e] = a * a; v1[e] = b * b; } }
                    v0 = v0 * f; v1 = v1 * f; u32x4 w; w.x = cvt_pk_bf16(v0[0], v0[1]); w.y = cvt_pk_bf16(v0[2], v0[3]); w.z = cvt_pk_bf16(v1[0], v1[1]); w.w = cvt_pk_bf16(v1[2], v1[3]);
                    if (kplane) *(u32x4*)(base + ((size_t)(((colt >> 6) + 2 * bj + (wc >> 1)) * 8 + (wc & 1) * 4 + fq) * kprows + row) * 8) = w;
                    else if (tiled) { const int r_ = row & 255, c_ = col0 + bj * HALF;
                        *(u32x4*)((char*)base + ((size_t)(((row >> 8) * 2 + (r_ >> 7)) * (ldc >> 6) + (c_ >> 6)) << 14) + lds_byte(r_ & 127, c_ & 63)) = w; }
                    else *(u32x4*)(rowp + bj * HALF) = w; } }
    }
};
struct EpiRes {
    static constexpr bool PERM = true, AFTER_DRAIN = false;
    const float* base; float* out; bf16_t* xn; float* st; int ldc; const float* rs;
    __device__ __forceinline__ void operator()(const f32x4 (&acc)[2][2][4][2], const Unit& u, int wr, int wc, int fr, int fq) const {
        const int col0 = u.pn * BM + wc * 32 + 8 * fq;
#pragma unroll
        for (int ai = 0; ai < 2; ++ai) {
            f32x4 rp[4];
            if (rs) {
#pragma unroll
                for (int m = 0; m < 4; ++m) rp[m] = *(const f32x4*)(rs + (size_t)(u.pm * BM + ai * HALF + wr * 64 + m * 16 + fr) * 16 + 4 * fq);
            }
            f32x4 bs[4][2][2];
#pragma unroll
            for (int m = 0; m < 4; ++m) { const size_t off = (size_t)(u.pm * BM + ai * HALF + wr * 64 + m * 16 + fr) * ldc + col0;
#pragma unroll
                for (int bj = 0; bj < 2; ++bj) { bs[m][bj][0] = *(const f32x4*)(base + off + bj * HALF); bs[m][bj][1] = *(const f32x4*)(base + off + bj * HALF + 4); } }
            __builtin_amdgcn_sched_barrier(0);
#pragma unroll
            for (int m = 0; m < 4; ++m) { const int row = u.pm * BM + ai * HALF + wr * 64 + m * 16 + fr; const size_t off = (size_t)row * ldc + col0; float ss = 0.f;
                float f = 1.f;
                if (rs) { float q = (rp[m][0] + rp[m][1]) + (rp[m][2] + rp[m][3]); q += __shfl_xor(q, 16); q += __shfl_xor(q, 32); const float r = __builtin_amdgcn_rsqf(q * (1.0f / 1024.0f) + 1e-6f); f = r * r; }
#pragma unroll
                for (int bj = 0; bj < 2; ++bj) {
                    const f32x4 o0 = bs[m][bj][0] + acc[ai][bj][m][0] * f, o1 = bs[m][bj][1] + acc[ai][bj][m][1] * f;
                    *(f32x4*)(out + off + bj * HALF) = o0; *(f32x4*)(out + off + bj * HALF + 4) = o1;
                    if (xn) { u32x4 w; w.x = cvt_pk_bf16(o0[0], o0[1]); w.y = cvt_pk_bf16(o0[2], o0[3]); w.z = cvt_pk_bf16(o1[0], o1[1]); w.w = cvt_pk_bf16(o1[2], o1[3]);
                        { const int c_ = col0 + bj * HALF;
                          *(u32x4*)((char*)xn + ((size_t)((u.pm * 2 + ai) * (ldc >> 6) + (c_ >> 6)) << 14) + lds_byte(wr * 64 + m * 16 + fr, c_ & 63)) = w; }
                        ss += (o0[0] * o0[0] + o0[1] * o0[1]) + (o0[2] * o0[2] + o0[3] * o0[3]) + (o1[0] * o1[0] + o1[1] * o1[1]) + (o1[2] * o1[2] + o1[3] * o1[3]); } }
                if (xn) { ss += __shfl_xor(ss, 16); ss += __shfl_xor(ss, 32); if (fq == 0) st[(size_t)row * 16 + u.pn * 4 + wc] = ss; } }
            __builtin_amdgcn_sched_barrier(0);
        }
    }
};
template <class Epi, class Sched, bool ALIGN_EPI = false, bool SP2 = false>
__device__ __forceinline__ void gemm_phase(PG8_LAS unsigned char* lds, const Gemm g, const Sched& S, const Epi& E, const int tid_in) {
    const int tid = tid_in, wid = __builtin_amdgcn_readfirstlane(tid >> 6), lane = tid & 63, wr = wid >> 2, wc = wid & 3, fr = lane & 15, fq = lane >> 4;
    const int K = g.K, nt = K / BK;
    unsigned voffA[2], voffB[2];
#pragma unroll
    for (int i = 0; i < 2; ++i) { int R, C; stage_rc(tid * 16 + i * 8192, R, C); const int Rb = Epi::PERM ? ((R & ~31) + perm32(R & 31)) : R;
        voffA[i] = g.a_tiled ? (unsigned)(tid * 16 + i * 8192) : (unsigned)(R * K + C) * 2u; voffB[i] = (unsigned)(tid * 16 + i * 8192); (void)Rb; }
    const size_t kstep = (size_t)(BK * 2);
    const size_t hstep = (size_t)HALF * K * 2;
    const size_t tstep = 2 * hstep;
    const size_t kstepB = 16384, hstepB = (size_t)nt * 16384, tstepB = 2 * hstepB;
    const size_t kstepA = g.a_tiled ? (size_t)16384 : kstep, hstepA = g.a_tiled ? (size_t)nt * 16384 : hstep, tstepA = 2 * hstepA;
    const unsigned ldsw = (unsigned)wid * 1024u;
    const int aoff = lds_byte(wr * 64 + fr, fq * 8), boff = lds_byte(wc * 32 + fr, fq * 8);
#define PG8_SA(b, h) (((b) * 2 + (h)) * HTB)
#define PG8_SB(b, h) ((4 + (b) * 2 + (h)) * HTB)
#define PG8_STAGE(bufoff, gbase, voff) do { _Pragma("unroll") for (int _i = 0; _i < 2; ++_i) \
        __builtin_amdgcn_global_load_lds((const unsigned*)((const char*)(gbase) + (voff)[_i]), (PG8_LAS unsigned*)(lds + (bufoff) + ldsw + _i * 8192), 16, 0, 0); } while (0)
#define PG8_LDA(dst, b, h) do { _Pragma("unroll") for (int m = 0; m < 4; ++m) _Pragma("unroll") for (int k = 0; k < 2; ++k) dst[m][k] = *(const PG8_LAS bf16x8*)(lds + PG8_SA(b, h) + aoff + m * 2048 + k * 1024); } while (0)
#define PG8_LDB(dst, b, h) do { _Pragma("unroll") for (int n = 0; n < 2; ++n) _Pragma("unroll") for (int k = 0; k < 2; ++k) dst[n][k] = *(const PG8_LAS bf16x8*)(lds + PG8_SB(b, h) + boff + n * 2048 + k * 1024); } while (0)
#define PG8_MMA(ai, bj, At, Bt) do { __builtin_amdgcn_s_setprio(1); _Pragma("unroll") for (int m = 0; m < 4; ++m) _Pragma("unroll") for (int n = 0; n < 2; ++n) _Pragma("unroll") for (int k = 0; k < 2; ++k) \
        acc[ai][bj][m][n] = __builtin_amdgcn_mfma_f32_16x16x32_bf16(Bt[n][k], At[m][k], acc[ai][bj][m][n], 0, 0, 0); __builtin_amdgcn_s_setprio(0); } while (0)
#define PG8_WAIT_V(n) asm volatile("s_waitcnt vmcnt(" #n ")" ::: "memory")
#define PG8_WAIT_L(n) asm volatile("s_waitcnt lgkmcnt(" #n ")" ::: "memory")
#define PG8_BAR __builtin_amdgcn_s_barrier()
#define PG8_SCHED __builtin_amdgcn_sched_barrier(0)
    Unit cur, nxt; int ui = 0;
    if (!S.next(0, cur)) return;
    f32x4 acc[2][2][4][2];
#pragma unroll
    for (int a = 0; a < 2; ++a)
#pragma unroll
        for (int b = 0; b < 2; ++b)
#pragma unroll
            for (int m = 0; m < 4; ++m)
#pragma unroll
                for (int n = 0; n < 2; ++n) acc[a][b][m][n] = (f32x4){0.f, 0.f, 0.f, 0.f};
    bf16x8 At[4][2], B0[2][2], B1[2][2];
    const char* cA = (const char*)g.A + (size_t)cur.pm * tstepA + (size_t)cur.pn * g.a_pn_stride; const char* cB = (const char*)g.Bt + (size_t)cur.pn * tstepB;
    S.a_ready(cur);
    if constexpr (SP2) {
        PG8_STAGE(PG8_SB(0, 0), cB, voffB); PG8_STAGE(PG8_SB(0, 1), cB + hstepB, voffB); PG8_STAGE(PG8_SA(0, 0), cA, voffA); PG8_STAGE(PG8_SA(0, 1), cA + hstepA, voffA);
        if (wr == 1) PG8_BAR;
        PG8_WAIT_V(2); PG8_BAR;
        PG8_STAGE(PG8_SB(1, 0), cB + kstepB, voffB); PG8_STAGE(PG8_SA(1, 0), cA + kstepA, voffA); PG8_STAGE(PG8_SB(1, 1), cB + hstepB + kstepB, voffB);
        PG8_WAIT_V(6); PG8_BAR;
    } else {
        PG8_STAGE(PG8_SB(0, 0), cB, voffB); PG8_STAGE(PG8_SA(0, 0), cA, voffA); PG8_STAGE(PG8_SB(0, 1), cB + hstepB, voffB); PG8_STAGE(PG8_SA(0, 1), cA + hstepA, voffA);
        if (wr == 1) PG8_BAR;
        PG8_WAIT_V(4); PG8_BAR;
        PG8_STAGE(PG8_SB(1, 0), cB + kstepB, voffB); PG8_STAGE(PG8_SA(1, 0), cA + kstepA, voffA); PG8_STAGE(PG8_SB(1, 1), cB + hstepB + kstepB, voffB);
        PG8_WAIT_V(6); PG8_BAR;
    }
    for (;;) {
        const bool has_next = S.next(ui + 1, nxt);
        const char* nA = has_next ? (const char*)g.A + (size_t)nxt.pm * tstepA + (size_t)nxt.pn * g.a_pn_stride : cA; const char* nB = has_next ? (const char*)g.Bt + (size_t)nxt.pn * tstepB : cB;
        for (int t = 0; t < nt; t += 2) {
            const bool last = (t == nt - 2);
            const char* a1 = cA + (size_t)(t + 1) * kstepA;
            const char* a2 = last ? nA : cA + (size_t)(t + 2) * kstepA; const char* b2 = last ? nB : cB + (size_t)(t + 2) * kstepB;
            const char* a3 = a2 + kstepA; const char* b3 = b2 + kstepB;
            if (last && has_next) S.a_ready(nxt);
            if constexpr (SP2) {
            PG8_LDB(B0, 0, 0); PG8_LDB(B1, 0, 1); PG8_SCHED; PG8_LDA(At, 0, 0); PG8_STAGE(PG8_SA(1, 1), a1 + hstepA, voffA);
            PG8_WAIT_V(8); PG8_WAIT_L(0); PG8_BAR; PG8_MMA(0, 0, At, B0); PG8_MMA(0, 1, At, B1); PG8_BAR; PG8_SCHED;
            PG8_LDA(At, 0, 1); PG8_STAGE(PG8_SB(0, 0), b2, voffB); PG8_STAGE(PG8_SB(0, 1), b2 + hstepB, voffB); PG8_STAGE(PG8_SA(0, 0), a2, voffA);
            PG8_WAIT_V(8); PG8_WAIT_L(0); PG8_BAR; PG8_MMA(1, 0, At, B0); PG8_MMA(1, 1, At, B1); PG8_BAR; PG8_SCHED;
            PG8_LDB(B0, 1, 0); PG8_LDB(B1, 1, 1); PG8_SCHED; PG8_LDA(At, 1, 0); PG8_STAGE(PG8_SA(0, 1), a2 + hstepA, voffA);
            PG8_WAIT_V(8); PG8_WAIT_L(0); PG8_BAR; PG8_MMA(0, 0, At, B0); PG8_MMA(0, 1, At, B1); PG8_BAR; PG8_SCHED;
            PG8_LDA(At, 1, 1); PG8_STAGE(PG8_SB(1, 0), b3, voffB); PG8_STAGE(PG8_SB(1, 1), b3 + hstepB, voffB); PG8_STAGE(PG8_SA(1, 0), a3, voffA);
            PG8_WAIT_V(8); PG8_WAIT_L(0); PG8_BAR; PG8_MMA(1, 0, At, B0); PG8_MMA(1, 1, At, B1); PG8_BAR; PG8_SCHED;
            } else {
            PG8_LDB(B0, 0, 0); PG8_SCHED; PG8_LDA(At, 0, 0); PG8_STAGE(PG8_SA(1, 1), a1 + hstepA, voffA);
            PG8_WAIT_L(8); PG8_BAR; PG8_WAIT_L(0); PG8_MMA(0, 0, At, B0); PG8_BAR; PG8_SCHED;
            PG8_LDB(B1, 0, 1); PG8_STAGE(PG8_SB(0, 0), b2, voffB);
            PG8_BAR; PG8_WAIT_L(0); PG8_MMA(0, 1, At, B1); PG8_BAR;
            PG8_LDA(At, 0, 1); PG8_STAGE(PG8_SA(0, 0), a2, voffA);
            PG8_BAR; PG8_WAIT_L(0); PG8_MMA(1, 0, At, B0); PG8_BAR; PG8_SCHED;
            PG8_STAGE(PG8_SB(0, 1), b2 + hstepB, voffB);
            PG8_WAIT_V(6); PG8_BAR; PG8_MMA(1, 1, At, B1); PG8_BAR;
            PG8_LDB(B0, 1, 0); PG8_SCHED; PG8_LDA(At, 1, 0); PG8_STAGE(PG8_SA(0, 1), a2 + hstepA, voffA);
            PG8_WAIT_L(8); PG8_BAR; PG8_WAIT_L(0); PG8_MMA(0, 0, At, B0); PG8_BAR; PG8_SCHED;
            PG8_LDB(B1, 1, 1); PG8_STAGE(PG8_SB(1, 0), b3, voffB);
            PG8_BAR; PG8_WAIT_L(0); PG8_MMA(0, 1, At, B1); PG8_BAR;
            PG8_LDA(At, 1, 1); PG8_STAGE(PG8_SA(1, 0), a3, voffA);
            PG8_BAR; PG8_WAIT_L(0); PG8_MMA(1, 0, At, B0); PG8_BAR; PG8_SCHED;
            PG8_STAGE(PG8_SB(1, 1), b3 + hstepB, voffB);
            PG8_WAIT_V(6); PG8_BAR; PG8_MMA(1, 1, At, B1); PG8_BAR;
            }
        }
        if constexpr (ALIGN_EPI) { if (wr == 0) PG8_BAR; }
        if constexpr (!Epi::AFTER_DRAIN) { E(acc, cur, wr, wc, fr, fq); S.done(cur); }
        if (!has_next) break;
#pragma unroll
        for (int a = 0; a < 2; ++a)
#pragma unroll
            for (int b = 0; b < 2; ++b)
#pragma unroll
                for (int m = 0; m < 4; ++m)
#pragma unroll
                    for (int n = 0; n < 2; ++n) acc[a][b][m][n] = (f32x4){0.f, 0.f, 0.f, 0.f};
        cur = nxt; cA = nA; cB = nB; ++ui;
        if constexpr (ALIGN_EPI) { if (wr == 1) PG8_BAR; }
    }
    PG8_WAIT_V(0);
    if constexpr (!ALIGN_EPI) { if (wr == 0) PG8_BAR; }
    PG8_BAR;
    if constexpr (Epi::AFTER_DRAIN) { E.fused(acc, cur, wr, wc, fr, fq, lds, wid, lane); S.done(cur); }
#undef PG8_SA
#undef PG8_SB
#undef PG8_STAGE
#undef PG8_LDA
#undef PG8_LDB
#undef PG8_MMA
#undef PG8_WAIT_V
#undef PG8_WAIT_L
#undef PG8_BAR
#undef PG8_SCHED
}
}
#ifndef PG8_SP2
#define PG8_SP2 true
#endif
#ifndef PG8_ALIGN
#define PG8_ALIGN true
#endif

constexpr int NWAVES = 8;
constexpr int D = 1024, FF = 4096, NH = 16, HD = 64, DEPTH = 4;
constexpr int NTOK = 131072;
constexpr int GROUP_TOK = 65536;
#ifndef MK_CH
#define MK_CH 65536
#endif
constexpr int CH = MK_CH;
constexpr int NCHUNK = NTOK / CH;
constexpr float RMS_EPS = 1e-6f;
constexpr float LOG2E = 1.4426950408889634f;
static_assert(GROUP_TOK % CH == 0 && CH % 4096 == 0, "chunking");

constexpr size_t MiB = 1u << 20;
constexpr size_t WS_WPOOL = 2 * MiB;
constexpr size_t WS_WQKV = 4 * MiB;
constexpr size_t WS_WO = 16 * MiB;
constexpr size_t WS_WUP = 20 * MiB;
constexpr size_t WS_WDN = 52 * MiB;
constexpr size_t WS_XN = 96 * MiB;
constexpr size_t WS_PG = WS_XN + (size_t)CH * D * 2;
constexpr size_t WS_ACT = WS_PG + (size_t)CH * D * 2;
constexpr size_t WS_CTL = 0, CTL_ZERO_BYTES = 65536;
constexpr size_t WS_STAT = 86 * MiB;
static_assert(WS_STAT + 2 * (size_t)CH * 64 <= WS_XN, "stat arrays");
constexpr size_t WS_END = WS_ACT + (size_t)CH * FF * 2;
static_assert(WS_XN >= WS_WDN + 32 * MiB && WS_END <= 1024 * MiB, "d_ws map");

constexpr int RING_BYTES = 131072;
constexpr int BIAS_OFF = RING_BYTES;
constexpr int MISC_OFF = RING_BYTES + 4096;
constexpr int LDS_BYTES = 147456;

#define GAS __attribute__((address_space(1)))
#define LAS __attribute__((address_space(3)))
typedef unsigned short bf16;
typedef unsigned v4u __attribute__((ext_vector_type(4)));
typedef unsigned v2u __attribute__((ext_vector_type(2)));
typedef float f32x4 __attribute__((ext_vector_type(4)));
typedef short bf16x8 __attribute__((ext_vector_type(8)));
typedef short s16x4 __attribute__((ext_vector_type(4)));
#define LDS_WAIT() asm volatile("s_waitcnt lgkmcnt(0)" ::: "memory")
typedef float f32x2_t __attribute__((ext_vector_type(2))); typedef __bf16 bf16x2_t __attribute__((ext_vector_type(2)));
__device__ __forceinline__ unsigned pk2(float lo, float hi) { f32x2_t v = {lo, hi}; bf16x2_t b = __builtin_convertvector(v, bf16x2_t); return __builtin_bit_cast(unsigned, b); }
__device__ __forceinline__ float wave_sum(float v) {
#pragma unroll
    for (int o = 1; o < 64; o <<= 1) v += __shfl_xor(v, o);
    return v;
}

__device__ __forceinline__ void transpose_item(const float* W, int K, int N, bf16* WT, int row_off, const float* nscale, const float* kscale, LAS float* scr, int item, int lane) {
    const int nblk = N / 32, kb = item / nblk, nb = item % nblk, k0 = 64 * kb, n0 = 32 * nb;
    float wv[32];
#pragma unroll
    for (int i = 0; i < 32; ++i) wv[i] = W[(size_t)(k0 + 2 * i + (lane >> 5)) * N + n0 + (lane & 31)];
#pragma unroll
    for (int i = 0; i < 32; ++i) scr[(2 * i + (lane >> 5)) * 33 + (lane & 31)] = wv[i];
    LDS_WAIT(); asm volatile("" ::: "memory");
    const int c = lane & 7;
    float ks[8];
#pragma unroll
    for (int e = 0; e < 8; ++e) ks[e] = kscale ? kscale[k0 + 8 * c + e] : 1.f;
#pragma unroll
    for (int j = 0; j < 4; ++j) { const int n = (lane >> 3) + 8 * j; const LAS float* s = scr + (8 * c) * 33 + n;
        const float sc = nscale ? nscale[n0 + n] : 1.f;
        v4u o; o.x = pk2(s[0 * 33] * sc * ks[0], s[1 * 33] * sc * ks[1]); o.y = pk2(s[2 * 33] * sc * ks[2], s[3 * 33] * sc * ks[3]); o.z = pk2(s[4 * 33] * sc * ks[4], s[5 * 33] * sc * ks[5]); o.w = pk2(s[6 * 33] * sc * ks[6], s[7 * 33] * sc * ks[7]);
        { const int ng = row_off + n0 + n, nr = ng & 127, cc = nr & 31, slot = (((cc >> 2) & 1) << 4) | ((cc >> 3) << 2) | (cc & 3), kk = k0 + 8 * c;
          *(GAS v4u*)((GAS char*)WT + ((size_t)(((ng >> 8) * 2 + ((ng >> 7) & 1)) * (K >> 6) + (kk >> 6)) << 14) + pg8::lds_byte((nr & ~31) + slot, kk & 63)) = o; } }
    LDS_WAIT(); asm volatile("" ::: "memory");
}

struct Ptrs {
    const float *x_in[2], *norm_mix, *pool_w, *pool_scale, *w_qkv, *rpb, *w_o, *norm_mlp, *w_up, *w_down, *norm_final;
    float* out; unsigned char* ws;
};

__device__ __forceinline__ void prologue(const Ptrs& P, LAS unsigned char* lds, int gw, int NGW, int wave, int lane) {
    LAS float* scr = (LAS float*)(lds + wave * 16384);
    bf16* WPOOL = (bf16*)(P.ws + WS_WPOOL); bf16* WQKV = (bf16*)(P.ws + WS_WQKV); bf16* WO = (bf16*)(P.ws + WS_WO); bf16* WUP = (bf16*)(P.ws + WS_WUP); bf16* WDN = (bf16*)(P.ws + WS_WDN);
    constexpr int I_POOL = (256 / 64) * (256 / 32), I_QKV = (D / 64) * (3 * D / 32), I_O = (D / 64) * (D / 32), I_UP = (D / 64) * (FF / 32), I_DN = (FF / 64) * (D / 32);
    constexpr int NITEMS = 8 * I_POOL + 2 * I_QKV + 2 * I_O + 4 * I_UP + 4 * I_DN;
    for (int it = gw; it < NITEMS; it += NGW) {
        int r = it;
        if (r < 8 * I_POOL) { const int mtx = r / I_POOL, j = mtx >> 2, g = mtx & 3; transpose_item(P.pool_w + (size_t)mtx * 65536, 256, 256, WPOOL + (size_t)j * 1024 * 256, g * 256, P.pool_scale + j * 1024 + g * 256, nullptr, scr, r % I_POOL, lane); continue; } r -= 8 * I_POOL;
        if (r < 2 * I_QKV) { const int j = r / I_QKV; transpose_item(P.w_qkv + (size_t)j * D * 3 * D, D, 3 * D, WQKV + (size_t)j * 3 * D * D, 0, nullptr, P.norm_mix + (2 * j + 1) * D, scr, r % I_QKV, lane); continue; } r -= 2 * I_QKV;
        if (r < 2 * I_O) { const int j = r / I_O; transpose_item(P.w_o + (size_t)j * D * D, D, D, WO + (size_t)j * D * D, 0, nullptr, nullptr, scr, r % I_O, lane); continue; } r -= 2 * I_O;
        if (r < 4 * I_UP) { const int j = r / I_UP; transpose_item(P.w_up + (size_t)j * D * FF, D, FF, WUP + (size_t)j * D * FF, 0, nullptr, P.norm_mlp + j * D, scr, r % I_UP, lane); continue; } r -= 4 * I_UP;
        { const int j = r / I_DN; transpose_item(P.w_down + (size_t)j * D * FF, FF, D, WDN + (size_t)j * D * FF, 0, nullptr, nullptr, scr, r % I_DN, lane); }
    }
}

__device__ __forceinline__ void norm_rows_f32_inplace(float* x, const float* gain, int nrows, int gw, int NGW, int lane) {
    f32x4 g[4];
#pragma unroll
    for (int j = 0; j < 4; ++j) g[j] = *((const f32x4*)gain + lane + 64 * j);
    for (int m = gw * 4; m < nrows; m += NGW * 4) {
        GAS f32x4* xr = (GAS f32x4*)(x + (size_t)m * D) + lane;
        f32x4 v[4][4];
#pragma unroll
        for (int r = 0; r < 4; ++r)
#pragma unroll
            for (int j = 0; j < 4; ++j) v[r][j] = xr[r * 256 + 64 * j];
        __builtin_amdgcn_sched_barrier(0);
#pragma unroll
        for (int r = 0; r < 4; ++r) { float s = 0.f;
#pragma unroll
            for (int j = 0; j < 4; ++j) s += (v[r][j].x * v[r][j].x + v[r][j].y * v[r][j].y) + (v[r][j].z * v[r][j].z + v[r][j].w * v[r][j].w);
            const float rr = 1.0f / sqrtf(wave_sum(s) * (1.f / D) + RMS_EPS);
#pragma unroll
            for (int j = 0; j < 4; ++j) xr[r * 256 + 64 * j] = v[r][j] * rr * g[j]; }
    }
}

constexpr int PT = 32, PROWS = 48;
typedef float f32x2v __attribute__((ext_vector_type(2)));
__device__ __forceinline__ f32x2v bfpair(unsigned u) { return (f32x2v){__builtin_bit_cast(float, u << 16), __builtin_bit_cast(float, u & 0xffff0000u)}; }
struct f32x8 { f32x4 lo, hi; };
__device__ __forceinline__ f32x8 bf8(const v4u u) { f32x8 r; r.lo = (f32x4){__builtin_bit_cast(float, u.x << 16), __builtin_bit_cast(float, u.x & 0xffff0000u), __builtin_bit_cast(float, u.y << 16), __builtin_bit_cast(float, u.y & 0xffff0000u)};
    r.hi = (f32x4){__builtin_bit_cast(float, u.z << 16), __builtin_bit_cast(float, u.z & 0xffff0000u), __builtin_bit_cast(float, u.w << 16), __builtin_bit_cast(float, u.w & 0xffff0000u)}; return r; }
__device__ __forceinline__ v4u pack8(const f32x4 a, const f32x4 b) { v4u o; o.x = pk2(a[0], a[1]); o.y = pk2(a[2], a[3]); o.z = pk2(b[0], b[1]); o.w = pk2(b[2], b[3]); return o; }
template <int W> __device__ __forceinline__ void pool_rows_interior(const LAS v4u* hrow, GAS v4u* po) {
    constexpr int HW = W / 2; constexpr float INV = 1.0f / (float)W;
    f32x4 sl = {0.f, 0.f, 0.f, 0.f}, sh = {0.f, 0.f, 0.f, 0.f};
#pragma unroll
    for (int o = -HW; o < HW; ++o) { const f32x8 h = bf8(hrow[(8 + o) * 128]); sl += h.lo; sh += h.hi; }
    __builtin_amdgcn_sched_barrier(0);
#pragma unroll
    for (int i = 0; i < 8; ++i) {
        const f32x8 c = bf8(hrow[(8 + i) * 128]);
        po[(size_t)i * 32] = pack8(sl * INV - c.lo, sh * INV - c.hi);
        if (i + 1 < 8) { const f32x8 a = bf8(hrow[(8 + i + HW) * 128]), b = bf8(hrow[(8 + i - HW) * 128]); sl += a.lo - b.lo; sh += a.hi - b.hi; }
        __builtin_amdgcn_sched_barrier(0);
    }
}
__device__ __forceinline__ void pool_load_rows(f32x4 (&v)[6][4], const float* x, int m0, int seq_len, int wave, int lane) {
    const int sb = m0 / seq_len * seq_len, t0 = m0 - sb;
#pragma unroll
    for (int k = 0; k < 6; ++k) { const int t = min(max(t0 - 8 + wave + NWAVES * k, 0), seq_len - 1);
        const GAS f32x4* xr = (const GAS f32x4*)(x + (size_t)(sb + t) * D) + lane;
#pragma unroll
        for (int j = 0; j < 4; ++j) v[k][j] = xr[64 * j]; }
}
__device__ __forceinline__ void pool_phase(LAS unsigned char* lds, const float* x, const float* gain, bf16* Pg, int seq_len, int vcu, int G, int tid, int wave, int lane) {
    f32x4 v[6][4];
    if (vcu < CH / PT) pool_load_rows(v, x, vcu * PT, seq_len, wave, lane);
    for (int tile = vcu; tile < CH / PT; tile += G) {
        const int m0 = tile * PT;
        const int sb = m0 / seq_len * seq_len;
        const int t0 = m0 - sb;
        f32x4 g[4];
#pragma unroll
        for (int j = 0; j < 4; ++j) g[j] = *((const GAS f32x4*)gain + lane + 64 * j);
#pragma unroll
        for (int k = 0; k < 6; ++k) { float s = 0.f;
#pragma unroll
            for (int j = 0; j < 4; ++j) s += (v[k][j].x * v[k][j].x + v[k][j].y * v[k][j].y) + (v[k][j].z * v[k][j].z + v[k][j].w * v[k][j].w);
            const float r = 1.0f / sqrtf(wave_sum(s) * (1.f / D) + RMS_EPS);
            LAS v2u* hr = (LAS v2u*)(lds + (wave + NWAVES * k) * 2048) + lane;
#pragma unroll
            for (int j = 0; j < 4; ++j) { v2u o; o.x = pk2(v[k][j].x * r * g[j].x, v[k][j].y * r * g[j].y); o.y = pk2(v[k][j].z * r * g[j].z, v[k][j].w * r * g[j].w); hr[64 * j] = o; } }
        __syncthreads();
        if (tile + G < CH / PT) { pool_load_rows(v, x, (tile + G) * PT, seq_len, wave, lane); __builtin_amdgcn_sched_barrier(0); }
        {
            const int pg = wave & 3, part = (lane >> 5) + 2 * (wave >> 2), oc = lane & 31, pw = 2 << pg, phw = pw >> 1;
            const LAS v4u* hrow = (const LAS v4u*)(lds + (8 * part) * 2048 + pg * 512 + oc * 16);
            GAS v4u* po = (GAS v4u*)(Pg + ((size_t)pg * CH + m0 + 8 * part) * 256 + oc * 8);
            if (t0 >= 8 && t0 + PT + 8 <= seq_len) {
                switch (pg) { case 0: pool_rows_interior<2>(hrow, po); break; case 1: pool_rows_interior<4>(hrow, po); break; case 2: pool_rows_interior<8>(hrow, po); break; default: pool_rows_interior<16>(hrow, po); break; }
            } else {
                for (int i = 0; i < 8; ++i) {
                    const int t = t0 + 8 * part + i;
                    const int lo = max(t - phw, 0), hi = min(t + phw - 1, seq_len - 1);
                    f32x4 sl = {0.f, 0.f, 0.f, 0.f}, sh = {0.f, 0.f, 0.f, 0.f};
                    for (int q = lo; q <= hi; ++q) { const f32x8 h = bf8(hrow[(8 + q - t + i) * 128]); sl += h.lo; sh += h.hi; }
                    const f32x8 c = bf8(hrow[(8 + i) * 128]);
                    const float inv = 1.0f / (float)(hi - lo + 1);
                    po[(size_t)i * 32] = pack8(sl * inv - c.lo, sh * inv - c.hi);
                }
            }
        }
        __syncthreads();
    }
}

#define RLX_AGENT __ATOMIC_RELAXED, __HIP_MEMORY_SCOPE_AGENT
#define XB_TMO      128
#define XB_XCNT(j)  (256  + 64 * (j))
#define XB_XSUB(j)  (1280 + 64 * (j))
#define XB_XGEN(j)  (2304 + 64 * (j))
#define XB_TOP      3328
#define XB_TOPGEN   3392
#define XCD_BAR_WORDS 3456
#define XB_SPIN_CAP (1u << 18)

__device__ __forceinline__ unsigned xb_ld(unsigned* p)              { return __hip_atomic_load(p, __ATOMIC_RELAXED, __HIP_MEMORY_SCOPE_AGENT); }
__device__ __forceinline__ unsigned xb_add(unsigned* p, unsigned v) { return __hip_atomic_fetch_add(p, v, __ATOMIC_RELAXED, __HIP_MEMORY_SCOPE_AGENT); }
__device__ __forceinline__ unsigned xb_xcc_id() { return (unsigned)__builtin_amdgcn_s_getreg((3 << 11) | 20) & 0xFu; }
#define XB_SPIN(cond, bar) do { unsigned _sp = 0; while (cond) { __builtin_amdgcn_s_sleep(1); \
    if ((++_sp & 255u) == 0u) { if (xb_ld(&(bar)[XB_TMO])) break; if (_sp > XB_SPIN_CAP) { atomicAdd(&(bar)[XB_TMO], 1u); break; } } } } while (0)

struct XcdBarrier {
    unsigned* bar; unsigned x;
    volatile LAS unsigned* st;
};

__device__ __forceinline__ XcdBarrier xcd_barrier_post(unsigned* bar, volatile LAS unsigned* st) {
    XcdBarrier b; b.bar = bar; b.x = xb_xcc_id(); b.st = st;
    if (threadIdx.x == 0) (void)xb_add(&bar[XB_XCNT(b.x)], 1u);
    return b;
}
__device__ __forceinline__ void xcd_barrier_complete(unsigned* bar, unsigned x, unsigned& nloc, unsigned& nx) {
    const unsigned G = gridDim.x * gridDim.y * gridDim.z;
    unsigned sum, cnt, mine, sp = 0u;
    for (;;) {
        sum = 0u; cnt = 0u; mine = 0u;
#pragma unroll
        for (unsigned j = 0; j < 16; ++j) { const unsigned c = xb_ld(&bar[XB_XCNT(j)]); sum += c; cnt += (c > 0u) ? 1u : 0u; mine = (j == x) ? c : mine; }
        if (sum == G) break;
        __builtin_amdgcn_s_sleep(1);
        if ((++sp & 255u) == 0u) { if (xb_ld(&bar[XB_TMO])) break; if (sp > XB_SPIN_CAP) { atomicAdd(&bar[XB_TMO], 1u); break; } }
    }
    nloc = mine > 0u ? mine : 1u; nx = cnt > 0u ? cnt : 1u;
}

__device__ __forceinline__ void xcd_barrier(const XcdBarrier& b) {
    asm volatile("s_waitcnt vmcnt(0)" ::: "memory");
    __syncthreads();
    if (threadIdx.x == 0) {
        unsigned* bar = b.bar;
        __builtin_amdgcn_s_waitcnt(0);
        unsigned nloc = b.st[0], nx = b.st[1];
        if (nloc == 0u) { xcd_barrier_complete(bar, b.x, nloc, nx); b.st[0] = nloc; b.st[1] = nx; }
        const unsigned old = xb_add(&bar[XB_XSUB(b.x)], 1u);
        const unsigned gen = old / nloc;
        if (old + 1u == (gen + 1u) * nloc) {
            __builtin_amdgcn_fence(__ATOMIC_RELEASE, "agent");
            asm volatile("s_waitcnt vmcnt(0)" ::: "memory");
            const unsigned og = xb_add(&bar[XB_TOP], 1u);
            const unsigned tg = og / nx;
            if (og + 1u == (tg + 1u) * nx) xb_add(&bar[XB_TOPGEN], 1u);
            else XB_SPIN(xb_ld(&bar[XB_TOPGEN]) == tg, bar);
            __builtin_amdgcn_fence(__ATOMIC_ACQUIRE, "agent");
            xb_add(&bar[XB_XGEN(b.x)], 1u);
            asm volatile("s_waitcnt vmcnt(0)" ::: "memory");
        } else {
            XB_SPIN(xb_ld(&bar[XB_XGEN(b.x)]) == gen, bar);
            __builtin_amdgcn_fence(__ATOMIC_ACQUIRE, "agent");
            asm volatile("s_waitcnt vmcnt(0)" ::: "memory");
        }
    }
    __syncthreads();
}


__device__ __forceinline__ unsigned cvtpk(float lo, float hi) { return pk2(lo, hi); }
__device__ __forceinline__ s16x4 vtr(const LAS unsigned char* p) { return __builtin_bit_cast(s16x4, __builtin_amdgcn_ds_read_tr16_b64_v4i16((LAS s16x4*)p)); }
__device__ __forceinline__ void attn_phase(LAS unsigned char* lds, bf16* Qb, const bf16* Kb, const bf16* Vb, const float* rpb_l, int seq_len, int G, int bx, int tid, int wave, int lane) {
    const int fr = lane & 15, fq = lane >> 4;
    const int rows = seq_len >> 6, rows_shift = (seq_len == 2048) ? 5 : 6;
    constexpr int NI = (CH / 64) * 8;
    int nx, xc, lc, per;
    if ((G & 7) == 0) { nx = G >> 3; xc = bx & 7; lc = bx >> 3; per = NI >> 3; } else { nx = G; xc = 0; lc = bx; per = NI; }
    LAS float* bias = (LAS float*)(lds + BIAS_OFF);
    const int qb = wave & 3, hh = wave >> 2;
    const int qc = (qb < 3) ? (8 + 16 * qb + fr) : (fr < 8 ? fr : 48 + fr);
    const int a0 = (qb < 3) ? qb : 0, a1 = (qb < 3) ? qb + 1 : 3;
    const int wst = min(max(qc - 8, 0), 48);
    const int q4 = (lane & 15) >> 2, p4 = lane & 3;
    float madd[2][4];
#pragma unroll
    for (int ai = 0; ai < 2; ++ai)
#pragma unroll
        for (int i = 0; i < 4; ++i) { const int kc = 16 * (ai ? a1 : a0) + 4 * fq + i; madd[ai][i] = ((kc >= wst) && (kc < wst + 16)) ? 0.f : -1.0e30f; }
    int voff[4];
#pragma unroll
    for (int i3 = 0; i3 < 4; ++i3) voff[i3] = (lane >> 4) * D + (((lane & 15) ^ (((lane >> 4) << 2) | i3)) * 8);
    if (lc >= per) return;
    int id = xc * per + lc;
    int r = id & (rows - 1), hp = (id >> rows_shift) & 7, tb = (id >> (rows_shift + 3)) * seq_len, r0 = min(max(r - 4, 0), rows - 8);
    bf16x8 qf0, qf1, kf[4][2][2];
    float bnext[2];
#define ATT_PREFETCH() do { \
        const int h_ = 2 * hp + hh; const size_t qo_ = (size_t)(tb + r * 64 + qc) * D + h_ * 64; \
        qf0 = *(const GAS bf16x8*)(Qb + qo_ + 8 * fq); qf1 = *(const GAS bf16x8*)(Qb + qo_ + 32 + 8 * fq); \
        const bf16* kb_ = Kb + ((size_t)(h_ * 8 + fq) * CH + (tb + r0 * 64 + fr)) * 8; \
        _Pragma("unroll") for (int kr = 0; kr < 4; ++kr) _Pragma("unroll") for (int ai = 0; ai < 2; ++ai) { const bf16* kp = kb_ + (kr * 64 + 16 * (ai ? a1 : a0)) * 8; kf[kr][ai][0] = *(const GAS bf16x8*)kp; kf[kr][ai][1] = *(const GAS bf16x8*)(kp + (size_t)4 * CH * 8); } \
        bnext[0] = rpb_l[hp * 930 + tid] * LOG2E; bnext[1] = (tid + 512 < 930) ? rpb_l[hp * 930 + tid + 512] * LOG2E : 0.f; } while (0)
#define ATT_BIAS_WRITE() do { bias[tid] = bnext[0]; if (tid + 512 < 930) bias[tid + 512] = bnext[1]; } while (0)
    ATT_PREFETCH();
    ATT_BIAS_WRITE();
    for (int loc = lc; loc < per; loc += nx) {
        const int h = 2 * hp + hh;
        const size_t qoff = (size_t)(tb + r * 64 + qc) * D + h * 64;
        const bf16* kbase = Kb + ((size_t)(h * 8 + fq) * CH + (tb + r0 * 64 + fr)) * 8;
        const int drb = r0 - r + 7;
        __syncthreads();
        {
            const int a = wave >> 1, ub = (wave & 1) * 2;
#pragma unroll
            for (int i = 0; i < 16; ++i) { const int kr = 2 * (ub + (i >> 3)) + (i & 1), cb = 16 * a + 4 * ((i & 7) >> 1);
                const bf16* src = Vb + (size_t)(tb + (r0 + kr) * 64 + cb) * D + hp * 128 + voff[i & 3];
                __builtin_amdgcn_global_load_lds((const unsigned*)src, (LAS unsigned*)(lds + (wave * 16 + i) * 1024), 16, 0, 0); }
        }
        f32x4 S[8][2];
        float mx = -3.0e38f;
        const LAS float* bptr[2][4];
#pragma unroll
        for (int ai = 0; ai < 2; ++ai)
#pragma unroll
            for (int i = 0; i < 4; ++i) { const int kc = 16 * (ai ? a1 : a0) + 4 * fq + i; bptr[ai][i] = bias + hh * 465 + drb * 31 + min(max(kc - qc + 15, 0), 30); }
#pragma unroll
        for (int kr = 0; kr < 8; ++kr) {
#pragma unroll
            for (int ai = 0; ai < 2; ++ai) {
                f32x4 z = {0.f, 0.f, 0.f, 0.f};
                z = __builtin_amdgcn_mfma_f32_16x16x32_bf16(kf[kr & 3][ai][0], qf0, z, 0, 0, 0);
                z = __builtin_amdgcn_mfma_f32_16x16x32_bf16(kf[kr & 3][ai][1], qf1, z, 0, 0, 0);
#pragma unroll
                for (int i = 0; i < 4; ++i) { z[i] = (z[i] + bptr[ai][i][kr * 31]) + madd[ai][i]; mx = fmaxf(mx, z[i]); }
                S[kr][ai] = z;
            }
            if (kr < 4) {
#pragma unroll
                for (int ai = 0; ai < 2; ++ai) { const bf16* kp = kbase + ((kr + 4) * 64 + 16 * (ai ? a1 : a0)) * 8; kf[kr & 3][ai][0] = *(const GAS bf16x8*)kp; kf[kr & 3][ai][1] = *(const GAS bf16x8*)(kp + (size_t)4 * CH * 8); }
            }
            __builtin_amdgcn_sched_barrier(0);
        }
        mx = fmaxf(mx, __shfl_xor(mx, 16)); mx = fmaxf(mx, __shfl_xor(mx, 32));
        float sum = 0.f;
#pragma unroll
        for (int kr = 0; kr < 8; ++kr)
#pragma unroll
            for (int ai = 0; ai < 2; ++ai)
#pragma unroll
                for (int i = 0; i < 4; ++i) { const float p = __builtin_amdgcn_exp2f(S[kr][ai][i] - mx); S[kr][ai][i] = p; sum += p; }
        sum += __shfl_xor(sum, 16); sum += __shfl_xor(sum, 32);
        bf16x8 pf[4][2];
#pragma unroll
        for (int u = 0; u < 4; ++u)
#pragma unroll
            for (int ai = 0; ai < 2; ++ai) { v4u pw; pw.x = cvtpk(S[2 * u][ai][0], S[2 * u][ai][1]); pw.y = cvtpk(S[2 * u][ai][2], S[2 * u][ai][3]); pw.z = cvtpk(S[2 * u + 1][ai][0], S[2 * u + 1][ai][1]); pw.w = cvtpk(S[2 * u + 1][ai][2], S[2 * u + 1][ai][3]);
                pf[u][ai] = __builtin_bit_cast(bf16x8, pw); }
        asm volatile("s_waitcnt vmcnt(0)" ::: "memory");
        __syncthreads();
        const int nloc = loc + nx; const bool has_next = nloc < per;
        const int r_cur = r, tb_cur = tb;
        if (has_next) { id = xc * per + nloc; r = id & (rows - 1); hp = (id >> rows_shift) & 7; tb = (id >> (rows_shift + 3)) * seq_len; r0 = min(max(r - 4, 0), rows - 8); ATT_PREFETCH(); }
        (void)r_cur; (void)tb_cur;
        f32x4 O[4];
#pragma unroll
        for (int c = 0; c < 4; ++c) O[c] = (f32x4){0.f, 0.f, 0.f, 0.f};
        const LAS unsigned char* vb[2][2][4];
#pragma unroll
        for (int ai = 0; ai < 2; ++ai)
#pragma unroll
            for (int t = 0; t < 2; ++t)
#pragma unroll
                for (int c = 0; c < 4; ++c) { const int rho = 8 * fq + 4 * t + q4, chn = 2 * (4 * hh + c) + (p4 >> 1);
                    vb[ai][t][c] = lds + (ai ? a1 : a0) * 32768 + 256 * rho + 16 * (chn ^ (((rho & 3) << 2) | ((rho >> 2) & 3))) + 8 * (p4 & 1); }
#pragma unroll
        for (int u = 0; u < 4; ++u) {
#pragma unroll
            for (int ai = 0; ai < 2; ++ai) {
#pragma unroll
                for (int c = 0; c < 4; ++c) {
                    const s16x4 v0 = vtr(vb[ai][0][c] + u * 8192), v1 = vtr(vb[ai][1][c] + u * 8192);
                    const bf16x8 vf = __builtin_shufflevector(v0, v1, 0, 1, 2, 3, 4, 5, 6, 7);
                    O[c] = __builtin_amdgcn_mfma_f32_16x16x32_bf16(vf, pf[u][ai], O[c], 0, 0, 0);
                }
            }
            __builtin_amdgcn_sched_barrier(0);
        }
        const float inv = 1.0f / sum;
#pragma unroll
        for (int c = 0; c < 4; ++c) { v2u w; w.x = cvtpk(O[c][0] * inv, O[c][1] * inv); w.y = cvtpk(O[c][2] * inv, O[c][3] * inv);
            *(GAS v2u*)(Qb + qoff + 16 * c + 4 * fq) = w; }
        if (has_next) ATT_BIAS_WRITE();
    }
    __syncthreads();
#undef ATT_PREFETCH
#undef ATT_BIAS_WRITE
}
enum { K_POOL = 1, K_GEMM_RES = 3, K_GEMM_QKV = 4, K_GEMM_UP = 5, K_ATTN = 6, K_FINAL = 7 };
enum { F_A_X = 1, F_A_IN = 2, F_AUX_X = 4, F_AUX_IN = 8 };
struct Ph { int kind, flags, N, K; const void* A; const void* B; void* C; const void* aux; float* st; float* rs; unsigned long long a_pn_stride, pad; };
constexpr int PPC = 19;
struct Args { Ptrs p; Ph tab[PPC]; };
__global__ void __launch_bounds__(NWAVES * 64, 2) fwd_megakernel(Args args) {
    extern __shared__ __attribute__((aligned(16))) unsigned char lds_raw[];
    cg::grid_group grid = cg::this_grid();
    LAS unsigned char* lds = (LAS unsigned char*)lds_raw;
    volatile LAS unsigned* MISC = (volatile LAS unsigned*)(lds + MISC_OFF);
    for (int u = threadIdx.x; u < 32; u += NWAVES * 64) MISC[u] = 0u;
    __syncthreads();
    const XcdBarrier bar = xcd_barrier_post((unsigned*)(args.p.ws + WS_CTL), MISC + 8);
    {
        const int tid = threadIdx.x, lane = tid & 63, wave = __builtin_amdgcn_readfirstlane(tid >> 6);
        const int G = gridDim.x, bx = blockIdx.x;
        const int vcu = (G % 8 == 0) ? (bx % 8) * (G / 8) + bx / 8 : bx;
        prologue(args.p, lds, vcu * NWAVES + wave, G * NWAVES, wave, lane);
    }
    grid.sync();

    for (int ph = 0; ph < NCHUNK * PPC; ++ph) {
        int tid = threadIdx.x; asm volatile("" : "+v"(tid));
        int G = gridDim.x, bx = blockIdx.x; asm volatile("" : "+s"(G), "+s"(bx));
        const int lane = tid & 63, wave = __builtin_amdgcn_readfirstlane(tid >> 6);
        const int vcu = (G % 8 == 0) ? (bx % 8) * (G / 8) + bx / 8 : bx;
        const int gw = vcu * NWAVES + wave, NGW = G * NWAVES;
        const int ck = ph / PPC, idx = ph - ck * PPC;
        const Ph d = args.tab[idx];
        const int tok0 = ck * CH, grp = tok0 / GROUP_TOK, seq_len = grp ? 4096 : 2048;
        const float* xin = args.p.x_in[grp] + (size_t)(tok0 - grp * GROUP_TOK) * D;
        float* X = args.p.out + (size_t)tok0 * D;
        const void* A = (d.flags & F_A_X) ? (const void*)X : (d.flags & F_A_IN) ? (const void*)xin : d.A;
        const void* aux = (d.flags & F_AUX_X) ? (const void*)X : (d.flags & F_AUX_IN) ? (const void*)xin : d.aux;
#define KIND_IS(x) ([&]() { int kd_ = d.kind; asm volatile("" : "+s"(kd_)); return kd_ == (x); }())
        if (0) {}
        else if (KIND_IS(K_POOL)) { { int tid2 = threadIdx.x; asm volatile("" : "+v"(tid2));
            pool_phase(lds, (const float*)A, (const float*)aux, (bf16*)d.C, seq_len, vcu, G, tid2, __builtin_amdgcn_readfirstlane(tid2 >> 6), tid2 & 63); } }
        else if (KIND_IS(K_GEMM_RES)) { pg8::Gemm g{(const bf16*)A, (const bf16*)d.B, CH, d.N, d.K, (size_t)d.a_pn_stride, d.K == FF  }; pg8::StaticOrder S; S.init(CH, d.N, G, bx);
            pg8::EpiRes E{(const float*)aux, X, (bf16*)d.C, d.st, D, d.rs};
            pg8::gemm_phase<pg8::EpiRes, pg8::StaticOrder, false, PG8_SP2>(lds, g, S, E, tid); }
        else if (KIND_IS(K_GEMM_QKV)) { pg8::Gemm g{(const bf16*)A, (const bf16*)d.B, CH, d.N, d.K, 0, 1  }; pg8::StaticOrder S; S.init(CH, d.N, G, bx);
            pg8::EpiBf16<0, true> E{(bf16*)d.C, D, D, (size_t)CH * D, 0.125f * LOG2E, d.st, 0};
            pg8::gemm_phase<pg8::EpiBf16<0, true>, pg8::StaticOrder, PG8_ALIGN, PG8_SP2>(lds, g, S, E, tid); }
        else if (KIND_IS(K_GEMM_UP)) { pg8::Gemm g{(const bf16*)A, (const bf16*)d.B, CH, d.N, d.K, 0, 1  }; pg8::StaticOrder S; S.init(CH, d.N, G, bx);
            pg8::EpiBf16<2, false> E{(bf16*)d.C, FF, 0, 0, 1.f, nullptr, 1};
            pg8::gemm_phase<pg8::EpiBf16<2, false>, pg8::StaticOrder, PG8_ALIGN, PG8_SP2>(lds, g, S, E, tid); }
        else if (KIND_IS(K_ATTN)) { attn_phase(lds, (bf16*)d.C, (const bf16*)d.C + (size_t)CH * D, (const bf16*)d.C + 2 * (size_t)CH * D, (const float*)aux, seq_len, G, bx, tid, wave, lane); }
        else { norm_rows_f32_inplace(X, (const float*)aux, CH, gw, NGW, lane); }
#undef KIND_IS
        if (d.kind != K_FINAL) xcd_barrier(bar);
    }
}

extern "C" void kernel_launch(void* const* d_in, const int* in_sizes, int n_in, void* d_out, int out_size, void* d_ws, size_t ws_size, hipStream_t stream) {
    static int grid = 0;
    if (grid == 0) {
        if (n_in != 12 || in_sizes[0] != GROUP_TOK * D || in_sizes[1] != GROUP_TOK * D || out_size != NTOK * D || ws_size < WS_END) {
            fprintf(stderr, "kernel_launch: unexpected shapes (n_in %d, out %d, ws %zu < %zu); nothing launched\n", n_in, out_size, ws_size, (size_t)WS_END); grid = -1; return; }
        int dev = 0, cus = 0, per_cu = 0;
        if (hipGetDevice(&dev) != hipSuccess || hipDeviceGetAttribute(&cus, hipDeviceAttributeMultiprocessorCount, dev) != hipSuccess) { fprintf(stderr, "kernel_launch: device query failed\n"); grid = -1; return; }
        if (hipFuncSetAttribute((const void*)fwd_megakernel, hipFuncAttributeMaxDynamicSharedMemorySize, LDS_BYTES) != hipSuccess) { fprintf(stderr, "kernel_launch: hipFuncSetAttribute failed\n"); grid = -1; return; }
        if (hipOccupancyMaxActiveBlocksPerMultiprocessor(&per_cu, (const void*)fwd_megakernel, NWAVES * 64, LDS_BYTES) != hipSuccess || per_cu < 1) { fprintf(stderr, "kernel_launch: occupancy query gave %d\n", per_cu); per_cu = 1; }
        (void)hipGetLastError();
        grid = cus * per_cu;
    }
    if (grid < 0) return;
    if (hipMemsetAsync((char*)d_ws + WS_CTL, 0, CTL_ZERO_BYTES, stream) != hipSuccess) { fprintf(stderr, "kernel_launch: hipMemsetAsync failed\n"); return; }
    Args a{};
    Ptrs& p = a.p;
    p.x_in[0] = (const float*)d_in[0]; p.x_in[1] = (const float*)d_in[1]; p.norm_mix = (const float*)d_in[2]; p.pool_w = (const float*)d_in[3]; p.pool_scale = (const float*)d_in[4];
    p.w_qkv = (const float*)d_in[5]; p.rpb = (const float*)d_in[6]; p.w_o = (const float*)d_in[7]; p.norm_mlp = (const float*)d_in[8]; p.w_up = (const float*)d_in[9];
    p.w_down = (const float*)d_in[10]; p.norm_final = (const float*)d_in[11]; p.out = (float*)d_out; p.ws = (unsigned char*)d_ws;
    unsigned char* ws = (unsigned char*)d_ws;
    bf16* WPOOL = (bf16*)(ws + WS_WPOOL); bf16* WQKV = (bf16*)(ws + WS_WQKV); bf16* WO = (bf16*)(ws + WS_WO); bf16* WUP = (bf16*)(ws + WS_WUP); bf16* WDN = (bf16*)(ws + WS_WDN);
    bf16* XN = (bf16*)(ws + WS_XN); bf16* PG = (bf16*)(ws + WS_PG); bf16* QB = (bf16*)(ws + WS_ACT); bf16* HB = (bf16*)(ws + WS_ACT);
    float* SA = (float*)(ws + WS_STAT); float* SB = SA + (size_t)CH * 16;
    int n = 0;
    auto add = [&](int kind, int flags, int N, int K, const void* A, const void* B, void* C, const void* aux, float* st, float* rs, unsigned long long aps) {
        Ph& d = a.tab[n++]; d.kind = kind; d.flags = flags; d.N = N; d.K = K; d.A = A; d.B = B; d.C = C; d.aux = aux; d.st = st; d.rs = rs; d.a_pn_stride = aps; d.pad = 0; };
    for (int layer = 0; layer < DEPTH; ++layer) {
        const int j = layer >> 1;
        if ((layer & 1) == 0) {
            add(K_POOL, layer == 0 ? F_A_IN : F_A_X, 0, 0, nullptr, nullptr, PG, p.norm_mix + layer * D, nullptr, nullptr, 0);
            add(K_GEMM_RES, layer == 0 ? F_AUX_IN : F_AUX_X, D, 256, PG, WPOOL + (size_t)j * 1024 * 256, XN, nullptr, SA, nullptr, (unsigned long long)CH * 256 * 2);
        } else {
            add(K_GEMM_QKV, 0, 3 * D, D, XN, WQKV + (size_t)j * 3 * D * D, QB, nullptr, SB, nullptr, 0);
            add(K_ATTN, 0, 0, 0, nullptr, nullptr, QB, p.rpb + (size_t)j * NH * 15 * 31, nullptr, nullptr, 0);
            add(K_GEMM_RES, F_AUX_X, D, D, QB, WO + (size_t)j * D * D, XN, nullptr, SA, nullptr, 0);
        }
        add(K_GEMM_UP, 0, FF, D, XN, WUP + (size_t)layer * D * FF, HB, nullptr, SA, nullptr, 0);
        add(K_GEMM_RES, F_AUX_X, D, FF, HB, WDN + (size_t)layer * D * FF, (layer & 1) == 0 ? XN : nullptr, nullptr, SB, SA, 0);
    }
    add(K_FINAL, 0, 0, 0, nullptr, nullptr, nullptr, p.norm_final, nullptr, nullptr, 0);
    if (n != PPC) { fprintf(stderr, "kernel_launch: phase table has %d entries, expected %d\n", n, PPC); return; }
    void* kargs[] = {&a};
    hipError_t e = hipLaunchCooperativeKernel((const void*)fwd_megakernel, dim3(grid), dim3(NWAVES * 64), kargs, LDS_BYTES, stream);
    if (e != hipSuccess) fprintf(stderr, "kernel_launch: cooperative launch failed: %s (grid %d)\n", hipGetErrorString(e), grid);
}
```

```cpp
#include <hip/hip_runtime.h>
#include <hip/hip_cooperative_groups.h>
#include <cstdio>
#include <cstdint>
namespace cg = cooperative_groups;
namespace pg8 {
#define PG8_LAS __attribute__((address_space(3)))
typedef unsigned short bf16_t;
typedef short bf16x8 __attribute__((ext_vector_type(8)));
typedef float f32x4 __attribute__((ext_vector_type(4)));
typedef unsigned u32x4 __attribute__((ext_vector_type(4)));
constexpr int BM = 256, BK = 64, HALF = 128, HTB = HALF * BK * 2  , STAGE_BYTES = 8 * HTB, NXCD = 8, WGM = 8;

__host__ __device__ __forceinline__ int lds_byte(int r, int c) { const int st = (r >> 4) * 2 + (c >> 5), rr = r & 15, cc = c & 31, ob = rr * 64 + cc * 2; return st * 1024 + (ob ^ (((ob >> 9) & 1) << 5)); }
__host__ __device__ __forceinline__ void stage_rc(int b, int& R, int& C) { const int st = b / 1024, sb = b % 1024, swz = sb ^ (((sb >> 9) & 1) << 5); R = (st >> 1) * 16 + swz / 64; C = (st & 1) * 32 + (swz % 64) / 2; }
__host__ __device__ __forceinline__ int perm32(int rho) { const int n = rho >> 4, i = rho & 15; return 8 * (i >> 2) + 4 * n + (i & 3); }

struct Unit { int pm, pn; };
struct Gemm { const bf16_t* A; const bf16_t* Bt; int M, N, K; size_t a_pn_stride; int a_tiled; };

struct StaticOrder {
    int nM, nN, nwg, G, c;
    __host__ __device__ void init(int M, int N, int G_, int c_) { nM = M / BM; nN = N / BM; nwg = nM * nN; G = G_; c = c_; }
    __host__ __device__ bool next(int i, Unit& u) const {
        const long L = (long)i * G + c; if (L >= nwg) return false;
        int wgid = (int)L; { const int q = nwg / NXCD, r = nwg % NXCD, xcd = wgid % NXCD, off = wgid / NXCD; wgid = (xcd < r ? xcd * (q + 1) : r * (q + 1) + (xcd - r) * q) + off; }
        const int nig = WGM * nN, gid = wgid / nig, fm = gid * WGM, gsz = (nM - fm) < WGM ? (nM - fm) : WGM;
        u.pm = fm + ((wgid % nig) % gsz); u.pn = (wgid % nig) / gsz; return true;
    }
    __device__ __forceinline__ void a_ready(const Unit&) const {}
    __device__ __forceinline__ void done(const Unit&) const {}
};

__device__ __forceinline__ unsigned cvt_pk_bf16(float lo, float hi) { unsigned r; asm volatile("v_cvt_pk_bf16_f32 %0, %1, %2" : "=v"(r) : "v"(lo), "v"(hi)); return r; }
typedef float f32x2 __attribute__((ext_vector_type(2)));
template <int ACT, bool RS> struct EpiBf16 {
    static constexpr bool PERM = true, AFTER_DRAIN = false;
    bf16_t* O; int ldc; int split_cols; size_t split_stride; float scale0; const float* st; int tiled;
    __device__ __forceinline__ void operator()(const f32x4 (&acc)[2][2][4][2], const Unit& u, int wr, int wc, int fr, int fq) const {
        const int row0 = u.pm * BM + wr * 64 + fr; int colt = u.pn * BM; bf16_t* base = O;
        float sc = 1.f; bool kplane = false;
        if (split_cols) { const int t = colt / split_cols; base += (size_t)t * split_stride; colt -= t * split_cols; if (t == 0) sc = scale0; kplane = (t == 1); }
        const size_t kprows = split_stride / 1024;
        const int col0 = colt + wc * 32 + 8 * fq;
        f32x4 pv[2][4];
        if (RS) {
#pragma unroll
            for (int ai = 0; ai < 2; ++ai)
#pragma unroll
                for (int m = 0; m < 4; ++m) pv[ai][m] = *(const f32x4*)(st + (size_t)(row0 + ai * HALF + m * 16) * 16 + 4 * fq);
            __builtin_amdgcn_sched_barrier(0);
        }
#pragma unroll
        for (int ai = 0; ai < 2; ++ai)
#pragma unroll
            for (int m = 0; m < 4; ++m) { const int row = row0 + ai * HALF + m * 16; bf16_t* rowp = base + (size_t)row * ldc + col0;
                float f = sc;
                if (RS) { float ss = (pv[ai][m][0] + pv[ai][m][1]) + (pv[ai][m][2] + pv[ai][m][3]); ss += __shfl_xor(ss, 16); ss += __shfl_xor(ss, 32);
                    const float r = __builtin_amdgcn_rsqf(ss * (1.0f / 1024.0f) + 1e-6f); f *= (ACT == 2) ? r * r : r; }
#pragma unroll
                for (int bj = 0; bj < 2; ++bj) { f32x4 v0 = acc[ai][bj][m][0], v1 = acc[ai][bj][m][1];
                    if (ACT == 2) {
#pragma unroll
                        for (int e = 0; e < 4; ++e) { const float a = fmaxf(v0[e], 0.f), b = fmaxf(v1[e], 0.f); v0[e] = a * a; v1[e] = b * b; } }
                    v0 = v0 * f; v1 = v1 * f; u32x4 w; w.x = cvt_pk_bf16(v0[0], v0[1]); w.y = cvt_pk_bf16(v0[2], v0[3]); w.z = cvt_pk_bf16(v1[0], v1[1]); w.w = cvt_pk_bf16(v1[2], v1[3]);
                    if (kplane) *(u32x4*)(base + ((size_t)(((colt >> 6) + 2 * bj + (wc >> 1)) * 8 + (wc & 1) * 4 + fq) * kprows + row) * 8) = w;
                    else if (tiled) { const int r_ = row & 255, c_ = col0 + bj * HALF;
                        *(u32x4*)((char*)base + ((size_t)(((row >> 8) * 2 + (r_ >> 7)) * (ldc >> 6) + (c_ >> 6)) << 14) + lds_byte(r_ & 127, c_ & 63)) = w; }
                    else *(u32x4*)(rowp + bj * HALF) = w; } }
    }
};
struct EpiRes {
    static constexpr bool PERM = true, AFTER_DRAIN = false;
    const float* base; float* out; bf16_t* xn; float* st; int ldc; const float* rs;
    __device__ __forceinline__ void operator()(const f32x4 (&acc)[2][2][4][2], const Unit& u, int wr, int wc, int fr, int fq) const {
        const int col0 = u.pn * BM + wc * 32 + 8 * fq;
#pragma unroll
        for (int ai = 0; ai < 2; ++ai) {
            f32x4 rp[4];
            if (rs) {
#pragma unroll
                for (int m = 0; m < 4; ++m) rp[m] = *(const f32x4*)(rs + (size_t)(u.pm * BM + ai * HALF + wr * 64 + m * 16 + fr) * 16 + 4 * fq);
            }
            f32x4 bs[4][2][2];
#pragma unroll
            for (int m = 0; m < 4; ++m) { const size_t off = (size_t)(u.pm * BM + ai * HALF + wr * 64 + m * 16 + fr) * ldc + col0;
#pragma unroll
                for (int bj = 0; bj < 2; ++bj) { bs[m][bj][0] = *(const f32x4*)(base + off + bj * HALF); bs[m][bj][1] = *(const f32x4*)(base + off + bj * HALF + 4); } }
            __builtin_amdgcn_sched_barrier(0);
#pragma unroll
            for (int m = 0; m < 4; ++m) { const int row = u.pm * BM + ai * HALF + wr * 64 + m * 16 + fr; const size_t off = (size_t)row * ldc + col0; float ss = 0.f;
                float f = 1.f;
                if (rs) { float q = (rp[m][0] + rp[m][1]) + (rp[m][2] + rp[m][3]); q += __shfl_xor(q, 16); q += __shfl_xor(q, 32); const float r = __builtin_amdgcn_rsqf(q * (1.0f / 1024.0f) + 1e-6f); f = r * r; }
#pragma unroll
                for (int bj = 0; bj < 2; ++bj) {
                    const f32x4 o0 = bs[m][bj][0] + acc[ai][bj][m][0] * f, o1 = bs[m][bj][1] + acc[ai][bj][m][1] * f;
                    *(f32x4*)(out + off + bj * HALF) = o0; *(f32x4*)(out + off + bj * HALF + 4) = o1;
                    if (xn) { u32x4 w; w.x = cvt_pk_bf16(o0[0], o0[1]); w.y = cvt_pk_bf16(o0[2], o0[3]); w.z = cvt_pk_bf16(o1[0], o1[1]); w.w = cvt_pk_bf16(o1[2], o1[3]);
                        { const int c_ = col0 + bj * HALF;
                          *(u32x4*)((char*)xn + ((size_t)((u.pm * 2 + ai) * (ldc >> 6) + (c_ >> 6)) << 14) + lds_byte(wr * 64 + m * 16 + fr, c_ & 63)) = w; }
                        ss += (o0[0] * o0[0] + o0[1] * o0[1]) + (o0[2] * o0[2] + o0[3] * o0[3]) + (o1[0] * o1[0] + o1[1] * o1[1]) + (o1[2] * o1[2] + o1[3] * o1[3]); } }
                if (xn) { ss += __shfl_xor(ss, 16); ss += __shfl_xor(ss, 32); if (fq == 0) st[(size_t)row * 16 + u.pn * 4 + wc] = ss; } }
            __builtin_amdgcn_sched_barrier(0);
        }
    }
};
template <class Epi, class Sched, bool ALIGN_EPI = false, bool SP2 = false>
__device__ __forceinline__ void gemm_phase(PG8_LAS unsigned char* lds, const Gemm g, const Sched& S, const Epi& E, const int tid_in) {
    const int tid = tid_in, wid = __builtin_amdgcn_readfirstlane(tid >> 6), lane = tid & 63, wr = wid >> 2, wc = wid & 3, fr = lane & 15, fq = lane >> 4;
    const int K = g.K, nt = K / BK;
    unsigned voffA[2], voffB[2];
#pragma unroll
    for (int i = 0; i < 2; ++i) { int R, C; stage_rc(tid * 16 + i * 8192, R, C); const int Rb = Epi::PERM ? ((R & ~31) + perm32(R & 31)) : R;
        voffA[i] = g.a_tiled ? (unsigned)(tid * 16 + i * 8192) : (unsigned)(R * K + C) * 2u; voffB[i] = (unsigned)(tid * 16 + i * 8192); (void)Rb; }
    const size_t kstep = (size_t)(BK * 2);
    const size_t hstep = (size_t)HALF * K * 2;
    const size_t tstep = 2 * hstep;
    const size_t kstepB = 16384, hstepB = (size_t)nt * 16384, tstepB = 2 * hstepB;
    const size_t kstepA = g.a_tiled ? (size_t)16384 : kstep, hstepA = g.a_tiled ? (size_t)nt * 16384 : hstep, tstepA = 2 * hstepA;
    const unsigned ldsw = (unsigned)wid * 1024u;
    const int aoff = lds_byte(wr * 64 + fr, fq * 8), boff = lds_byte(wc * 32 + fr, fq * 8);
#define PG8_SA(b, h) (((b) * 2 + (h)) * HTB)
#define PG8_SB(b, h) ((4 + (b) * 2 + (h)) * HTB)
#define PG8_STAGE(bufoff, gbase, voff) do { _Pragma("unroll") for (int _i = 0; _i < 2; ++_i) \
        __builtin_amdgcn_global_load_lds((const unsigned*)((const char*)(gbase) + (voff)[_i]), (PG8_LAS unsigned*)(lds + (bufoff) + ldsw + _i * 8192), 16, 0, 0); } while (0)
#define PG8_LDA(dst, b, h) do { _Pragma("unroll") for (int m = 0; m < 4; ++m) _Pragma("unroll") for (int k = 0; k < 2; ++k) dst[m][k] = *(const PG8_LAS bf16x8*)(lds + PG8_SA(b, h) + aoff + m * 2048 + k * 1024); } while (0)
#define PG8_LDB(dst, b, h) do { _Pragma("unroll") for (int n = 0; n < 2; ++n) _Pragma("unroll") for (int k = 0; k < 2; ++k) dst[n][k] = *(const PG8_LAS bf16x8*)(lds + PG8_SB(b, h) + boff + n * 2048 + k * 1024); } while (0)
#define PG8_MMA(ai, bj, At, Bt) do { __builtin_amdgcn_s_setprio(1); _Pragma("unroll") for (int m = 0; m < 4; ++m) _Pragma("unroll") for (int n = 0; n < 2; ++n) _Pragma("unroll") for (int k = 0; k < 2; ++k) \
        acc[ai][bj][m][n] = __builtin_amdgcn_mfma_f32_16x16x32_bf16(Bt[n][k], At[m][k], acc[ai][bj][m][n], 0, 0, 0); __builtin_amdgcn_s_setprio(0); } while (0)
#define PG8_WAIT_V(n) asm volatile("s_waitcnt vmcnt(" #n ")" ::: "memory")
#define PG8_WAIT_L(n) asm volatile("s_waitcnt lgkmcnt(" #n ")" ::: "memory")
#define PG8_BAR __builtin_amdgcn_s_barrier()
#define PG8_SCHED __builtin_amdgcn_sched_barrier(0)
    Unit cur, nxt; int ui = 0;
    if (!S.next(0, cur)) return;
    f32x4 acc[2][2][4][2];
#pragma unroll
    for (int a = 0; a < 2; ++a)
#pragma unroll
        for (int b = 0; b < 2; ++b)
#pragma unroll
            for (int m = 0; m < 4; ++m)
#pragma unroll
                for (int n = 0; n < 2; ++n) acc[a][b][m][n] = (f32x4){0.f, 0.f, 0.f, 0.f};
    bf16x8 At[4][2], B0[2][2], B1[2][2];
    const char* cA = (const char*)g.A + (size_t)cur.pm * tstepA + (size_t)cur.pn * g.a_pn_stride; const char* cB = (const char*)g.Bt + (size_t)cur.pn * tstepB;
    S.a_ready(cur);
    if constexpr (SP2) {
        PG8_STAGE(PG8_SB(0, 0), cB, voffB); PG8_STAGE(PG8_SB(0, 1), cB + hstepB, voffB); PG8_STAGE(PG8_SA(0, 0), cA, voffA); PG8_STAGE(PG8_SA(0, 1), cA + hstepA, voffA);
        if (wr == 1) PG8_BAR;
        PG8_WAIT_V(2); PG8_BAR;
        PG8_STAGE(PG8_SB(1, 0), cB + kstepB, voffB); PG8_STAGE(PG8_SA(1, 0), cA + kstepA, voffA); PG8_STAGE(PG8_SB(1, 1), cB + hstepB + kstepB, voffB);
        PG8_WAIT_V(6); PG8_BAR;
    } else {
        PG8_STAGE(PG8_SB(0, 0), cB, voffB); PG8_STAGE(PG8_SA(0, 0), cA, voffA); PG8_STAGE(PG8_SB(0, 1), cB + hstepB, voffB); PG8_STAGE(PG8_SA(0, 1), cA + hstepA, voffA);
        if (wr == 1) PG8_BAR;
        PG8_WAIT_V(4); PG8_BAR;
        PG8_STAGE(PG8_SB(1, 0), cB + kstepB, voffB); PG8_STAGE(PG8_SA(1, 0), cA + kstepA, voffA); PG8_STAGE(PG8_SB(1, 1), cB + hstepB + kstepB, voffB);
        PG8_WAIT_V(6); PG8_BAR;
    }
    for (;;) {
        const bool has_next = S.next(ui + 1, nxt);
        const char* nA = has_next ? (const char*)g.A + (size_t)nxt.pm * tstepA + (size_t)nxt.pn * g.a_pn_stride : cA; const char* nB = has_next ? (const char*)g.Bt + (size_t)nxt.pn * tstepB : cB;
        for (int t = 0; t < nt; t += 2) {
            const bool last = (t == nt - 2);
            const char* a1 = cA + (size_t)(t + 1) * kstepA;
            const char* a2 = last ? nA : cA + (size_t)(t + 2) * kstepA; const char* b2 = last ? nB : cB + (size_t)(t + 2) * kstepB;
            const char* a3 = a2 + kstepA; const char* b3 = b2 + kstepB;
            if (last && has_next) S.a_ready(nxt);
            if constexpr (SP2) {
            PG8_LDB(B0, 0, 0); PG8_LDB(B1, 0, 1); PG8_SCHED; PG8_LDA(At, 0, 0); PG8_STAGE(PG8_SA(1, 1), a1 + hstepA, voffA);
            PG8_WAIT_V(8); PG8_WAIT_L(0); PG8_BAR; PG8_MMA(0, 0, At, B0); PG8_MMA(0, 1, At, B1); PG8_BAR; PG8_SCHED;
            PG8_LDA(At, 0, 1); PG8_STAGE(PG8_SB(0, 0), b2, voffB); PG8_STAGE(PG8_SB(0, 1), b2 + hstepB, voffB); PG8_STAGE(PG8_SA(0, 0), a2, voffA);
            PG8_WAIT_V(8); PG8_WAIT_L(0); PG8_BAR; PG8_MMA(1, 0, At, B0); PG8_MMA(1, 1, At, B1); PG8_BAR; PG8_SCHED;
            PG8_LDB(B0, 1, 0); PG8_LDB(B1, 1, 1); PG8_SCHED; PG8_LDA(At, 1, 0); PG8_STAGE(PG8_SA(0, 1), a2 + hstepA, voffA);
            PG8_WAIT_V(8); PG8_WAIT_L(0); PG8_BAR; PG8_MMA(0, 0, At, B0); PG8_MMA(0, 1, At, B1); PG8_BAR; PG8_SCHED;
            PG8_LDA(At, 1, 1); PG8_STAGE(PG8_SB(1, 0), b3, voffB); PG8_STAGE(PG8_SB(1, 1), b3 + hstepB, voffB); PG8_STAGE(PG8_SA(1, 0), a3, voffA);
            PG8_WAIT_V(8); PG8_WAIT_L(0); PG8_BAR; PG8_MMA(1, 0, At, B0); PG8_MMA(1, 1, At, B1); PG8_BAR; PG8_SCHED;
            } else {
            PG8_LDB(B0, 0, 0); PG8_SCHED; PG8_LDA(At, 0, 0); PG8_STAGE(PG8_SA(1, 1), a1 + hstepA, voffA);
            PG8_WAIT_L(8); PG8_BAR; PG8_WAIT_L(0); PG8_MMA(0, 0, At, B0); PG8_BAR; PG8_SCHED;
            PG8_LDB(B1, 0, 1); PG8_STAGE(PG8_SB(0, 0), b2, voffB);
            PG8_BAR; PG8_WAIT_L(0); PG8_MMA(0, 1, At, B1); PG8_BAR;
            PG8_LDA(At, 0, 1); PG8_STAGE(PG8_SA(0, 0), a2, voffA);
            PG8_BAR; PG8_WAIT_L(0); PG8_MMA(1, 0, At, B0); PG8_BAR; PG8_SCHED;
            PG8_STAGE(PG8_SB(0, 1), b2 + hstepB, voffB);
            PG8_WAIT_V(6); PG8_BAR; PG8_MMA(1, 1, At, B1); PG8_BAR;
            PG8_LDB(B0, 1, 0); PG8_SCHED; PG8_LDA(At, 1, 0); PG8_STAGE(PG8_SA(0, 1), a2 + hstepA, voffA);
            PG8_WAIT_L(8); PG8_BAR; PG8_WAIT_L(0); PG8_MMA(0, 0, At, B0); PG8_BAR; PG8_SCHED;
            PG8_LDB(B1, 1, 1); PG8_STAGE(PG8_SB(1, 0), b3, voffB);
            PG8_BAR; PG8_WAIT_L(0); PG8_MMA(0, 1, At, B1); PG8_BAR;
            PG8_LDA(At, 1, 1); PG8_STAGE(PG8_SA(1, 0), a3, voffA);
            PG8_BAR; PG8_WAIT_L(0); PG8_MMA(1, 0, At, B0); PG8_BAR; PG8_SCHED;
            PG8_STAGE(PG8_SB(1, 1), b3 + hstepB, voffB);
            PG8_WAIT_V(6); PG8_BAR; PG8_MMA(1, 1, At, B1); PG8_BAR;
            }
        }
        if constexpr (ALIGN_EPI) { if (wr == 0) PG8_BAR; }
        if constexpr (!Epi::AFTER_DRAIN) { E(acc, cur, wr, wc, fr, fq); S.done(cur); }
        if (!has_next) break;
#pragma unroll
        for (int a = 0; a < 2; ++a)
#pragma unroll
            for (int b = 0; b < 2; ++b)
#pragma unroll
                for (int m = 0; m < 4; ++m)
#pragma unroll
                    for (int n = 0; n < 2; ++n) acc[a][b][m][n] = (f32x4){0.f, 0.f, 0.f, 0.f};
        cur = nxt; cA = nA; cB = nB; ++ui;
        if constexpr (ALIGN_EPI) { if (wr == 1) PG8_BAR; }
    }
    PG8_WAIT_V(0);
    if constexpr (!ALIGN_EPI) { if (wr == 0) PG8_BAR; }
    PG8_BAR;
    if constexpr (Epi::AFTER_DRAIN) { E.fused(acc, cur, wr, wc, fr, fq, lds, wid, lane); S.done(cur); }
#undef PG8_SA
#undef PG8_SB
#undef PG8_STAGE
#undef PG8_LDA
#undef PG8_LDB
#undef PG8_MMA
#undef PG8_WAIT_V
#undef PG8_WAIT_L
#undef PG8_BAR
#undef PG8_SCHED
}
}
#ifndef PG8_SP2
#define PG8_SP2 true
#endif
#ifndef PG8_ALIGN
#define PG8_ALIGN true
#endif

constexpr int NWAVES = 8;
constexpr int D = 1024, FF = 4096, NH = 16, HD = 64, DEPTH = 4;
constexpr int NTOK = 131072;
constexpr int GROUP_TOK = 65536;
#ifndef MK_CH
#define MK_CH 65536
#endif
constexpr int CH = MK_CH;
constexpr int NCHUNK = NTOK / CH;
constexpr float RMS_EPS = 1e-6f;
constexpr float LOG2E = 1.4426950408889634f;
static_assert(GROUP_TOK % CH == 0 && CH % 4096 == 0, "chunking");

constexpr size_t MiB = 1u << 20;
constexpr size_t WS_WPOOL = 2 * MiB;
constexpr size_t WS_WQKV = 4 * MiB;
constexpr size_t WS_WO = 16 * MiB;
constexpr size_t WS_WUP = 20 * MiB;
constexpr size_t WS_WDN = 52 * MiB;
constexpr size_t WS_XN = 96 * MiB;
constexpr size_t WS_PG = WS_XN + (size_t)CH * D * 2;
constexpr size_t WS_ACT = WS_PG + (size_t)CH * D * 2;
constexpr size_t WS_CTL = 0, CTL_ZERO_BYTES = 65536;
constexpr size_t WS_STAT = 86 * MiB;
static_assert(WS_STAT + 2 * (size_t)CH * 64 <= WS_XN, "stat arrays");
constexpr size_t WS_END = WS_ACT + (size_t)CH * FF * 2;
static_assert(WS_XN >= WS_WDN + 32 * MiB && WS_END <= 1024 * MiB, "d_ws map");

constexpr int RING_BYTES = 131072;
constexpr int BIAS_OFF = RING_BYTES;
constexpr int MISC_OFF = RING_BYTES + 4096;
constexpr int LDS_BYTES = 147456;

#define GAS __attribute__((address_space(1)))
#define LAS __attribute__((address_space(3)))
typedef unsigned short bf16;
typedef unsigned v4u __attribute__((ext_vector_type(4)));
typedef unsigned v2u __attribute__((ext_vector_type(2)));
typedef float f32x4 __attribute__((ext_vector_type(4)));
typedef short bf16x8 __attribute__((ext_vector_type(8)));
typedef short s16x4 __attribute__((ext_vector_type(4)));
#define LDS_WAIT() asm volatile("s_waitcnt lgkmcnt(0)" ::: "memory")
typedef float f32x2_t __attribute__((ext_vector_type(2))); typedef __bf16 bf16x2_t __attribute__((ext_vector_type(2)));
__device__ __forceinline__ unsigned pk2(float lo, float hi) { f32x2_t v = {lo, hi}; bf16x2_t b = __builtin_convertvector(v, bf16x2_t); return __builtin_bit_cast(unsigned, b); }
__device__ __forceinline__ float wave_sum(float v) {
#pragma unroll
    for (int o = 1; o < 64; o <<= 1) v += __shfl_xor(v, o);
    return v;
}

__device__ __forceinline__ void transpose_item(const float* W, int K, int N, bf16* WT, int row_off, const float* nscale, const float* kscale, LAS float* scr, int item, int lane) {
    const int nblk = N / 32, kb = item / nblk, nb = item % nblk, k0 = 64 * kb, n0 = 32 * nb;
    float wv[32];
#pragma unroll
    for (int i = 0; i < 32; ++i) wv[i] = W[(size_t)(k0 + 2 * i + (lane >> 5)) * N + n0 + (lane & 31)];
#pragma unroll
    for (int i = 0; i < 32; ++i) scr[(2 * i + (lane >> 5)) * 33 + (lane & 31)] = wv[i];
    LDS_WAIT(); asm volatile("" ::: "memory");
    const int c = lane & 7;
    float ks[8];
#pragma unroll
    for (int e = 0; e < 8; ++e) ks[e] = kscale ? kscale[k0 + 8 * c + e] : 1.f;
#pragma unroll
    for (int j = 0; j < 4; ++j) { const int n = (lane >> 3) + 8 * j; const LAS float* s = scr + (8 * c) * 33 + n;
        const float sc = nscale ? nscale[n0 + n] : 1.f;
        v4u o; o.x = pk2(s[0 * 33] * sc * ks[0], s[1 * 33] * sc * ks[1]); o.y = pk2(s[2 * 33] * sc * ks[2], s[3 * 33] * sc * ks[3]); o.z = pk2(s[4 * 33] * sc * ks[4], s[5 * 33] * sc * ks[5]); o.w = pk2(s[6 * 33] * sc * ks[6], s[7 * 33] * sc * ks[7]);
        { const int ng = row_off + n0 + n, nr = ng & 127, cc = nr & 31, slot = (((cc >> 2) & 1) << 4) | ((cc >> 3) << 2) | (cc & 3), kk = k0 + 8 * c;
          *(GAS v4u*)((GAS char*)WT + ((size_t)(((ng >> 8) * 2 + ((ng >> 7) & 1)) * (K >> 6) + (kk >> 6)) << 14) + pg8::lds_byte((nr & ~31) + slot, kk & 63)) = o; } }
    LDS_WAIT(); asm volatile("" ::: "memory");
}

struct Ptrs {
    const float *x_in[2], *norm_mix, *pool_w, *pool_scale, *w_qkv, *rpb, *w_o, *norm_mlp, *w_up, *w_down, *norm_final;
    float* out; unsigned char* ws;
};

__device__ __forceinline__ void prologue(const Ptrs& P, LAS unsigned char* lds, int gw, int NGW, int wave, int lane) {
    LAS float* scr = (LAS float*)(lds + wave * 16384);
    bf16* WPOOL = (bf16*)(P.ws + WS_WPOOL); bf16* WQKV = (bf16*)(P.ws + WS_WQKV); bf16* WO = (bf16*)(P.ws + WS_WO); bf16* WUP = (bf16*)(P.ws + WS_WUP); bf16* WDN = (bf16*)(P.ws + WS_WDN);
    constexpr int I_POOL = (256 / 64) * (256 / 32), I_QKV = (D / 64) * (3 * D / 32), I_O = (D / 64) * (D / 32), I_UP = (D / 64) * (FF / 32), I_DN = (FF / 64) * (D / 32);
    constexpr int NITEMS = 8 * I_POOL + 2 * I_QKV + 2 * I_O + 4 * I_UP + 4 * I_DN;
    for (int it = gw; it < NITEMS; it += NGW) {
        int r = it;
        if (r < 8 * I_POOL) { const int mtx = r / I_POOL, j = mtx >> 2, g = mtx & 3; transpose_item(P.pool_w + (size_t)mtx * 65536, 256, 256, WPOOL + (size_t)j * 1024 * 256, g * 256, P.pool_scale + j * 1024 + g * 256, nullptr, scr, r % I_POOL, lane); continue; } r -= 8 * I_POOL;
        if (r < 2 * I_QKV) { const int j = r / I_QKV; transpose_item(P.w_qkv + (size_t)j * D * 3 * D, D, 3 * D, WQKV + (size_t)j * 3 * D * D, 0, nullptr, P.norm_mix + (2 * j + 1) * D, scr, r % I_QKV, lane); continue; } r -= 2 * I_QKV;
        if (r < 2 * I_O) { const int j = r / I_O; transpose_item(P.w_o + (size_t)j * D * D, D, D, WO + (size_t)j * D * D, 0, nullptr, nullptr, scr, r % I_O, lane); continue; } r -= 2 * I_O;
        if (r < 4 * I_UP) { const int j = r / I_UP; transpose_item(P.w_up + (size_t)j * D * FF, D, FF, WUP + (size_t)j * D * FF, 0, nullptr, P.norm_mlp + j * D, scr, r % I_UP, lane); continue; } r -= 4 * I_UP;
        { const int j = r / I_DN; transpose_item(P.w_down + (size_t)j * D * FF, FF, D, WDN + (size_t)j * D * FF, 0, nullptr, nullptr, scr, r % I_DN, lane); }
    }
}

__device__ __forceinline__ void norm_rows_f32_inplace(float* x, const float* gain, int nrows, int gw, int NGW, int lane) {
    f32x4 g[4];
#pragma unroll
    for (int j = 0; j < 4; ++j) g[j] = *((const f32x4*)gain + lane + 64 * j);
    for (int m = gw * 4; m < nrows; m += NGW * 4) {
        GAS f32x4* xr = (GAS f32x4*)(x + (size_t)m * D) + lane;
        f32x4 v[4][4];
#pragma unroll
        for (int r = 0; r < 4; ++r)
#pragma unroll
            for (int j = 0; j < 4; ++j) v[r][j] = xr[r * 256 + 64 * j];
        __builtin_amdgcn_sched_barrier(0);
#pragma unroll
        for (int r = 0; r < 4; ++r) { float s = 0.f;
#pragma unroll
            for (int j = 0; j < 4; ++j) s += (v[r][j].x * v[r][j].x + v[r][j].y * v[r][j].y) + (v[r][j].z * v[r][j].z + v[r][j].w * v[r][j].w);
            const float rr = 1.0f / sqrtf(wave_sum(s) * (1.f / D) + RMS_EPS);
#pragma unroll
            for (int j = 0; j < 4; ++j) xr[r * 256 + 64 * j] = v[r][j] * rr * g[j]; }
    }
}

constexpr int PT = 32, PROWS = 48;
typedef float f32x2v __attribute__((ext_vector_type(2)));
__device__ __forceinline__ f32x2v bfpair(unsigned u) { return (f32x2v){__builtin_bit_cast(float, u << 16), __builtin_bit_cast(float, u & 0xffff0000u)}; }
struct f32x8 { f32x4 lo, hi; };
__device__ __forceinline__ f32x8 bf8(const v4u u) { f32x8 r; r.lo = (f32x4){__builtin_bit_cast(float, u.x << 16), __builtin_bit_cast(float, u.x & 0xffff0000u), __builtin_bit_cast(float, u.y << 16), __builtin_bit_cast(float, u.y & 0xffff0000u)};
    r.hi = (f32x4){__builtin_bit_cast(float, u.z << 16), __builtin_bit_cast(float, u.z & 0xffff0000u), __builtin_bit_cast(float, u.w << 16), __builtin_bit_cast(float, u.w & 0xffff0000u)}; return r; }
__device__ __forceinline__ v4u pack8(const f32x4 a, const f32x4 b) { v4u o; o.x = pk2(a[0], a[1]); o.y = pk2(a[2], a[3]); o.z = pk2(b[0], b[1]); o.w = pk2(b[2], b[3]); return o; }
template <int W> __device__ __forceinline__ void pool_rows_interior(const LAS v4u* hrow, GAS v4u* po) {
    constexpr int HW = W / 2; constexpr float INV = 1.0f / (float)W;
    f32x4 sl = {0.f, 0.f, 0.f, 0.f}, sh = {0.f, 0.f, 0.f, 0.f};
#pragma unroll
    for (int o = -HW; o < HW; ++o) { const f32x8 h = bf8(hrow[(8 + o) * 128]); sl += h.lo; sh += h.hi; }
    __builtin_amdgcn_sched_barrier(0);
#pragma unroll
    for (int i = 0; i < 8; ++i) {
        const f32x8 c = bf8(hrow[(8 + i) * 128]);
        po[(size_t)i * 32] = pack8(sl * INV - c.lo, sh * INV - c.hi);
        if (i + 1 < 8) { const f32x8 a = bf8(hrow[(8 + i + HW) * 128]), b = bf8(hrow[(8 + i - HW) * 128]); sl += a.lo - b.lo; sh += a.hi - b.hi; }
        __builtin_amdgcn_sched_barrier(0);
    }
}
__device__ __forceinline__ void pool_load_rows(f32x4 (&v)[6][4], const float* x, int m0, int seq_len, int wave, int lane) {
    const int sb = m0 / seq_len * seq_len, t0 = m0 - sb;
#pragma unroll
    for (int k = 0; k < 6; ++k) { const int t = min(max(t0 - 8 + wave + NWAVES * k, 0), seq_len - 1);
        const GAS f32x4* xr = (const GAS f32x4*)(x + (size_t)(sb + t) * D) + lane;
#pragma unroll
        for (int j = 0; j < 4; ++j) v[k][j] = xr[64 * j]; }
}
__device__ __forceinline__ void pool_phase(LAS unsigned char* lds, const float* x, const float* gain, bf16* Pg, int seq_len, int vcu, int G, int tid, int wave, int lane) {
    f32x4 v[6][4];
    if (vcu < CH / PT) pool_load_rows(v, x, vcu * PT, seq_len, wave, lane);
    for (int tile = vcu; tile < CH / PT; tile += G) {
        const int m0 = tile * PT;
        const int sb = m0 / seq_len * seq_len;
        const int t0 = m0 - sb;
        f32x4 g[4];
#pragma unroll
        for (int j = 0; j < 4; ++j) g[j] = *((const GAS f32x4*)gain + lane + 64 * j);
#pragma unroll
        for (int k = 0; k < 6; ++k) { float s = 0.f;
#pragma unroll
            for (int j = 0; j < 4; ++j) s += (v[k][j].x * v[k][j].x + v[k][j].y * v[k][j].y) + (v[k][j].z * v[k][j].z + v[k][j].w * v[k][j].w);
            const float r = 1.0f / sqrtf(wave_sum(s) * (1.f / D) + RMS_EPS);
            LAS v2u* hr = (LAS v2u*)(lds + (wave + NWAVES * k) * 2048) + lane;
#pragma unroll
            for (int j = 0; j < 4; ++j) { v2u o; o.x = pk2(v[k][j].x * r * g[j].x, v[k][j].y * r * g[j].y); o.y = pk2(v[k][j].z * r * g[j].z, v[k][j].w * r * g[j].w); hr[64 * j] = o; } }
        __syncthreads();
        if (tile + G < CH / PT) { pool_load_rows(v, x, (tile + G) * PT, seq_len, wave, lane); __builtin_amdgcn_sched_barrier(0); }
        {
            const int pg = wave & 3, part = (lane >> 5) + 2 * (wave >> 2), oc = lane & 31, pw = 2 << pg, phw = pw >> 1;
            const LAS v4u* hrow = (const LAS v4u*)(lds + (8 * part) * 2048 + pg * 512 + oc * 16);
            GAS v4u* po = (GAS v4u*)(Pg + ((size_t)pg * CH + m0 + 8 * part) * 256 + oc * 8);
            if (t0 >= 8 && t0 + PT + 8 <= seq_len) {
                switch (pg) { case 0: pool_rows_interior<2>(hrow, po); break; case 1: pool_rows_interior<4>(hrow, po); break; case 2: pool_rows_interior<8>(hrow, po); break; default: pool_rows_interior<16>(hrow, po); break; }
            } else {
                for (int i = 0; i < 8; ++i) {
                    const int t = t0 + 8 * part + i;
                    const int lo = max(t - phw, 0), hi = min(t + phw - 1, seq_len - 1);
                    f32x4 sl = {0.f, 0.f, 0.f, 0.f}, sh = {0.f, 0.f, 0.f, 0.f};
                    for (int q = lo; q <= hi; ++q) { const f32x8 h = bf8(hrow[(8 + q - t + i) * 128]); sl += h.lo; sh += h.hi; }
                    const f32x8 c = bf8(hrow[(8 + i) * 128]);
                    const float inv = 1.0f / (float)(hi - lo + 1);
                    po[(size_t)i * 32] = pack8(sl * inv - c.lo, sh * inv - c.hi);
                }
            }
        }
        __syncthreads();
    }
}

#define RLX_AGENT __ATOMIC_RELAXED, __HIP_MEMORY_SCOPE_AGENT
#define XB_TMO      128
#define XB_XCNT(j)  (256  + 64 * (j))
#define XB_XSUB(j)  (1280 + 64 * (j))
#define XB_XGEN(j)  (2304 + 64 * (j))
#define XB_TOP      3328
#define XB_TOPGEN   3392
#define XCD_BAR_WORDS 3456
#define XB_SPIN_CAP (1u << 18)

__device__ __forceinline__ unsigned xb_ld(unsigned* p)              { return __hip_atomic_load(p, __ATOMIC_RELAXED, __HIP_MEMORY_SCOPE_AGENT); }
__device__ __forceinline__ unsigned xb_add(unsigned* p, unsigned v) { return __hip_atomic_fetch_add(p, v, __ATOMIC_RELAXED, __HIP_MEMORY_SCOPE_AGENT); }
__device__ __forceinline__ unsigned xb_xcc_id() { return (unsigned)__builtin_amdgcn_s_getreg((3 << 11) | 20) & 0xFu; }
#define XB_SPIN(cond, bar) do { unsigned _sp = 0; while (cond) { __builtin_amdgcn_s_sleep(1); \
    if ((++_sp & 255u) == 0u) { if (xb_ld(&(bar)[XB_TMO])) break; if (_sp > XB_SPIN_CAP) { atomicAdd(&(bar)[XB_TMO], 1u); break; } } } } while (0)

struct XcdBarrier {
    unsigned* bar; unsigned x;
    volatile LAS unsigned* st;
};

__device__ __forceinline__ XcdBarrier xcd_barrier_post(unsigned* bar, volatile LAS unsigned* st) {
    XcdBarrier b; b.bar = bar; b.x = xb_xcc_id(); b.st = st;
    if (threadIdx.x == 0) (void)xb_add(&bar[XB_XCNT(b.x)], 1u);
    return b;
}
__device__ __forceinline__ void xcd_barrier_complete(unsigned* bar, unsigned x, unsigned& nloc, unsigned& nx) {
    const unsigned G = gridDim.x * gridDim.y * gridDim.z;
    unsigned sum, cnt, mine, sp = 0u;
    for (;;) {
        sum = 0u; cnt = 0u; mine = 0u;
#pragma unroll
        for (unsigned j = 0; j < 16; ++j) { const unsigned c = xb_ld(&bar[XB_XCNT(j)]); sum += c; cnt += (c > 0u) ? 1u : 0u; mine = (j == x) ? c : mine; }
        if (sum == G) break;
        __builtin_amdgcn_s_sleep(1);
        if ((++sp & 255u) == 0u) { if (xb_ld(&bar[XB_TMO])) break; if (sp > XB_SPIN_CAP) { atomicAdd(&bar[XB_TMO], 1u); break; } }
    }
    nloc = mine > 0u ? mine : 1u; nx = cnt > 0u ? cnt : 1u;
}

__device__ __forceinline__ void xcd_barrier(const XcdBarrier& b) {
    asm volatile("s_waitcnt vmcnt(0)" ::: "memory");
    __syncthreads();
    if (threadIdx.x == 0) {
        unsigned* bar = b.bar;
        __builtin_amdgcn_s_waitcnt(0);
        unsigned nloc = b.st[0], nx = b.st[1];
        if (nloc == 0u) { xcd_barrier_complete(bar, b.x, nloc, nx); b.st[0] = nloc; b.st[1] = nx; }
        const unsigned old = xb_add(&bar[XB_XSUB(b.x)], 1u);
        const unsigned gen = old / nloc;
        if (old + 1u == (gen + 1u) * nloc) {
            __builtin_amdgcn_fence(__ATOMIC_RELEASE, "agent");
            asm volatile("s_waitcnt vmcnt(0)" ::: "memory");
            const unsigned og = xb_add(&bar[XB_TOP], 1u);
            const unsigned tg = og / nx;
            if (og + 1u == (tg + 1u) * nx) xb_add(&bar[XB_TOPGEN], 1u);
            else XB_SPIN(xb_ld(&bar[XB_TOPGEN]) == tg, bar);
            __builtin_amdgcn_fence(__ATOMIC_ACQUIRE, "agent");
            xb_add(&bar[XB_XGEN(b.x)], 1u);
            asm volatile("s_waitcnt vmcnt(0)" ::: "memory");
        } else {
            XB_SPIN(xb_ld(&bar[XB_XGEN(b.x)]) == gen, bar);
            __builtin_amdgcn_fence(__ATOMIC_ACQUIRE, "agent");
            asm volatile("s_waitcnt vmcnt(0)" ::: "memory");
        }
    }
    __syncthreads();
}


__device__ __forceinline__ unsigned cvtpk(float lo, float hi) { return pk2(lo, hi); }
__device__ __forceinline__ s16x4 vtr(const LAS unsigned char* p) { return __builtin_bit_cast(s16x4, __builtin_amdgcn_ds_read_tr16_b64_v4i16((LAS s16x4*)p)); }
__device__ __forceinline__ void attn_phase(LAS unsigned char* lds, bf16* Qb, const bf16* Kb, const bf16* Vb, const float* rpb_l, int seq_len, int G, int bx, int tid, int wave, int lane) {
    const int fr = lane & 15, fq = lane >> 4;
    const int rows = seq_len >> 6, rows_shift = (seq_len == 2048) ? 5 : 6;
    constexpr int NI = (CH / 64) * 8;
    int nx, xc, lc, per;
    if ((G & 7) == 0) { nx = G >> 3; xc = bx & 7; lc = bx >> 3; per = NI >> 3; } else { nx = G; xc = 0; lc = bx; per = NI; }
    LAS float* bias = (LAS float*)(lds + BIAS_OFF);
    const int qb = wave & 3, hh = wave >> 2;
    const int qc = (qb < 3) ? (8 + 16 * qb + fr) : (fr < 8 ? fr : 48 + fr);
    const int a0 = (qb < 3) ? qb : 0, a1 = (qb < 3) ? qb + 1 : 3;
    const int wst = min(max(qc - 8, 0), 48);
    const int q4 = (lane & 15) >> 2, p4 = lane & 3;
    float madd[2][4];
#pragma unroll
    for (int ai = 0; ai < 2; ++ai)
#pragma unroll
        for (int i = 0; i < 4; ++i) { const int kc = 16 * (ai ? a1 : a0) + 4 * fq + i; madd[ai][i] = ((kc >= wst) && (kc < wst + 16)) ? 0.f : -1.0e30f; }
    int voff[4];
#pragma unroll
    for (int i3 = 0; i3 < 4; ++i3) voff[i3] = (lane >> 4) * D + (((lane & 15) ^ (((lane >> 4) << 2) | i3)) * 8);
    if (lc >= per) return;
    int id = xc * per + lc;
    int r = id & (rows - 1), hp = (id >> rows_shift) & 7, tb = (id >> (rows_shift + 3)) * seq_len, r0 = min(max(r - 4, 0), rows - 8);
    bf16x8 qf0, qf1, kf[4][2][2];
    float bnext[2];
#define ATT_PREFETCH() do { \
        const int h_ = 2 * hp + hh; const size_t qo_ = (size_t)(tb + r * 64 + qc) * D + h_ * 64; \
        qf0 = *(const GAS bf16x8*)(Qb + qo_ + 8 * fq); qf1 = *(const GAS bf16x8*)(Qb + qo_ + 32 + 8 * fq); \
        const bf16* kb_ = Kb + ((size_t)(h_ * 8 + fq) * CH + (tb + r0 * 64 + fr)) * 8; \
        _Pragma("unroll") for (int kr = 0; kr < 4; ++kr) _Pragma("unroll") for (int ai = 0; ai < 2; ++ai) { const bf16* kp = kb_ + (kr * 64 + 16 * (ai ? a1 : a0)) * 8; kf[kr][ai][0] = *(const GAS bf16x8*)kp; kf[kr][ai][1] = *(const GAS bf16x8*)(kp + (size_t)4 * CH * 8); } \
        bnext[0] = rpb_l[hp * 930 + tid] * LOG2E; bnext[1] = (tid + 512 < 930) ? rpb_l[hp * 930 + tid + 512] * LOG2E : 0.f; } while (0)
#define ATT_BIAS_WRITE() do { bias[tid] = bnext[0]; if (tid + 512 < 930) bias[tid + 512] = bnext[1]; } while (0)
    ATT_PREFETCH();
    ATT_BIAS_WRITE();
    for (int loc = lc; loc < per; loc += nx) {
        const int h = 2 * hp + hh;
        const size_t qoff = (size_t)(tb + r * 64 + qc) * D + h * 64;
        const bf16* kbase = Kb + ((size_t)(h * 8 + fq) * CH + (tb + r0 * 64 + fr)) * 8;
        const int drb = r0 - r + 7;
        __syncthreads();
        {
            const int a = wave >> 1, ub = (wave & 1) * 2;
#pragma unroll
            for (int i = 0; i < 16; ++i) { const int kr = 2 * (ub + (i >> 3)) + (i & 1), cb = 16 * a + 4 * ((i & 7) >> 1);
                const bf16* src = Vb + (size_t)(tb + (r0 + kr) * 64 + cb) * D + hp * 128 + voff[i & 3];
                __builtin_amdgcn_global_load_lds((const unsigned*)src, (LAS unsigned*)(lds + (wave * 16 + i) * 1024), 16, 0, 0); }
        }
        f32x4 S[8][2];
        float mx = -3.0e38f;
        const LAS float* bptr[2][4];
#pragma unroll
        for (int ai = 0; ai < 2; ++ai)
#pragma unroll
            for (int i = 0; i < 4; ++i) { const int kc = 16 * (ai ? a1 : a0) + 4 * fq + i; bptr[ai][i] = bias + hh * 465 + drb * 31 + min(max(kc - qc + 15, 0), 30); }
#pragma unroll
        for (int kr = 0; kr < 8; ++kr) {
#pragma unroll
            for (int ai = 0; ai < 2; ++ai) {
                f32x4 z = {0.f, 0.f, 0.f, 0.f};
                z = __builtin_amdgcn_mfma_f32_16x16x32_bf16(kf[kr & 3][ai][0], qf0, z, 0, 0, 0);
                z = __builtin_amdgcn_mfma_f32_16x16x32_bf16(kf[kr & 3][ai][1], qf1, z, 0, 0, 0);
#pragma unroll
                for (int i = 0; i < 4; ++i) { z[i] = (z[i] + bptr[ai][i][kr * 31]) + madd[ai][i]; mx = fmaxf(mx, z[i]); }
                S[kr][ai] = z;
            }
            if (kr < 4) {
#pragma unroll
                for (int ai = 0; ai < 2; ++ai) { const bf16* kp = kbase + ((kr + 4) * 64 + 16 * (ai ? a1 : a0)) * 8; kf[kr & 3][ai][0] = *(const GAS bf16x8*)kp; kf[kr & 3][ai][1] = *(const GAS bf16x8*)(kp + (size_t)4 * CH * 8); }
            }
        }
        mx = fmaxf(mx, __shfl_xor(mx, 16)); mx = fmaxf(mx, __shfl_xor(mx, 32));
        float sum = 0.f;
#pragma unroll
        for (int kr = 0; kr < 8; ++kr)
#pragma unroll
            for (int ai = 0; ai < 2; ++ai)
#pragma unroll
                for (int i = 0; i < 4; ++i) { const float p = __builtin_amdgcn_exp2f(S[kr][ai][i] - mx); S[kr][ai][i] = p; sum += p; }
        sum += __shfl_xor(sum, 16); sum += __shfl_xor(sum, 32);
        bf16x8 pf[4][2];
#pragma unroll
        for (int u = 0; u < 4; ++u)
#pragma unroll
            for (int ai = 0; ai < 2; ++ai) { v4u pw; pw.x = cvtpk(S[2 * u][ai][0], S[2 * u][ai][1]); pw.y = cvtpk(S[2 * u][ai][2], S[2 * u][ai][3]); pw.z = cvtpk(S[2 * u + 1][ai][0], S[2 * u + 1][ai][1]); pw.w = cvtpk(S[2 * u + 1][ai][2], S[2 * u + 1][ai][3]);
                pf[u][ai] = __builtin_bit_cast(bf16x8, pw); }
        asm volatile("s_waitcnt vmcnt(0)" ::: "memory");
        __syncthreads();
        const int nloc = loc + nx; const bool has_next = nloc < per;
        const int r_cur = r, tb_cur = tb;
        if (has_next) { id = xc * per + nloc; r = id & (rows - 1); hp = (id >> rows_shift) & 7; tb = (id >> (rows_shift + 3)) * seq_len; r0 = min(max(r - 4, 0), rows - 8); ATT_PREFETCH(); }
        (void)r_cur; (void)tb_cur;
        f32x4 O[4];
#pragma unroll
        for (int c = 0; c < 4; ++c) O[c] = (f32x4){0.f, 0.f, 0.f, 0.f};
        const LAS unsigned char* vb[2][2][4];
#pragma unroll
        for (int ai = 0; ai < 2; ++ai)
#pragma unroll
            for (int t = 0; t < 2; ++t)
#pragma unroll
                for (int c = 0; c < 4; ++c) { const int rho = 8 * fq + 4 * t + q4, chn = 2 * (4 * hh + c) + (p4 >> 1);
                    vb[ai][t][c] = lds + (ai ? a1 : a0) * 32768 + 256 * rho + 16 * (chn ^ (((rho & 3) << 2) | ((rho >> 2) & 3))) + 8 * (p4 & 1); }
#pragma unroll
        for (int u = 0; u < 4; ++u) {
#pragma unroll
            for (int ai = 0; ai < 2; ++ai) {
#pragma unroll
                for (int c = 0; c < 4; ++c) {
                    const s16x4 v0 = vtr(vb[ai][0][c] + u * 8192), v1 = vtr(vb[ai][1][c] + u * 8192);
                    const bf16x8 vf = __builtin_shufflevector(v0, v1, 0, 1, 2, 3, 4, 5, 6, 7);
                    O[c] = __builtin_amdgcn_mfma_f32_16x16x32_bf16(vf, pf[u][ai], O[c], 0, 0, 0);
                }
            }
        }
        const float inv = 1.0f / sum;
#pragma unroll
        for (int c = 0; c < 4; ++c) { v2u w; w.x = cvtpk(O[c][0] * inv, O[c][1] * inv); w.y = cvtpk(O[c][2] * inv, O[c][3] * inv);
            *(GAS v2u*)(Qb + qoff + 16 * c + 4 * fq) = w; }
        if (has_next) ATT_BIAS_WRITE();
    }
    __syncthreads();
#undef ATT_PREFETCH
#undef ATT_BIAS_WRITE
}
enum { K_POOL = 1, K_GEMM_RES = 3, K_GEMM_QKV = 4, K_GEMM_UP = 5, K_ATTN = 6, K_FINAL = 7 };
enum { F_A_X = 1, F_A_IN = 2, F_AUX_X = 4, F_AUX_IN = 8 };
struct Ph { int kind, flags, N, K; const void* A; const void* B; void* C; const void* aux; float* st; float* rs; unsigned long long a_pn_stride, pad; };
constexpr int PPC = 19;
struct Args { Ptrs p; Ph tab[PPC]; };
__global__ void __launch_bounds__(NWAVES * 64, 2) fwd_megakernel(Args args) {
    extern __shared__ __attribute__((aligned(16))) unsigned char lds_raw[];
    cg::grid_group grid = cg::this_grid();
    LAS unsigned char* lds = (LAS unsigned char*)lds_raw;
    volatile LAS unsigned* MISC = (volatile LAS unsigned*)(lds + MISC_OFF);
    for (int u = threadIdx.x; u < 32; u += NWAVES * 64) MISC[u] = 0u;
    __syncthreads();
    const XcdBarrier bar = xcd_barrier_post((unsigned*)(args.p.ws + WS_CTL), MISC + 8);
    {
        const int tid = threadIdx.x, lane = tid & 63, wave = __builtin_amdgcn_readfirstlane(tid >> 6);
        const int G = gridDim.x, bx = blockIdx.x;
        const int vcu = (G % 8 == 0) ? (bx % 8) * (G / 8) + bx / 8 : bx;
        prologue(args.p, lds, vcu * NWAVES + wave, G * NWAVES, wave, lane);
    }
    grid.sync();

    for (int ph = 0; ph < NCHUNK * PPC; ++ph) {
        int tid = threadIdx.x; asm volatile("" : "+v"(tid));
        int G = gridDim.x, bx = blockIdx.x; asm volatile("" : "+s"(G), "+s"(bx));
        const int lane = tid & 63, wave = __builtin_amdgcn_readfirstlane(tid >> 6);
        const int vcu = (G % 8 == 0) ? (bx % 8) * (G / 8) + bx / 8 : bx;
        const int gw = vcu * NWAVES + wave, NGW = G * NWAVES;
        const int ck = ph / PPC, idx = ph - ck * PPC;
        const Ph d = args.tab[idx];
        const int tok0 = ck * CH, grp = tok0 / GROUP_TOK, seq_len = grp ? 4096 : 2048;
        const float* xin = args.p.x_in[grp] + (size_t)(tok0 - grp * GROUP_TOK) * D;
        float* X = args.p.out + (size_t)tok0 * D;
        const void* A = (d.flags & F_A_X) ? (const void*)X : (d.flags & F_A_IN) ? (const void*)xin : d.A;
        const void* aux = (d.flags & F_AUX_X) ? (const void*)X : (d.flags & F_AUX_IN) ? (const void*)xin : d.aux;
#define KIND_IS(x) ([&]() { int kd_ = d.kind; asm volatile("" : "+s"(kd_)); return kd_ == (x); }())
        if (0) {}
        else if (KIND_IS(K_POOL)) { { int tid2 = threadIdx.x; asm volatile("" : "+v"(tid2));
            pool_phase(lds, (const float*)A, (const float*)aux, (bf16*)d.C, seq_len, vcu, G, tid2, __builtin_amdgcn_readfirstlane(tid2 >> 6), tid2 & 63); } }
        else if (KIND_IS(K_GEMM_RES)) { pg8::Gemm g{(const bf16*)A, (const bf16*)d.B, CH, d.N, d.K, (size_t)d.a_pn_stride, d.K == FF  }; pg8::StaticOrder S; S.init(CH, d.N, G, bx);
            pg8::EpiRes E{(const float*)aux, X, (bf16*)d.C, d.st, D, d.rs};
            pg8::gemm_phase<pg8::EpiRes, pg8::StaticOrder, false, PG8_SP2>(lds, g, S, E, tid); }
        else if (KIND_IS(K_GEMM_QKV)) { pg8::Gemm g{(const bf16*)A, (const bf16*)d.B, CH, d.N, d.K, 0, 1  }; pg8::StaticOrder S; S.init(CH, d.N, G, bx);
            pg8::EpiBf16<0, true> E{(bf16*)d.C, D, D, (size_t)CH * D, 0.125f * LOG2E, d.st, 0};
            pg8::gemm_phase<pg8::EpiBf16<0, true>, pg8::StaticOrder, PG8_ALIGN, PG8_SP2>(lds, g, S, E, tid); }
        else if (KIND_IS(K_GEMM_UP)) { pg8::Gemm g{(const bf16*)A, (const bf16*)d.B, CH, d.N, d.K, 0, 1  }; pg8::StaticOrder S; S.init(CH, d.N, G, bx);
            pg8::EpiBf16<2, false> E{(bf16*)d.C, FF, 0, 0, 1.f, nullptr, 1};
            pg8::gemm_phase<pg8::EpiBf16<2, false>, pg8::StaticOrder, PG8_ALIGN, PG8_SP2>(lds, g, S, E, tid); }
        else if (KIND_IS(K_ATTN)) { attn_phase(lds, (bf16*)d.C, (const bf16*)d.C + (size_t)CH * D, (const bf16*)d.C + 2 * (size_t)CH * D, (const float*)aux, seq_len, G, bx, tid, wave, lane); }
        else { norm_rows_f32_inplace(X, (const float*)aux, CH, gw, NGW, lane); }
#undef KIND_IS
        if (d.kind != K_FINAL) xcd_barrier(bar);
    }
}

extern "C" void kernel_launch(void* const* d_in, const int* in_sizes, int n_in, void* d_out, int out_size, void* d_ws, size_t ws_size, hipStream_t stream) {
    static int grid = 0;
    if (grid == 0) {
        if (n_in != 12 || in_sizes[0] != GROUP_TOK * D || in_sizes[1] != GROUP_TOK * D || out_size != NTOK * D || ws_size < WS_END) {
            fprintf(stderr, "kernel_launch: unexpected shapes (n_in %d, out %d, ws %zu < %zu); nothing launched\n", n_in, out_size, ws_size, (size_t)WS_END); grid = -1; return; }
        int dev = 0, cus = 0, per_cu = 0;
        if (hipGetDevice(&dev) != hipSuccess || hipDeviceGetAttribute(&cus, hipDeviceAttributeMultiprocessorCount, dev) != hipSuccess) { fprintf(stderr, "kernel_launch: device query failed\n"); grid = -1; return; }
        if (hipFuncSetAttribute((const void*)fwd_megakernel, hipFuncAttributeMaxDynamicSharedMemorySize, LDS_BYTES) != hipSuccess) { fprintf(stderr, "kernel_launch: hipFuncSetAttribute failed\n"); grid = -1; return; }
        if (hipOccupancyMaxActiveBlocksPerMultiprocessor(&per_cu, (const void*)fwd_megakernel, NWAVES * 64, LDS_BYTES) != hipSuccess || per_cu < 1) { fprintf(stderr, "kernel_launch: occupancy query gave %d\n", per_cu); per_cu = 1; }
        (void)hipGetLastError();
        grid = cus * per_cu;
    }
    if (grid < 0) return;
    if (hipMemsetAsync((char*)d_ws + WS_CTL, 0, CTL_ZERO_BYTES, stream) != hipSuccess) { fprintf(stderr, "kernel_launch: hipMemsetAsync failed\n"); return; }
    Args a{};
    Ptrs& p = a.p;
    p.x_in[0] = (const float*)d_in[0]; p.x_in[1] = (const float*)d_in[1]; p.norm_mix = (const float*)d_in[2]; p.pool_w = (const float*)d_in[3]; p.pool_scale = (const float*)d_in[4];
    p.w_qkv = (const float*)d_in[5]; p.rpb = (const float*)d_in[6]; p.w_o = (const float*)d_in[7]; p.norm_mlp = (const float*)d_in[8]; p.w_up = (const float*)d_in[9];
    p.w_down = (const float*)d_in[10]; p.norm_final = (const float*)d_in[11]; p.out = (float*)d_out; p.ws = (unsigned char*)d_ws;
    unsigned char* ws = (unsigned char*)d_ws;
    bf16* WPOOL = (bf16*)(ws + WS_WPOOL); bf16* WQKV = (bf16*)(ws + WS_WQKV); bf16* WO = (bf16*)(ws + WS_WO); bf16* WUP = (bf16*)(ws + WS_WUP); bf16* WDN = (bf16*)(ws + WS_WDN);
    bf16* XN = (bf16*)(ws + WS_XN); bf16* PG = (bf16*)(ws + WS_PG); bf16* QB = (bf16*)(ws + WS_ACT); bf16* HB = (bf16*)(ws + WS_ACT);
    float* SA = (float*)(ws + WS_STAT); float* SB = SA + (size_t)CH * 16;
    int n = 0;
    auto add = [&](int kind, int flags, int N, int K, const void* A, const void* B, void* C, const void* aux, float* st, float* rs, unsigned long long aps) {
        Ph& d = a.tab[n++]; d.kind = kind; d.flags = flags; d.N = N; d.K = K; d.A = A; d.B = B; d.C = C; d.aux = aux; d.st = st; d.rs = rs; d.a_pn_stride = aps; d.pad = 0; };
    for (int layer = 0; layer < DEPTH; ++layer) {
        const int j = layer >> 1;
        if ((layer & 1) == 0) {
            add(K_POOL, layer == 0 ? F_A_IN : F_A_X, 0, 0, nullptr, nullptr, PG, p.norm_mix + layer * D, nullptr, nullptr, 0);
            add(K_GEMM_RES, layer == 0 ? F_AUX_IN : F_AUX_X, D, 256, PG, WPOOL + (size_t)j * 1024 * 256, XN, nullptr, SA, nullptr, (unsigned long long)CH * 256 * 2);
        } else {
            add(K_GEMM_QKV, 0, 3 * D, D, XN, WQKV + (size_t)j * 3 * D * D, QB, nullptr, SB, nullptr, 0);
            add(K_ATTN, 0, 0, 0, nullptr, nullptr, QB, p.rpb + (size_t)j * NH * 15 * 31, nullptr, nullptr, 0);
            add(K_GEMM_RES, F_AUX_X, D, D, QB, WO + (size_t)j * D * D, XN, nullptr, SA, nullptr, 0);
        }
        add(K_GEMM_UP, 0, FF, D, XN, WUP + (size_t)layer * D * FF, HB, nullptr, SA, nullptr, 0);
        add(K_GEMM_RES, F_AUX_X, D, FF, HB, WDN + (size_t)layer * D * FF, (layer & 1) == 0 ? XN : nullptr, nullptr, SB, SA, 0);
    }
    add(K_FINAL, 0, 0, 0, nullptr, nullptr, nullptr, p.norm_final, nullptr, nullptr, 0);
    if (n != PPC) { fprintf(stderr, "kernel_launch: phase table has %d entries, expected %d\n", n, PPC); return; }
    void* kargs[] = {&a};
    hipError_t e = hipLaunchCooperativeKernel((const void*)fwd_megakernel, dim3(grid), dim3(NWAVES * 64), kargs, LDS_BYTES, stream);
    if (e != hipSuccess) fprintf(stderr, "kernel_launch: cooperative launch failed: %s (grid %d)\n", hipGetErrorString(e), grid);
}
```

```cpp
#include <hip/hip_runtime.h>
#include <hip/hip_cooperative_groups.h>
#include <cstdio>
#include <cstdint>
namespace cg = cooperative_groups;
namespace pg8 {
#define PG8_LAS __attribute__((address_space(3)))
typedef unsigned short bf16_t;
typedef short bf16x8 __attribute__((ext_vector_type(8)));
typedef float f32x4 __attribute__((ext_vector_type(4)));
typedef unsigned u32x4 __attribute__((ext_vector_type(4)));
constexpr int BM = 256, BK = 64, HALF = 128, HTB = HALF * BK * 2  , STAGE_BYTES = 8 * HTB, NXCD = 8, WGM = 8;

__host__ __device__ __forceinline__ int lds_byte(int r, int c) { const int st = (r >> 4) * 2 + (c >> 5), rr = r & 15, cc = c & 31, ob = rr * 64 + cc * 2; return st * 1024 + (ob ^ (((ob >> 9) & 1) << 5)); }
__host__ __device__ __forceinline__ void stage_rc(int b, int& R, int& C) { const int st = b / 1024, sb = b % 1024, swz = sb ^ (((sb >> 9) & 1) << 5); R = (st >> 1) * 16 + swz / 64; C = (st & 1) * 32 + (swz % 64) / 2; }
__host__ __device__ __forceinline__ int perm32(int rho) { const int n = rho >> 4, i = rho & 15; return 8 * (i >> 2) + 4 * n + (i & 3); }

struct Unit { int pm, pn; };
struct Gemm { const bf16_t* A; const bf16_t* Bt; int M, N, K; size_t a_pn_stride; int a_tiled; };

struct StaticOrder {
    int nM, nN, nwg, G, c;
    __host__ __device__ void init(int M, int N, int G_, int c_) { nM = M / BM; nN = N / BM; nwg = nM * nN; G = G_; c = c_; }
    __host__ __device__ bool next(int i, Unit& u) const {
        const long L = (long)i * G + c; if (L >= nwg) return false;
        int wgid = (int)L; { const int q = nwg / NXCD, r = nwg % NXCD, xcd = wgid % NXCD, off = wgid / NXCD; wgid = (xcd < r ? xcd * (q + 1) : r * (q + 1) + (xcd - r) * q) + off; }
        const int nig = WGM * nN, gid = wgid / nig, fm = gid * WGM, gsz = (nM - fm) < WGM ? (nM - fm) : WGM;
        u.pm = fm + ((wgid % nig) % gsz); u.pn = (wgid % nig) / gsz; return true;
    }
    __device__ __forceinline__ void a_ready(const Unit&) const {}
    __device__ __forceinline__ void done(const Unit&) const {}
};

__device__ __forceinline__ unsigned cvt_pk_bf16(float lo, float hi) { unsigned r; asm volatile("v_cvt_pk_bf16_f32 %0, %1, %2" : "=v"(r) : "v"(lo), "v"(hi)); return r; }
typedef float f32x2 __attribute__((ext_vector_type(2)));
template <int ACT, bool RS> struct EpiBf16 {
    static constexpr bool PERM = true, AFTER_DRAIN = false;
    bf16_t* O; int ldc; int split_cols; size_t split_stride; float scale0; const float* st; int tiled;
    __device__ __forceinline__ void operator()(const f32x4 (&acc)[2][2][4][2], const Unit& u, int wr, int wc, int fr, int fq) const {
        const int row0 = u.pm * BM + wr * 64 + fr; int colt = u.pn * BM; bf16_t* base = O;
        float sc = 1.f; bool kplane = false;
        if (split_cols) { const int t = colt / split_cols; base += (size_t)t * split_stride; colt -= t * split_cols; if (t == 0) sc = scale0; kplane = (t == 1); }
        const size_t kprows = split_stride / 1024;
        const int col0 = colt + wc * 32 + 8 * fq;
        f32x4 pv[2][4];
        if (RS) {
#pragma unroll
            for (int ai = 0; ai < 2; ++ai)
#pragma unroll
                for (int m = 0; m < 4; ++m) pv[ai][m] = *(const f32x4*)(st + (size_t)(row0 + ai * HALF + m * 16) * 16 + 4 * fq);
            __builtin_amdgcn_sched_barrier(0);
        }
#pragma unroll
        for (int ai = 0; ai < 2; ++ai)
#pragma unroll
            for (int m = 0; m < 4; ++m) { const int row = row0 + ai * HALF + m * 16; bf16_t* rowp = base + (size_t)row * ldc + col0;
                float f = sc;
                if (RS) { float ss = (pv[ai][m][0] + pv[ai][m][1]) + (pv[ai][m][2] + pv[ai][m][3]); ss += __shfl_xor(ss, 16); ss += __shfl_xor(ss, 32);
                    const float r = __builtin_amdgcn_rsqf(ss * (1.0f / 1024.0f) + 1e-6f); f *= (ACT == 2) ? r * r : r; }
#pragma unroll
                for (int bj = 0; bj < 2; ++bj) { f32x4 v0 = acc[ai][bj][m][0], v1 = acc[ai][bj][m][1];
                    if (ACT == 2) {
#pragma unroll
                        for (int e = 0; e < 4; ++e) { const float a = fmaxf(v0[e], 0.f), b = fmaxf(v1[e], 0.f); v0[e] = a * a; v1[e] = b * b; } }
                    v0 = v0 * f; v1 = v1 * f; u32x4 w; w.x = cvt_pk_bf16(v0[0], v0[1]); w.y = cvt_pk_bf16(v0[2], v0[3]); w.z = cvt_pk_bf16(v1[0], v1[1]); w.w = cvt_pk_bf16(v1[2], v1[3]);
                    if (kplane) *(u32x4*)(base + ((size_t)(((colt >> 6) + 2 * bj + (wc >> 1)) * 8 + (wc & 1) * 4 + fq) * kprows + row) * 8) = w;
                    else if (tiled) { const int r_ = row & 255, c_ = col0 + bj * HALF;
                        *(u32x4*)((char*)base + ((size_t)(((row >> 8) * 2 + (r_ >> 7)) * (ldc >> 6) + (c_ >> 6)) << 14) + lds_byte(r_ & 127, c_ & 63)) = w; }
                    else *(u32x4*)(rowp + bj * HALF) = w; } }
    }
};
struct EpiRes {
    static constexpr bool PERM = true, AFTER_DRAIN = false;
    const float* base; float* out; bf16_t* xn; float* st; int ldc; const float* rs;
    __device__ __forceinline__ void operator()(const f32x4 (&acc)[2][2][4][2], const Unit& u, int wr, int wc, int fr, int fq) const {
        const int col0 = u.pn * BM + wc * 32 + 8 * fq;
#pragma unroll
        for (int ai = 0; ai < 2; ++ai) {
            f32x4 rp[4];
            if (rs) {
#pragma unroll
                for (int m = 0; m < 4; ++m) rp[m] = *(const f32x4*)(rs + (size_t)(u.pm * BM + ai * HALF + wr * 64 + m * 16 + fr) * 16 + 4 * fq);
            }
            f32x4 bs[4][2][2];
#pragma unroll
            for (int m = 0; m < 4; ++m) { const size_t off = (size_t)(u.pm * BM + ai * HALF + wr * 64 + m * 16 + fr) * ldc + col0;
#pragma unroll
                for (int bj = 0; bj < 2; ++bj) { bs[m][bj][0] = *(const f32x4*)(base + off + bj * HALF); bs[m][bj][1] = *(const f32x4*)(base + off + bj * HALF + 4); } }
            __builtin_amdgcn_sched_barrier(0);
#pragma unroll
            for (int m = 0; m < 4; ++m) { const int row = u.pm * BM + ai * HALF + wr * 64 + m * 16 + fr; const size_t off = (size_t)row * ldc + col0; float ss = 0.f;
                float f = 1.f;
                if (rs) { float q = (rp[m][0] + rp[m][1]) + (rp[m][2] + rp[m][3]); q += __shfl_xor(q, 16); q += __shfl_xor(q, 32); const float r = __builtin_amdgcn_rsqf(q * (1.0f / 1024.0f) + 1e-6f); f = r * r; }
#pragma unroll
                for (int bj = 0; bj < 2; ++bj) {
                    const f32x4 o0 = bs[m][bj][0] + acc[ai][bj][m][0] * f, o1 = bs[m][bj][1] + acc[ai][bj][m][1] * f;
                    *(f32x4*)(out + off + bj * HALF) = o0; *(f32x4*)(out + off + bj * HALF + 4) = o1;
                    if (xn) { u32x4 w; w.x = cvt_pk_bf16(o0[0], o0[1]); w.y = cvt_pk_bf16(o0[2], o0[3]); w.z = cvt_pk_bf16(o1[0], o1[1]); w.w = cvt_pk_bf16(o1[2], o1[3]);
                        { const int c_ = col0 + bj * HALF;
                          *(u32x4*)((char*)xn + ((size_t)((u.pm * 2 + ai) * (ldc >> 6) + (c_ >> 6)) << 14) + lds_byte(wr * 64 + m * 16 + fr, c_ & 63)) = w; }
                        ss += (o0[0] * o0[0] + o0[1] * o0[1]) + (o0[2] * o0[2] + o0[3] * o0[3]) + (o1[0] * o1[0] + o1[1] * o1[1]) + (o1[2] * o1[2] + o1[3] * o1[3]); } }
                if (xn) { ss += __shfl_xor(ss, 16); ss += __shfl_xor(ss, 32); if (fq == 0) st[(size_t)row * 16 + u.pn * 4 + wc] = ss; } }
        }
    }
};
template <class Epi, class Sched, bool ALIGN_EPI = false, bool SP2 = false>
__device__ __forceinline__ void gemm_phase(PG8_LAS unsigned char* lds, const Gemm g, const Sched& S, const Epi& E, const int tid_in) {
    const int tid = tid_in, wid = __builtin_amdgcn_readfirstlane(tid >> 6), lane = tid & 63, wr = wid >> 2, wc = wid & 3, fr = lane & 15, fq = lane >> 4;
    const int K = g.K, nt = K / BK;
    unsigned voffA[2], voffB[2];
#pragma unroll
    for (int i = 0; i < 2; ++i) { int R, C; stage_rc(tid * 16 + i * 8192, R, C); const int Rb = Epi::PERM ? ((R & ~31) + perm32(R & 31)) : R;
        voffA[i] = g.a_tiled ? (unsigned)(tid * 16 + i * 8192) : (unsigned)(R * K + C) * 2u; voffB[i] = (unsigned)(tid * 16 + i * 8192); (void)Rb; }
    const size_t kstep = (size_t)(BK * 2);
    const size_t hstep = (size_t)HALF * K * 2;
    const size_t tstep = 2 * hstep;
    const size_t kstepB = 16384, hstepB = (size_t)nt * 16384, tstepB = 2 * hstepB;
    const size_t kstepA = g.a_tiled ? (size_t)16384 : kstep, hstepA = g.a_tiled ? (size_t)nt * 16384 : hstep, tstepA = 2 * hstepA;
    const unsigned ldsw = (unsigned)wid * 1024u;
    const int aoff = lds_byte(wr * 64 + fr, fq * 8), boff = lds_byte(wc * 32 + fr, fq * 8);
#define PG8_SA(b, h) (((b) * 2 + (h)) * HTB)
#define PG8_SB(b, h) ((4 + (b) * 2 + (h)) * HTB)
#define PG8_STAGE(bufoff, gbase, voff) do { _Pragma("unroll") for (int _i = 0; _i < 2; ++_i) \
        __builtin_amdgcn_global_load_lds((const unsigned*)((const char*)(gbase) + (voff)[_i]), (PG8_LAS unsigned*)(lds + (bufoff) + ldsw + _i * 8192), 16, 0, 0); } while (0)
#define PG8_LDA(dst, b, h) do { _Pragma("unroll") for (int m = 0; m < 4; ++m) _Pragma("unroll") for (int k = 0; k < 2; ++k) dst[m][k] = *(const PG8_LAS bf16x8*)(lds + PG8_SA(b, h) + aoff + m * 2048 + k * 1024); } while (0)
#define PG8_LDB(dst, b, h) do { _Pragma("unroll") for (int n = 0; n < 2; ++n) _Pragma("unroll") for (int k = 0; k < 2; ++k) dst[n][k] = *(const PG8_LAS bf16x8*)(lds + PG8_SB(b, h) + boff + n * 2048 + k * 1024); } while (0)
#define PG8_MMA(ai, bj, At, Bt) do { __builtin_amdgcn_s_setprio(1); _Pragma("unroll") for (int m = 0; m < 4; ++m) _Pragma("unroll") for (int n = 0; n < 2; ++n) _Pragma("unroll") for (int k = 0; k < 2; ++k) \
        acc[ai][bj][m][n] = __builtin_amdgcn_mfma_f32_16x16x32_bf16(Bt[n][k], At[m][k], acc[ai][bj][m][n], 0, 0, 0); __builtin_amdgcn_s_setprio(0); } while (0)
#define PG8_WAIT_V(n) asm volatile("s_waitcnt vmcnt(" #n ")" ::: "memory")
#define PG8_WAIT_L(n) asm volatile("s_waitcnt lgkmcnt(" #n ")" ::: "memory")
#define PG8_BAR __builtin_amdgcn_s_barrier()
#define PG8_SCHED __builtin_amdgcn_sched_barrier(0)
    Unit cur, nxt; int ui = 0;
    if (!S.next(0, cur)) return;
    f32x4 acc[2][2][4][2];
#pragma unroll
    for (int a = 0; a < 2; ++a)
#pragma unroll
        for (int b = 0; b < 2; ++b)
#pragma unroll
            for (int m = 0; m < 4; ++m)
#pragma unroll
                for (int n = 0; n < 2; ++n) acc[a][b][m][n] = (f32x4){0.f, 0.f, 0.f, 0.f};
    bf16x8 At[4][2], B0[2][2], B1[2][2];
    const char* cA = (const char*)g.A + (size_t)cur.pm * tstepA + (size_t)cur.pn * g.a_pn_stride; const char* cB = (const char*)g.Bt + (size_t)cur.pn * tstepB;
    S.a_ready(cur);
    if constexpr (SP2) {
        PG8_STAGE(PG8_SB(0, 0), cB, voffB); PG8_STAGE(PG8_SB(0, 1), cB + hstepB, voffB); PG8_STAGE(PG8_SA(0, 0), cA, voffA); PG8_STAGE(PG8_SA(0, 1), cA + hstepA, voffA);
        if (wr == 1) PG8_BAR;
        PG8_WAIT_V(2); PG8_BAR;
        PG8_STAGE(PG8_SB(1, 0), cB + kstepB, voffB); PG8_STAGE(PG8_SA(1, 0), cA + kstepA, voffA); PG8_STAGE(PG8_SB(1, 1), cB + hstepB + kstepB, voffB);
        PG8_WAIT_V(6); PG8_BAR;
    } else {
        PG8_STAGE(PG8_SB(0, 0), cB, voffB); PG8_STAGE(PG8_SA(0, 0), cA, voffA); PG8_STAGE(PG8_SB(0, 1), cB + hstepB, voffB); PG8_STAGE(PG8_SA(0, 1), cA + hstepA, voffA);
        if (wr == 1) PG8_BAR;
        PG8_WAIT_V(4); PG8_BAR;
        PG8_STAGE(PG8_SB(1, 0), cB + kstepB, voffB); PG8_STAGE(PG8_SA(1, 0), cA + kstepA, voffA); PG8_STAGE(PG8_SB(1, 1), cB + hstepB + kstepB, voffB);
        PG8_WAIT_V(6); PG8_BAR;
    }
    for (;;) {
        const bool has_next = S.next(ui + 1, nxt);
        const char* nA = has_next ? (const char*)g.A + (size_t)nxt.pm * tstepA + (size_t)nxt.pn * g.a_pn_stride : cA; const char* nB = has_next ? (const char*)g.Bt + (size_t)nxt.pn * tstepB : cB;
        for (int t = 0; t < nt; t += 2) {
            const bool last = (t == nt - 2);
            const char* a1 = cA + (size_t)(t + 1) * kstepA;
            const char* a2 = last ? nA : cA + (size_t)(t + 2) * kstepA; const char* b2 = last ? nB : cB + (size_t)(t + 2) * kstepB;
            const char* a3 = a2 + kstepA; const char* b3 = b2 + kstepB;
            if (last && has_next) S.a_ready(nxt);
            if constexpr (SP2) {
            PG8_LDB(B0, 0, 0); PG8_LDB(B1, 0, 1); PG8_SCHED; PG8_LDA(At, 0, 0); PG8_STAGE(PG8_SA(1, 1), a1 + hstepA, voffA);
            PG8_WAIT_V(8); PG8_WAIT_L(0); PG8_BAR; PG8_MMA(0, 0, At, B0); PG8_MMA(0, 1, At, B1); PG8_BAR; PG8_SCHED;
            PG8_LDA(At, 0, 1); PG8_STAGE(PG8_SB(0, 0), b2, voffB); PG8_STAGE(PG8_SB(0, 1), b2 + hstepB, voffB); PG8_STAGE(PG8_SA(0, 0), a2, voffA);
            PG8_WAIT_V(8); PG8_WAIT_L(0); PG8_BAR; PG8_MMA(1, 0, At, B0); PG8_MMA(1, 1, At, B1); PG8_BAR; PG8_SCHED;
            PG8_LDB(B0, 1, 0); PG8_LDB(B1, 1, 1); PG8_SCHED; PG8_LDA(At, 1, 0); PG8_STAGE(PG8_SA(0, 1), a2 + hstepA, voffA);
            PG8_WAIT_V(8); PG8_WAIT_L(0); PG8_BAR; PG8_MMA(0, 0, At, B0); PG8_MMA(0, 1, At, B1); PG8_BAR; PG8_SCHED;
            PG8_LDA(At, 1, 1); PG8_STAGE(PG8_SB(1, 0), b3, voffB); PG8_STAGE(PG8_SB(1, 1), b3 + hstepB, voffB); PG8_STAGE(PG8_SA(1, 0), a3, voffA);
            PG8_WAIT_V(8); PG8_WAIT_L(0); PG8_BAR; PG8_MMA(1, 0, At, B0); PG8_MMA(1, 1, At, B1); PG8_BAR; PG8_SCHED;
            } else {
            PG8_LDB(B0, 0, 0); PG8_SCHED; PG8_LDA(At, 0, 0); PG8_STAGE(PG8_SA(1, 1), a1 + hstepA, voffA);
            PG8_WAIT_L(8); PG8_BAR; PG8_WAIT_L(0); PG8_MMA(0, 0, At, B0); PG8_BAR; PG8_SCHED;
            PG8_LDB(B1, 0, 1); PG8_STAGE(PG8_SB(0, 0), b2, voffB);
            PG8_BAR; PG8_WAIT_L(0); PG8_MMA(0, 1, At, B1); PG8_BAR;
            PG8_LDA(At, 0, 1); PG8_STAGE(PG8_SA(0, 0), a2, voffA);
            PG8_BAR; PG8_WAIT_L(0); PG8_MMA(1, 0, At, B0); PG8_BAR; PG8_SCHED;
            PG8_STAGE(PG8_SB(0, 1), b2 + hstepB, voffB);
            PG8_WAIT_V(6); PG8_BAR; PG8_MMA(1, 1, At, B1); PG8_BAR;
            PG8_LDB(B0, 1, 0); PG8_SCHED; PG8_LDA(At, 1, 0); PG8_STAGE(PG8_SA(0, 1), a2 + hstepA, voffA);
            PG8_WAIT_L(8); PG8_BAR; PG8_WAIT_L(0); PG8_MMA(0, 0, At, B0); PG8_BAR; PG8_SCHED;
            PG8_LDB(B1, 1, 1); PG8_STAGE(PG8_SB(1, 0), b3, voffB);
            PG8_BAR; PG8_WAIT_L(0); PG8_MMA(0, 1, At, B1); PG8_BAR;
            PG8_LDA(At, 1, 1); PG8_STAGE(PG8_SA(1, 0), a3, voffA);
            PG8_BAR; PG8_WAIT_L(0); PG8_MMA(1, 0, At, B0); PG8_BAR; PG8_SCHED;
            PG8_STAGE(PG8_SB(1, 1), b3 + hstepB, voffB);
            PG8_WAIT_V(6); PG8_BAR; PG8_MMA(1, 1, At, B1); PG8_BAR;
            }
        }
        if constexpr (ALIGN_EPI) { if (wr == 0) PG8_BAR; }
        if constexpr (!Epi::AFTER_DRAIN) { E(acc, cur, wr, wc, fr, fq); S.done(cur); }
        if (!has_next) break;
#pragma unroll
        for (int a = 0; a < 2; ++a)
#pragma unroll
            for (int b = 0; b < 2; ++b)
#pragma unroll
                for (int m = 0; m < 4; ++m)
#pragma unroll
                    for (int n = 0; n < 2; ++n) acc[a][b][m][n] = (f32x4){0.f, 0.f, 0.f, 0.f};
        cur = nxt; cA = nA; cB = nB; ++ui;
        if constexpr (ALIGN_EPI) { if (wr == 1) PG8_BAR; }
    }
    PG8_WAIT_V(0);
    if constexpr (!ALIGN_EPI) { if (wr == 0) PG8_BAR; }
    PG8_BAR;
    if constexpr (Epi::AFTER_DRAIN) { E.fused(acc, cur, wr, wc, fr, fq, lds, wid, lane); S.done(cur); }
#undef PG8_SA
#undef PG8_SB
#undef PG8_STAGE
#undef PG8_LDA
#undef PG8_LDB
#undef PG8_MMA
#undef PG8_WAIT_V
#undef PG8_WAIT_L
#undef PG8_BAR
#undef PG8_SCHED
}
}
#ifndef PG8_SP2
#define PG8_SP2 true
#endif
#ifndef PG8_ALIGN
#define PG8_ALIGN true
#endif

constexpr int NWAVES = 8;
constexpr int D = 1024, FF = 4096, NH = 16, HD = 64, DEPTH = 4;
constexpr int NTOK = 131072;
constexpr int GROUP_TOK = 65536;
#ifndef MK_CH
#define MK_CH 65536
#endif
constexpr int CH = MK_CH;
constexpr int NCHUNK = NTOK / CH;
constexpr float RMS_EPS = 1e-6f;
constexpr float LOG2E = 1.4426950408889634f;
static_assert(GROUP_TOK % CH == 0 && CH % 4096 == 0, "chunking");

constexpr size_t MiB = 1u << 20;
constexpr size_t WS_WPOOL = 2 * MiB;
constexpr size_t WS_WQKV = 4 * MiB;
constexpr size_t WS_WO = 16 * MiB;
constexpr size_t WS_WUP = 20 * MiB;
constexpr size_t WS_WDN = 52 * MiB;
constexpr size_t WS_XN = 96 * MiB;
constexpr size_t WS_PG = WS_XN + (size_t)CH * D * 2;
constexpr size_t WS_ACT = WS_PG + (size_t)CH * D * 2;
constexpr size_t WS_CTL = 0, CTL_ZERO_BYTES = 65536;
constexpr size_t WS_STAT = 86 * MiB;
static_assert(WS_STAT + 2 * (size_t)CH * 64 <= WS_XN, "stat arrays");
constexpr size_t WS_END = WS_ACT + (size_t)CH * FF * 2;
static_assert(WS_XN >= WS_WDN + 32 * MiB && WS_END <= 1024 * MiB, "d_ws map");

constexpr int RING_BYTES = 131072;
constexpr int BIAS_OFF = RING_BYTES;
constexpr int MISC_OFF = RING_BYTES + 4096;
constexpr int LDS_BYTES = 147456;

#define GAS __attribute__((address_space(1)))
#define LAS __attribute__((address_space(3)))
typedef unsigned short bf16;
typedef unsigned v4u __attribute__((ext_vector_type(4)));
typedef unsigned v2u __attribute__((ext_vector_type(2)));
typedef float f32x4 __attribute__((ext_vector_type(4)));
typedef short bf16x8 __attribute__((ext_vector_type(8)));
typedef short s16x4 __attribute__((ext_vector_type(4)));
#define LDS_WAIT() asm volatile("s_waitcnt lgkmcnt(0)" ::: "memory")
typedef float f32x2_t __attribute__((ext_vector_type(2))); typedef __bf16 bf16x2_t __attribute__((ext_vector_type(2)));
__device__ __forceinline__ unsigned pk2(float lo, float hi) { f32x2_t v = {lo, hi}; bf16x2_t b = __builtin_convertvector(v, bf16x2_t); return __builtin_bit_cast(unsigned, b); }
__device__ __forceinline__ float wave_sum(float v) {
#pragma unroll
    for (int o = 1; o < 64; o <<= 1) v += __shfl_xor(v, o);
    return v;
}

__device__ __forceinline__ void transpose_item(const float* W, int K, int N, bf16* WT, int row_off, const float* nscale, const float* kscale, LAS float* scr, int item, int lane) {
    const int nblk = N / 32, kb = item / nblk, nb = item % nblk, k0 = 64 * kb, n0 = 32 * nb;
    float wv[32];
#pragma unroll
    for (int i = 0; i < 32; ++i) wv[i] = W[(size_t)(k0 + 2 * i + (lane >> 5)) * N + n0 + (lane & 31)];
#pragma unroll
    for (int i = 0; i < 32; ++i) scr[(2 * i + (lane >> 5)) * 33 + (lane & 31)] = wv[i];
    LDS_WAIT(); asm volatile("" ::: "memory");
    const int c = lane & 7;
    float ks[8];
#pragma unroll
    for (int e = 0; e < 8; ++e) ks[e] = kscale ? kscale[k0 + 8 * c + e] : 1.f;
#pragma unroll
    for (int j = 0; j < 4; ++j) { const int n = (lane >> 3) + 8 * j; const LAS float* s = scr + (8 * c) * 33 + n;
        const float sc = nscale ? nscale[n0 + n] : 1.f;
        v4u o; o.x = pk2(s[0 * 33] * sc * ks[0], s[1 * 33] * sc * ks[1]); o.y = pk2(s[2 * 33] * sc * ks[2], s[3 * 33] * sc * ks[3]); o.z = pk2(s[4 * 33] * sc * ks[4], s[5 * 33] * sc * ks[5]); o.w = pk2(s[6 * 33] * sc * ks[6], s[7 * 33] * sc * ks[7]);
        { const int ng = row_off + n0 + n, nr = ng & 127, cc = nr & 31, slot = (((cc >> 2) & 1) << 4) | ((cc >> 3) << 2) | (cc & 3), kk = k0 + 8 * c;
          *(GAS v4u*)((GAS char*)WT + ((size_t)(((ng >> 8) * 2 + ((ng >> 7) & 1)) * (K >> 6) + (kk >> 6)) << 14) + pg8::lds_byte((nr & ~31) + slot, kk & 63)) = o; } }
    LDS_WAIT(); asm volatile("" ::: "memory");
}

struct Ptrs {
    const float *x_in[2], *norm_mix, *pool_w, *pool_scale, *w_qkv, *rpb, *w_o, *norm_mlp, *w_up, *w_down, *norm_final;
    float* out; unsigned char* ws;
};

__device__ __forceinline__ void prologue(const Ptrs& P, LAS unsigned char* lds, int gw, int NGW, int wave, int lane) {
    LAS float* scr = (LAS float*)(lds + wave * 16384);
    bf16* WPOOL = (bf16*)(P.ws + WS_WPOOL); bf16* WQKV = (bf16*)(P.ws + WS_WQKV); bf16* WO = (bf16*)(P.ws + WS_WO); bf16* WUP = (bf16*)(P.ws + WS_WUP); bf16* WDN = (bf16*)(P.ws + WS_WDN);
    constexpr int I_POOL = (256 / 64) * (256 / 32), I_QKV = (D / 64) * (3 * D / 32), I_O = (D / 64) * (D / 32), I_UP = (D / 64) * (FF / 32), I_DN = (FF / 64) * (D / 32);
    constexpr int NITEMS = 8 * I_POOL + 2 * I_QKV + 2 * I_O + 4 * I_UP + 4 * I_DN;
    for (int it = gw; it < NITEMS; it += NGW) {
        int r = it;
        if (r < 8 * I_POOL) { const int mtx = r / I_POOL, j = mtx >> 2, g = mtx & 3; transpose_item(P.pool_w + (size_t)mtx * 65536, 256, 256, WPOOL + (size_t)j * 1024 * 256, g * 256, P.pool_scale + j * 1024 + g * 256, nullptr, scr, r % I_POOL, lane); continue; } r -= 8 * I_POOL;
        if (r < 2 * I_QKV) { const int j = r / I_QKV; transpose_item(P.w_qkv + (size_t)j * D * 3 * D, D, 3 * D, WQKV + (size_t)j * 3 * D * D, 0, nullptr, P.norm_mix + (2 * j + 1) * D, scr, r % I_QKV, lane); continue; } r -= 2 * I_QKV;
        if (r < 2 * I_O) { const int j = r / I_O; transpose_item(P.w_o + (size_t)j * D * D, D, D, WO + (size_t)j * D * D, 0, nullptr, nullptr, scr, r % I_O, lane); continue; } r -= 2 * I_O;
        if (r < 4 * I_UP) { const int j = r / I_UP; transpose_item(P.w_up + (size_t)j * D * FF, D, FF, WUP + (size_t)j * D * FF, 0, nullptr, P.norm_mlp + j * D, scr, r % I_UP, lane); continue; } r -= 4 * I_UP;
        { const int j = r / I_DN; transpose_item(P.w_down + (size_t)j * D * FF, FF, D, WDN + (size_t)j * D * FF, 0, nullptr, nullptr, scr, r % I_DN, lane); }
    }
}

__device__ __forceinline__ void norm_rows_f32_inplace(float* x, const float* gain, int nrows, int gw, int NGW, int lane) {
    f32x4 g[4];
#pragma unroll
    for (int j = 0; j < 4; ++j) g[j] = *((const f32x4*)gain + lane + 64 * j);
    for (int m = gw * 4; m < nrows; m += NGW * 4) {
        GAS f32x4* xr = (GAS f32x4*)(x + (size_t)m * D) + lane;
        f32x4 v[4][4];
#pragma unroll
        for (int r = 0; r < 4; ++r)
#pragma unroll
            for (int j = 0; j < 4; ++j) v[r][j] = xr[r * 256 + 64 * j];
        __builtin_amdgcn_sched_barrier(0);
#pragma unroll
        for (int r = 0; r < 4; ++r) { float s = 0.f;
#pragma unroll
            for (int j = 0; j < 4; ++j) s += (v[r][j].x * v[r][j].x + v[r][j].y * v[r][j].y) + (v[r][j].z * v[r][j].z + v[r][j].w * v[r][j].w);
            const float rr = 1.0f / sqrtf(wave_sum(s) * (1.f / D) + RMS_EPS);
#pragma unroll
            for (int j = 0; j < 4; ++j) xr[r * 256 + 64 * j] = v[r][j] * rr * g[j]; }
    }
}

constexpr int PT = 32, PROWS = 48;
typedef float f32x2v __attribute__((ext_vector_type(2)));
__device__ __forceinline__ f32x2v bfpair(unsigned u) { return (f32x2v){__builtin_bit_cast(float, u << 16), __builtin_bit_cast(float, u & 0xffff0000u)}; }
struct f32x8 { f32x4 lo, hi; };
__device__ __forceinline__ f32x8 bf8(const v4u u) { f32x8 r; r.lo = (f32x4){__builtin_bit_cast(float, u.x << 16), __builtin_bit_cast(float, u.x & 0xffff0000u), __builtin_bit_cast(float, u.y << 16), __builtin_bit_cast(float, u.y & 0xffff0000u)};
    r.hi = (f32x4){__builtin_bit_cast(float, u.z << 16), __builtin_bit_cast(float, u.z & 0xffff0000u), __builtin_bit_cast(float, u.w << 16), __builtin_bit_cast(float, u.w & 0xffff0000u)}; return r; }
__device__ __forceinline__ v4u pack8(const f32x4 a, const f32x4 b) { v4u o; o.x = pk2(a[0], a[1]); o.y = pk2(a[2], a[3]); o.z = pk2(b[0], b[1]); o.w = pk2(b[2], b[3]); return o; }
template <int W> __device__ __forceinline__ void pool_rows_interior(const LAS v4u* hrow, GAS v4u* po) {
    constexpr int HW = W / 2; constexpr float INV = 1.0f / (float)W;
    f32x4 sl = {0.f, 0.f, 0.f, 0.f}, sh = {0.f, 0.f, 0.f, 0.f};
#pragma unroll
    for (int o = -HW; o < HW; ++o) { const f32x8 h = bf8(hrow[(8 + o) * 128]); sl += h.lo; sh += h.hi; }
    __builtin_amdgcn_sched_barrier(0);
#pragma unroll
    for (int i = 0; i < 8; ++i) {
        const f32x8 c = bf8(hrow[(8 + i) * 128]);
        po[(size_t)i * 32] = pack8(sl * INV - c.lo, sh * INV - c.hi);
        if (i + 1 < 8) { const f32x8 a = bf8(hrow[(8 + i + HW) * 128]), b = bf8(hrow[(8 + i - HW) * 128]); sl += a.lo - b.lo; sh += a.hi - b.hi; }
        __builtin_amdgcn_sched_barrier(0);
    }
}
__device__ __forceinline__ void pool_load_rows(f32x4 (&v)[6][4], const float* x, int m0, int seq_len, int wave, int lane) {
    const int sb = m0 / seq_len * seq_len, t0 = m0 - sb;
#pragma unroll
    for (int k = 0; k < 6; ++k) { const int t = min(max(t0 - 8 + wave + NWAVES * k, 0), seq_len - 1);
        const GAS f32x4* xr = (const GAS f32x4*)(x + (size_t)(sb + t) * D) + lane;
#pragma unroll
        for (int j = 0; j < 4; ++j) v[k][j] = xr[64 * j]; }
}
__device__ __forceinline__ void pool_phase(LAS unsigned char* lds, const float* x, const float* gain, bf16* Pg, int seq_len, int vcu, int G, int tid, int wave, int lane) {
    f32x4 v[6][4];
    if (vcu < CH / PT) pool_load_rows(v, x, vcu * PT, seq_len, wave, lane);
    for (int tile = vcu; tile < CH / PT; tile += G) {
        const int m0 = tile * PT;
        const int sb = m0 / seq_len * seq_len;
        const int t0 = m0 - sb;
        f32x4 g[4];
#pragma unroll
        for (int j = 0; j < 4; ++j) g[j] = *((const GAS f32x4*)gain + lane + 64 * j);
#pragma unroll
        for (int k = 0; k < 6; ++k) { float s = 0.f;
#pragma unroll
            for (int j = 0; j < 4; ++j) s += (v[k][j].x * v[k][j].x + v[k][j].y * v[k][j].y) + (v[k][j].z * v[k][j].z + v[k][j].w * v[k][j].w);
            const float r = 1.0f / sqrtf(wave_sum(s) * (1.f / D) + RMS_EPS);
            LAS v2u* hr = (LAS v2u*)(lds + (wave + NWAVES * k) * 2048) + lane;
#pragma unroll
            for (int j = 0; j < 4; ++j) { v2u o; o.x = pk2(v[k][j].x * r * g[j].x, v[k][j].y * r * g[j].y); o.y = pk2(v[k][j].z * r * g[j].z, v[k][j].w * r * g[j].w); hr[64 * j] = o; } }
        __syncthreads();
        if (tile + G < CH / PT) { pool_load_rows(v, x, (tile + G) * PT, seq_len, wave, lane); __builtin_amdgcn_sched_barrier(0); }
        {
            const int pg = wave & 3, part = (lane >> 5) + 2 * (wave >> 2), oc = lane & 31, pw = 2 << pg, phw = pw >> 1;
            const LAS v4u* hrow = (const LAS v4u*)(lds + (8 * part) * 2048 + pg * 512 + oc * 16);
            GAS v4u* po = (GAS v4u*)(Pg + ((size_t)pg * CH + m0 + 8 * part) * 256 + oc * 8);
            if (t0 >= 8 && t0 + PT + 8 <= seq_len) {
                switch (pg) { case 0: pool_rows_interior<2>(hrow, po); break; case 1: pool_rows_interior<4>(hrow, po); break; case 2: pool_rows_interior<8>(hrow, po); break; default: pool_rows_interior<16>(hrow, po); break; }
            } else {
                for (int i = 0; i < 8; ++i) {
                    const int t = t0 + 8 * part + i;
                    const int lo = max(t - phw, 0), hi = min(t + phw - 1, seq_len - 1);
                    f32x4 sl = {0.f, 0.f, 0.f, 0.f}, sh = {0.f, 0.f, 0.f, 0.f};
                    for (int q = lo; q <= hi; ++q) { const f32x8 h = bf8(hrow[(8 + q - t + i) * 128]); sl += h.lo; sh += h.hi; }
                    const f32x8 c = bf8(hrow[(8 + i) * 128]);
                    const float inv = 1.0f / (float)(hi - lo + 1);
                    po[(size_t)i * 32] = pack8(sl * inv - c.lo, sh * inv - c.hi);
                }
            }
        }
        __syncthreads();
    }
}

#define RLX_AGENT __ATOMIC_RELAXED, __HIP_MEMORY_SCOPE_AGENT
#define XB_TMO      128
#define XB_XCNT(j)  (256  + 64 * (j))
#define XB_XSUB(j)  (1280 + 64 * (j))
#define XB_XGEN(j)  (2304 + 64 * (j))
#define XB_TOP      3328
#define XB_TOPGEN   3392
#define XCD_BAR_WORDS 3456
#define XB_SPIN_CAP (1u << 18)

__device__ __forceinline__ unsigned xb_ld(unsigned* p)              { return __hip_atomic_load(p, __ATOMIC_RELAXED, __HIP_MEMORY_SCOPE_AGENT); }
__device__ __forceinline__ unsigned xb_add(unsigned* p, unsigned v) { return __hip_atomic_fetch_add(p, v, __ATOMIC_RELAXED, __HIP_MEMORY_SCOPE_AGENT); }
__device__ __forceinline__ unsigned xb_xcc_id() { return (unsigned)__builtin_amdgcn_s_getreg((3 << 11) | 20) & 0xFu; }
#define XB_SPIN(cond, bar) do { unsigned _sp = 0; while (cond) { __builtin_amdgcn_s_sleep(1); \
    if ((++_sp & 255u) == 0u) { if (xb_ld(&(bar)[XB_TMO])) break; if (_sp > XB_SPIN_CAP) { atomicAdd(&(bar)[XB_TMO], 1u); break; } } } } while (0)

struct XcdBarrier {
    unsigned* bar; unsigned x;
    volatile LAS unsigned* st;
};

__device__ __forceinline__ XcdBarrier xcd_barrier_post(unsigned* bar, volatile LAS unsigned* st) {
    XcdBarrier b; b.bar = bar; b.x = xb_xcc_id(); b.st = st;
    if (threadIdx.x == 0) (void)xb_add(&bar[XB_XCNT(b.x)], 1u);
    return b;
}
__device__ __forceinline__ void xcd_barrier_complete(unsigned* bar, unsigned x, unsigned& nloc, unsigned& nx) {
    const unsigned G = gridDim.x * gridDim.y * gridDim.z;
    unsigned sum, cnt, mine, sp = 0u;
    for (;;) {
        sum = 0u; cnt = 0u; mine = 0u;
#pragma unroll
        for (unsigned j = 0; j < 16; ++j) { const unsigned c = xb_ld(&bar[XB_XCNT(j)]); sum += c; cnt += (c > 0u) ? 1u : 0u; mine = (j == x) ? c : mine; }
        if (sum == G) break;
        __builtin_amdgcn_s_sleep(1);
        if ((++sp & 255u) == 0u) { if (xb_ld(&bar[XB_TMO])) break; if (sp > XB_SPIN_CAP) { atomicAdd(&bar[XB_TMO], 1u); break; } }
    }
    nloc = mine > 0u ? mine : 1u; nx = cnt > 0u ? cnt : 1u;
}

__device__ __forceinline__ void xcd_barrier(const XcdBarrier& b) {
    asm volatile("s_waitcnt vmcnt(0)" ::: "memory");
    __syncthreads();
    if (threadIdx.x == 0) {
        unsigned* bar = b.bar;
        __builtin_amdgcn_s_waitcnt(0);
        unsigned nloc = b.st[0], nx = b.st[1];
        if (nloc == 0u) { xcd_barrier_complete(bar, b.x, nloc, nx); b.st[0] = nloc; b.st[1] = nx; }
        const unsigned old = xb_add(&bar[XB_XSUB(b.x)], 1u);
        const unsigned gen = old / nloc;
        if (old + 1u == (gen + 1u) * nloc) {
            __builtin_amdgcn_fence(__ATOMIC_RELEASE, "agent");
            asm volatile("s_waitcnt vmcnt(0)" ::: "memory");
            const unsigned og = xb_add(&bar[XB_TOP], 1u);
            const unsigned tg = og / nx;
            if (og + 1u == (tg + 1u) * nx) xb_add(&bar[XB_TOPGEN], 1u);
            else XB_SPIN(xb_ld(&bar[XB_TOPGEN]) == tg, bar);
            __builtin_amdgcn_fence(__ATOMIC_ACQUIRE, "agent");
            xb_add(&bar[XB_XGEN(b.x)], 1u);
            asm volatile("s_waitcnt vmcnt(0)" ::: "memory");
        } else {
            XB_SPIN(xb_ld(&bar[XB_XGEN(b.x)]) == gen, bar);
            __builtin_amdgcn_fence(__ATOMIC_ACQUIRE, "agent");
            asm volatile("s_waitcnt vmcnt(0)" ::: "memory");
        }
    }
    __syncthreads();
}


__device__ __forceinline__ unsigned cvtpk(float lo, float hi) { return pk2(lo, hi); }
__device__ __forceinline__ s16x4 vtr(const LAS unsigned char* p) { return __builtin_bit_cast(s16x4, __builtin_amdgcn_ds_read_tr16_b64_v4i16((LAS s16x4*)p)); }
__device__ __forceinline__ void attn_phase(LAS unsigned char* lds, bf16* Qb, const bf16* Kb, const bf16* Vb, const float* rpb_l, int seq_len, int G, int bx, int tid, int wave, int lane) {
    const int fr = lane & 15, fq = lane >> 4;
    const int rows = seq_len >> 6, rows_shift = (seq_len == 2048) ? 5 : 6;
    constexpr int NI = (CH / 64) * 8;
    int nx, xc, lc, per;
    if ((G & 7) == 0) { nx = G >> 3; xc = bx & 7; lc = bx >> 3; per = NI >> 3; } else { nx = G; xc = 0; lc = bx; per = NI; }
    LAS float* bias = (LAS float*)(lds + BIAS_OFF);
    const int qb = wave & 3, hh = wave >> 2;
    const int qc = (qb < 3) ? (8 + 16 * qb + fr) : (fr < 8 ? fr : 48 + fr);
    const int a0 = (qb < 3) ? qb : 0, a1 = (qb < 3) ? qb + 1 : 3;
    const int wst = min(max(qc - 8, 0), 48);
    const int q4 = (lane & 15) >> 2, p4 = lane & 3;
    bool sel[4];
#pragma unroll
    for (int i = 0; i < 4; ++i) sel[i] = (qb < 3) ? (4 * fq + i >= fr) : (fr < 8);
    int voff[4];
#pragma unroll
    for (int i3 = 0; i3 < 4; ++i3) voff[i3] = (lane >> 4) * D + (((lane & 15) ^ (((lane >> 4) << 2) | i3)) * 8);
    if (lc >= per) return;
    int id = xc * per + lc;
    int r = id & (rows - 1), hp = (id >> rows_shift) & 7, tb = (id >> (rows_shift + 3)) * seq_len, r0 = min(max(r - 4, 0), rows - 8);
    bf16x8 qf0, qf1, kf[4][2][2];
    float bnext[2];
#define ATT_PREFETCH() do { \
        const int h_ = 2 * hp + hh; const size_t qo_ = (size_t)(tb + r * 64 + qc) * D + h_ * 64; \
        qf0 = *(const GAS bf16x8*)(Qb + qo_ + 8 * fq); qf1 = *(const GAS bf16x8*)(Qb + qo_ + 32 + 8 * fq); \
        const bf16* kb_ = Kb + ((size_t)(h_ * 8 + fq) * CH + (tb + r0 * 64 + fr)) * 8; \
        _Pragma("unroll") for (int kr = 0; kr < 4; ++kr) _Pragma("unroll") for (int ai = 0; ai < 2; ++ai) { const bf16* kp = kb_ + (kr * 64 + 16 * (ai ? a1 : a0)) * 8; kf[kr][ai][0] = *(const GAS bf16x8*)kp; kf[kr][ai][1] = *(const GAS bf16x8*)(kp + (size_t)4 * CH * 8); } \
        bnext[0] = rpb_l[hp * 930 + tid] * LOG2E; bnext[1] = (tid + 512 < 930) ? rpb_l[hp * 930 + tid + 512] * LOG2E : 0.f; } while (0)
#define ATT_BIAS_WRITE() do { bias[tid] = bnext[0]; if (tid + 512 < 930) bias[tid + 512] = bnext[1]; } while (0)
    ATT_PREFETCH();
    ATT_BIAS_WRITE();
    for (int loc = lc; loc < per; loc += nx) {
        const int h = 2 * hp + hh;
        const size_t qoff = (size_t)(tb + r * 64 + qc) * D + h * 64;
        const bf16* kbase = Kb + ((size_t)(h * 8 + fq) * CH + (tb + r0 * 64 + fr)) * 8;
        const int drb = r0 - r + 7;
        __syncthreads();
        {
            const int a = wave >> 1, ub = (wave & 1) * 2;
#pragma unroll
            for (int i = 0; i < 16; ++i) { const int kr = 2 * (ub + (i >> 3)) + (i & 1), cb = 16 * a + 4 * ((i & 7) >> 1);
                const bf16* src = Vb + (size_t)(tb + (r0 + kr) * 64 + cb) * D + hp * 128 + voff[i & 3];
                __builtin_amdgcn_global_load_lds((const unsigned*)src, (LAS unsigned*)(lds + (wave * 16 + i) * 1024), 16, 0, 0); }
        }
        f32x4 S[8];
        float mx = -3.0e38f;
        const LAS float* bptr[4];
#pragma unroll
        for (int i = 0; i < 4; ++i) { const int kc = 16 * (sel[i] ? a0 : a1) + 4 * fq + i; bptr[i] = bias + hh * 465 + drb * 31 + min(max(kc - qc + 15, 0), 30); }
#pragma unroll
        for (int kr = 0; kr < 8; ++kr) {
            f32x4 z0 = {0.f, 0.f, 0.f, 0.f}, z1 = {0.f, 0.f, 0.f, 0.f};
            z0 = __builtin_amdgcn_mfma_f32_16x16x32_bf16(kf[kr & 3][0][0], qf0, z0, 0, 0, 0);
            z0 = __builtin_amdgcn_mfma_f32_16x16x32_bf16(kf[kr & 3][0][1], qf1, z0, 0, 0, 0);
            z1 = __builtin_amdgcn_mfma_f32_16x16x32_bf16(kf[kr & 3][1][0], qf0, z1, 0, 0, 0);
            z1 = __builtin_amdgcn_mfma_f32_16x16x32_bf16(kf[kr & 3][1][1], qf1, z1, 0, 0, 0);
            f32x4 z;
#pragma unroll
            for (int i = 0; i < 4; ++i) { z[i] = (sel[i] ? z0[i] : z1[i]) + bptr[i][kr * 31]; mx = fmaxf(mx, z[i]); }
            S[kr] = z;
            if (kr < 4) {
#pragma unroll
                for (int ai = 0; ai < 2; ++ai) { const bf16* kp = kbase + ((kr + 4) * 64 + 16 * (ai ? a1 : a0)) * 8; kf[kr & 3][ai][0] = *(const GAS bf16x8*)kp; kf[kr & 3][ai][1] = *(const GAS bf16x8*)(kp + (size_t)4 * CH * 8); }
            }
        }
        mx = fmaxf(mx, __shfl_xor(mx, 16)); mx = fmaxf(mx, __shfl_xor(mx, 32));
        float sum = 0.f;
#pragma unroll
        for (int kr = 0; kr < 8; ++kr)
#pragma unroll
            for (int i = 0; i < 4; ++i) { const float p = __builtin_amdgcn_exp2f(S[kr][i] - mx); S[kr][i] = p; sum += p; }
        sum += __shfl_xor(sum, 16); sum += __shfl_xor(sum, 32);
        bf16x8 pf[4][2];
#pragma unroll
        for (int u = 0; u < 4; ++u)
#pragma unroll
            for (int ai = 0; ai < 2; ++ai) {
                float pa[2][4];
#pragma unroll
                for (int t = 0; t < 2; ++t)
#pragma unroll
                    for (int i = 0; i < 4; ++i) pa[t][i] = (sel[i] == (ai == 0)) ? S[2 * u + t][i] : 0.f;
                v4u pw; pw.x = cvtpk(pa[0][0], pa[0][1]); pw.y = cvtpk(pa[0][2], pa[0][3]); pw.z = cvtpk(pa[1][0], pa[1][1]); pw.w = cvtpk(pa[1][2], pa[1][3]);
                pf[u][ai] = __builtin_bit_cast(bf16x8, pw); }
        asm volatile("s_waitcnt vmcnt(0)" ::: "memory");
        __syncthreads();
        const int nloc = loc + nx; const bool has_next = nloc < per;
        const int r_cur = r, tb_cur = tb;
        if (has_next) { id = xc * per + nloc; r = id & (rows - 1); hp = (id >> rows_shift) & 7; tb = (id >> (rows_shift + 3)) * seq_len; r0 = min(max(r - 4, 0), rows - 8); ATT_PREFETCH(); }
        (void)r_cur; (void)tb_cur;
        f32x4 O[4];
#pragma unroll
        for (int c = 0; c < 4; ++c) O[c] = (f32x4){0.f, 0.f, 0.f, 0.f};
        const LAS unsigned char* vb[2][2][4];
#pragma unroll
        for (int ai = 0; ai < 2; ++ai)
#pragma unroll
            for (int t = 0; t < 2; ++t)
#pragma unroll
                for (int c = 0; c < 4; ++c) { const int rho = 8 * fq + 4 * t + q4, chn = 2 * (4 * hh + c) + (p4 >> 1);
                    vb[ai][t][c] = lds + (ai ? a1 : a0) * 32768 + 256 * rho + 16 * (chn ^ (((rho & 3) << 2) | ((rho >> 2) & 3))) + 8 * (p4 & 1); }
#pragma unroll
        for (int u = 0; u < 4; ++u) {
#pragma unroll
            for (int ai = 0; ai < 2; ++ai) {
#pragma unroll
                for (int c = 0; c < 4; ++c) {
                    const s16x4 v0 = vtr(vb[ai][0][c] + u * 8192), v1 = vtr(vb[ai][1][c] + u * 8192);
                    const bf16x8 vf = __builtin_shufflevector(v0, v1, 0, 1, 2, 3, 4, 5, 6, 7);
                    O[c] = __builtin_amdgcn_mfma_f32_16x16x32_bf16(vf, pf[u][ai], O[c], 0, 0, 0);
                }
            }
        }
        const float inv = 1.0f / sum;
#pragma unroll
        for (int c = 0; c < 4; ++c) { v2u w; w.x = cvtpk(O[c][0] * inv, O[c][1] * inv); w.y = cvtpk(O[c][2] * inv, O[c][3] * inv);
            *(GAS v2u*)(Qb + qoff + 16 * c + 4 * fq) = w; }
        if (has_next) ATT_BIAS_WRITE();
    }
    __syncthreads();
#undef ATT_PREFETCH
#undef ATT_BIAS_WRITE
}
enum { K_POOL = 1, K_GEMM_RES = 3, K_GEMM_QKV = 4, K_GEMM_UP = 5, K_ATTN = 6, K_FINAL = 7 };
enum { F_A_X = 1, F_A_IN = 2, F_AUX_X = 4, F_AUX_IN = 8 };
struct Ph { int kind, flags, N, K; const void* A; const void* B; void* C; const void* aux; float* st; float* rs; unsigned long long a_pn_stride, pad; };
constexpr int PPC = 19;
struct Args { Ptrs p; Ph tab[PPC]; };
__global__ void __launch_bounds__(NWAVES * 64, 2) fwd_megakernel(Args args) {
    extern __shared__ __attribute__((aligned(16))) unsigned char lds_raw[];
    cg::grid_group grid = cg::this_grid();
    LAS unsigned char* lds = (LAS unsigned char*)lds_raw;
    volatile LAS unsigned* MISC = (volatile LAS unsigned*)(lds + MISC_OFF);
    for (int u = threadIdx.x; u < 32; u += NWAVES * 64) MISC[u] = 0u;
    __syncthreads();
    const XcdBarrier bar = xcd_barrier_post((unsigned*)(args.p.ws + WS_CTL), MISC + 8);
    {
        const int tid = threadIdx.x, lane = tid & 63, wave = __builtin_amdgcn_readfirstlane(tid >> 6);
        const int G = gridDim.x, bx = blockIdx.x;
        const int vcu = (G % 8 == 0) ? (bx % 8) * (G / 8) + bx / 8 : bx;
        prologue(args.p, lds, vcu * NWAVES + wave, G * NWAVES, wave, lane);
    }
    grid.sync();

    for (int ph = 0; ph < NCHUNK * PPC; ++ph) {
        int tid = threadIdx.x; asm volatile("" : "+v"(tid));
        int G = gridDim.x, bx = blockIdx.x; asm volatile("" : "+s"(G), "+s"(bx));
        const int lane = tid & 63, wave = __builtin_amdgcn_readfirstlane(tid >> 6);
        const int vcu = (G % 8 == 0) ? (bx % 8) * (G / 8) + bx / 8 : bx;
        const int gw = vcu * NWAVES + wave, NGW = G * NWAVES;
        const int ck = ph / PPC, idx = ph - ck * PPC;
        const Ph d = args.tab[idx];
        const int tok0 = ck * CH, grp = tok0 / GROUP_TOK, seq_len = grp ? 4096 : 2048;
        const float* xin = args.p.x_in[grp] + (size_t)(tok0 - grp * GROUP_TOK) * D;
        float* X = args.p.out + (size_t)tok0 * D;
        const void* A = (d.flags & F_A_X) ? (const void*)X : (d.flags & F_A_IN) ? (const void*)xin : d.A;
        const void* aux = (d.flags & F_AUX_X) ? (const void*)X : (d.flags & F_AUX_IN) ? (const void*)xin : d.aux;
#define KIND_IS(x) ([&]() { int kd_ = d.kind; asm volatile("" : "+s"(kd_)); return kd_ == (x); }())
        if (0) {}
        else if (KIND_IS(K_POOL)) { { int tid2 = threadIdx.x; asm volatile("" : "+v"(tid2));
            pool_phase(lds, (const float*)A, (const float*)aux, (bf16*)d.C, seq_len, vcu, G, tid2, __builtin_amdgcn_readfirstlane(tid2 >> 6), tid2 & 63); } }
        else if (KIND_IS(K_GEMM_RES)) { pg8::Gemm g{(const bf16*)A, (const bf16*)d.B, CH, d.N, d.K, (size_t)d.a_pn_stride, d.K == FF  }; pg8::StaticOrder S; S.init(CH, d.N, G, bx);
            pg8::EpiRes E{(const float*)aux, X, (bf16*)d.C, d.st, D, d.rs};
            pg8::gemm_phase<pg8::EpiRes, pg8::StaticOrder, false, PG8_SP2>(lds, g, S, E, tid); }
        else if (KIND_IS(K_GEMM_QKV)) { pg8::Gemm g{(const bf16*)A, (const bf16*)d.B, CH, d.N, d.K, 0, 1  }; pg8::StaticOrder S; S.init(CH, d.N, G, bx);
            pg8::EpiBf16<0, true> E{(bf16*)d.C, D, D, (size_t)CH * D, 0.125f * LOG2E, d.st, 0};
            pg8::gemm_phase<pg8::EpiBf16<0, true>, pg8::StaticOrder, PG8_ALIGN, PG8_SP2>(lds, g, S, E, tid); }
        else if (KIND_IS(K_GEMM_UP)) { pg8::Gemm g{(const bf16*)A, (const bf16*)d.B, CH, d.N, d.K, 0, 1  }; pg8::StaticOrder S; S.init(CH, d.N, G, bx);
            pg8::EpiBf16<2, false> E{(bf16*)d.C, FF, 0, 0, 1.f, nullptr, 1};
            pg8::gemm_phase<pg8::EpiBf16<2, false>, pg8::StaticOrder, PG8_ALIGN, PG8_SP2>(lds, g, S, E, tid); }
        else if (KIND_IS(K_ATTN)) { attn_phase(lds, (bf16*)d.C, (const bf16*)d.C + (size_t)CH * D, (const bf16*)d.C + 2 * (size_t)CH * D, (const float*)aux, seq_len, G, bx, tid, wave, lane); }
        else { norm_rows_f32_inplace(X, (const float*)aux, CH, gw, NGW, lane); }
#undef KIND_IS
        if (d.kind != K_FINAL) xcd_barrier(bar);
    }
}

extern "C" void kernel_launch(void* const* d_in, const int* in_sizes, int n_in, void* d_out, int out_size, void* d_ws, size_t ws_size, hipStream_t stream) {
    static int grid = 0;
    if (grid == 0) {
        if (n_in != 12 || in_sizes[0] != GROUP_TOK * D || in_sizes[1] != GROUP_TOK * D || out_size != NTOK * D || ws_size < WS_END) {
            fprintf(stderr, "kernel_launch: unexpected shapes (n_in %d, out %d, ws %zu < %zu); nothing launched\n", n_in, out_size, ws_size, (size_t)WS_END); grid = -1; return; }
        int dev = 0, cus = 0, per_cu = 0;
        if (hipGetDevice(&dev) != hipSuccess || hipDeviceGetAttribute(&cus, hipDeviceAttributeMultiprocessorCount, dev) != hipSuccess) { fprintf(stderr, "kernel_launch: device query failed\n"); grid = -1; return; }
        if (hipFuncSetAttribute((const void*)fwd_megakernel, hipFuncAttributeMaxDynamicSharedMemorySize, LDS_BYTES) != hipSuccess) { fprintf(stderr, "kernel_launch: hipFuncSetAttribute failed\n"); grid = -1; return; }
        if (hipOccupancyMaxActiveBlocksPerMultiprocessor(&per_cu, (const void*)fwd_megakernel, NWAVES * 64, LDS_BYTES) != hipSuccess || per_cu < 1) { fprintf(stderr, "kernel_launch: occupancy query gave %d\n", per_cu); per_cu = 1; }
        (void)hipGetLastError();
        grid = cus * per_cu;
    }
    if (grid < 0) return;
    if (hipMemsetAsync((char*)d_ws + WS_CTL, 0, CTL_ZERO_BYTES, stream) != hipSuccess) { fprintf(stderr, "kernel_launch: hipMemsetAsync failed\n"); return; }
    Args a{};
    Ptrs& p = a.p;
    p.x_in[0] = (const float*)d_in[0]; p.x_in[1] = (const float*)d_in[1]; p.norm_mix = (const float*)d_in[2]; p.pool_w = (const float*)d_in[3]; p.pool_scale = (const float*)d_in[4];
    p.w_qkv = (const float*)d_in[5]; p.rpb = (const float*)d_in[6]; p.w_o = (const float*)d_in[7]; p.norm_mlp = (const float*)d_in[8]; p.w_up = (const float*)d_in[9];
    p.w_down = (const float*)d_in[10]; p.norm_final = (const float*)d_in[11]; p.out = (float*)d_out; p.ws = (unsigned char*)d_ws;
    unsigned char* ws = (unsigned char*)d_ws;
    bf16* WPOOL = (bf16*)(ws + WS_WPOOL); bf16* WQKV = (bf16*)(ws + WS_WQKV); bf16* WO = (bf16*)(ws + WS_WO); bf16* WUP = (bf16*)(ws + WS_WUP); bf16* WDN = (bf16*)(ws + WS_WDN);
    bf16* XN = (bf16*)(ws + WS_XN); bf16* PG = (bf16*)(ws + WS_PG); bf16* QB = (bf16*)(ws + WS_ACT); bf16* HB = (bf16*)(ws + WS_ACT);
    float* SA = (float*)(ws + WS_STAT); float* SB = SA + (size_t)CH * 16;
    int n = 0;
    auto add = [&](int kind, int flags, int N, int K, const void* A, const void* B, void* C, const void* aux, float* st, float* rs, unsigned long long aps) {
        Ph& d = a.tab[n++]; d.kind = kind; d.flags = flags; d.N = N; d.K = K; d.A = A; d.B = B; d.C = C; d.aux = aux; d.st = st; d.rs = rs; d.a_pn_stride = aps; d.pad = 0; };
    for (int layer = 0; layer < DEPTH; ++layer) {
        const int j = layer >> 1;
        if ((layer & 1) == 0) {
            add(K_POOL, layer == 0 ? F_A_IN : F_A_X, 0, 0, nullptr, nullptr, PG, p.norm_mix + layer * D, nullptr, nullptr, 0);
            add(K_GEMM_RES, layer == 0 ? F_AUX_IN : F_AUX_X, D, 256, PG, WPOOL + (size_t)j * 1024 * 256, XN, nullptr, SA, nullptr, (unsigned long long)CH * 256 * 2);
        } else {
            add(K_GEMM_QKV, 0, 3 * D, D, XN, WQKV + (size_t)j * 3 * D * D, QB, nullptr, SB, nullptr, 0);
            add(K_ATTN, 0, 0, 0, nullptr, nullptr, QB, p.rpb + (size_t)j * NH * 15 * 31, nullptr, nullptr, 0);
            add(K_GEMM_RES, F_AUX_X, D, D, QB, WO + (size_t)j * D * D, XN, nullptr, SA, nullptr, 0);
        }
        add(K_GEMM_UP, 0, FF, D, XN, WUP + (size_t)layer * D * FF, HB, nullptr, SA, nullptr, 0);
        add(K_GEMM_RES, F_AUX_X, D, FF, HB, WDN + (size_t)layer * D * FF, (layer & 1) == 0 ? XN : nullptr, nullptr, SB, SA, 0);
    }
    add(K_FINAL, 0, 0, 0, nullptr, nullptr, nullptr, p.norm_final, nullptr, nullptr, 0);
    if (n != PPC) { fprintf(stderr, "kernel_launch: phase table has %d entries, expected %d\n", n, PPC); return; }
    void* kargs[] = {&a};
    hipError_t e = hipLaunchCooperativeKernel((const void*)fwd_megakernel, dim3(grid), dim3(NWAVES * 64), kargs, LDS_BYTES, stream);
    if (e != hipSuccess) fprintf(stderr, "kernel_launch: cooperative launch failed: %s (grid %d)\n", hipGetErrorString(e), grid);
}
```

```cpp
#include <hip/hip_runtime.h>
#include <hip/hip_cooperative_groups.h>
#include <cstdio>
#include <cstdint>
namespace cg = cooperative_groups;
namespace pg8 {
#define PG8_LAS __attribute__((address_space(3)))
typedef unsigned short bf16_t;
typedef short bf16x8 __attribute__((ext_vector_type(8)));
typedef float f32x4 __attribute__((ext_vector_type(4)));
typedef unsigned u32x4 __attribute__((ext_vector_type(4)));
constexpr int BM = 256, BK = 64, HALF = 128, HTB = HALF * BK * 2  , STAGE_BYTES = 8 * HTB, NXCD = 8, WGM = 8;

__host__ __device__ __forceinline__ int lds_byte(int r, int c) { const int st = (r >> 4) * 2 + (c >> 5), rr = r & 15, cc = c & 31, ob = rr * 64 + cc * 2; return st * 1024 + (ob ^ (((ob >> 9) & 1) << 5)); }
__host__ __device__ __forceinline__ void stage_rc(int b, int& R, int& C) { const int st = b / 1024, sb = b % 1024, swz = sb ^ (((sb >> 9) & 1) << 5); R = (st >> 1) * 16 + swz / 64; C = (st & 1) * 32 + (swz % 64) / 2; }
__host__ __device__ __forceinline__ int perm32(int rho) { const int n = rho >> 4, i = rho & 15; return 8 * (i >> 2) + 4 * n + (i & 3); }

struct Unit { int pm, pn; };
struct Gemm { const bf16_t* A; const bf16_t* Bt; int M, N, K; size_t a_pn_stride; int a_tiled; };

struct StaticOrder {
    int nM, nN, nwg, G, c;
    __host__ __device__ void init(int M, int N, int G_, int c_) { nM = M / BM; nN = N / BM; nwg = nM * nN; G = G_; c = c_; }
    __host__ __device__ bool next(int i, Unit& u) const {
        const long L = (long)i * G + c; if (L >= nwg) return false;
        int wgid = (int)L; { const int q = nwg / NXCD, r = nwg % NXCD, xcd = wgid % NXCD, off = wgid / NXCD; wgid = (xcd < r ? xcd * (q + 1) : r * (q + 1) + (xcd - r) * q) + off; }
        const int nig = WGM * nN, gid = wgid / nig, fm = gid * WGM, gsz = (nM - fm) < WGM ? (nM - fm) : WGM;
        u.pm = fm + ((wgid % nig) % gsz); u.pn = (wgid % nig) / gsz; return true;
    }
    __device__ __forceinline__ void a_ready(const Unit&) const {}
    __device__ __forceinline__ void done(const Unit&) const {}
};

__device__ __forceinline__ unsigned cvt_pk_bf16(float lo, float hi) { unsigned r; asm volatile("v_cvt_pk_bf16_f32 %0, %1, %2" : "=v"(r) : "v"(lo), "v"(hi)); return r; }
typedef float f32x2 __attribute__((ext_vector_type(2)));
template <int ACT, bool RS> struct EpiBf16 {
    static constexpr bool PERM = true, AFTER_DRAIN = false;
    bf16_t* O; int ldc; int split_cols; size_t split_stride; float scale0; const float* st; int tiled;
    __device__ __forceinline__ void operator()(const f32x4 (&acc)[2][2][4][2], const Unit& u, int wr, int wc, int fr, int fq) const {
        const int row0 = u.pm * BM + wr * 64 + fr; int colt = u.pn * BM; bf16_t* base = O;
        float sc = 1.f; bool kplane = false;
        if (split_cols) { const int t = colt / split_cols; base += (size_t)t * split_stride; colt -= t * split_cols; if (t == 0) sc = scale0; kplane = (t == 1); }
        const size_t kprows = split_stride / 1024;
        const int col0 = colt + wc * 32 + 8 * fq;
        f32x4 pv[2][4];
        if (RS) {
#pragma unroll
            for (int ai = 0; ai < 2; ++ai)
#pragma unroll
                for (int m = 0; m < 4; ++m) pv[ai][m] = *(const f32x4*)(st + (size_t)(row0 + ai * HALF + m * 16) * 16 + 4 * fq);
            __builtin_amdgcn_sched_barrier(0);
        }
#pragma unroll
        for (int ai = 0; ai < 2; ++ai)
#pragma unroll
            for (int m = 0; m < 4; ++m) { const int row = row0 + ai * HALF + m * 16; bf16_t* rowp = base + (size_t)row * ldc + col0;
                float f = sc;
                if (RS) { float ss = (pv[ai][m][0] + pv[ai][m][1]) + (pv[ai][m][2] + pv[ai][m][3]); ss += __shfl_xor(ss, 16); ss += __shfl_xor(ss, 32);
                    const float r = __builtin_amdgcn_rsqf(ss * (1.0f / 1024.0f) + 1e-6f); f *= (ACT == 2) ? r * r : r; }
#pragma unroll
                for (int bj = 0; bj < 2; ++bj) { f32x4 v0 = acc[ai][bj][m][0], v1 = acc[ai][bj][m][1];
                    if (ACT == 2) {
#pragma unroll
                        for (int e = 0; e < 4; ++e) { const float a = fmaxf(v0[e], 0.f), b = fmaxf(v1[e], 0.f); v0[e] = a * a; v1[e] = b * b; } }
                    v0 = v0 * f; v1 = v1 * f; u32x4 w; w.x = cvt_pk_bf16(v0[0], v0[1]); w.y = cvt_pk_bf16(v0[2], v0[3]); w.z = cvt_pk_bf16(v1[0], v1[1]); w.w = cvt_pk_bf16(v1[2], v1[3]);
                    if (kplane) *(u32x4*)(base + ((size_t)(((colt >> 6) + 2 * bj + (wc >> 1)) * 8 + (wc & 1) * 4 + fq) * kprows + row) * 8) = w;
                    else if (tiled) { const int r_ = row & 255, c_ = col0 + bj * HALF;
                        *(u32x4*)((char*)base + ((size_t)(((row >> 8) * 2 + (r_ >> 7)) * (ldc >> 6) + (c_ >> 6)) << 14) + lds_byte(r_ & 127, c_ & 63)) = w; }
                    else *(u32x4*)(rowp + bj * HALF) = w; } }
    }
};
struct EpiRes {
    static constexpr bool PERM = true, AFTER_DRAIN = false;
    const float* base; float* out; bf16_t* xn; float* st; int ldc; const float* rs; const bf16_t* b16;
    __device__ __forceinline__ void operator()(const f32x4 (&acc)[2][2][4][2], const Unit& u, int wr, int wc, int fr, int fq) const {
        const int col0 = u.pn * BM + wc * 32 + 8 * fq;
#pragma unroll
        for (int ai = 0; ai < 2; ++ai) {
            f32x4 rp[4];
            if (rs) {
#pragma unroll
                for (int m = 0; m < 4; ++m) rp[m] = *(const f32x4*)(rs + (size_t)(u.pm * BM + ai * HALF + wr * 64 + m * 16 + fr) * 16 + 4 * fq);
            }
            f32x4 bs[4][2][2];
            if (b16) {
#pragma unroll
                for (int m = 0; m < 4; ++m)
#pragma unroll
                    for (int bj = 0; bj < 2; ++bj) { const int c_ = col0 + bj * HALF;
                        const u32x4 w = *(const u32x4*)((const char*)b16 + ((size_t)((u.pm * 2 + ai) * (ldc >> 6) + (c_ >> 6)) << 14) + lds_byte(wr * 64 + m * 16 + fr, c_ & 63));
                        bs[m][bj][0] = (f32x4){__builtin_bit_cast(float, w.x << 16), __builtin_bit_cast(float, w.x & 0xffff0000u), __builtin_bit_cast(float, w.y << 16), __builtin_bit_cast(float, w.y & 0xffff0000u)};
                        bs[m][bj][1] = (f32x4){__builtin_bit_cast(float, w.z << 16), __builtin_bit_cast(float, w.z & 0xffff0000u), __builtin_bit_cast(float, w.w << 16), __builtin_bit_cast(float, w.w & 0xffff0000u)}; }
            } else {
#pragma unroll
                for (int m = 0; m < 4; ++m) { const size_t off = (size_t)(u.pm * BM + ai * HALF + wr * 64 + m * 16 + fr) * ldc + col0;
#pragma unroll
                    for (int bj = 0; bj < 2; ++bj) { bs[m][bj][0] = *(const f32x4*)(base + off + bj * HALF); bs[m][bj][1] = *(const f32x4*)(base + off + bj * HALF + 4); } }
            }
            __builtin_amdgcn_sched_barrier(0);
#pragma unroll
            for (int m = 0; m < 4; ++m) { const int row = u.pm * BM + ai * HALF + wr * 64 + m * 16 + fr; const size_t off = (size_t)row * ldc + col0; float ss = 0.f;
                float f = 1.f;
                if (rs) { float q = (rp[m][0] + rp[m][1]) + (rp[m][2] + rp[m][3]); q += __shfl_xor(q, 16); q += __shfl_xor(q, 32); const float r = __builtin_amdgcn_rsqf(q * (1.0f / 1024.0f) + 1e-6f); f = r * r; }
#pragma unroll
                for (int bj = 0; bj < 2; ++bj) {
                    const f32x4 o0 = bs[m][bj][0] + acc[ai][bj][m][0] * f, o1 = bs[m][bj][1] + acc[ai][bj][m][1] * f;
                    if (out) { *(f32x4*)(out + off + bj * HALF) = o0; *(f32x4*)(out + off + bj * HALF + 4) = o1; }
                    if (xn) { u32x4 w; w.x = cvt_pk_bf16(o0[0], o0[1]); w.y = cvt_pk_bf16(o0[2], o0[3]); w.z = cvt_pk_bf16(o1[0], o1[1]); w.w = cvt_pk_bf16(o1[2], o1[3]);
                        { const int c_ = col0 + bj * HALF;
                          *(u32x4*)((char*)xn + ((size_t)((u.pm * 2 + ai) * (ldc >> 6) + (c_ >> 6)) << 14) + lds_byte(wr * 64 + m * 16 + fr, c_ & 63)) = w; }
                        ss += (o0[0] * o0[0] + o0[1] * o0[1]) + (o0[2] * o0[2] + o0[3] * o0[3]) + (o1[0] * o1[0] + o1[1] * o1[1]) + (o1[2] * o1[2] + o1[3] * o1[3]); } }
                if (xn) { ss += __shfl_xor(ss, 16); ss += __shfl_xor(ss, 32); if (fq == 0) st[(size_t)row * 16 + u.pn * 4 + wc] = ss; } }
        }
    }
};
template <class Epi, class Sched, bool ALIGN_EPI = false, bool SP2 = false>
__device__ __forceinline__ void gemm_phase(PG8_LAS unsigned char* lds, const Gemm g, const Sched& S, const Epi& E, const int tid_in) {
    const int tid = tid_in, wid = __builtin_amdgcn_readfirstlane(tid >> 6), lane = tid & 63, wr = wid >> 2, wc = wid & 3, fr = lane & 15, fq = lane >> 4;
    const int K = g.K, nt = K / BK;
    unsigned voffA[2], voffB[2];
#pragma unroll
    for (int i = 0; i < 2; ++i) { int R, C; stage_rc(tid * 16 + i * 8192, R, C); const int Rb = Epi::PERM ? ((R & ~31) + perm32(R & 31)) : R;
        voffA[i] = g.a_tiled ? (unsigned)(tid * 16 + i * 8192) : (unsigned)(R * K + C) * 2u; voffB[i] = (unsigned)(tid * 16 + i * 8192); (void)Rb; }
    const size_t kstep = (size_t)(BK * 2);
    const size_t hstep = (size_t)HALF * K * 2;
    const size_t tstep = 2 * hstep;
    const size_t kstepB = 16384, hstepB = (size_t)nt * 16384, tstepB = 2 * hstepB;
    const size_t kstepA = g.a_tiled ? (size_t)16384 : kstep, hstepA = g.a_tiled ? (size_t)nt * 16384 : hstep, tstepA = 2 * hstepA;
    const unsigned ldsw = (unsigned)wid * 1024u;
    const int aoff = lds_byte(wr * 64 + fr, fq * 8), boff = lds_byte(wc * 32 + fr, fq * 8);
#define PG8_SA(b, h) (((b) * 2 + (h)) * HTB)
#define PG8_SB(b, h) ((4 + (b) * 2 + (h)) * HTB)
#define PG8_STAGE(bufoff, gbase, voff) do { _Pragma("unroll") for (int _i = 0; _i < 2; ++_i) \
        __builtin_amdgcn_global_load_lds((const unsigned*)((const char*)(gbase) + (voff)[_i]), (PG8_LAS unsigned*)(lds + (bufoff) + ldsw + _i * 8192), 16, 0, 0); } while (0)
#define PG8_LDA(dst, b, h) do { _Pragma("unroll") for (int m = 0; m < 4; ++m) _Pragma("unroll") for (int k = 0; k < 2; ++k) dst[m][k] = *(const PG8_LAS bf16x8*)(lds + PG8_SA(b, h) + aoff + m * 2048 + k * 1024); } while (0)
#define PG8_LDB(dst, b, h) do { _Pragma("unroll") for (int n = 0; n < 2; ++n) _Pragma("unroll") for (int k = 0; k < 2; ++k) dst[n][k] = *(const PG8_LAS bf16x8*)(lds + PG8_SB(b, h) + boff + n * 2048 + k * 1024); } while (0)
#define PG8_MMA(ai, bj, At, Bt) do { __builtin_amdgcn_s_setprio(1); _Pragma("unroll") for (int m = 0; m < 4; ++m) _Pragma("unroll") for (int n = 0; n < 2; ++n) _Pragma("unroll") for (int k = 0; k < 2; ++k) \
        acc[ai][bj][m][n] = __builtin_amdgcn_mfma_f32_16x16x32_bf16(Bt[n][k], At[m][k], acc[ai][bj][m][n], 0, 0, 0); __builtin_amdgcn_s_setprio(0); } while (0)
#define PG8_WAIT_V(n) asm volatile("s_waitcnt vmcnt(" #n ")" ::: "memory")
#define PG8_WAIT_L(n) asm volatile("s_waitcnt lgkmcnt(" #n ")" ::: "memory")
#define PG8_BAR __builtin_amdgcn_s_barrier()
#define PG8_SCHED __builtin_amdgcn_sched_barrier(0)
    Unit cur, nxt; int ui = 0;
    if (!S.next(0, cur)) return;
    f32x4 acc[2][2][4][2];
#pragma unroll
    for (int a = 0; a < 2; ++a)
#pragma unroll
        for (int b = 0; b < 2; ++b)
#pragma unroll
            for (int m = 0; m < 4; ++m)
#pragma unroll
                for (int n = 0; n < 2; ++n) acc[a][b][m][n] = (f32x4){0.f, 0.f, 0.f, 0.f};
    bf16x8 At[4][2], B0[2][2], B1[2][2];
    const char* cA = (const char*)g.A + (size_t)cur.pm * tstepA + (size_t)cur.pn * g.a_pn_stride; const char* cB = (const char*)g.Bt + (size_t)cur.pn * tstepB;
    S.a_ready(cur);
    if constexpr (SP2) {
        PG8_STAGE(PG8_SB(0, 0), cB, voffB); PG8_STAGE(PG8_SB(0, 1), cB + hstepB, voffB); PG8_STAGE(PG8_SA(0, 0), cA, voffA); PG8_STAGE(PG8_SA(0, 1), cA + hstepA, voffA);
        if (wr == 1) PG8_BAR;
        PG8_WAIT_V(2); PG8_BAR;
        PG8_STAGE(PG8_SB(1, 0), cB + kstepB, voffB); PG8_STAGE(PG8_SA(1, 0), cA + kstepA, voffA); PG8_STAGE(PG8_SB(1, 1), cB + hstepB + kstepB, voffB);
        PG8_WAIT_V(6); PG8_BAR;
    } else {
        PG8_STAGE(PG8_SB(0, 0), cB, voffB); PG8_STAGE(PG8_SA(0, 0), cA, voffA); PG8_STAGE(PG8_SB(0, 1), cB + hstepB, voffB); PG8_STAGE(PG8_SA(0, 1), cA + hstepA, voffA);
        if (wr == 1) PG8_BAR;
        PG8_WAIT_V(4); PG8_BAR;
        PG8_STAGE(PG8_SB(1, 0), cB + kstepB, voffB); PG8_STAGE(PG8_SA(1, 0), cA + kstepA, voffA); PG8_STAGE(PG8_SB(1, 1), cB + hstepB + kstepB, voffB);
        PG8_WAIT_V(6); PG8_BAR;
    }
    for (;;) {
        const bool has_next = S.next(ui + 1, nxt);
        const char* nA = has_next ? (const char*)g.A + (size_t)nxt.pm * tstepA + (size_t)nxt.pn * g.a_pn_stride : cA; const char* nB = has_next ? (const char*)g.Bt + (size_t)nxt.pn * tstepB : cB;
        for (int t = 0; t < nt; t += 2) {
            const bool last = (t == nt - 2);
            const char* a1 = cA + (size_t)(t + 1) * kstepA;
            const char* a2 = last ? nA : cA + (size_t)(t + 2) * kstepA; const char* b2 = last ? nB : cB + (size_t)(t + 2) * kstepB;
            const char* a3 = a2 + kstepA; const char* b3 = b2 + kstepB;
            if (last && has_next) S.a_ready(nxt);
            if constexpr (SP2) {
            PG8_LDB(B0, 0, 0); PG8_LDB(B1, 0, 1); PG8_SCHED; PG8_LDA(At, 0, 0); PG8_STAGE(PG8_SA(1, 1), a1 + hstepA, voffA);
            PG8_WAIT_V(8); PG8_WAIT_L(0); PG8_BAR; PG8_MMA(0, 0, At, B0); PG8_MMA(0, 1, At, B1); PG8_BAR; PG8_SCHED;
            PG8_LDA(At, 0, 1); PG8_STAGE(PG8_SB(0, 0), b2, voffB); PG8_STAGE(PG8_SB(0, 1), b2 + hstepB, voffB); PG8_STAGE(PG8_SA(0, 0), a2, voffA);
            PG8_WAIT_V(8); PG8_WAIT_L(0); PG8_BAR; PG8_MMA(1, 0, At, B0); PG8_MMA(1, 1, At, B1); PG8_BAR; PG8_SCHED;
            PG8_LDB(B0, 1, 0); PG8_LDB(B1, 1, 1); PG8_SCHED; PG8_LDA(At, 1, 0); PG8_STAGE(PG8_SA(0, 1), a2 + hstepA, voffA);
            PG8_WAIT_V(8); PG8_WAIT_L(0); PG8_BAR; PG8_MMA(0, 0, At, B0); PG8_MMA(0, 1, At, B1); PG8_BAR; PG8_SCHED;
            PG8_LDA(At, 1, 1); PG8_STAGE(PG8_SB(1, 0), b3, voffB); PG8_STAGE(PG8_SB(1, 1), b3 + hstepB, voffB); PG8_STAGE(PG8_SA(1, 0), a3, voffA);
            PG8_WAIT_V(8); PG8_WAIT_L(0); PG8_BAR; PG8_MMA(1, 0, At, B0); PG8_MMA(1, 1, At, B1); PG8_BAR; PG8_SCHED;
            } else {
            PG8_LDB(B0, 0, 0); PG8_SCHED; PG8_LDA(At, 0, 0); PG8_STAGE(PG8_SA(1, 1), a1 + hstepA, voffA);
            PG8_WAIT_L(8); PG8_BAR; PG8_WAIT_L(0); PG8_MMA(0, 0, At, B0); PG8_BAR; PG8_SCHED;
            PG8_LDB(B1, 0, 1); PG8_STAGE(PG8_SB(0, 0), b2, voffB);
            PG8_BAR; PG8_WAIT_L(0); PG8_MMA(0, 1, At, B1); PG8_BAR;
            PG8_LDA(At, 0, 1); PG8_STAGE(PG8_SA(0, 0), a2, voffA);
            PG8_BAR; PG8_WAIT_L(0); PG8_MMA(1, 0, At, B0); PG8_BAR; PG8_SCHED;
            PG8_STAGE(PG8_SB(0, 1), b2 + hstepB, voffB);
            PG8_WAIT_V(6); PG8_BAR; PG8_MMA(1, 1, At, B1); PG8_BAR;
            PG8_LDB(B0, 1, 0); PG8_SCHED; PG8_LDA(At, 1, 0); PG8_STAGE(PG8_SA(0, 1), a2 + hstepA, voffA);
            PG8_WAIT_L(8); PG8_BAR; PG8_WAIT_L(0); PG8_MMA(0, 0, At, B0); PG8_BAR; PG8_SCHED;
            PG8_LDB(B1, 1, 1); PG8_STAGE(PG8_SB(1, 0), b3, voffB);
            PG8_BAR; PG8_WAIT_L(0); PG8_MMA(0, 1, At, B1); PG8_BAR;
            PG8_LDA(At, 1, 1); PG8_STAGE(PG8_SA(1, 0), a3, voffA);
            PG8_BAR; PG8_WAIT_L(0); PG8_MMA(1, 0, At, B0); PG8_BAR; PG8_SCHED;
            PG8_STAGE(PG8_SB(1, 1), b3 + hstepB, voffB);
            PG8_WAIT_V(6); PG8_BAR; PG8_MMA(1, 1, At, B1); PG8_BAR;
            }
        }
        if constexpr (ALIGN_EPI) { if (wr == 0) PG8_BAR; }
        if constexpr (!Epi::AFTER_DRAIN) { E(acc, cur, wr, wc, fr, fq); S.done(cur); }
        if (!has_next) break;
#pragma unroll
        for (int a = 0; a < 2; ++a)
#pragma unroll
            for (int b = 0; b < 2; ++b)
#pragma unroll
                for (int m = 0; m < 4; ++m)
#pragma unroll
                    for (int n = 0; n < 2; ++n) acc[a][b][m][n] = (f32x4){0.f, 0.f, 0.f, 0.f};
        cur = nxt; cA = nA; cB = nB; ++ui;
        if constexpr (ALIGN_EPI) { if (wr == 1) PG8_BAR; }
    }
    PG8_WAIT_V(0);
    if constexpr (!ALIGN_EPI) { if (wr == 0) PG8_BAR; }
    PG8_BAR;
    if constexpr (Epi::AFTER_DRAIN) { E.fused(acc, cur, wr, wc, fr, fq, lds, wid, lane); S.done(cur); }
#undef PG8_SA
#undef PG8_SB
#undef PG8_STAGE
#undef PG8_LDA
#undef PG8_LDB
#undef PG8_MMA
#undef PG8_WAIT_V
#undef PG8_WAIT_L
#undef PG8_BAR
#undef PG8_SCHED
}
}
#ifndef PG8_SP2
#define PG8_SP2 true
#endif
#ifndef PG8_ALIGN
#define PG8_ALIGN true
#endif

constexpr int NWAVES = 8;
constexpr int D = 1024, FF = 4096, NH = 16, HD = 64, DEPTH = 4;
constexpr int NTOK = 131072;
constexpr int GROUP_TOK = 65536;
#ifndef MK_CH
#define MK_CH 65536
#endif
constexpr int CH = MK_CH;
constexpr int NCHUNK = NTOK / CH;
constexpr float RMS_EPS = 1e-6f;
constexpr float LOG2E = 1.4426950408889634f;
static_assert(GROUP_TOK % CH == 0 && CH % 4096 == 0, "chunking");

constexpr size_t MiB = 1u << 20;
constexpr size_t WS_WPOOL = 2 * MiB;
constexpr size_t WS_WQKV = 4 * MiB;
constexpr size_t WS_WO = 16 * MiB;
constexpr size_t WS_WUP = 20 * MiB;
constexpr size_t WS_WDN = 52 * MiB;
constexpr size_t WS_XN = 96 * MiB;
constexpr size_t WS_PG = WS_XN + (size_t)CH * D * 2;
constexpr size_t WS_ACT = WS_PG + (size_t)CH * D * 2;
constexpr size_t WS_CTL = 0, CTL_ZERO_BYTES = 65536;
constexpr size_t WS_STAT = 86 * MiB;
static_assert(WS_STAT + 2 * (size_t)CH * 64 <= WS_XN, "stat arrays");
constexpr size_t WS_END = WS_ACT + (size_t)CH * FF * 2;
static_assert(WS_XN >= WS_WDN + 32 * MiB && WS_END <= 1024 * MiB, "d_ws map");

constexpr int RING_BYTES = 131072;
constexpr int BIAS_OFF = RING_BYTES;
constexpr int MISC_OFF = RING_BYTES + 4096;
constexpr int LDS_BYTES = 147456;

#define GAS __attribute__((address_space(1)))
#define LAS __attribute__((address_space(3)))
typedef unsigned short bf16;
typedef unsigned v4u __attribute__((ext_vector_type(4)));
typedef unsigned v2u __attribute__((ext_vector_type(2)));
typedef float f32x4 __attribute__((ext_vector_type(4)));
typedef short bf16x8 __attribute__((ext_vector_type(8)));
typedef short s16x4 __attribute__((ext_vector_type(4)));
#define LDS_WAIT() asm volatile("s_waitcnt lgkmcnt(0)" ::: "memory")
typedef float f32x2_t __attribute__((ext_vector_type(2))); typedef __bf16 bf16x2_t __attribute__((ext_vector_type(2)));
__device__ __forceinline__ unsigned pk2(float lo, float hi) { f32x2_t v = {lo, hi}; bf16x2_t b = __builtin_convertvector(v, bf16x2_t); return __builtin_bit_cast(unsigned, b); }
__device__ __forceinline__ float wave_sum(float v) {
#pragma unroll
    for (int o = 1; o < 64; o <<= 1) v += __shfl_xor(v, o);
    return v;
}

__device__ __forceinline__ void transpose_item(const float* W, int K, int N, bf16* WT, int row_off, const float* nscale, const float* kscale, LAS float* scr, int item, int lane) {
    const int nblk = N / 32, kb = item / nblk, nb = item % nblk, k0 = 64 * kb, n0 = 32 * nb;
    float wv[32];
#pragma unroll
    for (int i = 0; i < 32; ++i) wv[i] = W[(size_t)(k0 + 2 * i + (lane >> 5)) * N + n0 + (lane & 31)];
#pragma unroll
    for (int i = 0; i < 32; ++i) scr[(2 * i + (lane >> 5)) * 33 + (lane & 31)] = wv[i];
    LDS_WAIT(); asm volatile("" ::: "memory");
    const int c = lane & 7;
    float ks[8];
#pragma unroll
    for (int e = 0; e < 8; ++e) ks[e] = kscale ? kscale[k0 + 8 * c + e] : 1.f;
#pragma unroll
    for (int j = 0; j < 4; ++j) { const int n = (lane >> 3) + 8 * j; const LAS float* s = scr + (8 * c) * 33 + n;
        const float sc = nscale ? nscale[n0 + n] : 1.f;
        v4u o; o.x = pk2(s[0 * 33] * sc * ks[0], s[1 * 33] * sc * ks[1]); o.y = pk2(s[2 * 33] * sc * ks[2], s[3 * 33] * sc * ks[3]); o.z = pk2(s[4 * 33] * sc * ks[4], s[5 * 33] * sc * ks[5]); o.w = pk2(s[6 * 33] * sc * ks[6], s[7 * 33] * sc * ks[7]);
        { const int ng = row_off + n0 + n, nr = ng & 127, cc = nr & 31, slot = (((cc >> 2) & 1) << 4) | ((cc >> 3) << 2) | (cc & 3), kk = k0 + 8 * c;
          *(GAS v4u*)((GAS char*)WT + ((size_t)(((ng >> 8) * 2 + ((ng >> 7) & 1)) * (K >> 6) + (kk >> 6)) << 14) + pg8::lds_byte((nr & ~31) + slot, kk & 63)) = o; } }
    LDS_WAIT(); asm volatile("" ::: "memory");
}

struct Ptrs {
    const float *x_in[2], *norm_mix, *pool_w, *pool_scale, *w_qkv, *rpb, *w_o, *norm_mlp, *w_up, *w_down, *norm_final;
    float* out; unsigned char* ws;
};

__device__ __forceinline__ void prologue(const Ptrs& P, LAS unsigned char* lds, int gw, int NGW, int wave, int lane) {
    LAS float* scr = (LAS float*)(lds + wave * 16384);
    bf16* WPOOL = (bf16*)(P.ws + WS_WPOOL); bf16* WQKV = (bf16*)(P.ws + WS_WQKV); bf16* WO = (bf16*)(P.ws + WS_WO); bf16* WUP = (bf16*)(P.ws + WS_WUP); bf16* WDN = (bf16*)(P.ws + WS_WDN);
    constexpr int I_POOL = (256 / 64) * (256 / 32), I_QKV = (D / 64) * (3 * D / 32), I_O = (D / 64) * (D / 32), I_UP = (D / 64) * (FF / 32), I_DN = (FF / 64) * (D / 32);
    constexpr int NITEMS = 8 * I_POOL + 2 * I_QKV + 2 * I_O + 4 * I_UP + 4 * I_DN;
    for (int it = gw; it < NITEMS; it += NGW) {
        int r = it;
        if (r < 8 * I_POOL) { const int mtx = r / I_POOL, j = mtx >> 2, g = mtx & 3; transpose_item(P.pool_w + (size_t)mtx * 65536, 256, 256, WPOOL + (size_t)j * 1024 * 256, g * 256, P.pool_scale + j * 1024 + g * 256, nullptr, scr, r % I_POOL, lane); continue; } r -= 8 * I_POOL;
        if (r < 2 * I_QKV) { const int j = r / I_QKV; transpose_item(P.w_qkv + (size_t)j * D * 3 * D, D, 3 * D, WQKV + (size_t)j * 3 * D * D, 0, nullptr, P.norm_mix + (2 * j + 1) * D, scr, r % I_QKV, lane); continue; } r -= 2 * I_QKV;
        if (r < 2 * I_O) { const int j = r / I_O; transpose_item(P.w_o + (size_t)j * D * D, D, D, WO + (size_t)j * D * D, 0, nullptr, nullptr, scr, r % I_O, lane); continue; } r -= 2 * I_O;
        if (r < 4 * I_UP) { const int j = r / I_UP; transpose_item(P.w_up + (size_t)j * D * FF, D, FF, WUP + (size_t)j * D * FF, 0, nullptr, P.norm_mlp + j * D, scr, r % I_UP, lane); continue; } r -= 4 * I_UP;
        { const int j = r / I_DN; transpose_item(P.w_down + (size_t)j * D * FF, FF, D, WDN + (size_t)j * D * FF, 0, nullptr, nullptr, scr, r % I_DN, lane); }
    }
}

__device__ __forceinline__ void norm_rows_f32_inplace(float* x, const float* gain, int nrows, int gw, int NGW, int lane) {
    f32x4 g[4];
#pragma unroll
    for (int j = 0; j < 4; ++j) g[j] = *((const f32x4*)gain + lane + 64 * j);
    for (int m = gw * 4; m < nrows; m += NGW * 4) {
        GAS f32x4* xr = (GAS f32x4*)(x + (size_t)m * D) + lane;
        f32x4 v[4][4];
#pragma unroll
        for (int r = 0; r < 4; ++r)
#pragma unroll
            for (int j = 0; j < 4; ++j) v[r][j] = xr[r * 256 + 64 * j];
        __builtin_amdgcn_sched_barrier(0);
#pragma unroll
        for (int r = 0; r < 4; ++r) { float s = 0.f;
#pragma unroll
            for (int j = 0; j < 4; ++j) s += (v[r][j].x * v[r][j].x + v[r][j].y * v[r][j].y) + (v[r][j].z * v[r][j].z + v[r][j].w * v[r][j].w);
            const float rr = 1.0f / sqrtf(wave_sum(s) * (1.f / D) + RMS_EPS);
#pragma unroll
            for (int j = 0; j < 4; ++j) xr[r * 256 + 64 * j] = v[r][j] * rr * g[j]; }
    }
}

constexpr int PT = 32, PROWS = 48;
typedef float f32x2v __attribute__((ext_vector_type(2)));
__device__ __forceinline__ f32x2v bfpair(unsigned u) { return (f32x2v){__builtin_bit_cast(float, u << 16), __builtin_bit_cast(float, u & 0xffff0000u)}; }
struct f32x8 { f32x4 lo, hi; };
__device__ __forceinline__ f32x8 bf8(const v4u u) { f32x8 r; r.lo = (f32x4){__builtin_bit_cast(float, u.x << 16), __builtin_bit_cast(float, u.x & 0xffff0000u), __builtin_bit_cast(float, u.y << 16), __builtin_bit_cast(float, u.y & 0xffff0000u)};
    r.hi = (f32x4){__builtin_bit_cast(float, u.z << 16), __builtin_bit_cast(float, u.z & 0xffff0000u), __builtin_bit_cast(float, u.w << 16), __builtin_bit_cast(float, u.w & 0xffff0000u)}; return r; }
__device__ __forceinline__ v4u pack8(const f32x4 a, const f32x4 b) { v4u o; o.x = pk2(a[0], a[1]); o.y = pk2(a[2], a[3]); o.z = pk2(b[0], b[1]); o.w = pk2(b[2], b[3]); return o; }
template <int W> __device__ __forceinline__ void pool_rows_interior(const LAS v4u* hrow, GAS v4u* po) {
    constexpr int HW = W / 2; constexpr float INV = 1.0f / (float)W;
    f32x4 sl = {0.f, 0.f, 0.f, 0.f}, sh = {0.f, 0.f, 0.f, 0.f};
#pragma unroll
    for (int o = -HW; o < HW; ++o) { const f32x8 h = bf8(hrow[(8 + o) * 128]); sl += h.lo; sh += h.hi; }
    __builtin_amdgcn_sched_barrier(0);
#pragma unroll
    for (int i = 0; i < 8; ++i) {
        const f32x8 c = bf8(hrow[(8 + i) * 128]);
        po[(size_t)i * 32] = pack8(sl * INV - c.lo, sh * INV - c.hi);
        if (i + 1 < 8) { const f32x8 a = bf8(hrow[(8 + i + HW) * 128]), b = bf8(hrow[(8 + i - HW) * 128]); sl += a.lo - b.lo; sh += a.hi - b.hi; }
        __builtin_amdgcn_sched_barrier(0);
    }
}
__device__ __forceinline__ void pool_load_rows(f32x4 (&v)[6][4], const float* x, int m0, int seq_len, int wave, int lane) {
    const int sb = m0 / seq_len * seq_len, t0 = m0 - sb;
#pragma unroll
    for (int k = 0; k < 6; ++k) { const int t = min(max(t0 - 8 + wave + NWAVES * k, 0), seq_len - 1);
        const GAS f32x4* xr = (const GAS f32x4*)(x + (size_t)(sb + t) * D) + lane;
#pragma unroll
        for (int j = 0; j < 4; ++j) v[k][j] = xr[64 * j]; }
}
__device__ __forceinline__ void pool_phase(LAS unsigned char* lds, const float* x, const float* gain, bf16* Pg, int seq_len, int vcu, int G, int tid, int wave, int lane) {
    f32x4 v[6][4];
    if (vcu < CH / PT) pool_load_rows(v, x, vcu * PT, seq_len, wave, lane);
    for (int tile = vcu; tile < CH / PT; tile += G) {
        const int m0 = tile * PT;
        const int sb = m0 / seq_len * seq_len;
        const int t0 = m0 - sb;
        f32x4 g[4];
#pragma unroll
        for (int j = 0; j < 4; ++j) g[j] = *((const GAS f32x4*)gain + lane + 64 * j);
#pragma unroll
        for (int k = 0; k < 6; ++k) { float s = 0.f;
#pragma unroll
            for (int j = 0; j < 4; ++j) s += (v[k][j].x * v[k][j].x + v[k][j].y * v[k][j].y) + (v[k][j].z * v[k][j].z + v[k][j].w * v[k][j].w);
            const float r = 1.0f / sqrtf(wave_sum(s) * (1.f / D) + RMS_EPS);
            LAS v2u* hr = (LAS v2u*)(lds + (wave + NWAVES * k) * 2048) + lane;
#pragma unroll
            for (int j = 0; j < 4; ++j) { v2u o; o.x = pk2(v[k][j].x * r * g[j].x, v[k][j].y * r * g[j].y); o.y = pk2(v[k][j].z * r * g[j].z, v[k][j].w * r * g[j].w); hr[64 * j] = o; } }
        __syncthreads();
        if (tile + G < CH / PT) { pool_load_rows(v, x, (tile + G) * PT, seq_len, wave, lane); __builtin_amdgcn_sched_barrier(0); }
        {
            const int pg = wave & 3, part = (lane >> 5) + 2 * (wave >> 2), oc = lane & 31, pw = 2 << pg, phw = pw >> 1;
            const LAS v4u* hrow = (const LAS v4u*)(lds + (8 * part) * 2048 + pg * 512 + oc * 16);
            GAS v4u* po = (GAS v4u*)(Pg + ((size_t)pg * CH + m0 + 8 * part) * 256 + oc * 8);
            if (t0 >= 8 && t0 + PT + 8 <= seq_len) {
                switch (pg) { case 0: pool_rows_interior<2>(hrow, po); break; case 1: pool_rows_interior<4>(hrow, po); break; case 2: pool_rows_interior<8>(hrow, po); break; default: pool_rows_interior<16>(hrow, po); break; }
            } else {
                for (int i = 0; i < 8; ++i) {
                    const int t = t0 + 8 * part + i;
                    const int lo = max(t - phw, 0), hi = min(t + phw - 1, seq_len - 1);
                    f32x4 sl = {0.f, 0.f, 0.f, 0.f}, sh = {0.f, 0.f, 0.f, 0.f};
                    for (int q = lo; q <= hi; ++q) { const f32x8 h = bf8(hrow[(8 + q - t + i) * 128]); sl += h.lo; sh += h.hi; }
                    const f32x8 c = bf8(hrow[(8 + i) * 128]);
                    const float inv = 1.0f / (float)(hi - lo + 1);
                    po[(size_t)i * 32] = pack8(sl * inv - c.lo, sh * inv - c.hi);
                }
            }
        }
        __syncthreads();
    }
}

#define RLX_AGENT __ATOMIC_RELAXED, __HIP_MEMORY_SCOPE_AGENT
#define XB_TMO      128
#define XB_XCNT(j)  (256  + 64 * (j))
#define XB_XSUB(j)  (1280 + 64 * (j))
#define XB_XGEN(j)  (2304 + 64 * (j))
#define XB_TOP      3328
#define XB_TOPGEN   3392
#define XCD_BAR_WORDS 3456
#define XB_SPIN_CAP (1u << 18)

__device__ __forceinline__ unsigned xb_ld(unsigned* p)              { return __hip_atomic_load(p, __ATOMIC_RELAXED, __HIP_MEMORY_SCOPE_AGENT); }
__device__ __forceinline__ unsigned xb_add(unsigned* p, unsigned v) { return __hip_atomic_fetch_add(p, v, __ATOMIC_RELAXED, __HIP_MEMORY_SCOPE_AGENT); }
__device__ __forceinline__ unsigned xb_xcc_id() { return (unsigned)__builtin_amdgcn_s_getreg((3 << 11) | 20) & 0xFu; }
#define XB_SPIN(cond, bar) do { unsigned _sp = 0; while (cond) { __builtin_amdgcn_s_sleep(1); \
    if ((++_sp & 255u) == 0u) { if (xb_ld(&(bar)[XB_TMO])) break; if (_sp > XB_SPIN_CAP) { atomicAdd(&(bar)[XB_TMO], 1u); break; } } } } while (0)

struct XcdBarrier {
    unsigned* bar; unsigned x;
    volatile LAS unsigned* st;
};

__device__ __forceinline__ XcdBarrier xcd_barrier_post(unsigned* bar, volatile LAS unsigned* st) {
    XcdBarrier b; b.bar = bar; b.x = xb_xcc_id(); b.st = st;
    if (threadIdx.x == 0) (void)xb_add(&bar[XB_XCNT(b.x)], 1u);
    return b;
}
__device__ __forceinline__ void xcd_barrier_complete(unsigned* bar, unsigned x, unsigned& nloc, unsigned& nx) {
    const unsigned G = gridDim.x * gridDim.y * gridDim.z;
    unsigned sum, cnt, mine, sp = 0u;
    for (;;) {
        sum = 0u; cnt = 0u; mine = 0u;
#pragma unroll
        for (unsigned j = 0; j < 16; ++j) { const unsigned c = xb_ld(&bar[XB_XCNT(j)]); sum += c; cnt += (c > 0u) ? 1u : 0u; mine = (j == x) ? c : mine; }
        if (sum == G) break;
        __builtin_amdgcn_s_sleep(1);
        if ((++sp & 255u) == 0u) { if (xb_ld(&bar[XB_TMO])) break; if (sp > XB_SPIN_CAP) { atomicAdd(&bar[XB_TMO], 1u); break; } }
    }
    nloc = mine > 0u ? mine : 1u; nx = cnt > 0u ? cnt : 1u;
}

__device__ __forceinline__ void xcd_barrier(const XcdBarrier& b) {
    asm volatile("s_waitcnt vmcnt(0)" ::: "memory");
    __syncthreads();
    if (threadIdx.x == 0) {
        unsigned* bar = b.bar;
        __builtin_amdgcn_s_waitcnt(0);
        unsigned nloc = b.st[0], nx = b.st[1];
        if (nloc == 0u) { xcd_barrier_complete(bar, b.x, nloc, nx); b.st[0] = nloc; b.st[1] = nx; }
        const unsigned old = xb_add(&bar[XB_XSUB(b.x)], 1u);
        const unsigned gen = old / nloc;
        if (old + 1u == (gen + 1u) * nloc) {
            __builtin_amdgcn_fence(__ATOMIC_RELEASE, "agent");
            asm volatile("s_waitcnt vmcnt(0)" ::: "memory");
            const unsigned og = xb_add(&bar[XB_TOP], 1u);
            const unsigned tg = og / nx;
            if (og + 1u == (tg + 1u) * nx) xb_add(&bar[XB_TOPGEN], 1u);
            else XB_SPIN(xb_ld(&bar[XB_TOPGEN]) == tg, bar);
            __builtin_amdgcn_fence(__ATOMIC_ACQUIRE, "agent");
            xb_add(&bar[XB_XGEN(b.x)], 1u);
            asm volatile("s_waitcnt vmcnt(0)" ::: "memory");
        } else {
            XB_SPIN(xb_ld(&bar[XB_XGEN(b.x)]) == gen, bar);
            __builtin_amdgcn_fence(__ATOMIC_ACQUIRE, "agent");
            asm volatile("s_waitcnt vmcnt(0)" ::: "memory");
        }
    }
    __syncthreads();
}


__device__ __forceinline__ unsigned cvtpk(float lo, float hi) { return pk2(lo, hi); }
__device__ __forceinline__ s16x4 vtr(const LAS unsigned char* p) { return __builtin_bit_cast(s16x4, __builtin_amdgcn_ds_read_tr16_b64_v4i16((LAS s16x4*)p)); }
__device__ __forceinline__ void attn_phase(LAS unsigned char* lds, bf16* Qb, const bf16* Kb, const bf16* Vb, const float* rpb_l, int seq_len, int G, int bx, int tid, int wave, int lane) {
    const int fr = lane & 15, fq = lane >> 4;
    const int rows = seq_len >> 6, rows_shift = (seq_len == 2048) ? 5 : 6;
    constexpr int NI = (CH / 64) * 8;
    int nx, xc, lc, per;
    if ((G & 7) == 0) { nx = G >> 3; xc = bx & 7; lc = bx >> 3; per = NI >> 3; } else { nx = G; xc = 0; lc = bx; per = NI; }
    LAS float* bias = (LAS float*)(lds + BIAS_OFF);
    const int qb = wave & 3, hh = wave >> 2;
    const int qc = (qb < 3) ? (8 + 16 * qb + fr) : (fr < 8 ? fr : 48 + fr);
    const int a0 = (qb < 3) ? qb : 0, a1 = (qb < 3) ? qb + 1 : 3;
    const int wst = min(max(qc - 8, 0), 48);
    const int q4 = (lane & 15) >> 2, p4 = lane & 3;
    bool sel[4];
#pragma unroll
    for (int i = 0; i < 4; ++i) sel[i] = (qb < 3) ? (4 * fq + i >= fr) : (fr < 8);
    int voff[4];
#pragma unroll
    for (int i3 = 0; i3 < 4; ++i3) voff[i3] = (lane >> 4) * D + (((lane & 15) ^ (((lane >> 4) << 2) | i3)) * 8);
    if (lc >= per) return;
    int id = xc * per + lc;
    int r = id & (rows - 1), hp = (id >> rows_shift) & 7, tb = (id >> (rows_shift + 3)) * seq_len, r0 = min(max(r - 4, 0), rows - 8);
    bf16x8 qf0, qf1, kf[4][2][2];
    float bnext[2];
#define ATT_PREFETCH() do { \
        const int h_ = 2 * hp + hh; const size_t qo_ = (size_t)(tb + r * 64 + qc) * D + h_ * 64; \
        qf0 = *(const GAS bf16x8*)(Qb + qo_ + 8 * fq); qf1 = *(const GAS bf16x8*)(Qb + qo_ + 32 + 8 * fq); \
        const bf16* kb_ = Kb + ((size_t)(h_ * 8 + fq) * CH + (tb + r0 * 64 + fr)) * 8; \
        _Pragma("unroll") for (int kr = 0; kr < 4; ++kr) _Pragma("unroll") for (int ai = 0; ai < 2; ++ai) { const bf16* kp = kb_ + (kr * 64 + 16 * (ai ? a1 : a0)) * 8; kf[kr][ai][0] = *(const GAS bf16x8*)kp; kf[kr][ai][1] = *(const GAS bf16x8*)(kp + (size_t)4 * CH * 8); } \
        bnext[0] = rpb_l[hp * 930 + tid] * LOG2E; bnext[1] = (tid + 512 < 930) ? rpb_l[hp * 930 + tid + 512] * LOG2E : 0.f; } while (0)
#define ATT_BIAS_WRITE() do { bias[tid] = bnext[0]; if (tid + 512 < 930) bias[tid + 512] = bnext[1]; } while (0)
    ATT_PREFETCH();
    ATT_BIAS_WRITE();
    for (int loc = lc; loc < per; loc += nx) {
        const int h = 2 * hp + hh;
        const size_t qoff = (size_t)(tb + r * 64 + qc) * D + h * 64;
        const bf16* kbase = Kb + ((size_t)(h * 8 + fq) * CH + (tb + r0 * 64 + fr)) * 8;
        const int drb = r0 - r + 7;
        __syncthreads();
        {
            const int a = wave >> 1, ub = (wave & 1) * 2;
#pragma unroll
            for (int i = 0; i < 16; ++i) { const int kr = 2 * (ub + (i >> 3)) + (i & 1), cb = 16 * a + 4 * ((i & 7) >> 1);
                const bf16* src = Vb + (size_t)(tb + (r0 + kr) * 64 + cb) * D + hp * 128 + voff[i & 3];
                __builtin_amdgcn_global_load_lds((const unsigned*)src, (LAS unsigned*)(lds + (wave * 16 + i) * 1024), 16, 0, 0); }
        }
        f32x4 S[8];
        float mx = -3.0e38f;
        const LAS float* bptr[4];
#pragma unroll
        for (int i = 0; i < 4; ++i) { const int kc = 16 * (sel[i] ? a0 : a1) + 4 * fq + i; bptr[i] = bias + hh * 465 + drb * 31 + min(max(kc - qc + 15, 0), 30); }
#pragma unroll
        for (int kr = 0; kr < 8; ++kr) {
            f32x4 z0 = {0.f, 0.f, 0.f, 0.f}, z1 = {0.f, 0.f, 0.f, 0.f};
            z0 = __builtin_amdgcn_mfma_f32_16x16x32_bf16(kf[kr & 3][0][0], qf0, z0, 0, 0, 0);
            z0 = __builtin_amdgcn_mfma_f32_16x16x32_bf16(kf[kr & 3][0][1], qf1, z0, 0, 0, 0);
            z1 = __builtin_amdgcn_mfma_f32_16x16x32_bf16(kf[kr & 3][1][0], qf0, z1, 0, 0, 0);
            z1 = __builtin_amdgcn_mfma_f32_16x16x32_bf16(kf[kr & 3][1][1], qf1, z1, 0, 0, 0);
            f32x4 z;
#pragma unroll
            for (int i = 0; i < 4; ++i) { z[i] = (sel[i] ? z0[i] : z1[i]) + bptr[i][kr * 31]; mx = fmaxf(mx, z[i]); }
            S[kr] = z;
            if (kr < 4) {
#pragma unroll
                for (int ai = 0; ai < 2; ++ai) { const bf16* kp = kbase + ((kr + 4) * 64 + 16 * (ai ? a1 : a0)) * 8; kf[kr & 3][ai][0] = *(const GAS bf16x8*)kp; kf[kr & 3][ai][1] = *(const GAS bf16x8*)(kp + (size_t)4 * CH * 8); }
            }
        }
        mx = fmaxf(mx, __shfl_xor(mx, 16)); mx = fmaxf(mx, __shfl_xor(mx, 32));
        float sum = 0.f;
#pragma unroll
        for (int kr = 0; kr < 8; ++kr)
#pragma unroll
            for (int i = 0; i < 4; ++i) { const float p = __builtin_amdgcn_exp2f(S[kr][i] - mx); S[kr][i] = p; sum += p; }
        sum += __shfl_xor(sum, 16); sum += __shfl_xor(sum, 32);
        bf16x8 pf[4][2];
#pragma unroll
        for (int u = 0; u < 4; ++u)
#pragma unroll
            for (int ai = 0; ai < 2; ++ai) {
                float pa[2][4];
#pragma unroll
                for (int t = 0; t < 2; ++t)
#pragma unroll
                    for (int i = 0; i < 4; ++i) pa[t][i] = (sel[i] == (ai == 0)) ? S[2 * u + t][i] : 0.f;
                v4u pw; pw.x = cvtpk(pa[0][0], pa[0][1]); pw.y = cvtpk(pa[0][2], pa[0][3]); pw.z = cvtpk(pa[1][0], pa[1][1]); pw.w = cvtpk(pa[1][2], pa[1][3]);
                pf[u][ai] = __builtin_bit_cast(bf16x8, pw); }
        asm volatile("s_waitcnt vmcnt(0)" ::: "memory");
        __syncthreads();
        const int nloc = loc + nx; const bool has_next = nloc < per;
        const int r_cur = r, tb_cur = tb;
        if (has_next) { id = xc * per + nloc; r = id & (rows - 1); hp = (id >> rows_shift) & 7; tb = (id >> (rows_shift + 3)) * seq_len; r0 = min(max(r - 4, 0), rows - 8); ATT_PREFETCH(); }
        (void)r_cur; (void)tb_cur;
        f32x4 O[4];
#pragma unroll
        for (int c = 0; c < 4; ++c) O[c] = (f32x4){0.f, 0.f, 0.f, 0.f};
        const LAS unsigned char* vb[2][2][4];
#pragma unroll
        for (int ai = 0; ai < 2; ++ai)
#pragma unroll
            for (int t = 0; t < 2; ++t)
#pragma unroll
                for (int c = 0; c < 4; ++c) { const int rho = 8 * fq + 4 * t + q4, chn = 2 * (4 * hh + c) + (p4 >> 1);
                    vb[ai][t][c] = lds + (ai ? a1 : a0) * 32768 + 256 * rho + 16 * (chn ^ (((rho & 3) << 2) | ((rho >> 2) & 3))) + 8 * (p4 & 1); }
#pragma unroll
        for (int u = 0; u < 4; ++u) {
#pragma unroll
            for (int ai = 0; ai < 2; ++ai) {
#pragma unroll
                for (int c = 0; c < 4; ++c) {
                    const s16x4 v0 = vtr(vb[ai][0][c] + u * 8192), v1 = vtr(vb[ai][1][c] + u * 8192);
                    const bf16x8 vf = __builtin_shufflevector(v0, v1, 0, 1, 2, 3, 4, 5, 6, 7);
                    O[c] = __builtin_amdgcn_mfma_f32_16x16x32_bf16(vf, pf[u][ai], O[c], 0, 0, 0);
                }
            }
        }
        const float inv = 1.0f / sum;
#pragma unroll
        for (int c = 0; c < 4; ++c) { v2u w; w.x = cvtpk(O[c][0] * inv, O[c][1] * inv); w.y = cvtpk(O[c][2] * inv, O[c][3] * inv);
            *(GAS v2u*)(Qb + qoff + 16 * c + 4 * fq) = w; }
        if (has_next) ATT_BIAS_WRITE();
    }
    __syncthreads();
#undef ATT_PREFETCH
#undef ATT_BIAS_WRITE
}
enum { K_POOL = 1, K_GEMM_RES = 3, K_GEMM_QKV = 4, K_GEMM_UP = 5, K_ATTN = 6, K_FINAL = 7 };
enum { F_A_X = 1, F_A_IN = 2, F_AUX_X = 4, F_AUX_IN = 8, F_NOX = 16, F_B16 = 32 };
struct Ph { int kind, flags, N, K; const void* A; const void* B; void* C; const void* aux; float* st; float* rs; unsigned long long a_pn_stride, pad; };
constexpr int PPC = 19;
struct Args { Ptrs p; Ph tab[PPC]; };
__global__ void __launch_bounds__(NWAVES * 64, 2) fwd_megakernel(Args args) {
    extern __shared__ __attribute__((aligned(16))) unsigned char lds_raw[];
    cg::grid_group grid = cg::this_grid();
    LAS unsigned char* lds = (LAS unsigned char*)lds_raw;
    volatile LAS unsigned* MISC = (volatile LAS unsigned*)(lds + MISC_OFF);
    for (int u = threadIdx.x; u < 32; u += NWAVES * 64) MISC[u] = 0u;
    __syncthreads();
    const XcdBarrier bar = xcd_barrier_post((unsigned*)(args.p.ws + WS_CTL), MISC + 8);
    {
        const int tid = threadIdx.x, lane = tid & 63, wave = __builtin_amdgcn_readfirstlane(tid >> 6);
        const int G = gridDim.x, bx = blockIdx.x;
        const int vcu = (G % 8 == 0) ? (bx % 8) * (G / 8) + bx / 8 : bx;
        prologue(args.p, lds, vcu * NWAVES + wave, G * NWAVES, wave, lane);
    }
    grid.sync();

    for (int ph = 0; ph < NCHUNK * PPC; ++ph) {
        int tid = threadIdx.x; asm volatile("" : "+v"(tid));
        int G = gridDim.x, bx = blockIdx.x; asm volatile("" : "+s"(G), "+s"(bx));
        const int lane = tid & 63, wave = __builtin_amdgcn_readfirstlane(tid >> 6);
        const int vcu = (G % 8 == 0) ? (bx % 8) * (G / 8) + bx / 8 : bx;
        const int gw = vcu * NWAVES + wave, NGW = G * NWAVES;
        const int ck = ph / PPC, idx = ph - ck * PPC;
        const Ph d = args.tab[idx];
        const int tok0 = ck * CH, grp = tok0 / GROUP_TOK, seq_len = grp ? 4096 : 2048;
        const float* xin = args.p.x_in[grp] + (size_t)(tok0 - grp * GROUP_TOK) * D;
        float* X = args.p.out + (size_t)tok0 * D;
        const void* A = (d.flags & F_A_X) ? (const void*)X : (d.flags & F_A_IN) ? (const void*)xin : d.A;
        const void* aux = (d.flags & F_AUX_X) ? (const void*)X : (d.flags & F_AUX_IN) ? (const void*)xin : d.aux;
#define KIND_IS(x) ([&]() { int kd_ = d.kind; asm volatile("" : "+s"(kd_)); return kd_ == (x); }())
        if (0) {}
        else if (KIND_IS(K_POOL)) { { int tid2 = threadIdx.x; asm volatile("" : "+v"(tid2));
            pool_phase(lds, (const float*)A, (const float*)aux, (bf16*)d.C, seq_len, vcu, G, tid2, __builtin_amdgcn_readfirstlane(tid2 >> 6), tid2 & 63); } }
        else if (KIND_IS(K_GEMM_RES)) { pg8::Gemm g{(const bf16*)A, (const bf16*)d.B, CH, d.N, d.K, (size_t)d.a_pn_stride, d.K == FF  }; pg8::StaticOrder S; S.init(CH, d.N, G, bx);
            pg8::EpiRes E{(const float*)aux, (d.flags & F_NOX) ? nullptr : X, (bf16*)d.C, d.st, D, d.rs, (d.flags & F_B16) ? (const bf16*)args.p.ws + WS_XN / 2 : nullptr};
            pg8::gemm_phase<pg8::EpiRes, pg8::StaticOrder, false, PG8_SP2>(lds, g, S, E, tid); }
        else if (KIND_IS(K_GEMM_QKV)) { pg8::Gemm g{(const bf16*)A, (const bf16*)d.B, CH, d.N, d.K, 0, 1  }; pg8::StaticOrder S; S.init(CH, d.N, G, bx);
            pg8::EpiBf16<0, true> E{(bf16*)d.C, D, D, (size_t)CH * D, 0.125f * LOG2E, d.st, 0};
            pg8::gemm_phase<pg8::EpiBf16<0, true>, pg8::StaticOrder, PG8_ALIGN, PG8_SP2>(lds, g, S, E, tid); }
        else if (KIND_IS(K_GEMM_UP)) { pg8::Gemm g{(const bf16*)A, (const bf16*)d.B, CH, d.N, d.K, 0, 1  }; pg8::StaticOrder S; S.init(CH, d.N, G, bx);
            pg8::EpiBf16<2, false> E{(bf16*)d.C, FF, 0, 0, 1.f, nullptr, 1};
            pg8::gemm_phase<pg8::EpiBf16<2, false>, pg8::StaticOrder, PG8_ALIGN, PG8_SP2>(lds, g, S, E, tid); }
        else if (KIND_IS(K_ATTN)) { attn_phase(lds, (bf16*)d.C, (const bf16*)d.C + (size_t)CH * D, (const bf16*)d.C + 2 * (size_t)CH * D, (const float*)aux, seq_len, G, bx, tid, wave, lane); }
        else { norm_rows_f32_inplace(X, (const float*)aux, CH, gw, NGW, lane); }
#undef KIND_IS
        if (d.kind != K_FINAL) xcd_barrier(bar);
    }
}

extern "C" void kernel_launch(void* const* d_in, const int* in_sizes, int n_in, void* d_out, int out_size, void* d_ws, size_t ws_size, hipStream_t stream) {
    static int grid = 0;
    if (grid == 0) {
        if (n_in != 12 || in_sizes[0] != GROUP_TOK * D || in_sizes[1] != GROUP_TOK * D || out_size != NTOK * D || ws_size < WS_END) {
            fprintf(stderr, "kernel_launch: unexpected shapes (n_in %d, out %d, ws %zu < %zu); nothing launched\n", n_in, out_size, ws_size, (size_t)WS_END); grid = -1; return; }
        int dev = 0, cus = 0, per_cu = 0;
        if (hipGetDevice(&dev) != hipSuccess || hipDeviceGetAttribute(&cus, hipDeviceAttributeMultiprocessorCount, dev) != hipSuccess) { fprintf(stderr, "kernel_launch: device query failed\n"); grid = -1; return; }
        if (hipFuncSetAttribute((const void*)fwd_megakernel, hipFuncAttributeMaxDynamicSharedMemorySize, LDS_BYTES) != hipSuccess) { fprintf(stderr, "kernel_launch: hipFuncSetAttribute failed\n"); grid = -1; return; }
        if (hipOccupancyMaxActiveBlocksPerMultiprocessor(&per_cu, (const void*)fwd_megakernel, NWAVES * 64, LDS_BYTES) != hipSuccess || per_cu < 1) { fprintf(stderr, "kernel_launch: occupancy query gave %d\n", per_cu); per_cu = 1; }
        (void)hipGetLastError();
        grid = cus * per_cu;
    }
    if (grid < 0) return;
    if (hipMemsetAsync((char*)d_ws + WS_CTL, 0, CTL_ZERO_BYTES, stream) != hipSuccess) { fprintf(stderr, "kernel_launch: hipMemsetAsync failed\n"); return; }
    Args a{};
    Ptrs& p = a.p;
    p.x_in[0] = (const float*)d_in[0]; p.x_in[1] = (const float*)d_in[1]; p.norm_mix = (const float*)d_in[2]; p.pool_w = (const float*)d_in[3]; p.pool_scale = (const float*)d_in[4];
    p.w_qkv = (const float*)d_in[5]; p.rpb = (const float*)d_in[6]; p.w_o = (const float*)d_in[7]; p.norm_mlp = (const float*)d_in[8]; p.w_up = (const float*)d_in[9];
    p.w_down = (const float*)d_in[10]; p.norm_final = (const float*)d_in[11]; p.out = (float*)d_out; p.ws = (unsigned char*)d_ws;
    unsigned char* ws = (unsigned char*)d_ws;
    bf16* WPOOL = (bf16*)(ws + WS_WPOOL); bf16* WQKV = (bf16*)(ws + WS_WQKV); bf16* WO = (bf16*)(ws + WS_WO); bf16* WUP = (bf16*)(ws + WS_WUP); bf16* WDN = (bf16*)(ws + WS_WDN);
    bf16* XN = (bf16*)(ws + WS_XN); bf16* PG = (bf16*)(ws + WS_PG); bf16* QB = (bf16*)(ws + WS_ACT); bf16* HB = (bf16*)(ws + WS_ACT);
    float* SA = (float*)(ws + WS_STAT); float* SB = SA + (size_t)CH * 16;
    int n = 0;
    auto add = [&](int kind, int flags, int N, int K, const void* A, const void* B, void* C, const void* aux, float* st, float* rs, unsigned long long aps) {
        Ph& d = a.tab[n++]; d.kind = kind; d.flags = flags; d.N = N; d.K = K; d.A = A; d.B = B; d.C = C; d.aux = aux; d.st = st; d.rs = rs; d.a_pn_stride = aps; d.pad = 0; };
    for (int layer = 0; layer < DEPTH; ++layer) {
        const int j = layer >> 1;
        if ((layer & 1) == 0) {
            add(K_POOL, layer == 0 ? F_A_IN : F_A_X, 0, 0, nullptr, nullptr, PG, p.norm_mix + layer * D, nullptr, nullptr, 0);
            add(K_GEMM_RES, (layer == 0 ? F_AUX_IN : F_AUX_X) | F_NOX, D, 256, PG, WPOOL + (size_t)j * 1024 * 256, XN, nullptr, SA, nullptr, (unsigned long long)CH * 256 * 2);
        } else {
            add(K_GEMM_QKV, 0, 3 * D, D, XN, WQKV + (size_t)j * 3 * D * D, QB, nullptr, SB, nullptr, 0);
            add(K_ATTN, 0, 0, 0, nullptr, nullptr, QB, p.rpb + (size_t)j * NH * 15 * 31, nullptr, nullptr, 0);
            add(K_GEMM_RES, F_AUX_X | F_NOX, D, D, QB, WO + (size_t)j * D * D, XN, nullptr, SA, nullptr, 0);
        }
        add(K_GEMM_UP, 0, FF, D, XN, WUP + (size_t)layer * D * FF, HB, nullptr, SA, nullptr, 0);
        add(K_GEMM_RES, F_B16, D, FF, HB, WDN + (size_t)layer * D * FF, (layer & 1) == 0 ? XN : nullptr, nullptr, SB, SA, 0);
    }
    add(K_FINAL, 0, 0, 0, nullptr, nullptr, nullptr, p.norm_final, nullptr, nullptr, 0);
    if (n != PPC) { fprintf(stderr, "kernel_launch: phase table has %d entries, expected %d\n", n, PPC); return; }
    void* kargs[] = {&a};
    hipError_t e = hipLaunchCooperativeKernel((const void*)fwd_megakernel, dim3(grid), dim3(NWAVES * 64), kargs, LDS_BYTES, stream);
    if (e != hipSuccess) fprintf(stderr, "kernel_launch: cooperative launch failed: %s (grid %d)\n", hipGetErrorString(e), grid);
}
```

```cpp
#include <hip/hip_runtime.h>
#include <hip/hip_cooperative_groups.h>
#include <cstdio>
#include <cstdint>
namespace cg = cooperative_groups;
namespace pg8 {
#define PG8_LAS __attribute__((address_space(3)))
typedef unsigned short bf16_t;
typedef short bf16x8 __attribute__((ext_vector_type(8)));
typedef float f32x4 __attribute__((ext_vector_type(4)));
typedef unsigned u32x4 __attribute__((ext_vector_type(4)));
constexpr int BM = 256, BK = 64, HALF = 128, HTB = HALF * BK * 2  , STAGE_BYTES = 8 * HTB, NXCD = 8, WGM = 8;

__host__ __device__ __forceinline__ int lds_byte(int r, int c) { const int st = (r >> 4) * 2 + (c >> 5), rr = r & 15, cc = c & 31, ob = rr * 64 + cc * 2; return st * 1024 + (ob ^ (((ob >> 9) & 1) << 5)); }
__host__ __device__ __forceinline__ void stage_rc(int b, int& R, int& C) { const int st = b / 1024, sb = b % 1024, swz = sb ^ (((sb >> 9) & 1) << 5); R = (st >> 1) * 16 + swz / 64; C = (st & 1) * 32 + (swz % 64) / 2; }
__host__ __device__ __forceinline__ int perm32(int rho) { const int n = rho >> 4, i = rho & 15; return 8 * (i >> 2) + 4 * n + (i & 3); }

struct Unit { int pm, pn; };
struct Gemm { const bf16_t* A; const bf16_t* Bt; int M, N, K; size_t a_pn_stride; int a_tiled; };

struct StaticOrder {
    int nM, nN, nwg, G, c;
    __host__ __device__ void init(int M, int N, int G_, int c_) { nM = M / BM; nN = N / BM; nwg = nM * nN; G = G_; c = c_; }
    __host__ __device__ bool next(int i, Unit& u) const {
        const long L = (long)i * G + c; if (L >= nwg) return false;
        int wgid = (int)L; { const int q = nwg / NXCD, r = nwg % NXCD, xcd = wgid % NXCD, off = wgid / NXCD; wgid = (xcd < r ? xcd * (q + 1) : r * (q + 1) + (xcd - r) * q) + off; }
        const int nig = WGM * nN, gid = wgid / nig, fm = gid * WGM, gsz = (nM - fm) < WGM ? (nM - fm) : WGM;
        u.pm = fm + ((wgid % nig) % gsz); u.pn = (wgid % nig) / gsz; return true;
    }
    __device__ __forceinline__ void a_ready(const Unit&) const {}
    __device__ __forceinline__ void done(const Unit&) const {}
};

__device__ __forceinline__ unsigned cvt_pk_bf16(float lo, float hi) { unsigned r; asm volatile("v_cvt_pk_bf16_f32 %0, %1, %2" : "=v"(r) : "v"(lo), "v"(hi)); return r; }
typedef float f32x2 __attribute__((ext_vector_type(2)));
template <int ACT, bool RS> struct EpiBf16 {
    static constexpr bool PERM = true, AFTER_DRAIN = false;
    bf16_t* O; int ldc; int split_cols; size_t split_stride; float scale0; const float* st; int tiled;
    __device__ __forceinline__ void operator()(const f32x4 (&acc)[2][2][4][2], const Unit& u, int wr, int wc, int fr, int fq) const {
        const int row0 = u.pm * BM + wr * 64 + fr; int colt = u.pn * BM; bf16_t* base = O;
        float sc = 1.f; bool kplane = false;
        if (split_cols) { const int t = colt / split_cols; base += (size_t)t * split_stride; colt -= t * split_cols; if (t == 0) sc = scale0; kplane = (t == 1); }
        const size_t kprows = split_stride / 1024;
        const int col0 = colt + wc * 32 + 8 * fq;
        f32x4 pv[2][4];
        if (RS) {
#pragma unroll
            for (int ai = 0; ai < 2; ++ai)
#pragma unroll
                for (int m = 0; m < 4; ++m) pv[ai][m] = *(const f32x4*)(st + (size_t)(row0 + ai * HALF + m * 16) * 16 + 4 * fq);
            __builtin_amdgcn_sched_barrier(0);
        }
#pragma unroll
        for (int ai = 0; ai < 2; ++ai)
#pragma unroll
            for (int m = 0; m < 4; ++m) { const int row = row0 + ai * HALF + m * 16; bf16_t* rowp = base + (size_t)row * ldc + col0;
                float f = sc;
                if (RS) { float ss = (pv[ai][m][0] + pv[ai][m][1]) + (pv[ai][m][2] + pv[ai][m][3]); ss += __shfl_xor(ss, 16); ss += __shfl_xor(ss, 32);
                    const float r = __builtin_amdgcn_rsqf(ss * (1.0f / 1024.0f) + 1e-6f); f *= (ACT == 2) ? r * r : r; }
#pragma unroll
                for (int bj = 0; bj < 2; ++bj) { f32x4 v0 = acc[ai][bj][m][0], v1 = acc[ai][bj][m][1];
                    if (ACT == 2) {
#pragma unroll
                        for (int e = 0; e < 4; ++e) { const float a = fmaxf(v0[e], 0.f), b = fmaxf(v1[e], 0.f); v0[e] = a * a; v1[e] = b * b; } }
                    v0 = v0 * f; v1 = v1 * f; u32x4 w; w.x = cvt_pk_bf16(v0[0], v0[1]); w.y = cvt_pk_bf16(v0[2], v0[3]); w.z = cvt_pk_bf16(v1[0], v1[1]); w.w = cvt_pk_bf16(v1[2], v1[3]);
                    if (kplane) *(u32x4*)(base + ((size_t)(((colt >> 6) + 2 * bj + (wc >> 1)) * 8 + (wc & 1) * 4 + fq) * kprows + row) * 8) = w;
                    else if (tiled) { const int r_ = row & 255, c_ = col0 + bj * HALF;
                        *(u32x4*)((char*)base + ((size_t)(((row >> 8) * 2 + (r_ >> 7)) * (ldc >> 6) + (c_ >> 6)) << 14) + lds_byte(r_ & 127, c_ & 63)) = w; }
                    else *(u32x4*)(rowp + bj * HALF) = w; } }
    }
};
struct EpiRes {
    static constexpr bool PERM = true, AFTER_DRAIN = false;
    const float* base; float* out; bf16_t* xn; float* st; int ldc; const float* rs; const bf16_t* b16;
    __device__ __forceinline__ void operator()(const f32x4 (&acc)[2][2][4][2], const Unit& u, int wr, int wc, int fr, int fq) const {
        const int col0 = u.pn * BM + wc * 32 + 8 * fq;
#pragma unroll
        for (int ai = 0; ai < 2; ++ai) {
            f32x4 rp[4];
            if (rs) {
#pragma unroll
                for (int m = 0; m < 4; ++m) rp[m] = *(const f32x4*)(rs + (size_t)(u.pm * BM + ai * HALF + wr * 64 + m * 16 + fr) * 16 + 4 * fq);
            }
            f32x4 bs[4][2][2];
            if (b16) {
#pragma unroll
                for (int m = 0; m < 4; ++m)
#pragma unroll
                    for (int bj = 0; bj < 2; ++bj) { const int c_ = col0 + bj * HALF;
                        const u32x4 w = *(const u32x4*)((const char*)b16 + ((size_t)((u.pm * 2 + ai) * (ldc >> 6) + (c_ >> 6)) << 14) + lds_byte(wr * 64 + m * 16 + fr, c_ & 63));
                        bs[m][bj][0] = (f32x4){__builtin_bit_cast(float, w.x << 16), __builtin_bit_cast(float, w.x & 0xffff0000u), __builtin_bit_cast(float, w.y << 16), __builtin_bit_cast(float, w.y & 0xffff0000u)};
                        bs[m][bj][1] = (f32x4){__builtin_bit_cast(float, w.z << 16), __builtin_bit_cast(float, w.z & 0xffff0000u), __builtin_bit_cast(float, w.w << 16), __builtin_bit_cast(float, w.w & 0xffff0000u)}; }
            } else {
#pragma unroll
                for (int m = 0; m < 4; ++m) { const size_t off = (size_t)(u.pm * BM + ai * HALF + wr * 64 + m * 16 + fr) * ldc + col0;
#pragma unroll
                    for (int bj = 0; bj < 2; ++bj) { bs[m][bj][0] = *(const f32x4*)(base + off + bj * HALF); bs[m][bj][1] = *(const f32x4*)(base + off + bj * HALF + 4); } }
            }
            __builtin_amdgcn_sched_barrier(0);
#pragma unroll
            for (int m = 0; m < 4; ++m) { const int row = u.pm * BM + ai * HALF + wr * 64 + m * 16 + fr; const size_t off = (size_t)row * ldc + col0; float ss = 0.f;
                float f = 1.f;
                if (rs) { float q = (rp[m][0] + rp[m][1]) + (rp[m][2] + rp[m][3]); q += __shfl_xor(q, 16); q += __shfl_xor(q, 32); const float r = __builtin_amdgcn_rsqf(q * (1.0f / 1024.0f) + 1e-6f); f = r * r; }
#pragma unroll
                for (int bj = 0; bj < 2; ++bj) {
                    const f32x4 o0 = bs[m][bj][0] + acc[ai][bj][m][0] * f, o1 = bs[m][bj][1] + acc[ai][bj][m][1] * f;
                    if (out) { *(f32x4*)(out + off + bj * HALF) = o0; *(f32x4*)(out + off + bj * HALF + 4) = o1; }
                    if (xn) { u32x4 w; w.x = cvt_pk_bf16(o0[0], o0[1]); w.y = cvt_pk_bf16(o0[2], o0[3]); w.z = cvt_pk_bf16(o1[0], o1[1]); w.w = cvt_pk_bf16(o1[2], o1[3]);
                        { const int c_ = col0 + bj * HALF;
                          *(u32x4*)((char*)xn + ((size_t)((u.pm * 2 + ai) * (ldc >> 6) + (c_ >> 6)) << 14) + lds_byte(wr * 64 + m * 16 + fr, c_ & 63)) = w; }
                        ss += (o0[0] * o0[0] + o0[1] * o0[1]) + (o0[2] * o0[2] + o0[3] * o0[3]) + (o1[0] * o1[0] + o1[1] * o1[1]) + (o1[2] * o1[2] + o1[3] * o1[3]); } }
                if (xn) { ss += __shfl_xor(ss, 16); ss += __shfl_xor(ss, 32); if (fq == 0) st[(size_t)row * 16 + u.pn * 4 + wc] = ss; } }
        }
    }
};
template <class Epi, class Sched, bool ALIGN_EPI = false, bool SP2 = false>
__device__ __forceinline__ void gemm_phase(PG8_LAS unsigned char* lds, const Gemm g, const Sched& S, const Epi& E, const int tid_in) {
    const int tid = tid_in, wid = __builtin_amdgcn_readfirstlane(tid >> 6), lane = tid & 63, wr = wid >> 2, wc = wid & 3, fr = lane & 15, fq = lane >> 4;
    const int K = g.K, nt = K / BK;
    unsigned voffA[2], voffB[2];
#pragma unroll
    for (int i = 0; i < 2; ++i) { int R, C; stage_rc(tid * 16 + i * 8192, R, C); const int Rb = Epi::PERM ? ((R & ~31) + perm32(R & 31)) : R;
        voffA[i] = g.a_tiled ? (unsigned)(tid * 16 + i * 8192) : (unsigned)(R * K + C) * 2u; voffB[i] = (unsigned)(tid * 16 + i * 8192); (void)Rb; }
    const size_t kstep = (size_t)(BK * 2);
    const size_t hstep = (size_t)HALF * K * 2;
    const size_t tstep = 2 * hstep;
    const size_t kstepB = 16384, hstepB = (size_t)nt * 16384, tstepB = 2 * hstepB;
    const size_t kstepA = g.a_tiled ? (size_t)16384 : kstep, hstepA = g.a_tiled ? (size_t)nt * 16384 : hstep, tstepA = 2 * hstepA;
    const unsigned ldsw = (unsigned)wid * 1024u;
    const int aoff = lds_byte(wr * 64 + fr, fq * 8), boff = lds_byte(wc * 32 + fr, fq * 8);
#define PG8_SA(b, h) (((b) * 2 + (h)) * HTB)
#define PG8_SB(b, h) ((4 + (b) * 2 + (h)) * HTB)
#define PG8_STAGE(bufoff, gbase, voff) do { _Pragma("unroll") for (int _i = 0; _i < 2; ++_i) \
        __builtin_amdgcn_global_load_lds((const unsigned*)((const char*)(gbase) + (voff)[_i]), (PG8_LAS unsigned*)(lds + (bufoff) + ldsw + _i * 8192), 16, 0, 0); } while (0)
#define PG8_LDA(dst, b, h) do { _Pragma("unroll") for (int m = 0; m < 4; ++m) _Pragma("unroll") for (int k = 0; k < 2; ++k) dst[m][k] = *(const PG8_LAS bf16x8*)(lds + PG8_SA(b, h) + aoff + m * 2048 + k * 1024); } while (0)
#define PG8_LDB(dst, b, h) do { _Pragma("unroll") for (int n = 0; n < 2; ++n) _Pragma("unroll") for (int k = 0; k < 2; ++k) dst[n][k] = *(const PG8_LAS bf16x8*)(lds + PG8_SB(b, h) + boff + n * 2048 + k * 1024); } while (0)
#define PG8_MMA(ai, bj, At, Bt) do { __builtin_amdgcn_s_setprio(1); _Pragma("unroll") for (int m = 0; m < 4; ++m) _Pragma("unroll") for (int n = 0; n < 2; ++n) _Pragma("unroll") for (int k = 0; k < 2; ++k) \
        acc[ai][bj][m][n] = __builtin_amdgcn_mfma_f32_16x16x32_bf16(Bt[n][k], At[m][k], acc[ai][bj][m][n], 0, 0, 0); __builtin_amdgcn_s_setprio(0); } while (0)
#define PG8_WAIT_V(n) asm volatile("s_waitcnt vmcnt(" #n ")" ::: "memory")
#define PG8_WAIT_L(n) asm volatile("s_waitcnt lgkmcnt(" #n ")" ::: "memory")
#define PG8_BAR __builtin_amdgcn_s_barrier()
#define PG8_SCHED __builtin_amdgcn_sched_barrier(0)
    Unit cur, nxt; int ui = 0;
    if (!S.next(0, cur)) return;
    f32x4 acc[2][2][4][2];
#pragma unroll
    for (int a = 0; a < 2; ++a)
#pragma unroll
        for (int b = 0; b < 2; ++b)
#pragma unroll
            for (int m = 0; m < 4; ++m)
#pragma unroll
                for (int n = 0; n < 2; ++n) acc[a][b][m][n] = (f32x4){0.f, 0.f, 0.f, 0.f};
    bf16x8 At[4][2], B0[2][2], B1[2][2];
    const char* cA = (const char*)g.A + (size_t)cur.pm * tstepA + (size_t)cur.pn * g.a_pn_stride; const char* cB = (const char*)g.Bt + (size_t)cur.pn * tstepB;
    S.a_ready(cur);
    if constexpr (SP2) {
        PG8_STAGE(PG8_SB(0, 0), cB, voffB); PG8_STAGE(PG8_SB(0, 1), cB + hstepB, voffB); PG8_STAGE(PG8_SA(0, 0), cA, voffA); PG8_STAGE(PG8_SA(0, 1), cA + hstepA, voffA);
        if (wr == 1) PG8_BAR;
        PG8_WAIT_V(2); PG8_BAR;
        PG8_STAGE(PG8_SB(1, 0), cB + kstepB, voffB); PG8_STAGE(PG8_SA(1, 0), cA + kstepA, voffA); PG8_STAGE(PG8_SB(1, 1), cB + hstepB + kstepB, voffB);
        PG8_WAIT_V(6); PG8_BAR;
    } else {
        PG8_STAGE(PG8_SB(0, 0), cB, voffB); PG8_STAGE(PG8_SA(0, 0), cA, voffA); PG8_STAGE(PG8_SB(0, 1), cB + hstepB, voffB); PG8_STAGE(PG8_SA(0, 1), cA + hstepA, voffA);
        if (wr == 1) PG8_BAR;
        PG8_WAIT_V(4); PG8_BAR;
        PG8_STAGE(PG8_SB(1, 0), cB + kstepB, voffB); PG8_STAGE(PG8_SA(1, 0), cA + kstepA, voffA); PG8_STAGE(PG8_SB(1, 1), cB + hstepB + kstepB, voffB);
        PG8_WAIT_V(6); PG8_BAR;
    }
    for (;;) {
        const bool has_next = S.next(ui + 1, nxt);
        const char* nA = has_next ? (const char*)g.A + (size_t)nxt.pm * tstepA + (size_t)nxt.pn * g.a_pn_stride : cA; const char* nB = has_next ? (const char*)g.Bt + (size_t)nxt.pn * tstepB : cB;
        for (int t = 0; t < nt; t += 2) {
            const bool last = (t == nt - 2);
            const char* a1 = cA + (size_t)(t + 1) * kstepA;
            const char* a2 = last ? nA : cA + (size_t)(t + 2) * kstepA; const char* b2 = last ? nB : cB + (size_t)(t + 2) * kstepB;
            const char* a3 = a2 + kstepA; const char* b3 = b2 + kstepB;
            if (last && has_next) S.a_ready(nxt);
            if constexpr (SP2) {
            PG8_LDB(B0, 0, 0); PG8_LDB(B1, 0, 1); PG8_SCHED; PG8_LDA(At, 0, 0); PG8_STAGE(PG8_SA(1, 1), a1 + hstepA, voffA);
            PG8_WAIT_V(8); PG8_WAIT_L(0); PG8_BAR; PG8_MMA(0, 0, At, B0); PG8_MMA(0, 1, At, B1); PG8_BAR; PG8_SCHED;
            PG8_LDA(At, 0, 1); PG8_STAGE(PG8_SB(0, 0), b2, voffB); PG8_STAGE(PG8_SB(0, 1), b2 + hstepB, voffB); PG8_STAGE(PG8_SA(0, 0), a2, voffA);
            PG8_WAIT_V(8); PG8_WAIT_L(0); PG8_BAR; PG8_MMA(1, 0, At, B0); PG8_MMA(1, 1, At, B1); PG8_BAR; PG8_SCHED;
            PG8_LDB(B0, 1, 0); PG8_LDB(B1, 1, 1); PG8_SCHED; PG8_LDA(At, 1, 0); PG8_STAGE(PG8_SA(0, 1), a2 + hstepA, voffA);
            PG8_WAIT_V(8); PG8_WAIT_L(0); PG8_BAR; PG8_MMA(0, 0, At, B0); PG8_MMA(0, 1, At, B1); PG8_BAR; PG8_SCHED;
            PG8_LDA(At, 1, 1); PG8_STAGE(PG8_SB(1, 0), b3, voffB); PG8_STAGE(PG8_SB(1, 1), b3 + hstepB, voffB); PG8_STAGE(PG8_SA(1, 0), a3, voffA);
            PG8_WAIT_V(8); PG8_WAIT_L(0); PG8_BAR; PG8_MMA(1, 0, At, B0); PG8_MMA(1, 1, At, B1); PG8_BAR; PG8_SCHED;
            } else {
            PG8_LDB(B0, 0, 0); PG8_SCHED; PG8_LDA(At, 0, 0); PG8_STAGE(PG8_SA(1, 1), a1 + hstepA, voffA);
            PG8_WAIT_L(8); PG8_BAR; PG8_WAIT_L(0); PG8_MMA(0, 0, At, B0); PG8_BAR; PG8_SCHED;
            PG8_LDB(B1, 0, 1); PG8_STAGE(PG8_SB(0, 0), b2, voffB);
            PG8_BAR; PG8_WAIT_L(0); PG8_MMA(0, 1, At, B1); PG8_BAR;
            PG8_LDA(At, 0, 1); PG8_STAGE(PG8_SA(0, 0), a2, voffA);
            PG8_BAR; PG8_WAIT_L(0); PG8_MMA(1, 0, At, B0); PG8_BAR; PG8_SCHED;
            PG8_STAGE(PG8_SB(0, 1), b2 + hstepB, voffB);
            PG8_WAIT_V(6); PG8_BAR; PG8_MMA(1, 1, At, B1); PG8_BAR;
            PG8_LDB(B0, 1, 0); PG8_SCHED; PG8_LDA(At, 1, 0); PG8_STAGE(PG8_SA(0, 1), a2 + hstepA, voffA);
            PG8_WAIT_L(8); PG8_BAR; PG8_WAIT_L(0); PG8_MMA(0, 0, At, B0); PG8_BAR; PG8_SCHED;
            PG8_LDB(B1, 1, 1); PG8_STAGE(PG8_SB(1, 0), b3, voffB);
            PG8_BAR; PG8_WAIT_L(0); PG8_MMA(0, 1, At, B1); PG8_BAR;
            PG8_LDA(At, 1, 1); PG8_STAGE(PG8_SA(1, 0), a3, voffA);
            PG8_BAR; PG8_WAIT_L(0); PG8_MMA(1, 0, At, B0); PG8_BAR; PG8_SCHED;
            PG8_STAGE(PG8_SB(1, 1), b3 + hstepB, voffB);
            PG8_WAIT_V(6); PG8_BAR; PG8_MMA(1, 1, At, B1); PG8_BAR;
            }
        }
        if constexpr (ALIGN_EPI) { if (wr == 0) PG8_BAR; }
        if constexpr (!Epi::AFTER_DRAIN) { E(acc, cur, wr, wc, fr, fq); S.done(cur); }
        if (!has_next) break;
#pragma unroll
        for (int a = 0; a < 2; ++a)
#pragma unroll
            for (int b = 0; b < 2; ++b)
#pragma unroll
                for (int m = 0; m < 4; ++m)
#pragma unroll
                    for (int n = 0; n < 2; ++n) acc[a][b][m][n] = (f32x4){0.f, 0.f, 0.f, 0.f};
        cur = nxt; cA = nA; cB = nB; ++ui;
        if constexpr (ALIGN_EPI) { if (wr == 1) PG8_BAR; }
    }
    PG8_WAIT_V(0);
    if constexpr (!ALIGN_EPI) { if (wr == 0) PG8_BAR; }
    PG8_BAR;
    if constexpr (Epi::AFTER_DRAIN) { E.fused(acc, cur, wr, wc, fr, fq, lds, wid, lane); S.done(cur); }
#undef PG8_SA
#undef PG8_SB
#undef PG8_STAGE
#undef PG8_LDA
#undef PG8_LDB
#undef PG8_MMA
#undef PG8_WAIT_V
#undef PG8_WAIT_L
#undef PG8_BAR
#undef PG8_SCHED
}
}
#ifndef PG8_SP2
#define PG8_SP2 true
#endif
#ifndef PG8_ALIGN
#define PG8_ALIGN true
#endif

constexpr int NWAVES = 8;
constexpr int D = 1024, FF = 4096, NH = 16, HD = 64, DEPTH = 4;
constexpr int NTOK = 131072;
constexpr int GROUP_TOK = 65536;
#ifndef MK_CH
#define MK_CH 65536
#endif
constexpr int CH = MK_CH;
constexpr int NCHUNK = NTOK / CH;
constexpr float RMS_EPS = 1e-6f;
constexpr float LOG2E = 1.4426950408889634f;
static_assert(GROUP_TOK % CH == 0 && CH % 4096 == 0, "chunking");

constexpr size_t MiB = 1u << 20;
constexpr size_t WS_WPOOL = 2 * MiB;
constexpr size_t WS_WQKV = 4 * MiB;
constexpr size_t WS_WO = 16 * MiB;
constexpr size_t WS_WUP = 20 * MiB;
constexpr size_t WS_WDN = 52 * MiB;
constexpr size_t WS_XN = 96 * MiB;
constexpr size_t WS_PG = WS_XN + (size_t)CH * D * 2;
constexpr size_t WS_ACT = WS_PG + (size_t)CH * D * 2;
constexpr size_t WS_CTL = 0, CTL_ZERO_BYTES = 65536;
constexpr size_t WS_STAT = 86 * MiB;
static_assert(WS_STAT + 2 * (size_t)CH * 64 <= WS_XN, "stat arrays");
constexpr size_t WS_END = WS_ACT + (size_t)CH * FF * 2;
static_assert(WS_XN >= WS_WDN + 32 * MiB && WS_END <= 1024 * MiB, "d_ws map");

constexpr int RING_BYTES = 131072;
constexpr int BIAS_OFF = RING_BYTES;
constexpr int MISC_OFF = RING_BYTES + 4096;
constexpr int LDS_BYTES = 147456;

#define GAS __attribute__((address_space(1)))
#define LAS __attribute__((address_space(3)))
typedef unsigned short bf16;
typedef unsigned v4u __attribute__((ext_vector_type(4)));
typedef unsigned v2u __attribute__((ext_vector_type(2)));
typedef float f32x4 __attribute__((ext_vector_type(4)));
typedef short bf16x8 __attribute__((ext_vector_type(8)));
typedef short s16x4 __attribute__((ext_vector_type(4)));
#define LDS_WAIT() asm volatile("s_waitcnt lgkmcnt(0)" ::: "memory")
typedef float f32x2_t __attribute__((ext_vector_type(2))); typedef __bf16 bf16x2_t __attribute__((ext_vector_type(2)));
__device__ __forceinline__ unsigned pk2(float lo, float hi) { f32x2_t v = {lo, hi}; bf16x2_t b = __builtin_convertvector(v, bf16x2_t); return __builtin_bit_cast(unsigned, b); }
__device__ __forceinline__ float wave_sum(float v) {
#pragma unroll
    for (int o = 1; o < 64; o <<= 1) v += __shfl_xor(v, o);
    return v;
}

__device__ __forceinline__ void transpose_item(const float* W, int K, int N, bf16* WT, int row_off, const float* nscale, const float* kscale, LAS float* scr, int item, int lane) {
    const int nblk = N / 32, kb = item / nblk, nb = item % nblk, k0 = 64 * kb, n0 = 32 * nb;
    float wv[32];
#pragma unroll
    for (int i = 0; i < 32; ++i) wv[i] = W[(size_t)(k0 + 2 * i + (lane >> 5)) * N + n0 + (lane & 31)];
#pragma unroll
    for (int i = 0; i < 32; ++i) scr[(2 * i + (lane >> 5)) * 33 + (lane & 31)] = wv[i];
    LDS_WAIT(); asm volatile("" ::: "memory");
    const int c = lane & 7;
    float ks[8];
#pragma unroll
    for (int e = 0; e < 8; ++e) ks[e] = kscale ? kscale[k0 + 8 * c + e] : 1.f;
#pragma unroll
    for (int j = 0; j < 4; ++j) { const int n = (lane >> 3) + 8 * j; const LAS float* s = scr + (8 * c) * 33 + n;
        const float sc = nscale ? nscale[n0 + n] : 1.f;
        v4u o; o.x = pk2(s[0 * 33] * sc * ks[0], s[1 * 33] * sc * ks[1]); o.y = pk2(s[2 * 33] * sc * ks[2], s[3 * 33] * sc * ks[3]); o.z = pk2(s[4 * 33] * sc * ks[4], s[5 * 33] * sc * ks[5]); o.w = pk2(s[6 * 33] * sc * ks[6], s[7 * 33] * sc * ks[7]);
        { const int ng = row_off + n0 + n, nr = ng & 127, cc = nr & 31, slot = (((cc >> 2) & 1) << 4) | ((cc >> 3) << 2) | (cc & 3), kk = k0 + 8 * c;
          *(GAS v4u*)((GAS char*)WT + ((size_t)(((ng >> 8) * 2 + ((ng >> 7) & 1)) * (K >> 6) + (kk >> 6)) << 14) + pg8::lds_byte((nr & ~31) + slot, kk & 63)) = o; } }
    LDS_WAIT(); asm volatile("" ::: "memory");
}

struct Ptrs {
    const float *x_in[2], *norm_mix, *pool_w, *pool_scale, *w_qkv, *rpb, *w_o, *norm_mlp, *w_up, *w_down, *norm_final;
    float* out; unsigned char* ws;
};

__device__ __forceinline__ void prologue(const Ptrs& P, LAS unsigned char* lds, int gw, int NGW, int wave, int lane) {
    LAS float* scr = (LAS float*)(lds + wave * 16384);
    bf16* WPOOL = (bf16*)(P.ws + WS_WPOOL); bf16* WQKV = (bf16*)(P.ws + WS_WQKV); bf16* WO = (bf16*)(P.ws + WS_WO); bf16* WUP = (bf16*)(P.ws + WS_WUP); bf16* WDN = (bf16*)(P.ws + WS_WDN);
    constexpr int I_POOL = (256 / 64) * (256 / 32), I_QKV = (D / 64) * (3 * D / 32), I_O = (D / 64) * (D / 32), I_UP = (D / 64) * (FF / 32), I_DN = (FF / 64) * (D / 32);
    constexpr int NITEMS = 8 * I_POOL + 2 * I_QKV + 2 * I_O + 4 * I_UP + 4 * I_DN;
    for (int it = gw; it < NITEMS; it += NGW) {
        int r = it;
        if (r < 8 * I_POOL) { const int mtx = r / I_POOL, j = mtx >> 2, g = mtx & 3; transpose_item(P.pool_w + (size_t)mtx * 65536, 256, 256, WPOOL + (size_t)j * 1024 * 256, g * 256, P.pool_scale + j * 1024 + g * 256, nullptr, scr, r % I_POOL, lane); continue; } r -= 8 * I_POOL;
        if (r < 2 * I_QKV) { const int j = r / I_QKV; transpose_item(P.w_qkv + (size_t)j * D * 3 * D, D, 3 * D, WQKV + (size_t)j * 3 * D * D, 0, nullptr, P.norm_mix + (2 * j + 1) * D, scr, r % I_QKV, lane); continue; } r -= 2 * I_QKV;
        if (r < 2 * I_O) { const int j = r / I_O; transpose_item(P.w_o + (size_t)j * D * D, D, D, WO + (size_t)j * D * D, 0, nullptr, nullptr, scr, r % I_O, lane); continue; } r -= 2 * I_O;
        if (r < 4 * I_UP) { const int j = r / I_UP; transpose_item(P.w_up + (size_t)j * D * FF, D, FF, WUP + (size_t)j * D * FF, 0, nullptr, P.norm_mlp + j * D, scr, r % I_UP, lane); continue; } r -= 4 * I_UP;
        { const int j = r / I_DN; transpose_item(P.w_down + (size_t)j * D * FF, FF, D, WDN + (size_t)j * D * FF, 0, nullptr, nullptr, scr, r % I_DN, lane); }
    }
}

__device__ __forceinline__ void norm_rows_f32_inplace(float* x, const float* gain, int nrows, int gw, int NGW, int lane) {
    f32x4 g[4];
#pragma unroll
    for (int j = 0; j < 4; ++j) g[j] = *((const f32x4*)gain + lane + 64 * j);
    for (int m = gw * 4; m < nrows; m += NGW * 4) {
        GAS f32x4* xr = (GAS f32x4*)(x + (size_t)m * D) + lane;
        f32x4 v[4][4];
#pragma unroll
        for (int r = 0; r < 4; ++r)
#pragma unroll
            for (int j = 0; j < 4; ++j) v[r][j] = xr[r * 256 + 64 * j];
        __builtin_amdgcn_sched_barrier(0);
#pragma unroll
        for (int r = 0; r < 4; ++r) { float s = 0.f;
#pragma unroll
            for (int j = 0; j < 4; ++j) s += (v[r][j].x * v[r][j].x + v[r][j].y * v[r][j].y) + (v[r][j].z * v[r][j].z + v[r][j].w * v[r][j].w);
            const float rr = 1.0f / sqrtf(wave_sum(s) * (1.f / D) + RMS_EPS);
#pragma unroll
            for (int j = 0; j < 4; ++j) xr[r * 256 + 64 * j] = v[r][j] * rr * g[j]; }
    }
}

constexpr int PT = 32, PROWS = 48;
typedef float f32x2v __attribute__((ext_vector_type(2)));
__device__ __forceinline__ f32x2v bfpair(unsigned u) { return (f32x2v){__builtin_bit_cast(float, u << 16), __builtin_bit_cast(float, u & 0xffff0000u)}; }
struct f32x8 { f32x4 lo, hi; };
__device__ __forceinline__ f32x8 bf8(const v4u u) { f32x8 r; r.lo = (f32x4){__builtin_bit_cast(float, u.x << 16), __builtin_bit_cast(float, u.x & 0xffff0000u), __builtin_bit_cast(float, u.y << 16), __builtin_bit_cast(float, u.y & 0xffff0000u)};
    r.hi = (f32x4){__builtin_bit_cast(float, u.z << 16), __builtin_bit_cast(float, u.z & 0xffff0000u), __builtin_bit_cast(float, u.w << 16), __builtin_bit_cast(float, u.w & 0xffff0000u)}; return r; }
__device__ __forceinline__ v4u pack8(const f32x4 a, const f32x4 b) { v4u o; o.x = pk2(a[0], a[1]); o.y = pk2(a[2], a[3]); o.z = pk2(b[0], b[1]); o.w = pk2(b[2], b[3]); return o; }
template <int W> __device__ __forceinline__ void pool_rows_interior(const LAS v4u* hrow, GAS v4u* po) {
    constexpr int HW = W / 2; constexpr float INV = 1.0f / (float)W;
    f32x4 sl = {0.f, 0.f, 0.f, 0.f}, sh = {0.f, 0.f, 0.f, 0.f};
#pragma unroll
    for (int o = -HW; o < HW; ++o) { const f32x8 h = bf8(hrow[(8 + o) * 128]); sl += h.lo; sh += h.hi; }
    __builtin_amdgcn_sched_barrier(0);
#pragma unroll
    for (int i = 0; i < 8; ++i) {
        const f32x8 c = bf8(hrow[(8 + i) * 128]);
        po[(size_t)i * 32] = pack8(sl * INV - c.lo, sh * INV - c.hi);
        if (i + 1 < 8) { const f32x8 a = bf8(hrow[(8 + i + HW) * 128]), b = bf8(hrow[(8 + i - HW) * 128]); sl += a.lo - b.lo; sh += a.hi - b.hi; }
        __builtin_amdgcn_sched_barrier(0);
    }
}
__device__ __forceinline__ void pool_load_rows(f32x4 (&v)[6][4], const float* x, int m0, int seq_len, int wave, int lane) {
    const int sb = m0 / seq_len * seq_len, t0 = m0 - sb;
#pragma unroll
    for (int k = 0; k < 6; ++k) { const int t = min(max(t0 - 8 + wave + NWAVES * k, 0), seq_len - 1);
        const GAS f32x4* xr = (const GAS f32x4*)(x + (size_t)(sb + t) * D) + lane;
#pragma unroll
        for (int j = 0; j < 4; ++j) v[k][j] = xr[64 * j]; }
}
__device__ __forceinline__ void pool_phase(LAS unsigned char* lds, const float* x, const float* gain, bf16* Pg, int seq_len, int vcu, int G, int tid, int wave, int lane) {
    f32x4 v[6][4];
    if (vcu < CH / PT) pool_load_rows(v, x, vcu * PT, seq_len, wave, lane);
    for (int tile = vcu; tile < CH / PT; tile += G) {
        const int m0 = tile * PT;
        const int sb = m0 / seq_len * seq_len;
        const int t0 = m0 - sb;
        f32x4 g[4];
#pragma unroll
        for (int j = 0; j < 4; ++j) g[j] = *((const GAS f32x4*)gain + lane + 64 * j);
#pragma unroll
        for (int k = 0; k < 6; ++k) { float s = 0.f;
#pragma unroll
            for (int j = 0; j < 4; ++j) s += (v[k][j].x * v[k][j].x + v[k][j].y * v[k][j].y) + (v[k][j].z * v[k][j].z + v[k][j].w * v[k][j].w);
            const float r = 1.0f / sqrtf(wave_sum(s) * (1.f / D) + RMS_EPS);
            LAS v2u* hr = (LAS v2u*)(lds + (wave + NWAVES * k) * 2048) + lane;
#pragma unroll
            for (int j = 0; j < 4; ++j) { v2u o; o.x = pk2(v[k][j].x * r * g[j].x, v[k][j].y * r * g[j].y); o.y = pk2(v[k][j].z * r * g[j].z, v[k][j].w * r * g[j].w); hr[64 * j] = o; } }
        __syncthreads();
        if (tile + G < CH / PT) { pool_load_rows(v, x, (tile + G) * PT, seq_len, wave, lane); __builtin_amdgcn_sched_barrier(0); }
        {
            const int pg = wave & 3, part = (lane >> 5) + 2 * (wave >> 2), oc = lane & 31, pw = 2 << pg, phw = pw >> 1;
            const LAS v4u* hrow = (const LAS v4u*)(lds + (8 * part) * 2048 + pg * 512 + oc * 16);
            GAS v4u* po = (GAS v4u*)(Pg + ((size_t)pg * CH + m0 + 8 * part) * 256 + oc * 8);
            if (t0 >= 8 && t0 + PT + 8 <= seq_len) {
                switch (pg) { case 0: pool_rows_interior<2>(hrow, po); break; case 1: pool_rows_interior<4>(hrow, po); break; case 2: pool_rows_interior<8>(hrow, po); break; default: pool_rows_interior<16>(hrow, po); break; }
            } else {
                for (int i = 0; i < 8; ++i) {
                    const int t = t0 + 8 * part + i;
                    const int lo = max(t - phw, 0), hi = min(t + phw - 1, seq_len - 1);
                    f32x4 sl = {0.f, 0.f, 0.f, 0.f}, sh = {0.f, 0.f, 0.f, 0.f};
                    for (int q = lo; q <= hi; ++q) { const f32x8 h = bf8(hrow[(8 + q - t + i) * 128]); sl += h.lo; sh += h.hi; }
                    const f32x8 c = bf8(hrow[(8 + i) * 128]);
                    const float inv = 1.0f / (float)(hi - lo + 1);
                    po[(size_t)i * 32] = pack8(sl * inv - c.lo, sh * inv - c.hi);
                }
            }
        }
        __syncthreads();
    }
}

#define RLX_AGENT __ATOMIC_RELAXED, __HIP_MEMORY_SCOPE_AGENT
#define XB_TMO      128
#define XB_XCNT(j)  (256  + 64 * (j))
#define XB_XSUB(j)  (1280 + 64 * (j))
#define XB_XGEN(j)  (2304 + 64 * (j))
#define XB_TOP      3328
#define XB_TOPGEN   3392
#define XCD_BAR_WORDS 3456
#define XB_SPIN_CAP (1u << 18)

__device__ __forceinline__ unsigned xb_ld(unsigned* p)              { return __hip_atomic_load(p, __ATOMIC_RELAXED, __HIP_MEMORY_SCOPE_AGENT); }
__device__ __forceinline__ unsigned xb_add(unsigned* p, unsigned v) { return __hip_atomic_fetch_add(p, v, __ATOMIC_RELAXED, __HIP_MEMORY_SCOPE_AGENT); }
__device__ __forceinline__ unsigned xb_xcc_id() { return (unsigned)__builtin_amdgcn_s_getreg((3 << 11) | 20) & 0xFu; }
#define XB_SPIN(cond, bar) do { unsigned _sp = 0; while (cond) { __builtin_amdgcn_s_sleep(1); \
    if ((++_sp & 255u) == 0u) { if (xb_ld(&(bar)[XB_TMO])) break; if (_sp > XB_SPIN_CAP) { atomicAdd(&(bar)[XB_TMO], 1u); break; } } } } while (0)

struct XcdBarrier {
    unsigned* bar; unsigned x;
    volatile LAS unsigned* st;
};

__device__ __forceinline__ XcdBarrier xcd_barrier_post(unsigned* bar, volatile LAS unsigned* st) {
    XcdBarrier b; b.bar = bar; b.x = xb_xcc_id(); b.st = st;
    if (threadIdx.x == 0) (void)xb_add(&bar[XB_XCNT(b.x)], 1u);
    return b;
}
__device__ __forceinline__ void xcd_barrier_complete(unsigned* bar, unsigned x, unsigned& nloc, unsigned& nx) {
    const unsigned G = gridDim.x * gridDim.y * gridDim.z;
    unsigned sum, cnt, mine, sp = 0u;
    for (;;) {
        sum = 0u; cnt = 0u; mine = 0u;
#pragma unroll
        for (unsigned j = 0; j < 16; ++j) { const unsigned c = xb_ld(&bar[XB_XCNT(j)]); sum += c; cnt += (c > 0u) ? 1u : 0u; mine = (j == x) ? c : mine; }
        if (sum == G) break;
        __builtin_amdgcn_s_sleep(1);
        if ((++sp & 255u) == 0u) { if (xb_ld(&bar[XB_TMO])) break; if (sp > XB_SPIN_CAP) { atomicAdd(&bar[XB_TMO], 1u); break; } }
    }
    nloc = mine > 0u ? mine : 1u; nx = cnt > 0u ? cnt : 1u;
}

__device__ __forceinline__ void xcd_barrier(const XcdBarrier& b) {
    asm volatile("s_waitcnt vmcnt(0)" ::: "memory");
    __syncthreads();
    if (threadIdx.x == 0) {
        unsigned* bar = b.bar;
        __builtin_amdgcn_s_waitcnt(0);
        unsigned nloc = b.st[0], nx = b.st[1];
        if (nloc == 0u) { xcd_barrier_complete(bar, b.x, nloc, nx); b.st[0] = nloc; b.st[1] = nx; }
        const unsigned old = xb_add(&bar[XB_XSUB(b.x)], 1u);
        const unsigned gen = old / nloc;
        if (old + 1u == (gen + 1u) * nloc) {
            __builtin_amdgcn_fence(__ATOMIC_RELEASE, "agent");
            asm volatile("s_waitcnt vmcnt(0)" ::: "memory");
            const unsigned og = xb_add(&bar[XB_TOP], 1u);
            const unsigned tg = og / nx;
            if (og + 1u == (tg + 1u) * nx) xb_add(&bar[XB_TOPGEN], 1u);
            else XB_SPIN(xb_ld(&bar[XB_TOPGEN]) == tg, bar);
            __builtin_amdgcn_fence(__ATOMIC_ACQUIRE, "agent");
            xb_add(&bar[XB_XGEN(b.x)], 1u);
            asm volatile("s_waitcnt vmcnt(0)" ::: "memory");
        } else {
            XB_SPIN(xb_ld(&bar[XB_XGEN(b.x)]) == gen, bar);
            __builtin_amdgcn_fence(__ATOMIC_ACQUIRE, "agent");
            asm volatile("s_waitcnt vmcnt(0)" ::: "memory");
        }
    }
    __syncthreads();
}


__device__ __forceinline__ unsigned cvtpk(float lo, float hi) { return pk2(lo, hi); }
__device__ __forceinline__ s16x4 vtr(const LAS unsigned char* p) { return __builtin_bit_cast(s16x4, __builtin_amdgcn_ds_read_tr16_b64_v4i16((LAS s16x4*)p)); }
__device__ __forceinline__ void attn_phase(LAS unsigned char* lds, bf16* Qb, const bf16* Kb, const bf16* Vb, const float* rpb_l, int seq_len, int G, int bx, int tid, int wave, int lane) {
    const int fr = lane & 15, fq = lane >> 4;
    const int rows = seq_len >> 6, rows_shift = (seq_len == 2048) ? 5 : 6;
    constexpr int NI = (CH / 64) * 8;
    int nx, xc, lc, per;
    if ((G & 7) == 0) { nx = G >> 3; xc = bx & 7; lc = bx >> 3; per = NI >> 3; } else { nx = G; xc = 0; lc = bx; per = NI; }
    LAS float* bias = (LAS float*)(lds + BIAS_OFF);
    const int qb = wave & 3, hh = wave >> 2;
    const int qc = (qb < 3) ? (8 + 16 * qb + fr) : (fr < 8 ? fr : 48 + fr);
    const int a0 = (qb < 3) ? qb : 0, a1 = (qb < 3) ? qb + 1 : 3;
    const int wst = min(max(qc - 8, 0), 48);
    const int q4 = (lane & 15) >> 2, p4 = lane & 3;
    bool sel[4];
#pragma unroll
    for (int i = 0; i < 4; ++i) sel[i] = (qb < 3) ? (4 * fq + i >= fr) : (fr < 8);
    int voff[4];
#pragma unroll
    for (int i3 = 0; i3 < 4; ++i3) voff[i3] = (lane >> 4) * D + (((lane & 15) ^ (((lane >> 4) << 2) | i3)) * 8);
    if (lc >= per) return;
    int id = xc * per + lc;
    int r = id & (rows - 1), hp = (id >> rows_shift) & 7, tb = (id >> (rows_shift + 3)) * seq_len, r0 = min(max(r - 4, 0), rows - 8);
    bf16x8 qf0, qf1, kf[4][2][2];
    float bnext[2];
#define ATT_PREFETCH() do { \
        const int h_ = 2 * hp + hh; const size_t qo_ = (size_t)(tb + r * 64 + qc) * D + h_ * 64; \
        qf0 = *(const GAS bf16x8*)(Qb + qo_ + 8 * fq); qf1 = *(const GAS bf16x8*)(Qb + qo_ + 32 + 8 * fq); \
        const bf16* kb_ = Kb + ((size_t)(h_ * 8 + fq) * CH + (tb + r0 * 64 + fr)) * 8; \
        _Pragma("unroll") for (int kr = 0; kr < 4; ++kr) _Pragma("unroll") for (int ai = 0; ai < 2; ++ai) { const bf16* kp = kb_ + (kr * 64 + 16 * (ai ? a1 : a0)) * 8; kf[kr][ai][0] = *(const GAS bf16x8*)kp; kf[kr][ai][1] = *(const GAS bf16x8*)(kp + (size_t)4 * CH * 8); } \
        bnext[0] = rpb_l[hp * 930 + tid] * LOG2E; bnext[1] = (tid + 512 < 930) ? rpb_l[hp * 930 + tid + 512] * LOG2E : 0.f; } while (0)
#define ATT_BIAS_WRITE() do { bias[tid] = bnext[0]; if (tid + 512 < 930) bias[tid + 512] = bnext[1]; } while (0)
    ATT_PREFETCH();
    ATT_BIAS_WRITE();
    for (int loc = lc; loc < per; loc += nx) {
        const int h = 2 * hp + hh;
        const size_t qoff = (size_t)(tb + r * 64 + qc) * D + h * 64;
        const bf16* kbase = Kb + ((size_t)(h * 8 + fq) * CH + (tb + r0 * 64 + fr)) * 8;
        const int drb = r0 - r + 7;
        __syncthreads();
        {
            const int a = wave >> 1, ub = (wave & 1) * 2;
#pragma unroll
            for (int i = 0; i < 16; ++i) { const int kr = 2 * (ub + (i >> 3)) + (i & 1), cb = 16 * a + 4 * ((i & 7) >> 1);
                const bf16* src = Vb + (size_t)(tb + (r0 + kr) * 64 + cb) * D + hp * 128 + voff[i & 3];
                __builtin_amdgcn_global_load_lds((const unsigned*)src, (LAS unsigned*)(lds + (wave * 16 + i) * 1024), 16, 0, 0); }
        }
        f32x4 S[8];
        float mx = -3.0e38f;
        const LAS float* bptr[4];
#pragma unroll
        for (int i = 0; i < 4; ++i) { const int kc = 16 * (sel[i] ? a0 : a1) + 4 * fq + i; bptr[i] = bias + hh * 465 + drb * 31 + min(max(kc - qc + 15, 0), 30); }
#pragma unroll
        for (int kr = 0; kr < 8; ++kr) {
            f32x4 z0 = {0.f, 0.f, 0.f, 0.f}, z1 = {0.f, 0.f, 0.f, 0.f};
            z0 = __builtin_amdgcn_mfma_f32_16x16x32_bf16(kf[kr & 3][0][0], qf0, z0, 0, 0, 0);
            z0 = __builtin_amdgcn_mfma_f32_16x16x32_bf16(kf[kr & 3][0][1], qf1, z0, 0, 0, 0);
            z1 = __builtin_amdgcn_mfma_f32_16x16x32_bf16(kf[kr & 3][1][0], qf0, z1, 0, 0, 0);
            z1 = __builtin_amdgcn_mfma_f32_16x16x32_bf16(kf[kr & 3][1][1], qf1, z1, 0, 0, 0);
            f32x4 z;
#pragma unroll
            for (int i = 0; i < 4; ++i) { z[i] = (sel[i] ? z0[i] : z1[i]) + bptr[i][kr * 31]; mx = fmaxf(mx, z[i]); }
            S[kr] = z;
            if (kr < 4) {
#pragma unroll
                for (int ai = 0; ai < 2; ++ai) { const bf16* kp = kbase + ((kr + 4) * 64 + 16 * (ai ? a1 : a0)) * 8; kf[kr & 3][ai][0] = *(const GAS bf16x8*)kp; kf[kr & 3][ai][1] = *(const GAS bf16x8*)(kp + (size_t)4 * CH * 8); }
            }
        }
        mx = fmaxf(mx, __shfl_xor(mx, 16)); mx = fmaxf(mx, __shfl_xor(mx, 32));
        float sum = 0.f;
#pragma unroll
        for (int kr = 0; kr < 8; ++kr)
#pragma unroll
            for (int i = 0; i < 4; ++i) { const float p = __builtin_amdgcn_exp2f(S[kr][i] - mx); S[kr][i] = p; sum += p; }
        sum += __shfl_xor(sum, 16); sum += __shfl_xor(sum, 32);
        bf16x8 pf[4][2];
#pragma unroll
        for (int u = 0; u < 4; ++u)
#pragma unroll
            for (int ai = 0; ai < 2; ++ai) {
                float pa[2][4];
#pragma unroll
                for (int t = 0; t < 2; ++t)
#pragma unroll
                    for (int i = 0; i < 4; ++i) pa[t][i] = (sel[i] == (ai == 0)) ? S[2 * u + t][i] : 0.f;
                v4u pw; pw.x = cvtpk(pa[0][0], pa[0][1]); pw.y = cvtpk(pa[0][2], pa[0][3]); pw.z = cvtpk(pa[1][0], pa[1][1]); pw.w = cvtpk(pa[1][2], pa[1][3]);
                pf[u][ai] = __builtin_bit_cast(bf16x8, pw); }
        asm volatile("s_waitcnt vmcnt(0)" ::: "memory");
        __syncthreads();
        const int nloc = loc + nx; const bool has_next = nloc < per;
        const int r_cur = r, tb_cur = tb;
        if (has_next) { id = xc * per + nloc; r = id & (rows - 1); hp = (id >> rows_shift) & 7; tb = (id >> (rows_shift + 3)) * seq_len; r0 = min(max(r - 4, 0), rows - 8); ATT_PREFETCH(); }
        (void)r_cur; (void)tb_cur;
        f32x4 O[4];
#pragma unroll
        for (int c = 0; c < 4; ++c) O[c] = (f32x4){0.f, 0.f, 0.f, 0.f};
        const LAS unsigned char* vb[2][2][4];
#pragma unroll
        for (int ai = 0; ai < 2; ++ai)
#pragma unroll
            for (int t = 0; t < 2; ++t)
#pragma unroll
                for (int c = 0; c < 4; ++c) { const int rho = 8 * fq + 4 * t + q4, chn = 2 * (4 * hh + c) + (p4 >> 1);
                    vb[ai][t][c] = lds + (ai ? a1 : a0) * 32768 + 256 * rho + 16 * (chn ^ (((rho & 3) << 2) | ((rho >> 2) & 3))) + 8 * (p4 & 1); }
#pragma unroll
        for (int u = 0; u < 4; ++u) {
#pragma unroll
            for (int ai = 0; ai < 2; ++ai) {
#pragma unroll
                for (int c = 0; c < 4; ++c) {
                    const s16x4 v0 = vtr(vb[ai][0][c] + u * 8192), v1 = vtr(vb[ai][1][c] + u * 8192);
                    const bf16x8 vf = __builtin_shufflevector(v0, v1, 0, 1, 2, 3, 4, 5, 6, 7);
                    O[c] = __builtin_amdgcn_mfma_f32_16x16x32_bf16(vf, pf[u][ai], O[c], 0, 0, 0);
                }
            }
        }
        const float inv = 1.0f / sum;
#pragma unroll
        for (int c = 0; c < 4; ++c) { v2u w; w.x = cvtpk(O[c][0] * inv, O[c][1] * inv); w.y = cvtpk(O[c][2] * inv, O[c][3] * inv);
            *(GAS v2u*)(Qb + qoff + 16 * c + 4 * fq) = w; }
        if (has_next) ATT_BIAS_WRITE();
    }
    __syncthreads();
#undef ATT_PREFETCH
#undef ATT_BIAS_WRITE
}
enum { K_POOL = 1, K_GEMM_RES = 3, K_GEMM_QKV = 4, K_GEMM_UP = 5, K_ATTN = 6, K_FINAL = 7 };
enum { F_A_X = 1, F_A_IN = 2, F_AUX_X = 4, F_AUX_IN = 8, F_NOX = 16, F_B16 = 32 };
struct Ph { int kind, flags, N, K; const void* A; const void* B; void* C; const void* aux; float* st; float* rs; unsigned long long a_pn_stride, pad; };
constexpr int PPC = 19;
struct Args { Ptrs p; Ph tab[PPC]; };
__global__ void __launch_bounds__(NWAVES * 64, 2) fwd_megakernel(Args args) {
    extern __shared__ __attribute__((aligned(16))) unsigned char lds_raw[];
    cg::grid_group grid = cg::this_grid();
    LAS unsigned char* lds = (LAS unsigned char*)lds_raw;
    volatile LAS unsigned* MISC = (volatile LAS unsigned*)(lds + MISC_OFF);
    for (int u = threadIdx.x; u < 32; u += NWAVES * 64) MISC[u] = 0u;
    __syncthreads();
    const XcdBarrier bar = xcd_barrier_post((unsigned*)(args.p.ws + WS_CTL), MISC + 8);
    {
        const int tid = threadIdx.x, lane = tid & 63, wave = __builtin_amdgcn_readfirstlane(tid >> 6);
        const int G = gridDim.x, bx = blockIdx.x;
        const int vcu = (G % 8 == 0) ? (bx % 8) * (G / 8) + bx / 8 : bx;
        prologue(args.p, lds, vcu * NWAVES + wave, G * NWAVES, wave, lane);
    }
    grid.sync();

    for (int ph = 0; ph < NCHUNK * PPC; ++ph) {
        int tid = threadIdx.x; asm volatile("" : "+v"(tid));
        int G = gridDim.x, bx = blockIdx.x; asm volatile("" : "+s"(G), "+s"(bx));
        const int lane = tid & 63, wave = __builtin_amdgcn_readfirstlane(tid >> 6);
        const int vcu = (G % 8 == 0) ? (bx % 8) * (G / 8) + bx / 8 : bx;
        const int gw = vcu * NWAVES + wave, NGW = G * NWAVES;
        const int ck = ph / PPC, idx = ph - ck * PPC;
        const Ph d = args.tab[idx];
        const int tok0 = ck * CH, grp = tok0 / GROUP_TOK, seq_len = grp ? 4096 : 2048;
        const float* xin = args.p.x_in[grp] + (size_t)(tok0 - grp * GROUP_TOK) * D;
        float* X = args.p.out + (size_t)tok0 * D;
        const void* A = (d.flags & F_A_X) ? (const void*)X : (d.flags & F_A_IN) ? (const void*)xin : d.A;
        const void* aux = (d.flags & F_AUX_X) ? (const void*)X : (d.flags & F_AUX_IN) ? (const void*)xin : d.aux;
#define KIND_IS(x) ([&]() { int kd_ = d.kind; asm volatile("" : "+s"(kd_)); return kd_ == (x); }())
        if (0) {}
        else if (KIND_IS(K_POOL)) { { int tid2 = threadIdx.x; asm volatile("" : "+v"(tid2));
            pool_phase(lds, (const float*)A, (const float*)aux, (bf16*)d.C, seq_len, vcu, G, tid2, __builtin_amdgcn_readfirstlane(tid2 >> 6), tid2 & 63); } }
        else if (KIND_IS(K_GEMM_RES)) { pg8::Gemm g{(const bf16*)A, (const bf16*)d.B, CH, d.N, d.K, (size_t)d.a_pn_stride, d.K == FF  }; pg8::StaticOrder S; S.init(CH, d.N, G, bx);
            pg8::EpiRes E{(const float*)aux, (d.flags & F_NOX) ? nullptr : X, (bf16*)d.C, d.st, D, d.rs, (d.flags & F_B16) ? (const bf16*)args.p.ws + WS_XN / 2 : nullptr};
            pg8::gemm_phase<pg8::EpiRes, pg8::StaticOrder, false, PG8_SP2>(lds, g, S, E, tid); }
        else if (KIND_IS(K_GEMM_QKV)) { pg8::Gemm g{(const bf16*)A, (const bf16*)d.B, CH, d.N, d.K, 0, 1  }; pg8::StaticOrder S; S.init(CH, d.N, G, bx);
            pg8::EpiBf16<0, true> E{(bf16*)d.C, D, D, (size_t)CH * D, 0.125f * LOG2E, d.st, 0};
            pg8::gemm_phase<pg8::EpiBf16<0, true>, pg8::StaticOrder, PG8_ALIGN, PG8_SP2>(lds, g, S, E, tid); }
        else if (KIND_IS(K_GEMM_UP)) { pg8::Gemm g{(const bf16*)A, (const bf16*)d.B, CH, d.N, d.K, 0, 1  }; pg8::StaticOrder S; S.init(CH, d.N, G, bx);
            pg8::EpiBf16<2, false> E{(bf16*)d.C, FF, 0, 0, 1.f, nullptr, 1};
            pg8::gemm_phase<pg8::EpiBf16<2, false>, pg8::StaticOrder, PG8_ALIGN, PG8_SP2>(lds, g, S, E, tid); }
        else if (KIND_IS(K_ATTN)) { attn_phase(lds, (bf16*)d.C, (const bf16*)d.C + (size_t)CH * D, (const bf16*)d.C + 2 * (size_t)CH * D, (const float*)aux, seq_len, G, bx, tid, wave, lane); }
        else { norm_rows_f32_inplace(X, (const float*)aux, CH, gw, NGW, lane); }
#undef KIND_IS
        if (d.kind != K_FINAL) xcd_barrier(bar);
    }
}

extern "C" void kernel_launch(void* const* d_in, const int* in_sizes, int n_in, void* d_out, int out_size, void* d_ws, size_t ws_size, hipStream_t stream) {
    static int grid = 0;
    if (grid == 0) {
        if (n_in != 12 || in_sizes[0] != GROUP_TOK * D || in_sizes[1] != GROUP_TOK * D || out_size != NTOK * D || ws_size < WS_END) {
            fprintf(stderr, "kernel_launch: unexpected shapes (n_in %d, out %d, ws %zu < %zu); nothing launched\n", n_in, out_size, ws_size, (size_t)WS_END); grid = -1; return; }
        int dev = 0, cus = 0, per_cu = 0;
        if (hipGetDevice(&dev) != hipSuccess || hipDeviceGetAttribute(&cus, hipDeviceAttributeMultiprocessorCount, dev) != hipSuccess) { fprintf(stderr, "kernel_launch: device query failed\n"); grid = -1; return; }
        if (hipFuncSetAttribute((const void*)fwd_megakernel, hipFuncAttributeMaxDynamicSharedMemorySize, LDS_BYTES) != hipSuccess) { fprintf(stderr, "kernel_launch: hipFuncSetAttribute failed\n"); grid = -1; return; }
        if (hipOccupancyMaxActiveBlocksPerMultiprocessor(&per_cu, (const void*)fwd_megakernel, NWAVES * 64, LDS_BYTES) != hipSuccess || per_cu < 1) { fprintf(stderr, "kernel_launch: occupancy query gave %d\n", per_cu); per_cu = 1; }
        (void)hipGetLastError();
        grid = cus * per_cu;
    }
    if (grid < 0) return;
    if (hipMemsetAsync((char*)d_ws + WS_CTL, 0, CTL_ZERO_BYTES, stream) != hipSuccess) { fprintf(stderr, "kernel_launch: hipMemsetAsync failed\n"); return; }
    Args a{};
    Ptrs& p = a.p;
    p.x_in[0] = (const float*)d_in[0]; p.x_in[1] = (const float*)d_in[1]; p.norm_mix = (const float*)d_in[2]; p.pool_w = (const float*)d_in[3]; p.pool_scale = (const float*)d_in[4];
    p.w_qkv = (const float*)d_in[5]; p.rpb = (const float*)d_in[6]; p.w_o = (const float*)d_in[7]; p.norm_mlp = (const float*)d_in[8]; p.w_up = (const float*)d_in[9];
    p.w_down = (const float*)d_in[10]; p.norm_final = (const float*)d_in[11]; p.out = (float*)d_out; p.ws = (unsigned char*)d_ws;
    unsigned char* ws = (unsigned char*)d_ws;
    bf16* WPOOL = (bf16*)(ws + WS_WPOOL); bf16* WQKV = (bf16*)(ws + WS_WQKV); bf16* WO = (bf16*)(ws + WS_WO); bf16* WUP = (bf16*)(ws + WS_WUP); bf16* WDN = (bf16*)(ws + WS_WDN);
    bf16* XN = (bf16*)(ws + WS_XN); bf16* PG = (bf16*)(ws + WS_PG); bf16* QB = (bf16*)(ws + WS_ACT); bf16* HB = (bf16*)(ws + WS_ACT);
    float* SA = (float*)(ws + WS_STAT); float* SB = SA + (size_t)CH * 16;
    int n = 0;
    auto add = [&](int kind, int flags, int N, int K, const void* A, const void* B, void* C, const void* aux, float* st, float* rs, unsigned long long aps) {
        Ph& d = a.tab[n++]; d.kind = kind; d.flags = flags; d.N = N; d.K = K; d.A = A; d.B = B; d.C = C; d.aux = aux; d.st = st; d.rs = rs; d.a_pn_stride = aps; d.pad = 0; };
    for (int layer = 0; layer < DEPTH; ++layer) {
        const int j = layer >> 1;
        if ((layer & 1) == 0) {
            add(K_POOL, layer == 0 ? F_A_IN : F_A_X, 0, 0, nullptr, nullptr, PG, p.norm_mix + layer * D, nullptr, nullptr, 0);
            add(K_GEMM_RES, (layer == 0 ? F_AUX_IN : F_AUX_X) | F_NOX, D, 256, PG, WPOOL + (size_t)j * 1024 * 256, XN, nullptr, SA, nullptr, (unsigned long long)CH * 256 * 2);
        } else {
            add(K_GEMM_QKV, 0, 3 * D, D, XN, WQKV + (size_t)j * 3 * D * D, QB, nullptr, SB, nullptr, 0);
            add(K_ATTN, 0, 0, 0, nullptr, nullptr, QB, p.rpb + (size_t)j * NH * 15 * 31, nullptr, nullptr, 0);
            add(K_GEMM_RES, F_B16 | F_NOX, D, D, QB, WO + (size_t)j * D * D, XN, nullptr, SA, nullptr, 0);
        }
        add(K_GEMM_UP, 0, FF, D, XN, WUP + (size_t)layer * D * FF, HB, nullptr, SA, nullptr, 0);
        add(K_GEMM_RES, F_B16 | ((layer & 1) == 0 ? F_NOX : 0), D, FF, HB, WDN + (size_t)layer * D * FF, (layer & 1) == 0 ? XN : nullptr, nullptr, SB, SA, 0);
    }
    add(K_FINAL, 0, 0, 0, nullptr, nullptr, nullptr, p.norm_final, nullptr, nullptr, 0);
    if (n != PPC) { fprintf(stderr, "kernel_launch: phase table has %d entries, expected %d\n", n, PPC); return; }
    void* kargs[] = {&a};
    hipError_t e = hipLaunchCooperativeKernel((const void*)fwd_megakernel, dim3(grid), dim3(NWAVES * 64), kargs, LDS_BYTES, stream);
    if (e != hipSuccess) fprintf(stderr, "kernel_launch: cooperative launch failed: %s (grid %d)\n", hipGetErrorString(e), grid);
}
```

```cpp
#include <hip/hip_runtime.h>
#include <hip/hip_cooperative_groups.h>
#include <cstdio>
#include <cstdint>
namespace cg = cooperative_groups;
namespace pg8 {
#define PG8_LAS __attribute__((address_space(3)))
typedef unsigned short bf16_t;
typedef short bf16x8 __attribute__((ext_vector_type(8)));
typedef float f32x4 __attribute__((ext_vector_type(4)));
typedef unsigned u32x4 __attribute__((ext_vector_type(4)));
constexpr int BM = 256, BK = 64, HALF = 128, HTB = HALF * BK * 2  , STAGE_BYTES = 8 * HTB, NXCD = 8, WGM = 8;

__host__ __device__ __forceinline__ int lds_byte(int r, int c) { const int st = (r >> 4) * 2 + (c >> 5), rr = r & 15, cc = c & 31, ob = rr * 64 + cc * 2; return st * 1024 + (ob ^ (((ob >> 9) & 1) << 5)); }
__host__ __device__ __forceinline__ void stage_rc(int b, int& R, int& C) { const int st = b / 1024, sb = b % 1024, swz = sb ^ (((sb >> 9) & 1) << 5); R = (st >> 1) * 16 + swz / 64; C = (st & 1) * 32 + (swz % 64) / 2; }
__host__ __device__ __forceinline__ int perm32(int rho) { const int n = rho >> 4, i = rho & 15; return 8 * (i >> 2) + 4 * n + (i & 3); }

struct Unit { int pm, pn; };
struct Gemm { const bf16_t* A; const bf16_t* Bt; int M, N, K; size_t a_pn_stride; int a_tiled; };

struct StaticOrder {
    int nM, nN, nwg, G, c;
    __host__ __device__ void init(int M, int N, int G_, int c_) { nM = M / BM; nN = N / BM; nwg = nM * nN; G = G_; c = c_; }
    __host__ __device__ bool next(int i, Unit& u) const {
        const long L = (long)i * G + c; if (L >= nwg) return false;
        int wgid = (int)L; { const int q = nwg / NXCD, r = nwg % NXCD, xcd = wgid % NXCD, off = wgid / NXCD; wgid = (xcd < r ? xcd * (q + 1) : r * (q + 1) + (xcd - r) * q) + off; }
        const int nig = WGM * nN, gid = wgid / nig, fm = gid * WGM, gsz = (nM - fm) < WGM ? (nM - fm) : WGM;
        u.pm = fm + ((wgid % nig) % gsz); u.pn = (wgid % nig) / gsz; return true;
    }
    __device__ __forceinline__ void a_ready(const Unit&) const {}
    __device__ __forceinline__ void done(const Unit&) const {}
};

__device__ __forceinline__ unsigned cvt_pk_bf16(float lo, float hi) { unsigned r; asm volatile("v_cvt_pk_bf16_f32 %0, %1, %2" : "=v"(r) : "v"(lo), "v"(hi)); return r; }
typedef float f32x2 __attribute__((ext_vector_type(2)));
template <int ACT, bool RS> struct EpiBf16 {
    static constexpr bool PERM = true, AFTER_DRAIN = false;
    bf16_t* O; int ldc; int split_cols; size_t split_stride; float scale0; const float* st; int tiled;
    __device__ __forceinline__ void operator()(const f32x4 (&acc)[2][2][4][2], const Unit& u, int wr, int wc, int fr, int fq) const {
        const int row0 = u.pm * BM + wr * 64 + fr; int colt = u.pn * BM; bf16_t* base = O;
        float sc = 1.f; bool kplane = false;
        if (split_cols) { const int t = colt / split_cols; base += (size_t)t * split_stride; colt -= t * split_cols; if (t == 0) sc = scale0; kplane = (t == 1); }
        const size_t kprows = split_stride / 1024;
        const int col0 = colt + wc * 32 + 8 * fq;
        f32x4 pv[2][4];
        if (RS) {
#pragma unroll
            for (int ai = 0; ai < 2; ++ai)
#pragma unroll
                for (int m = 0; m < 4; ++m) pv[ai][m] = *(const f32x4*)(st + (size_t)(row0 + ai * HALF + m * 16) * 16 + 4 * fq);
            __builtin_amdgcn_sched_barrier(0);
        }
#pragma unroll
        for (int ai = 0; ai < 2; ++ai)
#pragma unroll
            for (int m = 0; m < 4; ++m) { const int row = row0 + ai * HALF + m * 16; bf16_t* rowp = base + (size_t)row * ldc + col0;
                float f = sc;
                if (RS) { float ss = (pv[ai][m][0] + pv[ai][m][1]) + (pv[ai][m][2] + pv[ai][m][3]); ss += __shfl_xor(ss, 16); ss += __shfl_xor(ss, 32);
                    const float r = __builtin_amdgcn_rsqf(ss * (1.0f / 1024.0f) + 1e-6f); f *= (ACT == 2) ? r * r : r; }
#pragma unroll
                for (int bj = 0; bj < 2; ++bj) { f32x4 v0 = acc[ai][bj][m][0], v1 = acc[ai][bj][m][1];
                    if (ACT == 2) {
#pragma unroll
                        for (int e = 0; e < 4; ++e) { const float a = fmaxf(v0[e], 0.f), b = fmaxf(v1[e], 0.f); v0[e] = a * a; v1[e] = b * b; } }
                    v0 = v0 * f; v1 = v1 * f; u32x4 w; w.x = cvt_pk_bf16(v0[0], v0[1]); w.y = cvt_pk_bf16(v0[2], v0[3]); w.z = cvt_pk_bf16(v1[0], v1[1]); w.w = cvt_pk_bf16(v1[2], v1[3]);
                    if (kplane) *(u32x4*)(base + ((size_t)(((colt >> 6) + 2 * bj + (wc >> 1)) * 8 + (wc & 1) * 4 + fq) * kprows + row) * 8) = w;
                    else if (tiled) { const int r_ = row & 255, c_ = col0 + bj * HALF;
                        *(u32x4*)((char*)base + ((size_t)(((row >> 8) * 2 + (r_ >> 7)) * (ldc >> 6) + (c_ >> 6)) << 14) + lds_byte(r_ & 127, c_ & 63)) = w; }
                    else *(u32x4*)(rowp + bj * HALF) = w; } }
    }
};
struct EpiRes {
    static constexpr bool PERM = true, AFTER_DRAIN = false;
    const float* base; float* out; bf16_t* xn; float* st; int ldc; const float* rs; const bf16_t* b16;
    __device__ __forceinline__ void operator()(const f32x4 (&acc)[2][2][4][2], const Unit& u, int wr, int wc, int fr, int fq) const {
        const int col0 = u.pn * BM + wc * 32 + 8 * fq;
#pragma unroll
        for (int ai = 0; ai < 2; ++ai) {
            f32x4 rp[4];
            if (rs) {
#pragma unroll
                for (int m = 0; m < 4; ++m) rp[m] = *(const f32x4*)(rs + (size_t)(u.pm * BM + ai * HALF + wr * 64 + m * 16 + fr) * 16 + 4 * fq);
            }
            f32x4 bs[4][2][2];
            if (b16) {
#pragma unroll
                for (int m = 0; m < 4; ++m)
#pragma unroll
                    for (int bj = 0; bj < 2; ++bj) { const int c_ = col0 + bj * HALF;
                        const u32x4 w = *(const u32x4*)((const char*)b16 + ((size_t)((u.pm * 2 + ai) * (ldc >> 6) + (c_ >> 6)) << 14) + lds_byte(wr * 64 + m * 16 + fr, c_ & 63));
                        bs[m][bj][0] = (f32x4){__builtin_bit_cast(float, w.x << 16), __builtin_bit_cast(float, w.x & 0xffff0000u), __builtin_bit_cast(float, w.y << 16), __builtin_bit_cast(float, w.y & 0xffff0000u)};
                        bs[m][bj][1] = (f32x4){__builtin_bit_cast(float, w.z << 16), __builtin_bit_cast(float, w.z & 0xffff0000u), __builtin_bit_cast(float, w.w << 16), __builtin_bit_cast(float, w.w & 0xffff0000u)}; }
            } else {
#pragma unroll
                for (int m = 0; m < 4; ++m) { const size_t off = (size_t)(u.pm * BM + ai * HALF + wr * 64 + m * 16 + fr) * ldc + col0;
#pragma unroll
                    for (int bj = 0; bj < 2; ++bj) { bs[m][bj][0] = *(const f32x4*)(base + off + bj * HALF); bs[m][bj][1] = *(const f32x4*)(base + off + bj * HALF + 4); } }
            }
            __builtin_amdgcn_sched_barrier(0);
#pragma unroll
            for (int m = 0; m < 4; ++m) { const int row = u.pm * BM + ai * HALF + wr * 64 + m * 16 + fr; const size_t off = (size_t)row * ldc + col0; float ss = 0.f;
                float f = 1.f;
                if (rs) { float q = (rp[m][0] + rp[m][1]) + (rp[m][2] + rp[m][3]); q += __shfl_xor(q, 16); q += __shfl_xor(q, 32); const float r = __builtin_amdgcn_rsqf(q * (1.0f / 1024.0f) + 1e-6f); f = r * r; }
#pragma unroll
                for (int bj = 0; bj < 2; ++bj) {
                    const f32x4 o0 = bs[m][bj][0] + acc[ai][bj][m][0] * f, o1 = bs[m][bj][1] + acc[ai][bj][m][1] * f;
                    if (out) { *(f32x4*)(out + off + bj * HALF) = o0; *(f32x4*)(out + off + bj * HALF + 4) = o1; }
                    if (xn) { u32x4 w; w.x = cvt_pk_bf16(o0[0], o0[1]); w.y = cvt_pk_bf16(o0[2], o0[3]); w.z = cvt_pk_bf16(o1[0], o1[1]); w.w = cvt_pk_bf16(o1[2], o1[3]);
                        { const int c_ = col0 + bj * HALF;
                          *(u32x4*)((char*)xn + ((size_t)((u.pm * 2 + ai) * (ldc >> 6) + (c_ >> 6)) << 14) + lds_byte(wr * 64 + m * 16 + fr, c_ & 63)) = w; }
                        ss += (o0[0] * o0[0] + o0[1] * o0[1]) + (o0[2] * o0[2] + o0[3] * o0[3]) + (o1[0] * o1[0] + o1[1] * o1[1]) + (o1[2] * o1[2] + o1[3] * o1[3]); } }
                if (xn) { ss += __shfl_xor(ss, 16); ss += __shfl_xor(ss, 32); if (fq == 0) st[(size_t)row * 16 + u.pn * 4 + wc] = ss; } }
        }
    }
};
template <class Epi, class Sched, bool ALIGN_EPI = false, bool SP2 = false>
__device__ __forceinline__ void gemm_phase(PG8_LAS unsigned char* lds, const Gemm g, const Sched& S, const Epi& E, const int tid_in) {
    const int tid = tid_in, wid = __builtin_amdgcn_readfirstlane(tid >> 6), lane = tid & 63, wr = wid >> 2, wc = wid & 3, fr = lane & 15, fq = lane >> 4;
    const int K = g.K, nt = K / BK;
    unsigned voffA[2], voffB[2];
#pragma unroll
    for (int i = 0; i < 2; ++i) { int R, C; stage_rc(tid * 16 + i * 8192, R, C); const int Rb = Epi::PERM ? ((R & ~31) + perm32(R & 31)) : R;
        voffA[i] = g.a_tiled ? (unsigned)(tid * 16 + i * 8192) : (unsigned)(R * K + C) * 2u; voffB[i] = (unsigned)(tid * 16 + i * 8192); (void)Rb; }
    const size_t kstep = (size_t)(BK * 2);
    const size_t hstep = (size_t)HALF * K * 2;
    const size_t tstep = 2 * hstep;
    const size_t kstepB = 16384, hstepB = (size_t)nt * 16384, tstepB = 2 * hstepB;
    const size_t kstepA = g.a_tiled ? (size_t)16384 : kstep, hstepA = g.a_tiled ? (size_t)nt * 16384 : hstep, tstepA = 2 * hstepA;
    const unsigned ldsw = (unsigned)wid * 1024u;
    const int aoff = lds_byte(wr * 64 + fr, fq * 8), boff = lds_byte(wc * 32 + fr, fq * 8);
#define PG8_SA(b, h) (((b) * 2 + (h)) * HTB)
#define PG8_SB(b, h) ((4 + (b) * 2 + (h)) * HTB)
#define PG8_STAGE(bufoff, gbase, voff) do { _Pragma("unroll") for (int _i = 0; _i < 2; ++_i) \
        __builtin_amdgcn_global_load_lds((const unsigned*)((const char*)(gbase) + (voff)[_i]), (PG8_LAS unsigned*)(lds + (bufoff) + ldsw + _i * 8192), 16, 0, 0); } while (0)
#define PG8_LDA(dst, b, h) do { _Pragma("unroll") for (int m = 0; m < 4; ++m) _Pragma("unroll") for (int k = 0; k < 2; ++k) dst[m][k] = *(const PG8_LAS bf16x8*)(lds + PG8_SA(b, h) + aoff + m * 2048 + k * 1024); } while (0)
#define PG8_LDB(dst, b, h) do { _Pragma("unroll") for (int n = 0; n < 2; ++n) _Pragma("unroll") for (int k = 0; k < 2; ++k) dst[n][k] = *(const PG8_LAS bf16x8*)(lds + PG8_SB(b, h) + boff + n * 2048 + k * 1024); } while (0)
#define PG8_MMA(ai, bj, At, Bt) do { __builtin_amdgcn_s_setprio(1); _Pragma("unroll") for (int m = 0; m < 4; ++m) _Pragma("unroll") for (int n = 0; n < 2; ++n) _Pragma("unroll") for (int k = 0; k < 2; ++k) \
        acc[ai][bj][m][n] = __builtin_amdgcn_mfma_f32_16x16x32_bf16(Bt[n][k], At[m][k], acc[ai][bj][m][n], 0, 0, 0); __builtin_amdgcn_s_setprio(0); } while (0)
#define PG8_WAIT_V(n) asm volatile("s_waitcnt vmcnt(" #n ")" ::: "memory")
#define PG8_WAIT_L(n) asm volatile("s_waitcnt lgkmcnt(" #n ")" ::: "memory")
#define PG8_BAR __builtin_amdgcn_s_barrier()
#define PG8_SCHED __builtin_amdgcn_sched_barrier(0)
    Unit cur, nxt; int ui = 0;
    if (!S.next(0, cur)) return;
    f32x4 acc[2][2][4][2];
#pragma unroll
    for (int a = 0; a < 2; ++a)
#pragma unroll
        for (int b = 0; b < 2; ++b)
#pragma unroll
            for (int m = 0; m < 4; ++m)
#pragma unroll
                for (int n = 0; n < 2; ++n) acc[a][b][m][n] = (f32x4){0.f, 0.f, 0.f, 0.f};
    bf16x8 At[4][2], B0[2][2], B1[2][2];
    const char* cA = (const char*)g.A + (size_t)cur.pm * tstepA + (size_t)cur.pn * g.a_pn_stride; const char* cB = (const char*)g.Bt + (size_t)cur.pn * tstepB;
    S.a_ready(cur);
    if constexpr (SP2) {
        PG8_STAGE(PG8_SB(0, 0), cB, voffB); PG8_STAGE(PG8_SB(0, 1), cB + hstepB, voffB); PG8_STAGE(PG8_SA(0, 0), cA, voffA); PG8_STAGE(PG8_SA(0, 1), cA + hstepA, voffA);
        if (wr == 1) PG8_BAR;
        PG8_WAIT_V(2); PG8_BAR;
        PG8_STAGE(PG8_SB(1, 0), cB + kstepB, voffB); PG8_STAGE(PG8_SA(1, 0), cA + kstepA, voffA); PG8_STAGE(PG8_SB(1, 1), cB + hstepB + kstepB, voffB);
        PG8_WAIT_V(6); PG8_BAR;
    } else {
        PG8_STAGE(PG8_SB(0, 0), cB, voffB); PG8_STAGE(PG8_SA(0, 0), cA, voffA); PG8_STAGE(PG8_SB(0, 1), cB + hstepB, voffB); PG8_STAGE(PG8_SA(0, 1), cA + hstepA, voffA);
        if (wr == 1) PG8_BAR;
        PG8_WAIT_V(4); PG8_BAR;
        PG8_STAGE(PG8_SB(1, 0), cB + kstepB, voffB); PG8_STAGE(PG8_SA(1, 0), cA + kstepA, voffA); PG8_STAGE(PG8_SB(1, 1), cB + hstepB + kstepB, voffB);
        PG8_WAIT_V(6); PG8_BAR;
    }
    for (;;) {
        const bool has_next = S.next(ui + 1, nxt);
        const char* nA = has_next ? (const char*)g.A + (size_t)nxt.pm * tstepA + (size_t)nxt.pn * g.a_pn_stride : cA; const char* nB = has_next ? (const char*)g.Bt + (size_t)nxt.pn * tstepB : cB;
        for (int t = 0; t < nt; t += 2) {
            const bool last = (t == nt - 2);
            const char* a1 = cA + (size_t)(t + 1) * kstepA;
            const char* a2 = last ? nA : cA + (size_t)(t + 2) * kstepA; const char* b2 = last ? nB : cB + (size_t)(t + 2) * kstepB;
            const char* a3 = a2 + kstepA; const char* b3 = b2 + kstepB;
            if (last && has_next) S.a_ready(nxt);
            if constexpr (SP2) {
            PG8_LDB(B0, 0, 0); PG8_LDB(B1, 0, 1); PG8_SCHED; PG8_LDA(At, 0, 0); PG8_STAGE(PG8_SA(1, 1), a1 + hstepA, voffA);
            PG8_WAIT_V(8); PG8_WAIT_L(0); PG8_BAR; PG8_MMA(0, 0, At, B0); PG8_MMA(0, 1, At, B1); PG8_BAR; PG8_SCHED;
            PG8_LDA(At, 0, 1); PG8_STAGE(PG8_SB(0, 0), b2, voffB); PG8_STAGE(PG8_SB(0, 1), b2 + hstepB, voffB); PG8_STAGE(PG8_SA(0, 0), a2, voffA);
            PG8_WAIT_V(8); PG8_WAIT_L(0); PG8_BAR; PG8_MMA(1, 0, At, B0); PG8_MMA(1, 1, At, B1); PG8_BAR; PG8_SCHED;
            PG8_LDB(B0, 1, 0); PG8_LDB(B1, 1, 1); PG8_SCHED; PG8_LDA(At, 1, 0); PG8_STAGE(PG8_SA(0, 1), a2 + hstepA, voffA);
            PG8_WAIT_V(8); PG8_WAIT_L(0); PG8_BAR; PG8_MMA(0, 0, At, B0); PG8_MMA(0, 1, At, B1); PG8_BAR; PG8_SCHED;
            PG8_LDA(At, 1, 1); PG8_STAGE(PG8_SB(1, 0), b3, voffB); PG8_STAGE(PG8_SB(1, 1), b3 + hstepB, voffB); PG8_STAGE(PG8_SA(1, 0), a3, voffA);
            PG8_WAIT_V(8); PG8_WAIT_L(0); PG8_BAR; PG8_MMA(1, 0, At, B0); PG8_MMA(1, 1, At, B1); PG8_BAR; PG8_SCHED;
            } else {
            PG8_LDB(B0, 0, 0); PG8_SCHED; PG8_LDA(At, 0, 0); PG8_STAGE(PG8_SA(1, 1), a1 + hstepA, voffA);
            PG8_WAIT_L(8); PG8_BAR; PG8_WAIT_L(0); PG8_MMA(0, 0, At, B0); PG8_BAR; PG8_SCHED;
            PG8_LDB(B1, 0, 1); PG8_STAGE(PG8_SB(0, 0), b2, voffB);
            PG8_BAR; PG8_WAIT_L(0); PG8_MMA(0, 1, At, B1); PG8_BAR;
            PG8_LDA(At, 0, 1); PG8_STAGE(PG8_SA(0, 0), a2, voffA);
            PG8_BAR; PG8_WAIT_L(0); PG8_MMA(1, 0, At, B0); PG8_BAR; PG8_SCHED;
            PG8_STAGE(PG8_SB(0, 1), b2 + hstepB, voffB);
            PG8_WAIT_V(6); PG8_BAR; PG8_MMA(1, 1, At, B1); PG8_BAR;
            PG8_LDB(B0, 1, 0); PG8_SCHED; PG8_LDA(At, 1, 0); PG8_STAGE(PG8_SA(0, 1), a2 + hstepA, voffA);
            PG8_WAIT_L(8); PG8_BAR; PG8_WAIT_L(0); PG8_MMA(0, 0, At, B0); PG8_BAR; PG8_SCHED;
            PG8_LDB(B1, 1, 1); PG8_STAGE(PG8_SB(1, 0), b3, voffB);
            PG8_BAR; PG8_WAIT_L(0); PG8_MMA(0, 1, At, B1); PG8_BAR;
            PG8_LDA(At, 1, 1); PG8_STAGE(PG8_SA(1, 0), a3, voffA);
            PG8_BAR; PG8_WAIT_L(0); PG8_MMA(1, 0, At, B0); PG8_BAR; PG8_SCHED;
            PG8_STAGE(PG8_SB(1, 1), b3 + hstepB, voffB);
            PG8_WAIT_V(6); PG8_BAR; PG8_MMA(1, 1, At, B1); PG8_BAR;
            }
        }
        if constexpr (ALIGN_EPI) { if (wr == 0) PG8_BAR; }
        if constexpr (!Epi::AFTER_DRAIN) { E(acc, cur, wr, wc, fr, fq); S.done(cur); }
        if (!has_next) break;
#pragma unroll
        for (int a = 0; a < 2; ++a)
#pragma unroll
            for (int b = 0; b < 2; ++b)
#pragma unroll
                for (int m = 0; m < 4; ++m)
#pragma unroll
                    for (int n = 0; n < 2; ++n) acc[a][b][m][n] = (f32x4){0.f, 0.f, 0.f, 0.f};
        cur = nxt; cA = nA; cB = nB; ++ui;
        if constexpr (ALIGN_EPI) { if (wr == 1) PG8_BAR; }
    }
    PG8_WAIT_V(0);
    if constexpr (!ALIGN_EPI) { if (wr == 0) PG8_BAR; }
    PG8_BAR;
    if constexpr (Epi::AFTER_DRAIN) { E.fused(acc, cur, wr, wc, fr, fq, lds, wid, lane); S.done(cur); }
#undef PG8_SA
#undef PG8_SB
#undef PG8_STAGE
#undef PG8_LDA
#undef PG8_LDB
#undef PG8_MMA
#undef PG8_WAIT_V
#undef PG8_WAIT_L
#undef PG8_BAR
#undef PG8_SCHED
}
}
#ifndef PG8_SP2
#define PG8_SP2 true
#endif
#ifndef PG8_ALIGN
#define PG8_ALIGN true
#endif

constexpr int NWAVES = 8;
constexpr int D = 1024, FF = 4096, NH = 16, HD = 64, DEPTH = 4;
constexpr int NTOK = 131072;
constexpr int GROUP_TOK = 65536;
#ifndef MK_CH
#define MK_CH 65536
#endif
constexpr int CH = MK_CH;
constexpr int NCHUNK = NTOK / CH;
constexpr float RMS_EPS = 1e-6f;
constexpr float LOG2E = 1.4426950408889634f;
static_assert(GROUP_TOK % CH == 0 && CH % 4096 == 0, "chunking");

constexpr size_t MiB = 1u << 20;
constexpr size_t WS_WPOOL = 2 * MiB;
constexpr size_t WS_WQKV = 4 * MiB;
constexpr size_t WS_WO = 16 * MiB;
constexpr size_t WS_WUP = 20 * MiB;
constexpr size_t WS_WDN = 52 * MiB;
constexpr size_t WS_XN = 96 * MiB;
constexpr size_t WS_PG = WS_XN + (size_t)CH * D * 2;
constexpr size_t WS_ACT = WS_PG + (size_t)CH * D * 2;
constexpr size_t WS_CTL = 0, CTL_ZERO_BYTES = 65536;
constexpr size_t WS_STAT = 86 * MiB;
static_assert(WS_STAT + 2 * (size_t)CH * 64 <= WS_XN, "stat arrays");
constexpr size_t WS_END = WS_ACT + (size_t)CH * FF * 2;
static_assert(WS_XN >= WS_WDN + 32 * MiB && WS_END <= 1024 * MiB, "d_ws map");

constexpr int RING_BYTES = 131072;
constexpr int BIAS_OFF = RING_BYTES;
constexpr int MISC_OFF = RING_BYTES + 4096;
constexpr int LDS_BYTES = 147456;

#define GAS __attribute__((address_space(1)))
#define LAS __attribute__((address_space(3)))
typedef unsigned short bf16;
typedef unsigned v4u __attribute__((ext_vector_type(4)));
typedef unsigned v2u __attribute__((ext_vector_type(2)));
typedef float f32x4 __attribute__((ext_vector_type(4)));
typedef short bf16x8 __attribute__((ext_vector_type(8)));
typedef short s16x4 __attribute__((ext_vector_type(4)));
#define LDS_WAIT() asm volatile("s_waitcnt lgkmcnt(0)" ::: "memory")
typedef float f32x2_t __attribute__((ext_vector_type(2))); typedef __bf16 bf16x2_t __attribute__((ext_vector_type(2)));
__device__ __forceinline__ unsigned pk2(float lo, float hi) { f32x2_t v = {lo, hi}; bf16x2_t b = __builtin_convertvector(v, bf16x2_t); return __builtin_bit_cast(unsigned, b); }
__device__ __forceinline__ float wave_sum(float v) {
#pragma unroll
    for (int o = 1; o < 64; o <<= 1) v += __shfl_xor(v, o);
    return v;
}

__device__ __forceinline__ void transpose_item(const float* W, int K, int N, bf16* WT, int row_off, const float* nscale, const float* kscale, LAS float* scr, int item, int lane) {
    const int nblk = N / 32, kb = item / nblk, nb = item % nblk, k0 = 64 * kb, n0 = 32 * nb;
    float wv[32];
#pragma unroll
    for (int i = 0; i < 32; ++i) wv[i] = W[(size_t)(k0 + 2 * i + (lane >> 5)) * N + n0 + (lane & 31)];
#pragma unroll
    for (int i = 0; i < 32; ++i) scr[(2 * i + (lane >> 5)) * 33 + (lane & 31)] = wv[i];
    LDS_WAIT(); asm volatile("" ::: "memory");
    const int c = lane & 7;
    float ks[8];
#pragma unroll
    for (int e = 0; e < 8; ++e) ks[e] = kscale ? kscale[k0 + 8 * c + e] : 1.f;
#pragma unroll
    for (int j = 0; j < 4; ++j) { const int n = (lane >> 3) + 8 * j; const LAS float* s = scr + (8 * c) * 33 + n;
        const float sc = nscale ? nscale[n0 + n] : 1.f;
        v4u o; o.x = pk2(s[0 * 33] * sc * ks[0], s[1 * 33] * sc * ks[1]); o.y = pk2(s[2 * 33] * sc * ks[2], s[3 * 33] * sc * ks[3]); o.z = pk2(s[4 * 33] * sc * ks[4], s[5 * 33] * sc * ks[5]); o.w = pk2(s[6 * 33] * sc * ks[6], s[7 * 33] * sc * ks[7]);
        { const int ng = row_off + n0 + n, nr = ng & 127, cc = nr & 31, slot = (((cc >> 2) & 1) << 4) | ((cc >> 3) << 2) | (cc & 3), kk = k0 + 8 * c;
          *(GAS v4u*)((GAS char*)WT + ((size_t)(((ng >> 8) * 2 + ((ng >> 7) & 1)) * (K >> 6) + (kk >> 6)) << 14) + pg8::lds_byte((nr & ~31) + slot, kk & 63)) = o; } }
    LDS_WAIT(); asm volatile("" ::: "memory");
}

struct Ptrs {
    const float *x_in[2], *norm_mix, *pool_w, *pool_scale, *w_qkv, *rpb, *w_o, *norm_mlp, *w_up, *w_down, *norm_final;
    float* out; unsigned char* ws;
};

__device__ __forceinline__ void prologue(const Ptrs& P, LAS unsigned char* lds, int gw, int NGW, int wave, int lane) {
    LAS float* scr = (LAS float*)(lds + wave * 16384);
    bf16* WPOOL = (bf16*)(P.ws + WS_WPOOL); bf16* WQKV = (bf16*)(P.ws + WS_WQKV); bf16* WO = (bf16*)(P.ws + WS_WO); bf16* WUP = (bf16*)(P.ws + WS_WUP); bf16* WDN = (bf16*)(P.ws + WS_WDN);
    constexpr int I_POOL = (256 / 64) * (256 / 32), I_QKV = (D / 64) * (3 * D / 32), I_O = (D / 64) * (D / 32), I_UP = (D / 64) * (FF / 32), I_DN = (FF / 64) * (D / 32);
    constexpr int NITEMS = 8 * I_POOL + 2 * I_QKV + 2 * I_O + 4 * I_UP + 4 * I_DN;
    for (int it = gw; it < NITEMS; it += NGW) {
        int r = it;
        if (r < 8 * I_POOL) { const int mtx = r / I_POOL, j = mtx >> 2, g = mtx & 3; transpose_item(P.pool_w + (size_t)mtx * 65536, 256, 256, WPOOL + (size_t)j * 1024 * 256, g * 256, P.pool_scale + j * 1024 + g * 256, nullptr, scr, r % I_POOL, lane); continue; } r -= 8 * I_POOL;
        if (r < 2 * I_QKV) { const int j = r / I_QKV; transpose_item(P.w_qkv + (size_t)j * D * 3 * D, D, 3 * D, WQKV + (size_t)j * 3 * D * D, 0, nullptr, P.norm_mix + (2 * j + 1) * D, scr, r % I_QKV, lane); continue; } r -= 2 * I_QKV;
        if (r < 2 * I_O) { const int j = r / I_O; transpose_item(P.w_o + (size_t)j * D * D, D, D, WO + (size_t)j * D * D, 0, nullptr, nullptr, scr, r % I_O, lane); continue; } r -= 2 * I_O;
        if (r < 4 * I_UP) { const int j = r / I_UP; transpose_item(P.w_up + (size_t)j * D * FF, D, FF, WUP + (size_t)j * D * FF, 0, nullptr, P.norm_mlp + j * D, scr, r % I_UP, lane); continue; } r -= 4 * I_UP;
        { const int j = r / I_DN; transpose_item(P.w_down + (size_t)j * D * FF, FF, D, WDN + (size_t)j * D * FF, 0, nullptr, nullptr, scr, r % I_DN, lane); }
    }
}

__device__ __forceinline__ void norm_rows_f32_inplace(float* x, const float* gain, int nrows, int gw, int NGW, int lane) {
    f32x4 g[4];
#pragma unroll
    for (int j = 0; j < 4; ++j) g[j] = *((const f32x4*)gain + lane + 64 * j);
    for (int m = gw * 4; m < nrows; m += NGW * 4) {
        GAS f32x4* xr = (GAS f32x4*)(x + (size_t)m * D) + lane;
        f32x4 v[4][4];
#pragma unroll
        for (int r = 0; r < 4; ++r)
#pragma unroll
            for (int j = 0; j < 4; ++j) v[r][j] = xr[r * 256 + 64 * j];
        __builtin_amdgcn_sched_barrier(0);
#pragma unroll
        for (int r = 0; r < 4; ++r) { float s = 0.f;
#pragma unroll
            for (int j = 0; j < 4; ++j) s += (v[r][j].x * v[r][j].x + v[r][j].y * v[r][j].y) + (v[r][j].z * v[r][j].z + v[r][j].w * v[r][j].w);
            const float rr = 1.0f / sqrtf(wave_sum(s) * (1.f / D) + RMS_EPS);
#pragma unroll
            for (int j = 0; j < 4; ++j) xr[r * 256 + 64 * j] = v[r][j] * rr * g[j]; }
    }
}

constexpr int PT = 32, PROWS = 48;
typedef float f32x2v __attribute__((ext_vector_type(2)));
__device__ __forceinline__ f32x2v bfpair(unsigned u) { return (f32x2v){__builtin_bit_cast(float, u << 16), __builtin_bit_cast(float, u & 0xffff0000u)}; }
struct f32x8 { f32x4 lo, hi; };
__device__ __forceinline__ f32x8 bf8(const v4u u) { f32x8 r; r.lo = (f32x4){__builtin_bit_cast(float, u.x << 16), __builtin_bit_cast(float, u.x & 0xffff0000u), __builtin_bit_cast(float, u.y << 16), __builtin_bit_cast(float, u.y & 0xffff0000u)};
    r.hi = (f32x4){__builtin_bit_cast(float, u.z << 16), __builtin_bit_cast(float, u.z & 0xffff0000u), __builtin_bit_cast(float, u.w << 16), __builtin_bit_cast(float, u.w & 0xffff0000u)}; return r; }
__device__ __forceinline__ v4u pack8(const f32x4 a, const f32x4 b) { v4u o; o.x = pk2(a[0], a[1]); o.y = pk2(a[2], a[3]); o.z = pk2(b[0], b[1]); o.w = pk2(b[2], b[3]); return o; }
template <int W> __device__ __forceinline__ void pool_rows_interior(const LAS v4u* hrow, GAS v4u* po) {
    constexpr int HW = W / 2; constexpr float INV = 1.0f / (float)W;
    f32x4 sl = {0.f, 0.f, 0.f, 0.f}, sh = {0.f, 0.f, 0.f, 0.f};
#pragma unroll
    for (int o = -HW; o < HW; ++o) { const f32x8 h = bf8(hrow[(8 + o) * 128]); sl += h.lo; sh += h.hi; }
    __builtin_amdgcn_sched_barrier(0);
#pragma unroll
    for (int i = 0; i < 8; ++i) {
        const f32x8 c = bf8(hrow[(8 + i) * 128]);
        po[(size_t)i * 32] = pack8(sl * INV - c.lo, sh * INV - c.hi);
        if (i + 1 < 8) { const f32x8 a = bf8(hrow[(8 + i + HW) * 128]), b = bf8(hrow[(8 + i - HW) * 128]); sl += a.lo - b.lo; sh += a.hi - b.hi; }
        __builtin_amdgcn_sched_barrier(0);
    }
}
__device__ __forceinline__ void pool_load_rows(f32x4 (&v)[6][4], const float* x, int m0, int seq_len, int wave, int lane) {
    const int sb = m0 / seq_len * seq_len, t0 = m0 - sb;
#pragma unroll
    for (int k = 0; k < 6; ++k) { const int t = min(max(t0 - 8 + wave + NWAVES * k, 0), seq_len - 1);
        const GAS f32x4* xr = (const GAS f32x4*)(x + (size_t)(sb + t) * D) + lane;
#pragma unroll
        for (int j = 0; j < 4; ++j) v[k][j] = xr[64 * j]; }
}
__device__ __forceinline__ void pool_load_rows_b16(v4u (&w)[6][2], float (&sv)[6], const bf16* xn, const float* st, int m0, int seq_len, int wave, int lane) {
    const int sb = m0 / seq_len * seq_len, t0 = m0 - sb;
    int wv = wave; asm volatile("" : "+v"(wv));
#pragma unroll
    for (int k = 0; k < 6; ++k) { const int row = sb + min(max(t0 - 8 + wv + NWAVES * k, 0), seq_len - 1);
#pragma unroll
        for (int j = 0; j < 2; ++j) { const int q = lane + 64 * j;
            w[k][j] = *(const GAS v4u*)((const char*)xn + ((size_t)(((row >> 8) * 2 + ((row >> 7) & 1)) * 16 + (q >> 3)) << 14) + pg8::lds_byte(row & 127, 8 * (q & 7))); }
        sv[k] = st[(size_t)row * 16 + (lane & 15)]; }
}
template <bool B16> __device__ __forceinline__ void pool_phase(LAS unsigned char* lds, const float* x, const bf16* xn16, const float* st16, const float* gain, bf16* Pg, int seq_len, int vcu, int G, int tid, int wave, int lane) {
    f32x4 v[B16 ? 1 : 6][4];
    v4u w16[B16 ? 6 : 1][2]; float sv[6];
    if (vcu < CH / PT) { if constexpr (B16) pool_load_rows_b16(w16, sv, xn16, st16, vcu * PT, seq_len, wave, lane); else pool_load_rows(v, x, vcu * PT, seq_len, wave, lane); }
    for (int tile = vcu; tile < CH / PT; tile += G) {
        const int m0 = tile * PT;
        const int sb = m0 / seq_len * seq_len;
        const int t0 = m0 - sb;
        if constexpr (B16) {
            f32x4 g16[2][2];
#pragma unroll
            for (int j = 0; j < 2; ++j) { g16[j][0] = *(const GAS f32x4*)(gain + 8 * (lane + 64 * j)); g16[j][1] = *(const GAS f32x4*)(gain + 8 * (lane + 64 * j) + 4); }
#pragma unroll
            for (int k = 0; k < 6; ++k) { float ss = sv[k]; ss += __shfl_xor(ss, 1); ss += __shfl_xor(ss, 2); ss += __shfl_xor(ss, 4); ss += __shfl_xor(ss, 8);
                const float r = 1.0f / sqrtf(ss * (1.f / D) + RMS_EPS);
                LAS v4u* hr = (LAS v4u*)(lds + (wave + NWAVES * k) * 2048) + lane;
#pragma unroll
                for (int j = 0; j < 2; ++j) { const f32x8 h = bf8(w16[k][j]); hr[64 * j] = pack8(h.lo * r * g16[j][0], h.hi * r * g16[j][1]); } }
        } else {
        f32x4 g[4];
#pragma unroll
        for (int j = 0; j < 4; ++j) g[j] = *((const GAS f32x4*)gain + lane + 64 * j);
#pragma unroll
        for (int k = 0; k < 6; ++k) { float s = 0.f;
#pragma unroll
            for (int j = 0; j < 4; ++j) s += (v[k][j].x * v[k][j].x + v[k][j].y * v[k][j].y) + (v[k][j].z * v[k][j].z + v[k][j].w * v[k][j].w);
            const float r = 1.0f / sqrtf(wave_sum(s) * (1.f / D) + RMS_EPS);
            LAS v2u* hr = (LAS v2u*)(lds + (wave + NWAVES * k) * 2048) + lane;
#pragma unroll
            for (int j = 0; j < 4; ++j) { v2u o; o.x = pk2(v[k][j].x * r * g[j].x, v[k][j].y * r * g[j].y); o.y = pk2(v[k][j].z * r * g[j].z, v[k][j].w * r * g[j].w); hr[64 * j] = o; } }
        }
        __syncthreads();
        if (tile + G < CH / PT) { if constexpr (B16) pool_load_rows_b16(w16, sv, xn16, st16, (tile + G) * PT, seq_len, wave, lane); else pool_load_rows(v, x, (tile + G) * PT, seq_len, wave, lane); __builtin_amdgcn_sched_barrier(0); }
        {
            const int pg = wave & 3, part = (lane >> 5) + 2 * (wave >> 2), oc = lane & 31, pw = 2 << pg, phw = pw >> 1;
            const LAS v4u* hrow = (const LAS v4u*)(lds + (8 * part) * 2048 + pg * 512 + oc * 16);
            GAS v4u* po = (GAS v4u*)(Pg + ((size_t)pg * CH + m0 + 8 * part) * 256 + oc * 8);
            if (t0 >= 8 && t0 + PT + 8 <= seq_len) {
                switch (pg) { case 0: pool_rows_interior<2>(hrow, po); break; case 1: pool_rows_interior<4>(hrow, po); break; case 2: pool_rows_interior<8>(hrow, po); break; default: pool_rows_interior<16>(hrow, po); break; }
            } else {
                for (int i = 0; i < 8; ++i) {
                    const int t = t0 + 8 * part + i;
                    const int lo = max(t - phw, 0), hi = min(t + phw - 1, seq_len - 1);
                    f32x4 sl = {0.f, 0.f, 0.f, 0.f}, sh = {0.f, 0.f, 0.f, 0.f};
                    for (int q = lo; q <= hi; ++q) { const f32x8 h = bf8(hrow[(8 + q - t + i) * 128]); sl += h.lo; sh += h.hi; }
                    const f32x8 c = bf8(hrow[(8 + i) * 128]);
                    const float inv = 1.0f / (float)(hi - lo + 1);
                    po[(size_t)i * 32] = pack8(sl * inv - c.lo, sh * inv - c.hi);
                }
            }
        }
        __syncthreads();
    }
}

#define RLX_AGENT __ATOMIC_RELAXED, __HIP_MEMORY_SCOPE_AGENT
#define XB_TMO      128
#define XB_XCNT(j)  (256  + 64 * (j))
#define XB_XSUB(j)  (1280 + 64 * (j))
#define XB_XGEN(j)  (2304 + 64 * (j))
#define XB_TOP      3328
#define XB_TOPGEN   3392
#define XCD_BAR_WORDS 3456
#define XB_SPIN_CAP (1u << 18)

__device__ __forceinline__ unsigned xb_ld(unsigned* p)              { return __hip_atomic_load(p, __ATOMIC_RELAXED, __HIP_MEMORY_SCOPE_AGENT); }
__device__ __forceinline__ unsigned xb_add(unsigned* p, unsigned v) { return __hip_atomic_fetch_add(p, v, __ATOMIC_RELAXED, __HIP_MEMORY_SCOPE_AGENT); }
__device__ __forceinline__ unsigned xb_xcc_id() { return (unsigned)__builtin_amdgcn_s_getreg((3 << 11) | 20) & 0xFu; }
#define XB_SPIN(cond, bar) do { unsigned _sp = 0; while (cond) { __builtin_amdgcn_s_sleep(1); \
    if ((++_sp & 255u) == 0u) { if (xb_ld(&(bar)[XB_TMO])) break; if (_sp > XB_SPIN_CAP) { atomicAdd(&(bar)[XB_TMO], 1u); break; } } } } while (0)

struct XcdBarrier {
    unsigned* bar; unsigned x;
    volatile LAS unsigned* st;
};

__device__ __forceinline__ XcdBarrier xcd_barrier_post(unsigned* bar, volatile LAS unsigned* st) {
    XcdBarrier b; b.bar = bar; b.x = xb_xcc_id(); b.st = st;
    if (threadIdx.x == 0) (void)xb_add(&bar[XB_XCNT(b.x)], 1u);
    return b;
}
__device__ __forceinline__ void xcd_barrier_complete(unsigned* bar, unsigned x, unsigned& nloc, unsigned& nx) {
    const unsigned G = gridDim.x * gridDim.y * gridDim.z;
    unsigned sum, cnt, mine, sp = 0u;
    for (;;) {
        sum = 0u; cnt = 0u; mine = 0u;
#pragma unroll
        for (unsigned j = 0; j < 16; ++j) { const unsigned c = xb_ld(&bar[XB_XCNT(j)]); sum += c; cnt += (c > 0u) ? 1u : 0u; mine = (j == x) ? c : mine; }
        if (sum == G) break;
        __builtin_amdgcn_s_sleep(1);
        if ((++sp & 255u) == 0u) { if (xb_ld(&bar[XB_TMO])) break; if (sp > XB_SPIN_CAP) { atomicAdd(&bar[XB_TMO], 1u); break; } }
    }
    nloc = mine > 0u ? mine : 1u; nx = cnt > 0u ? cnt : 1u;
}

__device__ __forceinline__ void xcd_barrier(const XcdBarrier& b) {
    asm volatile("s_waitcnt vmcnt(0)" ::: "memory");
    __syncthreads();
    if (threadIdx.x == 0) {
        unsigned* bar = b.bar;
        __builtin_amdgcn_s_waitcnt(0);
        unsigned nloc = b.st[0], nx = b.st[1];
        if (nloc == 0u) { xcd_barrier_complete(bar, b.x, nloc, nx); b.st[0] = nloc; b.st[1] = nx; }
        const unsigned old = xb_add(&bar[XB_XSUB(b.x)], 1u);
        const unsigned gen = old / nloc;
        if (old + 1u == (gen + 1u) * nloc) {
            __builtin_amdgcn_fence(__ATOMIC_RELEASE, "agent");
            asm volatile("s_waitcnt vmcnt(0)" ::: "memory");
            const unsigned og = xb_add(&bar[XB_TOP], 1u);
            const unsigned tg = og / nx;
            if (og + 1u == (tg + 1u) * nx) xb_add(&bar[XB_TOPGEN], 1u);
            else XB_SPIN(xb_ld(&bar[XB_TOPGEN]) == tg, bar);
            __builtin_amdgcn_fence(__ATOMIC_ACQUIRE, "agent");
            xb_add(&bar[XB_XGEN(b.x)], 1u);
            asm volatile("s_waitcnt vmcnt(0)" ::: "memory");
        } else {
            XB_SPIN(xb_ld(&bar[XB_XGEN(b.x)]) == gen, bar);
            __builtin_amdgcn_fence(__ATOMIC_ACQUIRE, "agent");
            asm volatile("s_waitcnt vmcnt(0)" ::: "memory");
        }
    }
    __syncthreads();
}


__device__ __forceinline__ unsigned cvtpk(float lo, float hi) { return pk2(lo, hi); }
__device__ __forceinline__ s16x4 vtr(const LAS unsigned char* p) { return __builtin_bit_cast(s16x4, __builtin_amdgcn_ds_read_tr16_b64_v4i16((LAS s16x4*)p)); }
__device__ __forceinline__ void attn_phase(LAS unsigned char* lds, bf16* Qb, const bf16* Kb, const bf16* Vb, const float* rpb_l, int seq_len, int G, int bx, int tid, int wave, int lane) {
    const int fr = lane & 15, fq = lane >> 4;
    const int rows = seq_len >> 6, rows_shift = (seq_len == 2048) ? 5 : 6;
    constexpr int NI = (CH / 64) * 8;
    int nx, xc, lc, per;
    if ((G & 7) == 0) { nx = G >> 3; xc = bx & 7; lc = bx >> 3; per = NI >> 3; } else { nx = G; xc = 0; lc = bx; per = NI; }
    LAS float* bias = (LAS float*)(lds + BIAS_OFF);
    const int qb = wave & 3, hh = wave >> 2;
    const int qc = (qb < 3) ? (8 + 16 * qb + fr) : (fr < 8 ? fr : 48 + fr);
    const int a0 = (qb < 3) ? qb : 0, a1 = (qb < 3) ? qb + 1 : 3;
    const int wst = min(max(qc - 8, 0), 48);
    const int q4 = (lane & 15) >> 2, p4 = lane & 3;
    bool sel[4];
#pragma unroll
    for (int i = 0; i < 4; ++i) sel[i] = (qb < 3) ? (4 * fq + i >= fr) : (fr < 8);
    int voff[4];
#pragma unroll
    for (int i3 = 0; i3 < 4; ++i3) voff[i3] = (lane >> 4) * D + (((lane & 15) ^ (((lane >> 4) << 2) | i3)) * 8);
    if (lc >= per) return;
    int id = xc * per + lc;
    int r = id & (rows - 1), hp = (id >> rows_shift) & 7, tb = (id >> (rows_shift + 3)) * seq_len, r0 = min(max(r - 4, 0), rows - 8);
    bf16x8 qf0, qf1, kf[4][2][2];
    float bnext[2];
#define ATT_PREFETCH() do { \
        const int h_ = 2 * hp + hh; const size_t qo_ = (size_t)(tb + r * 64 + qc) * D + h_ * 64; \
        qf0 = *(const GAS bf16x8*)(Qb + qo_ + 8 * fq); qf1 = *(const GAS bf16x8*)(Qb + qo_ + 32 + 8 * fq); \
        const bf16* kb_ = Kb + ((size_t)(h_ * 8 + fq) * CH + (tb + r0 * 64 + fr)) * 8; \
        _Pragma("unroll") for (int kr = 0; kr < 4; ++kr) _Pragma("unroll") for (int ai = 0; ai < 2; ++ai) { const bf16* kp = kb_ + (kr * 64 + 16 * (ai ? a1 : a0)) * 8; kf[kr][ai][0] = *(const GAS bf16x8*)kp; kf[kr][ai][1] = *(const GAS bf16x8*)(kp + (size_t)4 * CH * 8); } \
        bnext[0] = rpb_l[hp * 930 + tid] * LOG2E; bnext[1] = (tid + 512 < 930) ? rpb_l[hp * 930 + tid + 512] * LOG2E : 0.f; } while (0)
#define ATT_BIAS_WRITE() do { bias[tid] = bnext[0]; if (tid + 512 < 930) bias[tid + 512] = bnext[1]; } while (0)
    ATT_PREFETCH();
    ATT_BIAS_WRITE();
    for (int loc = lc; loc < per; loc += nx) {
        const int h = 2 * hp + hh;
        const size_t qoff = (size_t)(tb + r * 64 + qc) * D + h * 64;
        const bf16* kbase = Kb + ((size_t)(h * 8 + fq) * CH + (tb + r0 * 64 + fr)) * 8;
        const int drb = r0 - r + 7;
        __syncthreads();
        {
            const int a = wave >> 1, ub = (wave & 1) * 2;
#pragma unroll
            for (int i = 0; i < 16; ++i) { const int kr = 2 * (ub + (i >> 3)) + (i & 1), cb = 16 * a + 4 * ((i & 7) >> 1);
                const bf16* src = Vb + (size_t)(tb + (r0 + kr) * 64 + cb) * D + hp * 128 + voff[i & 3];
                __builtin_amdgcn_global_load_lds((const unsigned*)src, (LAS unsigned*)(lds + (wave * 16 + i) * 1024), 16, 0, 0); }
        }
        f32x4 S[8];
        float mx = -3.0e38f;
        const LAS float* bptr[4];
#pragma unroll
        for (int i = 0; i < 4; ++i) { const int kc = 16 * (sel[i] ? a0 : a1) + 4 * fq + i; bptr[i] = bias + hh * 465 + drb * 31 + min(max(kc - qc + 15, 0), 30); }
#pragma unroll
        for (int kr = 0; kr < 8; ++kr) {
            f32x4 z0 = {0.f, 0.f, 0.f, 0.f}, z1 = {0.f, 0.f, 0.f, 0.f};
            z0 = __builtin_amdgcn_mfma_f32_16x16x32_bf16(kf[kr & 3][0][0], qf0, z0, 0, 0, 0);
            z0 = __builtin_amdgcn_mfma_f32_16x16x32_bf16(kf[kr & 3][0][1], qf1, z0, 0, 0, 0);
            z1 = __builtin_amdgcn_mfma_f32_16x16x32_bf16(kf[kr & 3][1][0], qf0, z1, 0, 0, 0);
            z1 = __builtin_amdgcn_mfma_f32_16x16x32_bf16(kf[kr & 3][1][1], qf1, z1, 0, 0, 0);
            f32x4 z;
#pragma unroll
            for (int i = 0; i < 4; ++i) { z[i] = (sel[i] ? z0[i] : z1[i]) + bptr[i][kr * 31]; mx = fmaxf(mx, z[i]); }
            S[kr] = z;
            if (kr < 4) {
#pragma unroll
                for (int ai = 0; ai < 2; ++ai) { const bf16* kp = kbase + ((kr + 4) * 64 + 16 * (ai ? a1 : a0)) * 8; kf[kr & 3][ai][0] = *(const GAS bf16x8*)kp; kf[kr & 3][ai][1] = *(const GAS bf16x8*)(kp + (size_t)4 * CH * 8); }
            }
        }
        mx = fmaxf(mx, __shfl_xor(mx, 16)); mx = fmaxf(mx, __shfl_xor(mx, 32));
        float sum = 0.f;
#pragma unroll
        for (int kr = 0; kr < 8; ++kr)
#pragma unroll
            for (int i = 0; i < 4; ++i) { const float p = __builtin_amdgcn_exp2f(S[kr][i] - mx); S[kr][i] = p; sum += p; }
        sum += __shfl_xor(sum, 16); sum += __shfl_xor(sum, 32);
        bf16x8 pf[4][2];
#pragma unroll
        for (int u = 0; u < 4; ++u)
#pragma unroll
            for (int ai = 0; ai < 2; ++ai) {
                float pa[2][4];
#pragma unroll
                for (int t = 0; t < 2; ++t)
#pragma unroll
                    for (int i = 0; i < 4; ++i) pa[t][i] = (sel[i] == (ai == 0)) ? S[2 * u + t][i] : 0.f;
                v4u pw; pw.x = cvtpk(pa[0][0], pa[0][1]); pw.y = cvtpk(pa[0][2], pa[0][3]); pw.z = cvtpk(pa[1][0], pa[1][1]); pw.w = cvtpk(pa[1][2], pa[1][3]);
                pf[u][ai] = __builtin_bit_cast(bf16x8, pw); }
        asm volatile("s_waitcnt vmcnt(0)" ::: "memory");
        __syncthreads();
        const int nloc = loc + nx; const bool has_next = nloc < per;
        const int r_cur = r, tb_cur = tb;
        if (has_next) { id = xc * per + nloc; r = id & (rows - 1); hp = (id >> rows_shift) & 7; tb = (id >> (rows_shift + 3)) * seq_len; r0 = min(max(r - 4, 0), rows - 8); ATT_PREFETCH(); }
        (void)r_cur; (void)tb_cur;
        f32x4 O[4];
#pragma unroll
        for (int c = 0; c < 4; ++c) O[c] = (f32x4){0.f, 0.f, 0.f, 0.f};
        const LAS unsigned char* vb[2][2][4];
#pragma unroll
        for (int ai = 0; ai < 2; ++ai)
#pragma unroll
            for (int t = 0; t < 2; ++t)
#pragma unroll
                for (int c = 0; c < 4; ++c) { const int rho = 8 * fq + 4 * t + q4, chn = 2 * (4 * hh + c) + (p4 >> 1);
                    vb[ai][t][c] = lds + (ai ? a1 : a0) * 32768 + 256 * rho + 16 * (chn ^ (((rho & 3) << 2) | ((rho >> 2) & 3))) + 8 * (p4 & 1); }
#pragma unroll
        for (int u = 0; u < 4; ++u) {
#pragma unroll
            for (int ai = 0; ai < 2; ++ai) {
#pragma unroll
                for (int c = 0; c < 4; ++c) {
                    const s16x4 v0 = vtr(vb[ai][0][c] + u * 8192), v1 = vtr(vb[ai][1][c] + u * 8192);
                    const bf16x8 vf = __builtin_shufflevector(v0, v1, 0, 1, 2, 3, 4, 5, 6, 7);
                    O[c] = __builtin_amdgcn_mfma_f32_16x16x32_bf16(vf, pf[u][ai], O[c], 0, 0, 0);
                }
            }
        }
        const float inv = 1.0f / sum;
#pragma unroll
        for (int c = 0; c < 4; ++c) { v2u w; w.x = cvtpk(O[c][0] * inv, O[c][1] * inv); w.y = cvtpk(O[c][2] * inv, O[c][3] * inv);
            *(GAS v2u*)(Qb + qoff + 16 * c + 4 * fq) = w; }
        if (has_next) ATT_BIAS_WRITE();
    }
    __syncthreads();
#undef ATT_PREFETCH
#undef ATT_BIAS_WRITE
}
enum { K_POOL = 1, K_GEMM_RES = 3, K_GEMM_QKV = 4, K_GEMM_UP = 5, K_ATTN = 6, K_FINAL = 7 };
enum { F_A_X = 1, F_A_IN = 2, F_AUX_X = 4, F_AUX_IN = 8, F_NOX = 16, F_B16 = 32 };
struct Ph { int kind, flags, N, K; const void* A; const void* B; void* C; const void* aux; float* st; float* rs; unsigned long long a_pn_stride, pad; };
constexpr int PPC = 19;
struct Args { Ptrs p; Ph tab[PPC]; };
__global__ void __launch_bounds__(NWAVES * 64, 2) fwd_megakernel(Args args) {
    extern __shared__ __attribute__((aligned(16))) unsigned char lds_raw[];
    cg::grid_group grid = cg::this_grid();
    LAS unsigned char* lds = (LAS unsigned char*)lds_raw;
    volatile LAS unsigned* MISC = (volatile LAS unsigned*)(lds + MISC_OFF);
    for (int u = threadIdx.x; u < 32; u += NWAVES * 64) MISC[u] = 0u;
    __syncthreads();
    const XcdBarrier bar = xcd_barrier_post((unsigned*)(args.p.ws + WS_CTL), MISC + 8);
    {
        const int tid = threadIdx.x, lane = tid & 63, wave = __builtin_amdgcn_readfirstlane(tid >> 6);
        const int G = gridDim.x, bx = blockIdx.x;
        const int vcu = (G % 8 == 0) ? (bx % 8) * (G / 8) + bx / 8 : bx;
        prologue(args.p, lds, vcu * NWAVES + wave, G * NWAVES, wave, lane);
    }
    grid.sync();

    for (int ph = 0; ph < NCHUNK * PPC; ++ph) {
        int tid = threadIdx.x; asm volatile("" : "+v"(tid));
        int G = gridDim.x, bx = blockIdx.x; asm volatile("" : "+s"(G), "+s"(bx));
        const int lane = tid & 63, wave = __builtin_amdgcn_readfirstlane(tid >> 6);
        const int vcu = (G % 8 == 0) ? (bx % 8) * (G / 8) + bx / 8 : bx;
        const int gw = vcu * NWAVES + wave, NGW = G * NWAVES;
        const int ck = ph / PPC, idx = ph - ck * PPC;
        const Ph& d = args.tab[idx];
        const int tok0 = ck * CH, grp = tok0 / GROUP_TOK, seq_len = grp ? 4096 : 2048;
        const float* xin = args.p.x_in[grp] + (size_t)(tok0 - grp * GROUP_TOK) * D;
        float* X = args.p.out + (size_t)tok0 * D;
        const void* A = (d.flags & F_A_IN) ? (const void*)xin : d.A;
        const void* aux = (d.flags & F_AUX_IN) ? (const void*)xin : d.aux;
#define KIND_IS(x) ([&]() { int kd_ = d.kind; asm volatile("" : "+s"(kd_)); return kd_ == (x); }())
        if (0) {}
        else if (KIND_IS(K_POOL)) { { int tid2 = threadIdx.x; asm volatile("" : "+v"(tid2));
            if (d.flags & F_B16) pool_phase<true>(lds, nullptr, (const bf16*)d.A, d.st, (const float*)aux, (bf16*)d.C, seq_len, vcu, G, tid2, __builtin_amdgcn_readfirstlane(tid2 >> 6), tid2 & 63);
            else pool_phase<false>(lds, (const float*)A, nullptr, nullptr, (const float*)aux, (bf16*)d.C, seq_len, vcu, G, tid2, __builtin_amdgcn_readfirstlane(tid2 >> 6), tid2 & 63); } }
        else if (KIND_IS(K_GEMM_RES)) { pg8::Gemm g{(const bf16*)A, (const bf16*)d.B, CH, d.N, d.K, (size_t)d.a_pn_stride, d.K == FF  }; pg8::StaticOrder S; S.init(CH, d.N, G, bx);
            pg8::EpiRes E{(const float*)aux, (d.flags & F_NOX) ? nullptr : X, (bf16*)d.C, d.st, D, d.rs, (d.flags & F_B16) ? (const bf16*)args.p.ws + WS_XN / 2 : nullptr};
            pg8::gemm_phase<pg8::EpiRes, pg8::StaticOrder, false, PG8_SP2>(lds, g, S, E, tid); }
        else if (KIND_IS(K_GEMM_QKV)) { pg8::Gemm g{(const bf16*)A, (const bf16*)d.B, CH, d.N, d.K, 0, 1  }; pg8::StaticOrder S; S.init(CH, d.N, G, bx);
            pg8::EpiBf16<0, true> E{(bf16*)d.C, D, D, (size_t)CH * D, 0.125f * LOG2E, d.st, 0};
            pg8::gemm_phase<pg8::EpiBf16<0, true>, pg8::StaticOrder, PG8_ALIGN, PG8_SP2>(lds, g, S, E, tid); }
        else if (KIND_IS(K_GEMM_UP)) { pg8::Gemm g{(const bf16*)A, (const bf16*)d.B, CH, d.N, d.K, 0, 1  }; pg8::StaticOrder S; S.init(CH, d.N, G, bx);
            pg8::EpiBf16<2, false> E{(bf16*)d.C, FF, 0, 0, 1.f, nullptr, 1};
            pg8::gemm_phase<pg8::EpiBf16<2, false>, pg8::StaticOrder, PG8_ALIGN, PG8_SP2>(lds, g, S, E, tid); }
        else if (KIND_IS(K_ATTN)) { attn_phase(lds, (bf16*)d.C, (const bf16*)d.C + (size_t)CH * D, (const bf16*)d.C + 2 * (size_t)CH * D, (const float*)aux, seq_len, G, bx, tid, wave, lane); }
        else { norm_rows_f32_inplace(X, (const float*)aux, CH, gw, NGW, lane); }
#undef KIND_IS
        if (d.kind != K_FINAL) xcd_barrier(bar);
    }
}

extern "C" void kernel_launch(void* const* d_in, const int* in_sizes, int n_in, void* d_out, int out_size, void* d_ws, size_t ws_size, hipStream_t stream) {
    static int grid = 0;
    if (grid == 0) {
        if (n_in != 12 || in_sizes[0] != GROUP_TOK * D || in_sizes[1] != GROUP_TOK * D || out_size != NTOK * D || ws_size < WS_END) {
            fprintf(stderr, "kernel_launch: unexpected shapes (n_in %d, out %d, ws %zu < %zu); nothing launched\n", n_in, out_size, ws_size, (size_t)WS_END); grid = -1; return; }
        int dev = 0, cus = 0, per_cu = 0;
        if (hipGetDevice(&dev) != hipSuccess || hipDeviceGetAttribute(&cus, hipDeviceAttributeMultiprocessorCount, dev) != hipSuccess) { fprintf(stderr, "kernel_launch: device query failed\n"); grid = -1; return; }
        if (hipFuncSetAttribute((const void*)fwd_megakernel, hipFuncAttributeMaxDynamicSharedMemorySize, LDS_BYTES) != hipSuccess) { fprintf(stderr, "kernel_launch: hipFuncSetAttribute failed\n"); grid = -1; return; }
        if (hipOccupancyMaxActiveBlocksPerMultiprocessor(&per_cu, (const void*)fwd_megakernel, NWAVES * 64, LDS_BYTES) != hipSuccess || per_cu < 1) { fprintf(stderr, "kernel_launch: occupancy query gave %d\n", per_cu); per_cu = 1; }
        (void)hipGetLastError();
        grid = cus * per_cu;
    }
    if (grid < 0) return;
    if (hipMemsetAsync((char*)d_ws + WS_CTL, 0, CTL_ZERO_BYTES, stream) != hipSuccess) { fprintf(stderr, "kernel_launch: hipMemsetAsync failed\n"); return; }
    Args a{};
    Ptrs& p = a.p;
    p.x_in[0] = (const float*)d_in[0]; p.x_in[1] = (const float*)d_in[1]; p.norm_mix = (const float*)d_in[2]; p.pool_w = (const float*)d_in[3]; p.pool_scale = (const float*)d_in[4];
    p.w_qkv = (const float*)d_in[5]; p.rpb = (const float*)d_in[6]; p.w_o = (const float*)d_in[7]; p.norm_mlp = (const float*)d_in[8]; p.w_up = (const float*)d_in[9];
    p.w_down = (const float*)d_in[10]; p.norm_final = (const float*)d_in[11]; p.out = (float*)d_out; p.ws = (unsigned char*)d_ws;
    unsigned char* ws = (unsigned char*)d_ws;
    bf16* WPOOL = (bf16*)(ws + WS_WPOOL); bf16* WQKV = (bf16*)(ws + WS_WQKV); bf16* WO = (bf16*)(ws + WS_WO); bf16* WUP = (bf16*)(ws + WS_WUP); bf16* WDN = (bf16*)(ws + WS_WDN);
    bf16* XN = (bf16*)(ws + WS_XN); bf16* PG = (bf16*)(ws + WS_PG); bf16* QB = (bf16*)(ws + WS_ACT); bf16* HB = (bf16*)(ws + WS_ACT);
    float* SA = (float*)(ws + WS_STAT); float* SB = SA + (size_t)CH * 16;
    int n = 0;
    auto add = [&](int kind, int flags, int N, int K, const void* A, const void* B, void* C, const void* aux, float* st, float* rs, unsigned long long aps) {
        Ph& d = a.tab[n++]; d.kind = kind; d.flags = flags; d.N = N; d.K = K; d.A = A; d.B = B; d.C = C; d.aux = aux; d.st = st; d.rs = rs; d.a_pn_stride = aps; d.pad = 0; };
    for (int layer = 0; layer < DEPTH; ++layer) {
        const int j = layer >> 1;
        if ((layer & 1) == 0) {
            add(K_POOL, layer == 0 ? F_A_IN : F_B16, 0, 0, layer == 0 ? nullptr : (const void*)XN, nullptr, PG, p.norm_mix + layer * D, layer == 0 ? nullptr : SB, nullptr, 0);
            add(K_GEMM_RES, (layer == 0 ? F_AUX_IN : F_B16) | F_NOX, D, 256, PG, WPOOL + (size_t)j * 1024 * 256, XN, nullptr, SA, nullptr, (unsigned long long)CH * 256 * 2);
        } else {
            add(K_GEMM_QKV, 0, 3 * D, D, XN, WQKV + (size_t)j * 3 * D * D, QB, nullptr, SB, nullptr, 0);
            add(K_ATTN, 0, 0, 0, nullptr, nullptr, QB, p.rpb + (size_t)j * NH * 15 * 31, nullptr, nullptr, 0);
            add(K_GEMM_RES, F_B16 | F_NOX, D, D, QB, WO + (size_t)j * D * D, XN, nullptr, SA, nullptr, 0);
        }
        add(K_GEMM_UP, 0, FF, D, XN, WUP + (size_t)layer * D * FF, HB, nullptr, SA, nullptr, 0);
        add(K_GEMM_RES, F_B16 | (layer != DEPTH - 1 ? F_NOX : 0), D, FF, HB, WDN + (size_t)layer * D * FF, layer != DEPTH - 1 ? XN : nullptr, nullptr, SB, SA, 0);
    }
    add(K_FINAL, 0, 0, 0, nullptr, nullptr, nullptr, p.norm_final, nullptr, nullptr, 0);
    if (n != PPC) { fprintf(stderr, "kernel_launch: phase table has %d entries, expected %d\n", n, PPC); return; }
    void* kargs[] = {&a};
    hipError_t e = hipLaunchCooperativeKernel((const void*)fwd_megakernel, dim3(grid), dim3(NWAVES * 64), kargs, LDS_BYTES, stream);
    if (e != hipSuccess) fprintf(stderr, "kernel_launch: cooperative launch failed: %s (grid %d)\n", hipGetErrorString(e), grid);
}
```

```cpp
#include <hip/hip_runtime.h>
#include <hip/hip_cooperative_groups.h>
#include <cstdio>
#include <cstdint>
namespace cg = cooperative_groups;
namespace pg8 {
#define PG8_LAS __attribute__((address_space(3)))
typedef unsigned short bf16_t;
typedef short bf16x8 __attribute__((ext_vector_type(8)));
typedef float f32x4 __attribute__((ext_vector_type(4)));
typedef unsigned u32x4 __attribute__((ext_vector_type(4)));
constexpr int BM = 256, BK = 64, HALF = 128, HTB = HALF * BK * 2  , STAGE_BYTES = 8 * HTB, NXCD = 8, WGM = 8;

__host__ __device__ __forceinline__ int lds_byte(int r, int c) { const int st = (r >> 4) * 2 + (c >> 5), rr = r & 15, cc = c & 31, ob = rr * 64 + cc * 2; return st * 1024 + (ob ^ (((ob >> 9) & 1) << 5)); }
__host__ __device__ __forceinline__ void stage_rc(int b, int& R, int& C) { const int st = b / 1024, sb = b % 1024, swz = sb ^ (((sb >> 9) & 1) << 5); R = (st >> 1) * 16 + swz / 64; C = (st & 1) * 32 + (swz % 64) / 2; }
__host__ __device__ __forceinline__ int perm32(int rho) { const int n = rho >> 4, i = rho & 15; return 8 * (i >> 2) + 4 * n + (i & 3); }

struct Unit { int pm, pn; };
struct Gemm { const bf16_t* A; const bf16_t* Bt; int M, N, K; size_t a_pn_stride; int a_tiled; };

struct StaticOrder {
    int nM, nN, nwg, G, c;
    __host__ __device__ void init(int M, int N, int G_, int c_) { nM = M / BM; nN = N / BM; nwg = nM * nN; G = G_; c = c_; }
    __host__ __device__ bool next(int i, Unit& u) const {
        const long L = (long)i * G + c; if (L >= nwg) return false;
        int wgid = (int)L; { const int q = nwg / NXCD, r = nwg % NXCD, xcd = wgid % NXCD, off = wgid / NXCD; wgid = (xcd < r ? xcd * (q + 1) : r * (q + 1) + (xcd - r) * q) + off; }
        const int nig = WGM * nN, gid = wgid / nig, fm = gid * WGM, gsz = (nM - fm) < WGM ? (nM - fm) : WGM;
        u.pm = fm + ((wgid % nig) % gsz); u.pn = (wgid % nig) / gsz; return true;
    }
    __device__ __forceinline__ void a_ready(const Unit&) const {}
    __device__ __forceinline__ void done(const Unit&) const {}
};

__device__ __forceinline__ unsigned cvt_pk_bf16(float lo, float hi) { unsigned r; asm volatile("v_cvt_pk_bf16_f32 %0, %1, %2" : "=v"(r) : "v"(lo), "v"(hi)); return r; }
typedef float f32x2 __attribute__((ext_vector_type(2)));
template <int ACT, bool RS> struct EpiBf16 {
    static constexpr bool PERM = true, AFTER_DRAIN = false;
    bf16_t* O; int ldc; int split_cols; size_t split_stride; float scale0; const float* st; int tiled;
    __device__ __forceinline__ void operator()(const f32x4 (&acc)[2][2][4][2], const Unit& u, int wr, int wc, int fr, int fq) const {
        const int row0 = u.pm * BM + wr * 64 + fr; int colt = u.pn * BM; bf16_t* base = O;
        float sc = 1.f; bool kplane = false;
        if (split_cols) { const int t = colt / split_cols; base += (size_t)t * split_stride; colt -= t * split_cols; if (t == 0) sc = scale0; kplane = (t == 1); }
        const size_t kprows = split_stride / 1024;
        const int col0 = colt + wc * 32 + 8 * fq;
        f32x4 pv[2][4];
        if (RS) {
#pragma unroll
            for (int ai = 0; ai < 2; ++ai)
#pragma unroll
                for (int m = 0; m < 4; ++m) pv[ai][m] = *(const f32x4*)(st + (size_t)(row0 + ai * HALF + m * 16) * 16 + 4 * fq);
            __builtin_amdgcn_sched_barrier(0);
        }
#pragma unroll
        for (int ai = 0; ai < 2; ++ai)
#pragma unroll
            for (int m = 0; m < 4; ++m) { const int row = row0 + ai * HALF + m * 16; bf16_t* rowp = base + (size_t)row * ldc + col0;
                float f = sc;
                if (RS) { float ss = (pv[ai][m][0] + pv[ai][m][1]) + (pv[ai][m][2] + pv[ai][m][3]); ss += __shfl_xor(ss, 16); ss += __shfl_xor(ss, 32);
                    const float r = __builtin_amdgcn_rsqf(ss * (1.0f / 1024.0f) + 1e-6f); f *= (ACT == 2) ? r * r : r; }
#pragma unroll
                for (int bj = 0; bj < 2; ++bj) { f32x4 v0 = acc[ai][bj][m][0], v1 = acc[ai][bj][m][1];
                    if (ACT == 2) {
#pragma unroll
                        for (int e = 0; e < 4; ++e) { const float a = fmaxf(v0[e], 0.f), b = fmaxf(v1[e], 0.f); v0[e] = a * a; v1[e] = b * b; } }
                    v0 = v0 * f; v1 = v1 * f; u32x4 w; w.x = cvt_pk_bf16(v0[0], v0[1]); w.y = cvt_pk_bf16(v0[2], v0[3]); w.z = cvt_pk_bf16(v1[0], v1[1]); w.w = cvt_pk_bf16(v1[2], v1[3]);
                    if (kplane) *(u32x4*)(base + ((size_t)(((colt >> 6) + 2 * bj + (wc >> 1)) * 8 + (wc & 1) * 4 + fq) * kprows + row) * 8) = w;
                    else if (tiled) { const int r_ = row & 255, c_ = col0 + bj * HALF;
                        *(u32x4*)((char*)base + ((size_t)(((row >> 8) * 2 + (r_ >> 7)) * (ldc >> 6) + (c_ >> 6)) << 14) + lds_byte(r_ & 127, c_ & 63)) = w; }
                    else *(u32x4*)(rowp + bj * HALF) = w; } }
    }
};
struct EpiRes {
    static constexpr bool PERM = true, AFTER_DRAIN = false;
    const float* base; float* out; bf16_t* xn; float* st; int ldc; const float* rs; const bf16_t* b16;
    __device__ __forceinline__ void operator()(const f32x4 (&acc)[2][2][4][2], const Unit& u, int wr, int wc, int fr, int fq) const {
        const int col0 = u.pn * BM + wc * 32 + 8 * fq;
#pragma unroll
        for (int ai = 0; ai < 2; ++ai) {
            f32x4 rp[4];
            if (rs) {
#pragma unroll
                for (int m = 0; m < 4; ++m) rp[m] = *(const f32x4*)(rs + (size_t)(u.pm * BM + ai * HALF + wr * 64 + m * 16 + fr) * 16 + 4 * fq);
            }
            f32x4 bs[4][2][2];
            if (b16) {
#pragma unroll
                for (int m = 0; m < 4; ++m)
#pragma unroll
                    for (int bj = 0; bj < 2; ++bj) { const int c_ = col0 + bj * HALF;
                        const u32x4 w = *(const u32x4*)((const char*)b16 + ((size_t)((u.pm * 2 + ai) * (ldc >> 6) + (c_ >> 6)) << 14) + lds_byte(wr * 64 + m * 16 + fr, c_ & 63));
                        bs[m][bj][0] = (f32x4){__builtin_bit_cast(float, w.x << 16), __builtin_bit_cast(float, w.x & 0xffff0000u), __builtin_bit_cast(float, w.y << 16), __builtin_bit_cast(float, w.y & 0xffff0000u)};
                        bs[m][bj][1] = (f32x4){__builtin_bit_cast(float, w.z << 16), __builtin_bit_cast(float, w.z & 0xffff0000u), __builtin_bit_cast(float, w.w << 16), __builtin_bit_cast(float, w.w & 0xffff0000u)}; }
            } else {
#pragma unroll
                for (int m = 0; m < 4; ++m) { const size_t off = (size_t)(u.pm * BM + ai * HALF + wr * 64 + m * 16 + fr) * ldc + col0;
#pragma unroll
                    for (int bj = 0; bj < 2; ++bj) { bs[m][bj][0] = *(const f32x4*)(base + off + bj * HALF); bs[m][bj][1] = *(const f32x4*)(base + off + bj * HALF + 4); } }
            }
            __builtin_amdgcn_sched_barrier(0);
#pragma unroll
            for (int m = 0; m < 4; ++m) { const int row = u.pm * BM + ai * HALF + wr * 64 + m * 16 + fr; const size_t off = (size_t)row * ldc + col0; float ss = 0.f;
                float f = 1.f;
                if (rs) { float q = (rp[m][0] + rp[m][1]) + (rp[m][2] + rp[m][3]); q += __shfl_xor(q, 16); q += __shfl_xor(q, 32); const float r = __builtin_amdgcn_rsqf(q * (1.0f / 1024.0f) + 1e-6f); f = r * r; }
#pragma unroll
                for (int bj = 0; bj < 2; ++bj) {
                    const f32x4 o0 = bs[m][bj][0] + acc[ai][bj][m][0] * f, o1 = bs[m][bj][1] + acc[ai][bj][m][1] * f;
                    if (out) { *(f32x4*)(out + off + bj * HALF) = o0; *(f32x4*)(out + off + bj * HALF + 4) = o1; }
                    if (xn) { u32x4 w; w.x = cvt_pk_bf16(o0[0], o0[1]); w.y = cvt_pk_bf16(o0[2], o0[3]); w.z = cvt_pk_bf16(o1[0], o1[1]); w.w = cvt_pk_bf16(o1[2], o1[3]);
                        { const int c_ = col0 + bj * HALF;
                          *(u32x4*)((char*)xn + ((size_t)((u.pm * 2 + ai) * (ldc >> 6) + (c_ >> 6)) << 14) + lds_byte(wr * 64 + m * 16 + fr, c_ & 63)) = w; }
                        ss += (o0[0] * o0[0] + o0[1] * o0[1]) + (o0[2] * o0[2] + o0[3] * o0[3]) + (o1[0] * o1[0] + o1[1] * o1[1]) + (o1[2] * o1[2] + o1[3] * o1[3]); } }
                if (xn) { ss += __shfl_xor(ss, 16); ss += __shfl_xor(ss, 32); if (fq == 0) st[(size_t)row * 16 + u.pn * 4 + wc] = ss; } }
        }
    }
};
template <class Epi, class Sched, bool ALIGN_EPI = false, bool SP2 = false>
__device__ __forceinline__ void gemm_phase(PG8_LAS unsigned char* lds, const Gemm g, const Sched& S, const Epi& E, const int tid_in) {
    const int tid = tid_in, wid = __builtin_amdgcn_readfirstlane(tid >> 6), lane = tid & 63, wr = wid >> 2, wc = wid & 3, fr = lane & 15, fq = lane >> 4;
    const int K = g.K, nt = K / BK;
    unsigned voffA[2], voffB[2];
#pragma unroll
    for (int i = 0; i < 2; ++i) { int R, C; stage_rc(tid * 16 + i * 8192, R, C); const int Rb = Epi::PERM ? ((R & ~31) + perm32(R & 31)) : R;
        voffA[i] = g.a_tiled ? (unsigned)(tid * 16 + i * 8192) : (unsigned)(R * K + C) * 2u; voffB[i] = (unsigned)(tid * 16 + i * 8192); (void)Rb; }
    const size_t kstep = (size_t)(BK * 2);
    const size_t hstep = (size_t)HALF * K * 2;
    const size_t tstep = 2 * hstep;
    const size_t kstepB = 16384, hstepB = (size_t)nt * 16384, tstepB = 2 * hstepB;
    const size_t kstepA = g.a_tiled ? (size_t)16384 : kstep, hstepA = g.a_tiled ? (size_t)nt * 16384 : hstep, tstepA = 2 * hstepA;
    const unsigned ldsw = (unsigned)wid * 1024u;
    const int aoff = lds_byte(wr * 64 + fr, fq * 8), boff = lds_byte(wc * 32 + fr, fq * 8);
#define PG8_SA(b, h) (((b) * 2 + (h)) * HTB)
#define PG8_SB(b, h) ((4 + (b) * 2 + (h)) * HTB)
#define PG8_STAGE(bufoff, gbase, voff) do { _Pragma("unroll") for (int _i = 0; _i < 2; ++_i) \
        __builtin_amdgcn_global_load_lds((const unsigned*)((const char*)(gbase) + (voff)[_i]), (PG8_LAS unsigned*)(lds + (bufoff) + ldsw + _i * 8192), 16, 0, 0); } while (0)
#define PG8_LDA(dst, b, h) do { _Pragma("unroll") for (int m = 0; m < 4; ++m) _Pragma("unroll") for (int k = 0; k < 2; ++k) dst[m][k] = *(const PG8_LAS bf16x8*)(lds + PG8_SA(b, h) + aoff + m * 2048 + k * 1024); } while (0)
#define PG8_LDB(dst, b, h) do { _Pragma("unroll") for (int n = 0; n < 2; ++n) _Pragma("unroll") for (int k = 0; k < 2; ++k) dst[n][k] = *(const PG8_LAS bf16x8*)(lds + PG8_SB(b, h) + boff + n * 2048 + k * 1024); } while (0)
#define PG8_MMA(ai, bj, At, Bt) do { __builtin_amdgcn_s_setprio(1); _Pragma("unroll") for (int m = 0; m < 4; ++m) _Pragma("unroll") for (int n = 0; n < 2; ++n) _Pragma("unroll") for (int k = 0; k < 2; ++k) \
        acc[ai][bj][m][n] = __builtin_amdgcn_mfma_f32_16x16x32_bf16(Bt[n][k], At[m][k], acc[ai][bj][m][n], 0, 0, 0); __builtin_amdgcn_s_setprio(0); } while (0)
#define PG8_WAIT_V(n) asm volatile("s_waitcnt vmcnt(" #n ")" ::: "memory")
#define PG8_WAIT_L(n) asm volatile("s_waitcnt lgkmcnt(" #n ")" ::: "memory")
#define PG8_BAR __builtin_amdgcn_s_barrier()
#define PG8_SCHED __builtin_amdgcn_sched_barrier(0)
    Unit cur, nxt; int ui = 0;
    if (!S.next(0, cur)) return;
    f32x4 acc[2][2][4][2];
#pragma unroll
    for (int a = 0; a < 2; ++a)
#pragma unroll
        for (int b = 0; b < 2; ++b)
#pragma unroll
            for (int m = 0; m < 4; ++m)
#pragma unroll
                for (int n = 0; n < 2; ++n) acc[a][b][m][n] = (f32x4){0.f, 0.f, 0.f, 0.f};
    bf16x8 At[4][2], B0[2][2], B1[2][2];
    const char* cA = (const char*)g.A + (size_t)cur.pm * tstepA + (size_t)cur.pn * g.a_pn_stride; const char* cB = (const char*)g.Bt + (size_t)cur.pn * tstepB;
    S.a_ready(cur);
    if constexpr (SP2) {
        PG8_STAGE(PG8_SB(0, 0), cB, voffB); PG8_STAGE(PG8_SB(0, 1), cB + hstepB, voffB); PG8_STAGE(PG8_SA(0, 0), cA, voffA); PG8_STAGE(PG8_SA(0, 1), cA + hstepA, voffA);
        if (wr == 1) PG8_BAR;
        PG8_WAIT_V(2); PG8_BAR;
        PG8_STAGE(PG8_SB(1, 0), cB + kstepB, voffB); PG8_STAGE(PG8_SA(1, 0), cA + kstepA, voffA); PG8_STAGE(PG8_SB(1, 1), cB + hstepB + kstepB, voffB);
        PG8_WAIT_V(6); PG8_BAR;
    } else {
        PG8_STAGE(PG8_SB(0, 0), cB, voffB); PG8_STAGE(PG8_SA(0, 0), cA, voffA); PG8_STAGE(PG8_SB(0, 1), cB + hstepB, voffB); PG8_STAGE(PG8_SA(0, 1), cA + hstepA, voffA);
        if (wr == 1) PG8_BAR;
        PG8_WAIT_V(4); PG8_BAR;
        PG8_STAGE(PG8_SB(1, 0), cB + kstepB, voffB); PG8_STAGE(PG8_SA(1, 0), cA + kstepA, voffA); PG8_STAGE(PG8_SB(1, 1), cB + hstepB + kstepB, voffB);
        PG8_WAIT_V(6); PG8_BAR;
    }
    for (;;) {
        const bool has_next = S.next(ui + 1, nxt);
        const char* nA = has_next ? (const char*)g.A + (size_t)nxt.pm * tstepA + (size_t)nxt.pn * g.a_pn_stride : cA; const char* nB = has_next ? (const char*)g.Bt + (size_t)nxt.pn * tstepB : cB;
        for (int t = 0; t < nt; t += 2) {
            const bool last = (t == nt - 2);
            const char* a1 = cA + (size_t)(t + 1) * kstepA;
            const char* a2 = last ? nA : cA + (size_t)(t + 2) * kstepA; const char* b2 = last ? nB : cB + (size_t)(t + 2) * kstepB;
            const char* a3 = a2 + kstepA; const char* b3 = b2 + kstepB;
            if (last && has_next) S.a_ready(nxt);
            if constexpr (SP2) {
            PG8_LDB(B0, 0, 0); PG8_LDB(B1, 0, 1); PG8_SCHED; PG8_LDA(At, 0, 0); PG8_STAGE(PG8_SA(1, 1), a1 + hstepA, voffA);
            PG8_WAIT_V(8); PG8_WAIT_L(0); PG8_BAR; PG8_MMA(0, 0, At, B0); PG8_MMA(0, 1, At, B1); PG8_BAR; PG8_SCHED;
            PG8_LDA(At, 0, 1); PG8_STAGE(PG8_SB(0, 0), b2, voffB); PG8_STAGE(PG8_SB(0, 1), b2 + hstepB, voffB); PG8_STAGE(PG8_SA(0, 0), a2, voffA);
            PG8_WAIT_V(8); PG8_WAIT_L(0); PG8_BAR; PG8_MMA(1, 0, At, B0); PG8_MMA(1, 1, At, B1); PG8_BAR; PG8_SCHED;
            PG8_LDB(B0, 1, 0); PG8_LDB(B1, 1, 1); PG8_SCHED; PG8_LDA(At, 1, 0); PG8_STAGE(PG8_SA(0, 1), a2 + hstepA, voffA);
            PG8_WAIT_V(8); PG8_WAIT_L(0); PG8_BAR; PG8_MMA(0, 0, At, B0); PG8_MMA(0, 1, At, B1); PG8_BAR; PG8_SCHED;
            PG8_LDA(At, 1, 1); PG8_STAGE(PG8_SB(1, 0), b3, voffB); PG8_STAGE(PG8_SB(1, 1), b3 + hstepB, voffB); PG8_STAGE(PG8_SA(1, 0), a3, voffA);
            PG8_WAIT_V(8); PG8_WAIT_L(0); PG8_BAR; PG8_MMA(1, 0, At, B0); PG8_MMA(1, 1, At, B1); PG8_BAR; PG8_SCHED;
            } else {
            PG8_LDB(B0, 0, 0); PG8_SCHED; PG8_LDA(At, 0, 0); PG8_STAGE(PG8_SA(1, 1), a1 + hstepA, voffA);
            PG8_WAIT_L(8); PG8_BAR; PG8_WAIT_L(0); PG8_MMA(0, 0, At, B0); PG8_BAR; PG8_SCHED;
            PG8_LDB(B1, 0, 1); PG8_STAGE(PG8_SB(0, 0), b2, voffB);
            PG8_BAR; PG8_WAIT_L(0); PG8_MMA(0, 1, At, B1); PG8_BAR;
            PG8_LDA(At, 0, 1); PG8_STAGE(PG8_SA(0, 0), a2, voffA);
            PG8_BAR; PG8_WAIT_L(0); PG8_MMA(1, 0, At, B0); PG8_BAR; PG8_SCHED;
            PG8_STAGE(PG8_SB(0, 1), b2 + hstepB, voffB);
            PG8_WAIT_V(6); PG8_BAR; PG8_MMA(1, 1, At, B1); PG8_BAR;
            PG8_LDB(B0, 1, 0); PG8_SCHED; PG8_LDA(At, 1, 0); PG8_STAGE(PG8_SA(0, 1), a2 + hstepA, voffA);
            PG8_WAIT_L(8); PG8_BAR; PG8_WAIT_L(0); PG8_MMA(0, 0, At, B0); PG8_BAR; PG8_SCHED;
            PG8_LDB(B1, 1, 1); PG8_STAGE(PG8_SB(1, 0), b3, voffB);
            PG8_BAR; PG8_WAIT_L(0); PG8_MMA(0, 1, At, B1); PG8_BAR;
            PG8_LDA(At, 1, 1); PG8_STAGE(PG8_SA(1, 0), a3, voffA);
            PG8_BAR; PG8_WAIT_L(0); PG8_MMA(1, 0, At, B0); PG8_BAR; PG8_SCHED;
            PG8_STAGE(PG8_SB(1, 1), b3 + hstepB, voffB);
            PG8_WAIT_V(6); PG8_BAR; PG8_MMA(1, 1, At, B1); PG8_BAR;
            }
        }
        if constexpr (ALIGN_EPI) { if (wr == 0) PG8_BAR; }
        if constexpr (!Epi::AFTER_DRAIN) { E(acc, cur, wr, wc, fr, fq); S.done(cur); }
        if (!has_next) break;
#pragma unroll
        for (int a = 0; a < 2; ++a)
#pragma unroll
            for (int b = 0; b < 2; ++b)
#pragma unroll
                for (int m = 0; m < 4; ++m)
#pragma unroll
                    for (int n = 0; n < 2; ++n) acc[a][b][m][n] = (f32x4){0.f, 0.f, 0.f, 0.f};
        cur = nxt; cA = nA; cB = nB; ++ui;
        if constexpr (ALIGN_EPI) { if (wr == 1) PG8_BAR; }
    }
    PG8_WAIT_V(0);
    if constexpr (!ALIGN_EPI) { if (wr == 0) PG8_BAR; }
    PG8_BAR;
    if constexpr (Epi::AFTER_DRAIN) { E.fused(acc, cur, wr, wc, fr, fq, lds, wid, lane); S.done(cur); }
#undef PG8_SA
#undef PG8_SB
#undef PG8_STAGE
#undef PG8_LDA
#undef PG8_LDB
#undef PG8_MMA
#undef PG8_WAIT_V
#undef PG8_WAIT_L
#undef PG8_BAR
#undef PG8_SCHED
}
}
#ifndef PG8_SP2
#define PG8_SP2 true
#endif
#ifndef PG8_ALIGN
#define PG8_ALIGN true
#endif

constexpr int NWAVES = 8;
constexpr int D = 1024, FF = 4096, NH = 16, HD = 64, DEPTH = 4;
constexpr int NTOK = 131072;
constexpr int GROUP_TOK = 65536;
#ifndef MK_CH
#define MK_CH 32768
#endif
constexpr int CH = MK_CH;
constexpr int NCHUNK = NTOK / CH;
constexpr float RMS_EPS = 1e-6f;
constexpr float LOG2E = 1.4426950408889634f;
static_assert(GROUP_TOK % CH == 0 && CH % 4096 == 0, "chunking");

constexpr size_t MiB = 1u << 20;
constexpr size_t WS_WPOOL = 2 * MiB;
constexpr size_t WS_WQKV = 4 * MiB;
constexpr size_t WS_WO = 16 * MiB;
constexpr size_t WS_WUP = 20 * MiB;
constexpr size_t WS_WDN = 52 * MiB;
constexpr size_t WS_XN = 96 * MiB;
constexpr size_t WS_PG = WS_XN + (size_t)CH * D * 2;
constexpr size_t WS_ACT = WS_PG + (size_t)CH * D * 2;
constexpr size_t WS_CTL = 0, CTL_ZERO_BYTES = 65536;
constexpr size_t WS_STAT = 86 * MiB;
static_assert(WS_STAT + 2 * (size_t)CH * 64 <= WS_XN, "stat arrays");
constexpr size_t WS_END = WS_ACT + (size_t)CH * FF * 2;
static_assert(WS_XN >= WS_WDN + 32 * MiB && WS_END <= 1024 * MiB, "d_ws map");

constexpr int RING_BYTES = 131072;
constexpr int BIAS_OFF = RING_BYTES;
constexpr int MISC_OFF = RING_BYTES + 4096;
constexpr int LDS_BYTES = 147456;

#define GAS __attribute__((address_space(1)))
#define LAS __attribute__((address_space(3)))
typedef unsigned short bf16;
typedef unsigned v4u __attribute__((ext_vector_type(4)));
typedef unsigned v2u __attribute__((ext_vector_type(2)));
typedef float f32x4 __attribute__((ext_vector_type(4)));
typedef short bf16x8 __attribute__((ext_vector_type(8)));
typedef short s16x4 __attribute__((ext_vector_type(4)));
#define LDS_WAIT() asm volatile("s_waitcnt lgkmcnt(0)" ::: "memory")
typedef float f32x2_t __attribute__((ext_vector_type(2))); typedef __bf16 bf16x2_t __attribute__((ext_vector_type(2)));
__device__ __forceinline__ unsigned pk2(float lo, float hi) { f32x2_t v = {lo, hi}; bf16x2_t b = __builtin_convertvector(v, bf16x2_t); return __builtin_bit_cast(unsigned, b); }
__device__ __forceinline__ float wave_sum(float v) {
#pragma unroll
    for (int o = 1; o < 64; o <<= 1) v += __shfl_xor(v, o);
    return v;
}

__device__ __forceinline__ void transpose_item(const float* W, int K, int N, bf16* WT, int row_off, const float* nscale, const float* kscale, LAS float* scr, int item, int lane) {
    const int nblk = N / 32, kb = item / nblk, nb = item % nblk, k0 = 64 * kb, n0 = 32 * nb;
    float wv[32];
#pragma unroll
    for (int i = 0; i < 32; ++i) wv[i] = W[(size_t)(k0 + 2 * i + (lane >> 5)) * N + n0 + (lane & 31)];
#pragma unroll
    for (int i = 0; i < 32; ++i) scr[(2 * i + (lane >> 5)) * 33 + (lane & 31)] = wv[i];
    LDS_WAIT(); asm volatile("" ::: "memory");
    const int c = lane & 7;
    float ks[8];
#pragma unroll
    for (int e = 0; e < 8; ++e) ks[e] = kscale ? kscale[k0 + 8 * c + e] : 1.f;
#pragma unroll
    for (int j = 0; j < 4; ++j) { const int n = (lane >> 3) + 8 * j; const LAS float* s = scr + (8 * c) * 33 + n;
        const float sc = nscale ? nscale[n0 + n] : 1.f;
        v4u o; o.x = pk2(s[0 * 33] * sc * ks[0], s[1 * 33] * sc * ks[1]); o.y = pk2(s[2 * 33] * sc * ks[2], s[3 * 33] * sc * ks[3]); o.z = pk2(s[4 * 33] * sc * ks[4], s[5 * 33] * sc * ks[5]); o.w = pk2(s[6 * 33] * sc * ks[6], s[7 * 33] * sc * ks[7]);
        { const int ng = row_off + n0 + n, nr = ng & 127, cc = nr & 31, slot = (((cc >> 2) & 1) << 4) | ((cc >> 3) << 2) | (cc & 3), kk = k0 + 8 * c;
          *(GAS v4u*)((GAS char*)WT + ((size_t)(((ng >> 8) * 2 + ((ng >> 7) & 1)) * (K >> 6) + (kk >> 6)) << 14) + pg8::lds_byte((nr & ~31) + slot, kk & 63)) = o; } }
    LDS_WAIT(); asm volatile("" ::: "memory");
}

struct Ptrs {
    const float *x_in[2], *norm_mix, *pool_w, *pool_scale, *w_qkv, *rpb, *w_o, *norm_mlp, *w_up, *w_down, *norm_final;
    float* out; unsigned char* ws;
};

__device__ __forceinline__ void prologue(const Ptrs& P, LAS unsigned char* lds, int gw, int NGW, int wave, int lane) {
    LAS float* scr = (LAS float*)(lds + wave * 16384);
    bf16* WPOOL = (bf16*)(P.ws + WS_WPOOL); bf16* WQKV = (bf16*)(P.ws + WS_WQKV); bf16* WO = (bf16*)(P.ws + WS_WO); bf16* WUP = (bf16*)(P.ws + WS_WUP); bf16* WDN = (bf16*)(P.ws + WS_WDN);
    constexpr int I_POOL = (256 / 64) * (256 / 32), I_QKV = (D / 64) * (3 * D / 32), I_O = (D / 64) * (D / 32), I_UP = (D / 64) * (FF / 32), I_DN = (FF / 64) * (D / 32);
    constexpr int NITEMS = 8 * I_POOL + 2 * I_QKV + 2 * I_O + 4 * I_UP + 4 * I_DN;
    for (int it = gw; it < NITEMS; it += NGW) {
        int r = it;
        if (r < 8 * I_POOL) { const int mtx = r / I_POOL, j = mtx >> 2, g = mtx & 3; transpose_item(P.pool_w + (size_t)mtx * 65536, 256, 256, WPOOL + (size_t)j * 1024 * 256, g * 256, P.pool_scale + j * 1024 + g * 256, nullptr, scr, r % I_POOL, lane); continue; } r -= 8 * I_POOL;
        if (r < 2 * I_QKV) { const int j = r / I_QKV; transpose_item(P.w_qkv + (size_t)j * D * 3 * D, D, 3 * D, WQKV + (size_t)j * 3 * D * D, 0, nullptr, P.norm_mix + (2 * j + 1) * D, scr, r % I_QKV, lane); continue; } r -= 2 * I_QKV;
        if (r < 2 * I_O) { const int j = r / I_O; transpose_item(P.w_o + (size_t)j * D * D, D, D, WO + (size_t)j * D * D, 0, nullptr, nullptr, scr, r % I_O, lane); continue; } r -= 2 * I_O;
        if (r < 4 * I_UP) { const int j = r / I_UP; transpose_item(P.w_up + (size_t)j * D * FF, D, FF, WUP + (size_t)j * D * FF, 0, nullptr, P.norm_mlp + j * D, scr, r % I_UP, lane); continue; } r -= 4 * I_UP;
        { const int j = r / I_DN; transpose_item(P.w_down + (size_t)j * D * FF, FF, D, WDN + (size_t)j * D * FF, 0, nullptr, nullptr, scr, r % I_DN, lane); }
    }
}

__device__ __forceinline__ void norm_rows_f32_inplace(float* x, const float* gain, int nrows, int gw, int NGW, int lane) {
    f32x4 g[4];
#pragma unroll
    for (int j = 0; j < 4; ++j) g[j] = *((const f32x4*)gain + lane + 64 * j);
    for (int m = gw * 4; m < nrows; m += NGW * 4) {
        GAS f32x4* xr = (GAS f32x4*)(x + (size_t)m * D) + lane;
        f32x4 v[4][4];
#pragma unroll
        for (int r = 0; r < 4; ++r)
#pragma unroll
            for (int j = 0; j < 4; ++j) v[r][j] = xr[r * 256 + 64 * j];
        __builtin_amdgcn_sched_barrier(0);
#pragma unroll
        for (int r = 0; r < 4; ++r) { float s = 0.f;
#pragma unroll
            for (int j = 0; j < 4; ++j) s += (v[r][j].x * v[r][j].x + v[r][j].y * v[r][j].y) + (v[r][j].z * v[r][j].z + v[r][j].w * v[r][j].w);
            const float rr = 1.0f / sqrtf(wave_sum(s) * (1.f / D) + RMS_EPS);
#pragma unroll
            for (int j = 0; j < 4; ++j) xr[r * 256 + 64 * j] = v[r][j] * rr * g[j]; }
    }
}

constexpr int PT = 32, PROWS = 48;
typedef float f32x2v __attribute__((ext_vector_type(2)));
__device__ __forceinline__ f32x2v bfpair(unsigned u) { return (f32x2v){__builtin_bit_cast(float, u << 16), __builtin_bit_cast(float, u & 0xffff0000u)}; }
struct f32x8 { f32x4 lo, hi; };
__device__ __forceinline__ f32x8 bf8(const v4u u) { f32x8 r; r.lo = (f32x4){__builtin_bit_cast(float, u.x << 16), __builtin_bit_cast(float, u.x & 0xffff0000u), __builtin_bit_cast(float, u.y << 16), __builtin_bit_cast(float, u.y & 0xffff0000u)};
    r.hi = (f32x4){__builtin_bit_cast(float, u.z << 16), __builtin_bit_cast(float, u.z & 0xffff0000u), __builtin_bit_cast(float, u.w << 16), __builtin_bit_cast(float, u.w & 0xffff0000u)}; return r; }
__device__ __forceinline__ v4u pack8(const f32x4 a, const f32x4 b) { v4u o; o.x = pk2(a[0], a[1]); o.y = pk2(a[2], a[3]); o.z = pk2(b[0], b[1]); o.w = pk2(b[2], b[3]); return o; }
template <int W> __device__ __forceinline__ void pool_rows_interior(const LAS v4u* hrow, GAS v4u* po) {
    constexpr int HW = W / 2; constexpr float INV = 1.0f / (float)W;
    f32x4 sl = {0.f, 0.f, 0.f, 0.f}, sh = {0.f, 0.f, 0.f, 0.f};
#pragma unroll
    for (int o = -HW; o < HW; ++o) { const f32x8 h = bf8(hrow[(8 + o) * 128]); sl += h.lo; sh += h.hi; }
    __builtin_amdgcn_sched_barrier(0);
#pragma unroll
    for (int i = 0; i < 8; ++i) {
        const f32x8 c = bf8(hrow[(8 + i) * 128]);
        po[(size_t)i * 32] = pack8(sl * INV - c.lo, sh * INV - c.hi);
        if (i + 1 < 8) { const f32x8 a = bf8(hrow[(8 + i + HW) * 128]), b = bf8(hrow[(8 + i - HW) * 128]); sl += a.lo - b.lo; sh += a.hi - b.hi; }
        __builtin_amdgcn_sched_barrier(0);
    }
}
__device__ __forceinline__ void pool_load_rows(f32x4 (&v)[6][4], const float* x, int m0, int seq_len, int wave, int lane) {
    const int sb = m0 / seq_len * seq_len, t0 = m0 - sb;
#pragma unroll
    for (int k = 0; k < 6; ++k) { const int t = min(max(t0 - 8 + wave + NWAVES * k, 0), seq_len - 1);
        const GAS f32x4* xr = (const GAS f32x4*)(x + (size_t)(sb + t) * D) + lane;
#pragma unroll
        for (int j = 0; j < 4; ++j) v[k][j] = xr[64 * j]; }
}
__device__ __forceinline__ void pool_load_rows_b16(v4u (&w)[6][2], float (&sv)[6], const bf16* xn, const float* st, int m0, int seq_len, int wave, int lane) {
    const int sb = m0 / seq_len * seq_len, t0 = m0 - sb;
    int wv = wave; asm volatile("" : "+v"(wv));
#pragma unroll
    for (int k = 0; k < 6; ++k) { const int row = sb + min(max(t0 - 8 + wv + NWAVES * k, 0), seq_len - 1);
#pragma unroll
        for (int j = 0; j < 2; ++j) { const int q = lane + 64 * j;
            w[k][j] = *(const GAS v4u*)((const char*)xn + ((size_t)(((row >> 8) * 2 + ((row >> 7) & 1)) * 16 + (q >> 3)) << 14) + pg8::lds_byte(row & 127, 8 * (q & 7))); }
        sv[k] = st[(size_t)row * 16 + (lane & 15)]; }
}
template <bool B16> __device__ __forceinline__ void pool_phase(LAS unsigned char* lds, const float* x, const bf16* xn16, const float* st16, const float* gain, bf16* Pg, int seq_len, int vcu, int G, int tid, int wave, int lane) {
    f32x4 v[B16 ? 1 : 6][4];
    v4u w16[B16 ? 6 : 1][2]; float sv[6];
    if (vcu < CH / PT) { if constexpr (B16) pool_load_rows_b16(w16, sv, xn16, st16, vcu * PT, seq_len, wave, lane); else pool_load_rows(v, x, vcu * PT, seq_len, wave, lane); }
    for (int tile = vcu; tile < CH / PT; tile += G) {
        const int m0 = tile * PT;
        const int sb = m0 / seq_len * seq_len;
        const int t0 = m0 - sb;
        if constexpr (B16) {
            f32x4 g16[2][2];
#pragma unroll
            for (int j = 0; j < 2; ++j) { g16[j][0] = *(const GAS f32x4*)(gain + 8 * (lane + 64 * j)); g16[j][1] = *(const GAS f32x4*)(gain + 8 * (lane + 64 * j) + 4); }
#pragma unroll
            for (int k = 0; k < 6; ++k) { float ss = sv[k]; ss += __shfl_xor(ss, 1); ss += __shfl_xor(ss, 2); ss += __shfl_xor(ss, 4); ss += __shfl_xor(ss, 8);
                const float r = 1.0f / sqrtf(ss * (1.f / D) + RMS_EPS);
                LAS v4u* hr = (LAS v4u*)(lds + (wave + NWAVES * k) * 2048) + lane;
#pragma unroll
                for (int j = 0; j < 2; ++j) { const f32x8 h = bf8(w16[k][j]); hr[64 * j] = pack8(h.lo * r * g16[j][0], h.hi * r * g16[j][1]); } }
        } else {
        f32x4 g[4];
#pragma unroll
        for (int j = 0; j < 4; ++j) g[j] = *((const GAS f32x4*)gain + lane + 64 * j);
#pragma unroll
        for (int k = 0; k < 6; ++k) { float s = 0.f;
#pragma unroll
            for (int j = 0; j < 4; ++j) s += (v[k][j].x * v[k][j].x + v[k][j].y * v[k][j].y) + (v[k][j].z * v[k][j].z + v[k][j].w * v[k][j].w);
            const float r = 1.0f / sqrtf(wave_sum(s) * (1.f / D) + RMS_EPS);
            LAS v2u* hr = (LAS v2u*)(lds + (wave + NWAVES * k) * 2048) + lane;
#pragma unroll
            for (int j = 0; j < 4; ++j) { v2u o; o.x = pk2(v[k][j].x * r * g[j].x, v[k][j].y * r * g[j].y); o.y = pk2(v[k][j].z * r * g[j].z, v[k][j].w * r * g[j].w); hr[64 * j] = o; } }
        }
        __syncthreads();
        if (tile + G < CH / PT) { if constexpr (B16) pool_load_rows_b16(w16, sv, xn16, st16, (tile + G) * PT, seq_len, wave, lane); else pool_load_rows(v, x, (tile + G) * PT, seq_len, wave, lane); __builtin_amdgcn_sched_barrier(0); }
        {
            const int pg = wave & 3, part = (lane >> 5) + 2 * (wave >> 2), oc = lane & 31, pw = 2 << pg, phw = pw >> 1;
            const LAS v4u* hrow = (const LAS v4u*)(lds + (8 * part) * 2048 + pg * 512 + oc * 16);
            GAS v4u* po = (GAS v4u*)(Pg + ((size_t)pg * CH + m0 + 8 * part) * 256 + oc * 8);
            if (t0 >= 8 && t0 + PT + 8 <= seq_len) {
                switch (pg) { case 0: pool_rows_interior<2>(hrow, po); break; case 1: pool_rows_interior<4>(hrow, po); break; case 2: pool_rows_interior<8>(hrow, po); break; default: pool_rows_interior<16>(hrow, po); break; }
            } else {
                for (int i = 0; i < 8; ++i) {
                    const int t = t0 + 8 * part + i;
                    const int lo = max(t - phw, 0), hi = min(t + phw - 1, seq_len - 1);
                    f32x4 sl = {0.f, 0.f, 0.f, 0.f}, sh = {0.f, 0.f, 0.f, 0.f};
                    for (int q = lo; q <= hi; ++q) { const f32x8 h = bf8(hrow[(8 + q - t + i) * 128]); sl += h.lo; sh += h.hi; }
                    const f32x8 c = bf8(hrow[(8 + i) * 128]);
                    const float inv = 1.0f / (float)(hi - lo + 1);
                    po[(size_t)i * 32] = pack8(sl * inv - c.lo, sh * inv - c.hi);
                }
            }
        }
        __syncthreads();
    }
}

#define RLX_AGENT __ATOMIC_RELAXED, __HIP_MEMORY_SCOPE_AGENT
#define XB_TMO      128
#define XB_XCNT(j)  (256  + 64 * (j))
#define XB_XSUB(j)  (1280 + 64 * (j))
#define XB_XGEN(j)  (2304 + 64 * (j))
#define XB_TOP      3328
#define XB_TOPGEN   3392
#define XCD_BAR_WORDS 3456
#define XB_SPIN_CAP (1u << 18)

__device__ __forceinline__ unsigned xb_ld(unsigned* p)              { return __hip_atomic_load(p, __ATOMIC_RELAXED, __HIP_MEMORY_SCOPE_AGENT); }
__device__ __forceinline__ unsigned xb_add(unsigned* p, unsigned v) { return __hip_atomic_fetch_add(p, v, __ATOMIC_RELAXED, __HIP_MEMORY_SCOPE_AGENT); }
__device__ __forceinline__ unsigned xb_xcc_id() { return (unsigned)__builtin_amdgcn_s_getreg((3 << 11) | 20) & 0xFu; }
#define XB_SPIN(cond, bar) do { unsigned _sp = 0; while (cond) { __builtin_amdgcn_s_sleep(1); \
    if ((++_sp & 255u) == 0u) { if (xb_ld(&(bar)[XB_TMO])) break; if (_sp > XB_SPIN_CAP) { atomicAdd(&(bar)[XB_TMO], 1u); break; } } } } while (0)

struct XcdBarrier {
    unsigned* bar; unsigned x;
    volatile LAS unsigned* st;
};

__device__ __forceinline__ XcdBarrier xcd_barrier_post(unsigned* bar, volatile LAS unsigned* st) {
    XcdBarrier b; b.bar = bar; b.x = xb_xcc_id(); b.st = st;
    if (threadIdx.x == 0) (void)xb_add(&bar[XB_XCNT(b.x)], 1u);
    return b;
}
__device__ __forceinline__ void xcd_barrier_complete(unsigned* bar, unsigned x, unsigned& nloc, unsigned& nx) {
    const unsigned G = gridDim.x * gridDim.y * gridDim.z;
    unsigned sum, cnt, mine, sp = 0u;
    for (;;) {
        sum = 0u; cnt = 0u; mine = 0u;
#pragma unroll
        for (unsigned j = 0; j < 16; ++j) { const unsigned c = xb_ld(&bar[XB_XCNT(j)]); sum += c; cnt += (c > 0u) ? 1u : 0u; mine = (j == x) ? c : mine; }
        if (sum == G) break;
        __builtin_amdgcn_s_sleep(1);
        if ((++sp & 255u) == 0u) { if (xb_ld(&bar[XB_TMO])) break; if (sp > XB_SPIN_CAP) { atomicAdd(&bar[XB_TMO], 1u); break; } }
    }
    nloc = mine > 0u ? mine : 1u; nx = cnt > 0u ? cnt : 1u;
}

__device__ __forceinline__ void xcd_barrier(const XcdBarrier& b) {
    asm volatile("s_waitcnt vmcnt(0)" ::: "memory");
    __syncthreads();
    if (threadIdx.x == 0) {
        unsigned* bar = b.bar;
        __builtin_amdgcn_s_waitcnt(0);
        unsigned nloc = b.st[0], nx = b.st[1];
        if (nloc == 0u) { xcd_barrier_complete(bar, b.x, nloc, nx); b.st[0] = nloc; b.st[1] = nx; }
        const unsigned old = xb_add(&bar[XB_XSUB(b.x)], 1u);
        const unsigned gen = old / nloc;
        if (old + 1u == (gen + 1u) * nloc) {
            __builtin_amdgcn_fence(__ATOMIC_RELEASE, "agent");
            asm volatile("s_waitcnt vmcnt(0)" ::: "memory");
            const unsigned og = xb_add(&bar[XB_TOP], 1u);
            const unsigned tg = og / nx;
            if (og + 1u == (tg + 1u) * nx) xb_add(&bar[XB_TOPGEN], 1u);
            else XB_SPIN(xb_ld(&bar[XB_TOPGEN]) == tg, bar);
            __builtin_amdgcn_fence(__ATOMIC_ACQUIRE, "agent");
            xb_add(&bar[XB_XGEN(b.x)], 1u);
            asm volatile("s_waitcnt vmcnt(0)" ::: "memory");
        } else {
            XB_SPIN(xb_ld(&bar[XB_XGEN(b.x)]) == gen, bar);
            __builtin_amdgcn_fence(__ATOMIC_ACQUIRE, "agent");
            asm volatile("s_waitcnt vmcnt(0)" ::: "memory");
        }
    }
    __syncthreads();
}


__device__ __forceinline__ unsigned cvtpk(float lo, float hi) { return pk2(lo, hi); }
__device__ __forceinline__ s16x4 vtr(const LAS unsigned char* p) { return __builtin_bit_cast(s16x4, __builtin_amdgcn_ds_read_tr16_b64_v4i16((LAS s16x4*)p)); }
__device__ __forceinline__ void attn_phase(LAS unsigned char* lds, bf16* Qb, const bf16* Kb, const bf16* Vb, const float* rpb_l, int seq_len, int G, int bx, int tid, int wave, int lane) {
    const int fr = lane & 15, fq = lane >> 4;
    const int rows = seq_len >> 6, rows_shift = (seq_len == 2048) ? 5 : 6;
    constexpr int NI = (CH / 64) * 8;
    int nx, xc, lc, per;
    if ((G & 7) == 0) { nx = G >> 3; xc = bx & 7; lc = bx >> 3; per = NI >> 3; } else { nx = G; xc = 0; lc = bx; per = NI; }
    LAS float* bias = (LAS float*)(lds + BIAS_OFF);
    const int qb = wave & 3, hh = wave >> 2;
    const int qc = (qb < 3) ? (8 + 16 * qb + fr) : (fr < 8 ? fr : 48 + fr);
    const int a0 = (qb < 3) ? qb : 0, a1 = (qb < 3) ? qb + 1 : 3;
    const int wst = min(max(qc - 8, 0), 48);
    const int q4 = (lane & 15) >> 2, p4 = lane & 3;
    bool sel[4];
#pragma unroll
    for (int i = 0; i < 4; ++i) sel[i] = (qb < 3) ? (4 * fq + i >= fr) : (fr < 8);
    int voff[4];
#pragma unroll
    for (int i3 = 0; i3 < 4; ++i3) voff[i3] = (lane >> 4) * D + (((lane & 15) ^ (((lane >> 4) << 2) | i3)) * 8);
    if (lc >= per) return;
    int id = xc * per + lc;
    int r = id & (rows - 1), hp = (id >> rows_shift) & 7, tb = (id >> (rows_shift + 3)) * seq_len, r0 = min(max(r - 4, 0), rows - 8);
    bf16x8 qf0, qf1, kf[4][2][2];
    float bnext[2];
#define ATT_PREFETCH() do { \
        const int h_ = 2 * hp + hh; const size_t qo_ = (size_t)(tb + r * 64 + qc) * D + h_ * 64; \
        qf0 = *(const GAS bf16x8*)(Qb + qo_ + 8 * fq); qf1 = *(const GAS bf16x8*)(Qb + qo_ + 32 + 8 * fq); \
        const bf16* kb_ = Kb + ((size_t)(h_ * 8 + fq) * CH + (tb + r0 * 64 + fr)) * 8; \
        _Pragma("unroll") for (int kr = 0; kr < 4; ++kr) _Pragma("unroll") for (int ai = 0; ai < 2; ++ai) { const bf16* kp = kb_ + (kr * 64 + 16 * (ai ? a1 : a0)) * 8; kf[kr][ai][0] = *(const GAS bf16x8*)kp; kf[kr][ai][1] = *(const GAS bf16x8*)(kp + (size_t)4 * CH * 8); } \
        bnext[0] = rpb_l[hp * 930 + tid] * LOG2E; bnext[1] = (tid + 512 < 930) ? rpb_l[hp * 930 + tid + 512] * LOG2E : 0.f; } while (0)
#define ATT_BIAS_WRITE() do { bias[tid] = bnext[0]; if (tid + 512 < 930) bias[tid + 512] = bnext[1]; } while (0)
    ATT_PREFETCH();
    ATT_BIAS_WRITE();
    for (int loc = lc; loc < per; loc += nx) {
        const int h = 2 * hp + hh;
        const size_t qoff = (size_t)(tb + r * 64 + qc) * D + h * 64;
        const bf16* kbase = Kb + ((size_t)(h * 8 + fq) * CH + (tb + r0 * 64 + fr)) * 8;
        const int drb = r0 - r + 7;
        __syncthreads();
        {
            const int a = wave >> 1, ub = (wave & 1) * 2;
#pragma unroll
            for (int i = 0; i < 16; ++i) { const int kr = 2 * (ub + (i >> 3)) + (i & 1), cb = 16 * a + 4 * ((i & 7) >> 1);
                const bf16* src = Vb + (size_t)(tb + (r0 + kr) * 64 + cb) * D + hp * 128 + voff[i & 3];
                __builtin_amdgcn_global_load_lds((const unsigned*)src, (LAS unsigned*)(lds + (wave * 16 + i) * 1024), 16, 0, 0); }
        }
        f32x4 S[8];
        float mx = -3.0e38f;
        const LAS float* bptr[4];
#pragma unroll
        for (int i = 0; i < 4; ++i) { const int kc = 16 * (sel[i] ? a0 : a1) + 4 * fq + i; bptr[i] = bias + hh * 465 + drb * 31 + min(max(kc - qc + 15, 0), 30); }
#pragma unroll
        for (int kr = 0; kr < 8; ++kr) {
            f32x4 z0 = {0.f, 0.f, 0.f, 0.f}, z1 = {0.f, 0.f, 0.f, 0.f};
            z0 = __builtin_amdgcn_mfma_f32_16x16x32_bf16(kf[kr & 3][0][0], qf0, z0, 0, 0, 0);
            z0 = __builtin_amdgcn_mfma_f32_16x16x32_bf16(kf[kr & 3][0][1], qf1, z0, 0, 0, 0);
            z1 = __builtin_amdgcn_mfma_f32_16x16x32_bf16(kf[kr & 3][1][0], qf0, z1, 0, 0, 0);
            z1 = __builtin_amdgcn_mfma_f32_16x16x32_bf16(kf[kr & 3][1][1], qf1, z1, 0, 0, 0);
            f32x4 z;
#pragma unroll
            for (int i = 0; i < 4; ++i) { z[i] = (sel[i] ? z0[i] : z1[i]) + bptr[i][kr * 31]; mx = fmaxf(mx, z[i]); }
            S[kr] = z;
            if (kr < 4) {
#pragma unroll
                for (int ai = 0; ai < 2; ++ai) { const bf16* kp = kbase + ((kr + 4) * 64 + 16 * (ai ? a1 : a0)) * 8; kf[kr & 3][ai][0] = *(const GAS bf16x8*)kp; kf[kr & 3][ai][1] = *(const GAS bf16x8*)(kp + (size_t)4 * CH * 8); }
            }
        }
        mx = fmaxf(mx, __shfl_xor(mx, 16)); mx = fmaxf(mx, __shfl_xor(mx, 32));
        float sum = 0.f;
#pragma unroll
        for (int kr = 0; kr < 8; ++kr)
#pragma unroll
            for (int i = 0; i < 4; ++i) { const float p = __builtin_amdgcn_exp2f(S[kr][i] - mx); S[kr][i] = p; sum += p; }
        sum += __shfl_xor(sum, 16); sum += __shfl_xor(sum, 32);
        bf16x8 pf[4][2];
#pragma unroll
        for (int u = 0; u < 4; ++u)
#pragma unroll
            for (int ai = 0; ai < 2; ++ai) {
                float pa[2][4];
#pragma unroll
                for (int t = 0; t < 2; ++t)
#pragma unroll
                    for (int i = 0; i < 4; ++i) pa[t][i] = (sel[i] == (ai == 0)) ? S[2 * u + t][i] : 0.f;
                v4u pw; pw.x = cvtpk(pa[0][0], pa[0][1]); pw.y = cvtpk(pa[0][2], pa[0][3]); pw.z = cvtpk(pa[1][0], pa[1][1]); pw.w = cvtpk(pa[1][2], pa[1][3]);
                pf[u][ai] = __builtin_bit_cast(bf16x8, pw); }
        asm volatile("s_waitcnt vmcnt(0)" ::: "memory");
        __syncthreads();
        const int nloc = loc + nx; const bool has_next = nloc < per;
        const int r_cur = r, tb_cur = tb;
        if (has_next) { id = xc * per + nloc; r = id & (rows - 1); hp = (id >> rows_shift) & 7; tb = (id >> (rows_shift + 3)) * seq_len; r0 = min(max(r - 4, 0), rows - 8); ATT_PREFETCH(); }
        (void)r_cur; (void)tb_cur;
        f32x4 O[4];
#pragma unroll
        for (int c = 0; c < 4; ++c) O[c] = (f32x4){0.f, 0.f, 0.f, 0.f};
        const LAS unsigned char* vb[2][2][4];
#pragma unroll
        for (int ai = 0; ai < 2; ++ai)
#pragma unroll
            for (int t = 0; t < 2; ++t)
#pragma unroll
                for (int c = 0; c < 4; ++c) { const int rho = 8 * fq + 4 * t + q4, chn = 2 * (4 * hh + c) + (p4 >> 1);
                    vb[ai][t][c] = lds + (ai ? a1 : a0) * 32768 + 256 * rho + 16 * (chn ^ (((rho & 3) << 2) | ((rho >> 2) & 3))) + 8 * (p4 & 1); }
#pragma unroll
        for (int u = 0; u < 4; ++u) {
#pragma unroll
            for (int ai = 0; ai < 2; ++ai) {
#pragma unroll
                for (int c = 0; c < 4; ++c) {
                    const s16x4 v0 = vtr(vb[ai][0][c] + u * 8192), v1 = vtr(vb[ai][1][c] + u * 8192);
                    const bf16x8 vf = __builtin_shufflevector(v0, v1, 0, 1, 2, 3, 4, 5, 6, 7);
                    O[c] = __builtin_amdgcn_mfma_f32_16x16x32_bf16(vf, pf[u][ai], O[c], 0, 0, 0);
                }
            }
        }
        const float inv = 1.0f / sum;
#pragma unroll
        for (int c = 0; c < 4; ++c) { v2u w; w.x = cvtpk(O[c][0] * inv, O[c][1] * inv); w.y = cvtpk(O[c][2] * inv, O[c][3] * inv);
            *(GAS v2u*)(Qb + qoff + 16 * c + 4 * fq) = w; }
        if (has_next) ATT_BIAS_WRITE();
    }
    __syncthreads();
#undef ATT_PREFETCH
#undef ATT_BIAS_WRITE
}
enum { K_POOL = 1, K_GEMM_RES = 3, K_GEMM_QKV = 4, K_GEMM_UP = 5, K_ATTN = 6, K_FINAL = 7 };
enum { F_A_X = 1, F_A_IN = 2, F_AUX_X = 4, F_AUX_IN = 8, F_NOX = 16, F_B16 = 32 };
struct Ph { int kind, flags, N, K; const void* A; const void* B; void* C; const void* aux; float* st; float* rs; unsigned long long a_pn_stride, pad; };
constexpr int PPC = 19;
struct Args { Ptrs p; Ph tab[PPC]; };
__global__ void __launch_bounds__(NWAVES * 64, 2) fwd_megakernel(Args args) {
    extern __shared__ __attribute__((aligned(16))) unsigned char lds_raw[];
    cg::grid_group grid = cg::this_grid();
    LAS unsigned char* lds = (LAS unsigned char*)lds_raw;
    volatile LAS unsigned* MISC = (volatile LAS unsigned*)(lds + MISC_OFF);
    for (int u = threadIdx.x; u < 32; u += NWAVES * 64) MISC[u] = 0u;
    __syncthreads();
    const XcdBarrier bar = xcd_barrier_post((unsigned*)(args.p.ws + WS_CTL), MISC + 8);
    {
        const int tid = threadIdx.x, lane = tid & 63, wave = __builtin_amdgcn_readfirstlane(tid >> 6);
        const int G = gridDim.x, bx = blockIdx.x;
        const int vcu = (G % 8 == 0) ? (bx % 8) * (G / 8) + bx / 8 : bx;
        prologue(args.p, lds, vcu * NWAVES + wave, G * NWAVES, wave, lane);
    }
    grid.sync();

    for (int ph = 0; ph < NCHUNK * PPC; ++ph) {
        int tid = threadIdx.x; asm volatile("" : "+v"(tid));
        int G = gridDim.x, bx = blockIdx.x; asm volatile("" : "+s"(G), "+s"(bx));
        const int lane = tid & 63, wave = __builtin_amdgcn_readfirstlane(tid >> 6);
        const int vcu = (G % 8 == 0) ? (bx % 8) * (G / 8) + bx / 8 : bx;
        const int gw = vcu * NWAVES + wave, NGW = G * NWAVES;
        const int ck = ph / PPC, idx = ph - ck * PPC;
        const Ph& d = args.tab[idx];
        const int tok0 = ck * CH, grp = tok0 / GROUP_TOK, seq_len = grp ? 4096 : 2048;
        const float* xin = args.p.x_in[grp] + (size_t)(tok0 - grp * GROUP_TOK) * D;
        float* X = args.p.out + (size_t)tok0 * D;
        const void* A = (d.flags & F_A_IN) ? (const void*)xin : d.A;
        const void* aux = (d.flags & F_AUX_IN) ? (const void*)xin : d.aux;
#define KIND_IS(x) ([&]() { int kd_ = d.kind; asm volatile("" : "+s"(kd_)); return kd_ == (x); }())
        if (0) {}
        else if (KIND_IS(K_POOL)) { { int tid2 = threadIdx.x; asm volatile("" : "+v"(tid2));
            if (d.flags & F_B16) pool_phase<true>(lds, nullptr, (const bf16*)d.A, d.st, (const float*)aux, (bf16*)d.C, seq_len, vcu, G, tid2, __builtin_amdgcn_readfirstlane(tid2 >> 6), tid2 & 63);
            else pool_phase<false>(lds, (const float*)A, nullptr, nullptr, (const float*)aux, (bf16*)d.C, seq_len, vcu, G, tid2, __builtin_amdgcn_readfirstlane(tid2 >> 6), tid2 & 63); } }
        else if (KIND_IS(K_GEMM_RES)) { pg8::Gemm g{(const bf16*)A, (const bf16*)d.B, CH, d.N, d.K, (size_t)d.a_pn_stride, d.K == FF  }; pg8::StaticOrder S; S.init(CH, d.N, G, bx);
            pg8::EpiRes E{(const float*)aux, (d.flags & F_NOX) ? nullptr : X, (bf16*)d.C, d.st, D, d.rs, (d.flags & F_B16) ? (const bf16*)args.p.ws + WS_XN / 2 : nullptr};
            pg8::gemm_phase<pg8::EpiRes, pg8::StaticOrder, false, PG8_SP2>(lds, g, S, E, tid); }
        else if (KIND_IS(K_GEMM_QKV)) { pg8::Gemm g{(const bf16*)A, (const bf16*)d.B, CH, d.N, d.K, 0, 1  }; pg8::StaticOrder S; S.init(CH, d.N, G, bx);
            pg8::EpiBf16<0, true> E{(bf16*)d.C, D, D, (size_t)CH * D, 0.125f * LOG2E, d.st, 0};
            pg8::gemm_phase<pg8::EpiBf16<0, true>, pg8::StaticOrder, PG8_ALIGN, PG8_SP2>(lds, g, S, E, tid); }
        else if (KIND_IS(K_GEMM_UP)) { pg8::Gemm g{(const bf16*)A, (const bf16*)d.B, CH, d.N, d.K, 0, 1  }; pg8::StaticOrder S; S.init(CH, d.N, G, bx);
            pg8::EpiBf16<2, false> E{(bf16*)d.C, FF, 0, 0, 1.f, nullptr, 1};
            pg8::gemm_phase<pg8::EpiBf16<2, false>, pg8::StaticOrder, PG8_ALIGN, PG8_SP2>(lds, g, S, E, tid); }
        else if (KIND_IS(K_ATTN)) { attn_phase(lds, (bf16*)d.C, (const bf16*)d.C + (size_t)CH * D, (const bf16*)d.C + 2 * (size_t)CH * D, (const float*)aux, seq_len, G, bx, tid, wave, lane); }
        else { norm_rows_f32_inplace(X, (const float*)aux, CH, gw, NGW, lane); }
#undef KIND_IS
        if (d.kind != K_FINAL) xcd_barrier(bar);
    }
}

extern "C" void kernel_launch(void* const* d_in, const int* in_sizes, int n_in, void* d_out, int out_size, void* d_ws, size_t ws_size, hipStream_t stream) {
    static int grid = 0;
    if (grid == 0) {
        if (n_in != 12 || in_sizes[0] != GROUP_TOK * D || in_sizes[1] != GROUP_TOK * D || out_size != NTOK * D || ws_size < WS_END) {
            fprintf(stderr, "kernel_launch: unexpected shapes (n_in %d, out %d, ws %zu < %zu); nothing launched\n", n_in, out_size, ws_size, (size_t)WS_END); grid = -1; return; }
        int dev = 0, cus = 0, per_cu = 0;
        if (hipGetDevice(&dev) != hipSuccess || hipDeviceGetAttribute(&cus, hipDeviceAttributeMultiprocessorCount, dev) != hipSuccess) { fprintf(stderr, "kernel_launch: device query failed\n"); grid = -1; return; }
        if (hipFuncSetAttribute((const void*)fwd_megakernel, hipFuncAttributeMaxDynamicSharedMemorySize, LDS_BYTES) != hipSuccess) { fprintf(stderr, "kernel_launch: hipFuncSetAttribute failed\n"); grid = -1; return; }
        if (hipOccupancyMaxActiveBlocksPerMultiprocessor(&per_cu, (const void*)fwd_megakernel, NWAVES * 64, LDS_BYTES) != hipSuccess || per_cu < 1) { fprintf(stderr, "kernel_launch: occupancy query gave %d\n", per_cu); per_cu = 1; }
        (void)hipGetLastError();
        grid = cus * per_cu;
    }
    if (grid < 0) return;
    if (hipMemsetAsync((char*)d_ws + WS_CTL, 0, CTL_ZERO_BYTES, stream) != hipSuccess) { fprintf(stderr, "kernel_launch: hipMemsetAsync failed\n"); return; }
    Args a{};
    Ptrs& p = a.p;
    p.x_in[0] = (const float*)d_in[0]; p.x_in[1] = (const float*)d_in[1]; p.norm_mix = (const float*)d_in[2]; p.pool_w = (const float*)d_in[3]; p.pool_scale = (const float*)d_in[4];
    p.w_qkv = (const float*)d_in[5]; p.rpb = (const float*)d_in[6]; p.w_o = (const float*)d_in[7]; p.norm_mlp = (const float*)d_in[8]; p.w_up = (const float*)d_in[9];
    p.w_down = (const float*)d_in[10]; p.norm_final = (const float*)d_in[11]; p.out = (float*)d_out; p.ws = (unsigned char*)d_ws;
    unsigned char* ws = (unsigned char*)d_ws;
    bf16* WPOOL = (bf16*)(ws + WS_WPOOL); bf16* WQKV = (bf16*)(ws + WS_WQKV); bf16* WO = (bf16*)(ws + WS_WO); bf16* WUP = (bf16*)(ws + WS_WUP); bf16* WDN = (bf16*)(ws + WS_WDN);
    bf16* XN = (bf16*)(ws + WS_XN); bf16* PG = (bf16*)(ws + WS_PG); bf16* QB = (bf16*)(ws + WS_ACT); bf16* HB = (bf16*)(ws + WS_ACT);
    float* SA = (float*)(ws + WS_STAT); float* SB = SA + (size_t)CH * 16;
    int n = 0;
    auto add = [&](int kind, int flags, int N, int K, const void* A, const void* B, void* C, const void* aux, float* st, float* rs, unsigned long long aps) {
        Ph& d = a.tab[n++]; d.kind = kind; d.flags = flags; d.N = N; d.K = K; d.A = A; d.B = B; d.C = C; d.aux = aux; d.st = st; d.rs = rs; d.a_pn_stride = aps; d.pad = 0; };
    for (int layer = 0; layer < DEPTH; ++layer) {
        const int j = layer >> 1;
        if ((layer & 1) == 0) {
            add(K_POOL, layer == 0 ? F_A_IN : F_B16, 0, 0, layer == 0 ? nullptr : (const void*)XN, nullptr, PG, p.norm_mix + layer * D, layer == 0 ? nullptr : SB, nullptr, 0);
            add(K_GEMM_RES, (layer == 0 ? F_AUX_IN : F_B16) | F_NOX, D, 256, PG, WPOOL + (size_t)j * 1024 * 256, XN, nullptr, SA, nullptr, (unsigned long long)CH * 256 * 2);
        } else {
            add(K_GEMM_QKV, 0, 3 * D, D, XN, WQKV + (size_t)j * 3 * D * D, QB, nullptr, SB, nullptr, 0);
            add(K_ATTN, 0, 0, 0, nullptr, nullptr, QB, p.rpb + (size_t)j * NH * 15 * 31, nullptr, nullptr, 0);
            add(K_GEMM_RES, F_B16 | F_NOX, D, D, QB, WO + (size_t)j * D * D, XN, nullptr, SA, nullptr, 0);
        }
        add(K_GEMM_UP, 0, FF, D, XN, WUP + (size_t)layer * D * FF, HB, nullptr, SA, nullptr, 0);
        add(K_GEMM_RES, F_B16 | (layer != DEPTH - 1 ? F_NOX : 0), D, FF, HB, WDN + (size_t)layer * D * FF, layer != DEPTH - 1 ? XN : nullptr, nullptr, SB, SA, 0);
    }
    add(K_FINAL, 0, 0, 0, nullptr, nullptr, nullptr, p.norm_final, nullptr, nullptr, 0);
    if (n != PPC) { fprintf(stderr, "kernel_launch: phase table has %d entries, expected %d\n", n, PPC); return; }
    void* kargs[] = {&a};
    hipError_t e = hipLaunchCooperativeKernel((const void*)fwd_megakernel, dim3(grid), dim3(NWAVES * 64), kargs, LDS_BYTES, stream);
    if (e != hipSuccess) fprintf(stderr, "kernel_launch: cooperative launch failed: %s (grid %d)\n", hipGetErrorString(e), grid);
}
```

```cpp
#include <hip/hip_runtime.h>
#include <hip/hip_cooperative_groups.h>
#include <cstdio>
#include <cstdint>
namespace cg = cooperative_groups;
namespace pg8 {
#define PG8_LAS __attribute__((address_space(3)))
typedef unsigned short bf16_t;
typedef short bf16x8 __attribute__((ext_vector_type(8)));
typedef float f32x4 __attribute__((ext_vector_type(4)));
typedef unsigned u32x4 __attribute__((ext_vector_type(4)));
constexpr int BM = 256, BK = 64, HALF = 128, HTB = HALF * BK * 2  , STAGE_BYTES = 8 * HTB, NXCD = 8, WGM = 8;

__host__ __device__ __forceinline__ int lds_byte(int r, int c) { const int st = (r >> 4) * 2 + (c >> 5), rr = r & 15, cc = c & 31, ob = rr * 64 + cc * 2; return st * 1024 + (ob ^ (((ob >> 9) & 1) << 5)); }
__host__ __device__ __forceinline__ void stage_rc(int b, int& R, int& C) { const int st = b / 1024, sb = b % 1024, swz = sb ^ (((sb >> 9) & 1) << 5); R = (st >> 1) * 16 + swz / 64; C = (st & 1) * 32 + (swz % 64) / 2; }
__host__ __device__ __forceinline__ int perm32(int rho) { const int n = rho >> 4, i = rho & 15; return 8 * (i >> 2) + 4 * n + (i & 3); }

struct Unit { int pm, pn; };
struct Gemm { const bf16_t* A; const bf16_t* Bt; int M, N, K; size_t a_pn_stride; int a_tiled; };

struct StaticOrder {
    int nM, nN, nwg, G, c, rev;
    __host__ __device__ void init(int M, int N, int G_, int c_, int rev_ = 0) { nM = M / BM; nN = N / BM; nwg = nM * nN; G = G_; c = c_; rev = rev_; }
    __host__ __device__ bool next(int i, Unit& u) const {
        long L = (long)i * G + c; if (L >= nwg) return false;
        if (rev) L = nwg - 1 - L;
        int wgid = (int)L; { const int q = nwg / NXCD, r = nwg % NXCD, xcd = wgid % NXCD, off = wgid / NXCD; wgid = (xcd < r ? xcd * (q + 1) : r * (q + 1) + (xcd - r) * q) + off; }
        const int nig = WGM * nN, gid = wgid / nig, fm = gid * WGM, gsz = (nM - fm) < WGM ? (nM - fm) : WGM;
        u.pm = fm + ((wgid % nig) % gsz); u.pn = (wgid % nig) / gsz; return true;
    }
    __device__ __forceinline__ void a_ready(const Unit&) const {}
    __device__ __forceinline__ void done(const Unit&) const {}
};

__device__ __forceinline__ unsigned cvt_pk_bf16(float lo, float hi) { unsigned r; asm volatile("v_cvt_pk_bf16_f32 %0, %1, %2" : "=v"(r) : "v"(lo), "v"(hi)); return r; }
typedef float f32x2 __attribute__((ext_vector_type(2)));
template <int ACT, bool RS> struct EpiBf16 {
    static constexpr bool PERM = true, AFTER_DRAIN = false;
    bf16_t* O; int ldc; int split_cols; size_t split_stride; float scale0; const float* st; int tiled;
    __device__ __forceinline__ void operator()(const f32x4 (&acc)[2][2][4][2], const Unit& u, int wr, int wc, int fr, int fq) const {
        const int row0 = u.pm * BM + wr * 64 + fr; int colt = u.pn * BM; bf16_t* base = O;
        float sc = 1.f; bool kplane = false;
        if (split_cols) { const int t = colt / split_cols; base += (size_t)t * split_stride; colt -= t * split_cols; if (t == 0) sc = scale0; kplane = (t == 1); }
        const size_t kprows = split_stride / 1024;
        const int col0 = colt + wc * 32 + 8 * fq;
        f32x4 pv[2][4];
        if (RS) {
#pragma unroll
            for (int ai = 0; ai < 2; ++ai)
#pragma unroll
                for (int m = 0; m < 4; ++m) pv[ai][m] = *(const f32x4*)(st + (size_t)(row0 + ai * HALF + m * 16) * 16 + 4 * fq);
            __builtin_amdgcn_sched_barrier(0);
        }
#pragma unroll
        for (int ai = 0; ai < 2; ++ai)
#pragma unroll
            for (int m = 0; m < 4; ++m) { const int row = row0 + ai * HALF + m * 16; bf16_t* rowp = base + (size_t)row * ldc + col0;
                float f = sc;
                if (RS) { float ss = (pv[ai][m][0] + pv[ai][m][1]) + (pv[ai][m][2] + pv[ai][m][3]); ss += __shfl_xor(ss, 16); ss += __shfl_xor(ss, 32);
                    const float r = __builtin_amdgcn_rsqf(ss * (1.0f / 1024.0f) + 1e-6f); f *= (ACT == 2) ? r * r : r; }
#pragma unroll
                for (int bj = 0; bj < 2; ++bj) { f32x4 v0 = acc[ai][bj][m][0], v1 = acc[ai][bj][m][1];
                    if (ACT == 2) {
#pragma unroll
                        for (int e = 0; e < 4; ++e) { const float a = fmaxf(v0[e], 0.f), b = fmaxf(v1[e], 0.f); v0[e] = a * a; v1[e] = b * b; } }
                    v0 = v0 * f; v1 = v1 * f; u32x4 w; w.x = cvt_pk_bf16(v0[0], v0[1]); w.y = cvt_pk_bf16(v0[2], v0[3]); w.z = cvt_pk_bf16(v1[0], v1[1]); w.w = cvt_pk_bf16(v1[2], v1[3]);
                    if (kplane) *(u32x4*)(base + ((size_t)(((colt >> 6) + 2 * bj + (wc >> 1)) * 8 + (wc & 1) * 4 + fq) * kprows + row) * 8) = w;
                    else if (tiled) { const int r_ = row & 255, c_ = col0 + bj * HALF;
                        *(u32x4*)((char*)base + ((size_t)(((row >> 8) * 2 + (r_ >> 7)) * (ldc >> 6) + (c_ >> 6)) << 14) + lds_byte(r_ & 127, c_ & 63)) = w; }
                    else *(u32x4*)(rowp + bj * HALF) = w; } }
    }
};
struct EpiRes {
    static constexpr bool PERM = true, AFTER_DRAIN = false;
    const float* base; float* out; bf16_t* xn; float* st; int ldc; const float* rs; const bf16_t* b16;
    __device__ __forceinline__ void operator()(const f32x4 (&acc)[2][2][4][2], const Unit& u, int wr, int wc, int fr, int fq) const {
        const int col0 = u.pn * BM + wc * 32 + 8 * fq;
#pragma unroll
        for (int ai = 0; ai < 2; ++ai) {
            f32x4 rp[4];
            if (rs) {
#pragma unroll
                for (int m = 0; m < 4; ++m) rp[m] = *(const f32x4*)(rs + (size_t)(u.pm * BM + ai * HALF + wr * 64 + m * 16 + fr) * 16 + 4 * fq);
            }
            f32x4 bs[4][2][2];
            if (b16) {
#pragma unroll
                for (int m = 0; m < 4; ++m)
#pragma unroll
                    for (int bj = 0; bj < 2; ++bj) { const int c_ = col0 + bj * HALF;
                        const u32x4 w = *(const u32x4*)((const char*)b16 + ((size_t)((u.pm * 2 + ai) * (ldc >> 6) + (c_ >> 6)) << 14) + lds_byte(wr * 64 + m * 16 + fr, c_ & 63));
                        bs[m][bj][0] = (f32x4){__builtin_bit_cast(float, w.x << 16), __builtin_bit_cast(float, w.x & 0xffff0000u), __builtin_bit_cast(float, w.y << 16), __builtin_bit_cast(float, w.y & 0xffff0000u)};
                        bs[m][bj][1] = (f32x4){__builtin_bit_cast(float, w.z << 16), __builtin_bit_cast(float, w.z & 0xffff0000u), __builtin_bit_cast(float, w.w << 16), __builtin_bit_cast(float, w.w & 0xffff0000u)}; }
            } else {
#pragma unroll
                for (int m = 0; m < 4; ++m) { const size_t off = (size_t)(u.pm * BM + ai * HALF + wr * 64 + m * 16 + fr) * ldc + col0;
#pragma unroll
                    for (int bj = 0; bj < 2; ++bj) { bs[m][bj][0] = *(const f32x4*)(base + off + bj * HALF); bs[m][bj][1] = *(const f32x4*)(base + off + bj * HALF + 4); } }
            }
            __builtin_amdgcn_sched_barrier(0);
#pragma unroll
            for (int m = 0; m < 4; ++m) { const int row = u.pm * BM + ai * HALF + wr * 64 + m * 16 + fr; const size_t off = (size_t)row * ldc + col0; float ss = 0.f;
                float f = 1.f;
                if (rs) { float q = (rp[m][0] + rp[m][1]) + (rp[m][2] + rp[m][3]); q += __shfl_xor(q, 16); q += __shfl_xor(q, 32); const float r = __builtin_amdgcn_rsqf(q * (1.0f / 1024.0f) + 1e-6f); f = r * r; }
#pragma unroll
                for (int bj = 0; bj < 2; ++bj) {
                    const f32x4 o0 = bs[m][bj][0] + acc[ai][bj][m][0] * f, o1 = bs[m][bj][1] + acc[ai][bj][m][1] * f;
                    if (out) { *(f32x4*)(out + off + bj * HALF) = o0; *(f32x4*)(out + off + bj * HALF + 4) = o1; }
                    if (xn) { u32x4 w; w.x = cvt_pk_bf16(o0[0], o0[1]); w.y = cvt_pk_bf16(o0[2], o0[3]); w.z = cvt_pk_bf16(o1[0], o1[1]); w.w = cvt_pk_bf16(o1[2], o1[3]);
                        { const int c_ = col0 + bj * HALF;
                          *(u32x4*)((char*)xn + ((size_t)((u.pm * 2 + ai) * (ldc >> 6) + (c_ >> 6)) << 14) + lds_byte(wr * 64 + m * 16 + fr, c_ & 63)) = w; }
                        ss += (o0[0] * o0[0] + o0[1] * o0[1]) + (o0[2] * o0[2] + o0[3] * o0[3]) + (o1[0] * o1[0] + o1[1] * o1[1]) + (o1[2] * o1[2] + o1[3] * o1[3]); } }
                if (xn) { ss += __shfl_xor(ss, 16); ss += __shfl_xor(ss, 32); if (fq == 0) st[(size_t)row * 16 + u.pn * 4 + wc] = ss; } }
        }
    }
};
template <class Epi, class Sched, bool ALIGN_EPI = false, bool SP2 = false>
__device__ __forceinline__ void gemm_phase(PG8_LAS unsigned char* lds, const Gemm g, const Sched& S, const Epi& E, const int tid_in) {
    const int tid = tid_in, wid = __builtin_amdgcn_readfirstlane(tid >> 6), lane = tid & 63, wr = wid >> 2, wc = wid & 3, fr = lane & 15, fq = lane >> 4;
    const int K = g.K, nt = K / BK;
    unsigned voffA[2], voffB[2];
#pragma unroll
    for (int i = 0; i < 2; ++i) { int R, C; stage_rc(tid * 16 + i * 8192, R, C); const int Rb = Epi::PERM ? ((R & ~31) + perm32(R & 31)) : R;
        voffA[i] = g.a_tiled ? (unsigned)(tid * 16 + i * 8192) : (unsigned)(R * K + C) * 2u; voffB[i] = (unsigned)(tid * 16 + i * 8192); (void)Rb; }
    const size_t kstep = (size_t)(BK * 2);
    const size_t hstep = (size_t)HALF * K * 2;
    const size_t tstep = 2 * hstep;
    const size_t kstepB = 16384, hstepB = (size_t)nt * 16384, tstepB = 2 * hstepB;
    const size_t kstepA = g.a_tiled ? (size_t)16384 : kstep, hstepA = g.a_tiled ? (size_t)nt * 16384 : hstep, tstepA = 2 * hstepA;
    const unsigned ldsw = (unsigned)wid * 1024u;
    const int aoff = lds_byte(wr * 64 + fr, fq * 8), boff = lds_byte(wc * 32 + fr, fq * 8);
#define PG8_SA(b, h) (((b) * 2 + (h)) * HTB)
#define PG8_SB(b, h) ((4 + (b) * 2 + (h)) * HTB)
#define PG8_STAGE(bufoff, gbase, voff) do { _Pragma("unroll") for (int _i = 0; _i < 2; ++_i) \
        __builtin_amdgcn_global_load_lds((const unsigned*)((const char*)(gbase) + (voff)[_i]), (PG8_LAS unsigned*)(lds + (bufoff) + ldsw + _i * 8192), 16, 0, 0); } while (0)
#define PG8_LDA(dst, b, h) do { _Pragma("unroll") for (int m = 0; m < 4; ++m) _Pragma("unroll") for (int k = 0; k < 2; ++k) dst[m][k] = *(const PG8_LAS bf16x8*)(lds + PG8_SA(b, h) + aoff + m * 2048 + k * 1024); } while (0)
#define PG8_LDB(dst, b, h) do { _Pragma("unroll") for (int n = 0; n < 2; ++n) _Pragma("unroll") for (int k = 0; k < 2; ++k) dst[n][k] = *(const PG8_LAS bf16x8*)(lds + PG8_SB(b, h) + boff + n * 2048 + k * 1024); } while (0)
#define PG8_MMA(ai, bj, At, Bt) do { __builtin_amdgcn_s_setprio(1); _Pragma("unroll") for (int m = 0; m < 4; ++m) _Pragma("unroll") for (int n = 0; n < 2; ++n) _Pragma("unroll") for (int k = 0; k < 2; ++k) \
        acc[ai][bj][m][n] = __builtin_amdgcn_mfma_f32_16x16x32_bf16(Bt[n][k], At[m][k], acc[ai][bj][m][n], 0, 0, 0); __builtin_amdgcn_s_setprio(0); } while (0)
#define PG8_WAIT_V(n) asm volatile("s_waitcnt vmcnt(" #n ")" ::: "memory")
#define PG8_WAIT_L(n) asm volatile("s_waitcnt lgkmcnt(" #n ")" ::: "memory")
#define PG8_BAR __builtin_amdgcn_s_barrier()
#define PG8_SCHED __builtin_amdgcn_sched_barrier(0)
    Unit cur, nxt; int ui = 0;
    if (!S.next(0, cur)) return;
    f32x4 acc[2][2][4][2];
#pragma unroll
    for (int a = 0; a < 2; ++a)
#pragma unroll
        for (int b = 0; b < 2; ++b)
#pragma unroll
            for (int m = 0; m < 4; ++m)
#pragma unroll
                for (int n = 0; n < 2; ++n) acc[a][b][m][n] = (f32x4){0.f, 0.f, 0.f, 0.f};
    bf16x8 At[4][2], B0[2][2], B1[2][2];
    const char* cA = (const char*)g.A + (size_t)cur.pm * tstepA + (size_t)cur.pn * g.a_pn_stride; const char* cB = (const char*)g.Bt + (size_t)cur.pn * tstepB;
    S.a_ready(cur);
    if constexpr (SP2) {
        PG8_STAGE(PG8_SB(0, 0), cB, voffB); PG8_STAGE(PG8_SB(0, 1), cB + hstepB, voffB); PG8_STAGE(PG8_SA(0, 0), cA, voffA); PG8_STAGE(PG8_SA(0, 1), cA + hstepA, voffA);
        if (wr == 1) PG8_BAR;
        PG8_WAIT_V(2); PG8_BAR;
        PG8_STAGE(PG8_SB(1, 0), cB + kstepB, voffB); PG8_STAGE(PG8_SA(1, 0), cA + kstepA, voffA); PG8_STAGE(PG8_SB(1, 1), cB + hstepB + kstepB, voffB);
        PG8_WAIT_V(6); PG8_BAR;
    } else {
        PG8_STAGE(PG8_SB(0, 0), cB, voffB); PG8_STAGE(PG8_SA(0, 0), cA, voffA); PG8_STAGE(PG8_SB(0, 1), cB + hstepB, voffB); PG8_STAGE(PG8_SA(0, 1), cA + hstepA, voffA);
        if (wr == 1) PG8_BAR;
        PG8_WAIT_V(4); PG8_BAR;
        PG8_STAGE(PG8_SB(1, 0), cB + kstepB, voffB); PG8_STAGE(PG8_SA(1, 0), cA + kstepA, voffA); PG8_STAGE(PG8_SB(1, 1), cB + hstepB + kstepB, voffB);
        PG8_WAIT_V(6); PG8_BAR;
    }
    for (;;) {
        const bool has_next = S.next(ui + 1, nxt);
        const char* nA = has_next ? (const char*)g.A + (size_t)nxt.pm * tstepA + (size_t)nxt.pn * g.a_pn_stride : cA; const char* nB = has_next ? (const char*)g.Bt + (size_t)nxt.pn * tstepB : cB;
        for (int t = 0; t < nt; t += 2) {
            const bool last = (t == nt - 2);
            const char* a1 = cA + (size_t)(t + 1) * kstepA;
            const char* a2 = last ? nA : cA + (size_t)(t + 2) * kstepA; const char* b2 = last ? nB : cB + (size_t)(t + 2) * kstepB;
            const char* a3 = a2 + kstepA; const char* b3 = b2 + kstepB;
            if (last && has_next) S.a_ready(nxt);
            if constexpr (SP2) {
            PG8_LDB(B0, 0, 0); PG8_LDB(B1, 0, 1); PG8_SCHED; PG8_LDA(At, 0, 0); PG8_STAGE(PG8_SA(1, 1), a1 + hstepA, voffA);
            PG8_WAIT_V(8); PG8_WAIT_L(0); PG8_BAR; PG8_MMA(0, 0, At, B0); PG8_MMA(0, 1, At, B1); PG8_BAR; PG8_SCHED;
            PG8_LDA(At, 0, 1); PG8_STAGE(PG8_SB(0, 0), b2, voffB); PG8_STAGE(PG8_SB(0, 1), b2 + hstepB, voffB); PG8_STAGE(PG8_SA(0, 0), a2, voffA);
            PG8_WAIT_V(8); PG8_WAIT_L(0); PG8_BAR; PG8_MMA(1, 0, At, B0); PG8_MMA(1, 1, At, B1); PG8_BAR; PG8_SCHED;
            PG8_LDB(B0, 1, 0); PG8_LDB(B1, 1, 1); PG8_SCHED; PG8_LDA(At, 1, 0); PG8_STAGE(PG8_SA(0, 1), a2 + hstepA, voffA);
            PG8_WAIT_V(8); PG8_WAIT_L(0); PG8_BAR; PG8_MMA(0, 0, At, B0); PG8_MMA(0, 1, At, B1); PG8_BAR; PG8_SCHED;
            PG8_LDA(At, 1, 1); PG8_STAGE(PG8_SB(1, 0), b3, voffB); PG8_STAGE(PG8_SB(1, 1), b3 + hstepB, voffB); PG8_STAGE(PG8_SA(1, 0), a3, voffA);
            PG8_WAIT_V(8); PG8_WAIT_L(0); PG8_BAR; PG8_MMA(1, 0, At, B0); PG8_MMA(1, 1, At, B1); PG8_BAR; PG8_SCHED;
            } else {
            PG8_LDB(B0, 0, 0); PG8_SCHED; PG8_LDA(At, 0, 0); PG8_STAGE(PG8_SA(1, 1), a1 + hstepA, voffA);
            PG8_WAIT_L(8); PG8_BAR; PG8_WAIT_L(0); PG8_MMA(0, 0, At, B0); PG8_BAR; PG8_SCHED;
            PG8_LDB(B1, 0, 1); PG8_STAGE(PG8_SB(0, 0), b2, voffB);
            PG8_BAR; PG8_WAIT_L(0); PG8_MMA(0, 1, At, B1); PG8_BAR;
            PG8_LDA(At, 0, 1); PG8_STAGE(PG8_SA(0, 0), a2, voffA);
            PG8_BAR; PG8_WAIT_L(0); PG8_MMA(1, 0, At, B0); PG8_BAR; PG8_SCHED;
            PG8_STAGE(PG8_SB(0, 1), b2 + hstepB, voffB);
            PG8_WAIT_V(6); PG8_BAR; PG8_MMA(1, 1, At, B1); PG8_BAR;
            PG8_LDB(B0, 1, 0); PG8_SCHED; PG8_LDA(At, 1, 0); PG8_STAGE(PG8_SA(0, 1), a2 + hstepA, voffA);
            PG8_WAIT_L(8); PG8_BAR; PG8_WAIT_L(0); PG8_MMA(0, 0, At, B0); PG8_BAR; PG8_SCHED;
            PG8_LDB(B1, 1, 1); PG8_STAGE(PG8_SB(1, 0), b3, voffB);
            PG8_BAR; PG8_WAIT_L(0); PG8_MMA(0, 1, At, B1); PG8_BAR;
            PG8_LDA(At, 1, 1); PG8_STAGE(PG8_SA(1, 0), a3, voffA);
            PG8_BAR; PG8_WAIT_L(0); PG8_MMA(1, 0, At, B0); PG8_BAR; PG8_SCHED;
            PG8_STAGE(PG8_SB(1, 1), b3 + hstepB, voffB);
            PG8_WAIT_V(6); PG8_BAR; PG8_MMA(1, 1, At, B1); PG8_BAR;
            }
        }
        if constexpr (ALIGN_EPI) { if (wr == 0) PG8_BAR; }
        if constexpr (!Epi::AFTER_DRAIN) { E(acc, cur, wr, wc, fr, fq); S.done(cur); }
        if (!has_next) break;
#pragma unroll
        for (int a = 0; a < 2; ++a)
#pragma unroll
            for (int b = 0; b < 2; ++b)
#pragma unroll
                for (int m = 0; m < 4; ++m)
#pragma unroll
                    for (int n = 0; n < 2; ++n) acc[a][b][m][n] = (f32x4){0.f, 0.f, 0.f, 0.f};
        cur = nxt; cA = nA; cB = nB; ++ui;
        if constexpr (ALIGN_EPI) { if (wr == 1) PG8_BAR; }
    }
    PG8_WAIT_V(0);
    if constexpr (!ALIGN_EPI) { if (wr == 0) PG8_BAR; }
    PG8_BAR;
    if constexpr (Epi::AFTER_DRAIN) { E.fused(acc, cur, wr, wc, fr, fq, lds, wid, lane); S.done(cur); }
#undef PG8_SA
#undef PG8_SB
#undef PG8_STAGE
#undef PG8_LDA
#undef PG8_LDB
#undef PG8_MMA
#undef PG8_WAIT_V
#undef PG8_WAIT_L
#undef PG8_BAR
#undef PG8_SCHED
}
}
#ifndef PG8_SP2
#define PG8_SP2 true
#endif
#ifndef PG8_ALIGN
#define PG8_ALIGN true
#endif

constexpr int NWAVES = 8;
constexpr int D = 1024, FF = 4096, NH = 16, HD = 64, DEPTH = 4;
constexpr int NTOK = 131072;
constexpr int GROUP_TOK = 65536;
#ifndef MK_CH
#define MK_CH 32768
#endif
constexpr int CH = MK_CH;
constexpr int NCHUNK = NTOK / CH;
constexpr float RMS_EPS = 1e-6f;
constexpr float LOG2E = 1.4426950408889634f;
static_assert(GROUP_TOK % CH == 0 && CH % 4096 == 0, "chunking");

constexpr size_t MiB = 1u << 20;
constexpr size_t WS_WPOOL = 2 * MiB;
constexpr size_t WS_WQKV = 4 * MiB;
constexpr size_t WS_WO = 16 * MiB;
constexpr size_t WS_WUP = 20 * MiB;
constexpr size_t WS_WDN = 52 * MiB;
constexpr size_t WS_XN = 96 * MiB;
constexpr size_t WS_PG = WS_XN + (size_t)CH * D * 2;
constexpr size_t WS_ACT = WS_PG + (size_t)CH * D * 2;
constexpr size_t WS_CTL = 0, CTL_ZERO_BYTES = 65536;
constexpr size_t WS_STAT = 86 * MiB;
static_assert(WS_STAT + 2 * (size_t)CH * 64 <= WS_XN, "stat arrays");
constexpr size_t WS_END = WS_ACT + (size_t)CH * FF * 2;
static_assert(WS_XN >= WS_WDN + 32 * MiB && WS_END <= 1024 * MiB, "d_ws map");

constexpr int RING_BYTES = 131072;
constexpr int BIAS_OFF = RING_BYTES;
constexpr int MISC_OFF = RING_BYTES + 4096;
constexpr int LDS_BYTES = 147456;

#define GAS __attribute__((address_space(1)))
#define LAS __attribute__((address_space(3)))
typedef unsigned short bf16;
typedef unsigned v4u __attribute__((ext_vector_type(4)));
typedef unsigned v2u __attribute__((ext_vector_type(2)));
typedef float f32x4 __attribute__((ext_vector_type(4)));
typedef short bf16x8 __attribute__((ext_vector_type(8)));
typedef short s16x4 __attribute__((ext_vector_type(4)));
#define LDS_WAIT() asm volatile("s_waitcnt lgkmcnt(0)" ::: "memory")
typedef float f32x2_t __attribute__((ext_vector_type(2))); typedef __bf16 bf16x2_t __attribute__((ext_vector_type(2)));
__device__ __forceinline__ unsigned pk2(float lo, float hi) { f32x2_t v = {lo, hi}; bf16x2_t b = __builtin_convertvector(v, bf16x2_t); return __builtin_bit_cast(unsigned, b); }
__device__ __forceinline__ float wave_sum(float v) {
#pragma unroll
    for (int o = 1; o < 64; o <<= 1) v += __shfl_xor(v, o);
    return v;
}

__device__ __forceinline__ void transpose_item(const float* W, int K, int N, bf16* WT, int row_off, const float* nscale, const float* kscale, LAS float* scr, int item, int lane) {
    const int nblk = N / 32, kb = item / nblk, nb = item % nblk, k0 = 64 * kb, n0 = 32 * nb;
    float wv[32];
#pragma unroll
    for (int i = 0; i < 32; ++i) wv[i] = W[(size_t)(k0 + 2 * i + (lane >> 5)) * N + n0 + (lane & 31)];
#pragma unroll
    for (int i = 0; i < 32; ++i) scr[(2 * i + (lane >> 5)) * 33 + (lane & 31)] = wv[i];
    LDS_WAIT(); asm volatile("" ::: "memory");
    const int c = lane & 7;
    float ks[8];
#pragma unroll
    for (int e = 0; e < 8; ++e) ks[e] = kscale ? kscale[k0 + 8 * c + e] : 1.f;
#pragma unroll
    for (int j = 0; j < 4; ++j) { const int n = (lane >> 3) + 8 * j; const LAS float* s = scr + (8 * c) * 33 + n;
        const float sc = nscale ? nscale[n0 + n] : 1.f;
        v4u o; o.x = pk2(s[0 * 33] * sc * ks[0], s[1 * 33] * sc * ks[1]); o.y = pk2(s[2 * 33] * sc * ks[2], s[3 * 33] * sc * ks[3]); o.z = pk2(s[4 * 33] * sc * ks[4], s[5 * 33] * sc * ks[5]); o.w = pk2(s[6 * 33] * sc * ks[6], s[7 * 33] * sc * ks[7]);
        { const int ng = row_off + n0 + n, nr = ng & 127, cc = nr & 31, slot = (((cc >> 2) & 1) << 4) | ((cc >> 3) << 2) | (cc & 3), kk = k0 + 8 * c;
          *(GAS v4u*)((GAS char*)WT + ((size_t)(((ng >> 8) * 2 + ((ng >> 7) & 1)) * (K >> 6) + (kk >> 6)) << 14) + pg8::lds_byte((nr & ~31) + slot, kk & 63)) = o; } }
    LDS_WAIT(); asm volatile("" ::: "memory");
}

struct Ptrs {
    const float *x_in[2], *norm_mix, *pool_w, *pool_scale, *w_qkv, *rpb, *w_o, *norm_mlp, *w_up, *w_down, *norm_final;
    float* out; unsigned char* ws;
};

__device__ __forceinline__ void prologue(const Ptrs& P, LAS unsigned char* lds, int gw, int NGW, int wave, int lane) {
    LAS float* scr = (LAS float*)(lds + wave * 16384);
    bf16* WPOOL = (bf16*)(P.ws + WS_WPOOL); bf16* WQKV = (bf16*)(P.ws + WS_WQKV); bf16* WO = (bf16*)(P.ws + WS_WO); bf16* WUP = (bf16*)(P.ws + WS_WUP); bf16* WDN = (bf16*)(P.ws + WS_WDN);
    constexpr int I_POOL = (256 / 64) * (256 / 32), I_QKV = (D / 64) * (3 * D / 32), I_O = (D / 64) * (D / 32), I_UP = (D / 64) * (FF / 32), I_DN = (FF / 64) * (D / 32);
    constexpr int NITEMS = 8 * I_POOL + 2 * I_QKV + 2 * I_O + 4 * I_UP + 4 * I_DN;
    for (int it = gw; it < NITEMS; it += NGW) {
        int r = it;
        if (r < 8 * I_POOL) { const int mtx = r / I_POOL, j = mtx >> 2, g = mtx & 3; transpose_item(P.pool_w + (size_t)mtx * 65536, 256, 256, WPOOL + (size_t)j * 1024 * 256, g * 256, P.pool_scale + j * 1024 + g * 256, nullptr, scr, r % I_POOL, lane); continue; } r -= 8 * I_POOL;
        if (r < 2 * I_QKV) { const int j = r / I_QKV; transpose_item(P.w_qkv + (size_t)j * D * 3 * D, D, 3 * D, WQKV + (size_t)j * 3 * D * D, 0, nullptr, P.norm_mix + (2 * j + 1) * D, scr, r % I_QKV, lane); continue; } r -= 2 * I_QKV;
        if (r < 2 * I_O) { const int j = r / I_O; transpose_item(P.w_o + (size_t)j * D * D, D, D, WO + (size_t)j * D * D, 0, nullptr, nullptr, scr, r % I_O, lane); continue; } r -= 2 * I_O;
        if (r < 4 * I_UP) { const int j = r / I_UP; transpose_item(P.w_up + (size_t)j * D * FF, D, FF, WUP + (size_t)j * D * FF, 0, nullptr, P.norm_mlp + j * D, scr, r % I_UP, lane); continue; } r -= 4 * I_UP;
        { const int j = r / I_DN; transpose_item(P.w_down + (size_t)j * D * FF, FF, D, WDN + (size_t)j * D * FF, 0, nullptr, nullptr, scr, r % I_DN, lane); }
    }
}

__device__ __forceinline__ void norm_rows_f32_inplace(float* x, const float* gain, int nrows, int gw, int NGW, int lane) {
    f32x4 g[4];
#pragma unroll
    for (int j = 0; j < 4; ++j) g[j] = *((const f32x4*)gain + lane + 64 * j);
    for (int m = gw * 4; m < nrows; m += NGW * 4) {
        GAS f32x4* xr = (GAS f32x4*)(x + (size_t)m * D) + lane;
        f32x4 v[4][4];
#pragma unroll
        for (int r = 0; r < 4; ++r)
#pragma unroll
            for (int j = 0; j < 4; ++j) v[r][j] = xr[r * 256 + 64 * j];
        __builtin_amdgcn_sched_barrier(0);
#pragma unroll
        for (int r = 0; r < 4; ++r) { float s = 0.f;
#pragma unroll
            for (int j = 0; j < 4; ++j) s += (v[r][j].x * v[r][j].x + v[r][j].y * v[r][j].y) + (v[r][j].z * v[r][j].z + v[r][j].w * v[r][j].w);
            const float rr = 1.0f / sqrtf(wave_sum(s) * (1.f / D) + RMS_EPS);
#pragma unroll
            for (int j = 0; j < 4; ++j) xr[r * 256 + 64 * j] = v[r][j] * rr * g[j]; }
    }
}

constexpr int PT = 32, PROWS = 48;
typedef float f32x2v __attribute__((ext_vector_type(2)));
__device__ __forceinline__ f32x2v bfpair(unsigned u) { return (f32x2v){__builtin_bit_cast(float, u << 16), __builtin_bit_cast(float, u & 0xffff0000u)}; }
struct f32x8 { f32x4 lo, hi; };
__device__ __forceinline__ f32x8 bf8(const v4u u) { f32x8 r; r.lo = (f32x4){__builtin_bit_cast(float, u.x << 16), __builtin_bit_cast(float, u.x & 0xffff0000u), __builtin_bit_cast(float, u.y << 16), __builtin_bit_cast(float, u.y & 0xffff0000u)};
    r.hi = (f32x4){__builtin_bit_cast(float, u.z << 16), __builtin_bit_cast(float, u.z & 0xffff0000u), __builtin_bit_cast(float, u.w << 16), __builtin_bit_cast(float, u.w & 0xffff0000u)}; return r; }
__device__ __forceinline__ v4u pack8(const f32x4 a, const f32x4 b) { v4u o; o.x = pk2(a[0], a[1]); o.y = pk2(a[2], a[3]); o.z = pk2(b[0], b[1]); o.w = pk2(b[2], b[3]); return o; }
template <int W> __device__ __forceinline__ void pool_rows_interior(const LAS v4u* hrow, GAS v4u* po) {
    constexpr int HW = W / 2; constexpr float INV = 1.0f / (float)W;
    f32x4 sl = {0.f, 0.f, 0.f, 0.f}, sh = {0.f, 0.f, 0.f, 0.f};
#pragma unroll
    for (int o = -HW; o < HW; ++o) { const f32x8 h = bf8(hrow[(8 + o) * 128]); sl += h.lo; sh += h.hi; }
    __builtin_amdgcn_sched_barrier(0);
#pragma unroll
    for (int i = 0; i < 8; ++i) {
        const f32x8 c = bf8(hrow[(8 + i) * 128]);
        po[(size_t)i * 32] = pack8(sl * INV - c.lo, sh * INV - c.hi);
        if (i + 1 < 8) { const f32x8 a = bf8(hrow[(8 + i + HW) * 128]), b = bf8(hrow[(8 + i - HW) * 128]); sl += a.lo - b.lo; sh += a.hi - b.hi; }
        __builtin_amdgcn_sched_barrier(0);
    }
}
__device__ __forceinline__ void pool_load_rows(f32x4 (&v)[6][4], const float* x, int m0, int seq_len, int wave, int lane) {
    const int sb = m0 / seq_len * seq_len, t0 = m0 - sb;
#pragma unroll
    for (int k = 0; k < 6; ++k) { const int t = min(max(t0 - 8 + wave + NWAVES * k, 0), seq_len - 1);
        const GAS f32x4* xr = (const GAS f32x4*)(x + (size_t)(sb + t) * D) + lane;
#pragma unroll
        for (int j = 0; j < 4; ++j) v[k][j] = xr[64 * j]; }
}
__device__ __forceinline__ void pool_load_rows_b16(v4u (&w)[6][2], float (&sv)[6], const bf16* xn, const float* st, int m0, int seq_len, int wave, int lane) {
    const int sb = m0 / seq_len * seq_len, t0 = m0 - sb;
    int wv = wave; asm volatile("" : "+v"(wv));
#pragma unroll
    for (int k = 0; k < 6; ++k) { const int row = sb + min(max(t0 - 8 + wv + NWAVES * k, 0), seq_len - 1);
#pragma unroll
        for (int j = 0; j < 2; ++j) { const int q = lane + 64 * j;
            w[k][j] = *(const GAS v4u*)((const char*)xn + ((size_t)(((row >> 8) * 2 + ((row >> 7) & 1)) * 16 + (q >> 3)) << 14) + pg8::lds_byte(row & 127, 8 * (q & 7))); }
        sv[k] = st[(size_t)row * 16 + (lane & 15)]; }
}
template <bool B16> __device__ __forceinline__ void pool_phase(LAS unsigned char* lds, const float* x, const bf16* xn16, const float* st16, const float* gain, bf16* Pg, int seq_len, int vcu, int G, int tid, int wave, int lane) {
    f32x4 v[B16 ? 1 : 6][4];
    v4u w16[B16 ? 6 : 1][2]; float sv[6];
    if (vcu < CH / PT) { if constexpr (B16) pool_load_rows_b16(w16, sv, xn16, st16, vcu * PT, seq_len, wave, lane); else pool_load_rows(v, x, vcu * PT, seq_len, wave, lane); }
    for (int tile = vcu; tile < CH / PT; tile += G) {
        const int m0 = tile * PT;
        const int sb = m0 / seq_len * seq_len;
        const int t0 = m0 - sb;
        if constexpr (B16) {
            f32x4 g16[2][2];
#pragma unroll
            for (int j = 0; j < 2; ++j) { g16[j][0] = *(const GAS f32x4*)(gain + 8 * (lane + 64 * j)); g16[j][1] = *(const GAS f32x4*)(gain + 8 * (lane + 64 * j) + 4); }
#pragma unroll
            for (int k = 0; k < 6; ++k) { float ss = sv[k]; ss += __shfl_xor(ss, 1); ss += __shfl_xor(ss, 2); ss += __shfl_xor(ss, 4); ss += __shfl_xor(ss, 8);
                const float r = 1.0f / sqrtf(ss * (1.f / D) + RMS_EPS);
                LAS v4u* hr = (LAS v4u*)(lds + (wave + NWAVES * k) * 2048) + lane;
#pragma unroll
                for (int j = 0; j < 2; ++j) { const f32x8 h = bf8(w16[k][j]); hr[64 * j] = pack8(h.lo * r * g16[j][0], h.hi * r * g16[j][1]); } }
        } else {
        f32x4 g[4];
#pragma unroll
        for (int j = 0; j < 4; ++j) g[j] = *((const GAS f32x4*)gain + lane + 64 * j);
#pragma unroll
        for (int k = 0; k < 6; ++k) { float s = 0.f;
#pragma unroll
            for (int j = 0; j < 4; ++j) s += (v[k][j].x * v[k][j].x + v[k][j].y * v[k][j].y) + (v[k][j].z * v[k][j].z + v[k][j].w * v[k][j].w);
            const float r = 1.0f / sqrtf(wave_sum(s) * (1.f / D) + RMS_EPS);
            LAS v2u* hr = (LAS v2u*)(lds + (wave + NWAVES * k) * 2048) + lane;
#pragma unroll
            for (int j = 0; j < 4; ++j) { v2u o; o.x = pk2(v[k][j].x * r * g[j].x, v[k][j].y * r * g[j].y); o.y = pk2(v[k][j].z * r * g[j].z, v[k][j].w * r * g[j].w); hr[64 * j] = o; } }
        }
        __syncthreads();
        if (tile + G < CH / PT) { if constexpr (B16) pool_load_rows_b16(w16, sv, xn16, st16, (tile + G) * PT, seq_len, wave, lane); else pool_load_rows(v, x, (tile + G) * PT, seq_len, wave, lane); __builtin_amdgcn_sched_barrier(0); }
        {
            const int pg = wave & 3, part = (lane >> 5) + 2 * (wave >> 2), oc = lane & 31, pw = 2 << pg, phw = pw >> 1;
            const LAS v4u* hrow = (const LAS v4u*)(lds + (8 * part) * 2048 + pg * 512 + oc * 16);
            GAS v4u* po = (GAS v4u*)(Pg + ((size_t)pg * CH + m0 + 8 * part) * 256 + oc * 8);
            if (t0 >= 8 && t0 + PT + 8 <= seq_len) {
                switch (pg) { case 0: pool_rows_interior<2>(hrow, po); break; case 1: pool_rows_interior<4>(hrow, po); break; case 2: pool_rows_interior<8>(hrow, po); break; default: pool_rows_interior<16>(hrow, po); break; }
            } else {
                for (int i = 0; i < 8; ++i) {
                    const int t = t0 + 8 * part + i;
                    const int lo = max(t - phw, 0), hi = min(t + phw - 1, seq_len - 1);
                    f32x4 sl = {0.f, 0.f, 0.f, 0.f}, sh = {0.f, 0.f, 0.f, 0.f};
                    for (int q = lo; q <= hi; ++q) { const f32x8 h = bf8(hrow[(8 + q - t + i) * 128]); sl += h.lo; sh += h.hi; }
                    const f32x8 c = bf8(hrow[(8 + i) * 128]);
                    const float inv = 1.0f / (float)(hi - lo + 1);
                    po[(size_t)i * 32] = pack8(sl * inv - c.lo, sh * inv - c.hi);
                }
            }
        }
        __syncthreads();
    }
}

#define RLX_AGENT __ATOMIC_RELAXED, __HIP_MEMORY_SCOPE_AGENT
#define XB_TMO      128
#define XB_XCNT(j)  (256  + 64 * (j))
#define XB_XSUB(j)  (1280 + 64 * (j))
#define XB_XGEN(j)  (2304 + 64 * (j))
#define XB_TOP      3328
#define XB_TOPGEN   3392
#define XCD_BAR_WORDS 3456
#define XB_SPIN_CAP (1u << 18)

__device__ __forceinline__ unsigned xb_ld(unsigned* p)              { return __hip_atomic_load(p, __ATOMIC_RELAXED, __HIP_MEMORY_SCOPE_AGENT); }
__device__ __forceinline__ unsigned xb_add(unsigned* p, unsigned v) { return __hip_atomic_fetch_add(p, v, __ATOMIC_RELAXED, __HIP_MEMORY_SCOPE_AGENT); }
__device__ __forceinline__ unsigned xb_xcc_id() { return (unsigned)__builtin_amdgcn_s_getreg((3 << 11) | 20) & 0xFu; }
#define XB_SPIN(cond, bar) do { unsigned _sp = 0; while (cond) { __builtin_amdgcn_s_sleep(1); \
    if ((++_sp & 255u) == 0u) { if (xb_ld(&(bar)[XB_TMO])) break; if (_sp > XB_SPIN_CAP) { atomicAdd(&(bar)[XB_TMO], 1u); break; } } } } while (0)

struct XcdBarrier {
    unsigned* bar; unsigned x;
    volatile LAS unsigned* st;
};

__device__ __forceinline__ XcdBarrier xcd_barrier_post(unsigned* bar, volatile LAS unsigned* st) {
    XcdBarrier b; b.bar = bar; b.x = xb_xcc_id(); b.st = st;
    if (threadIdx.x == 0) (void)xb_add(&bar[XB_XCNT(b.x)], 1u);
    return b;
}
__device__ __forceinline__ void xcd_barrier_complete(unsigned* bar, unsigned x, unsigned& nloc, unsigned& nx) {
    const unsigned G = gridDim.x * gridDim.y * gridDim.z;
    unsigned sum, cnt, mine, sp = 0u;
    for (;;) {
        sum = 0u; cnt = 0u; mine = 0u;
#pragma unroll
        for (unsigned j = 0; j < 16; ++j) { const unsigned c = xb_ld(&bar[XB_XCNT(j)]); sum += c; cnt += (c > 0u) ? 1u : 0u; mine = (j == x) ? c : mine; }
        if (sum == G) break;
        __builtin_amdgcn_s_sleep(1);
        if ((++sp & 255u) == 0u) { if (xb_ld(&bar[XB_TMO])) break; if (sp > XB_SPIN_CAP) { atomicAdd(&bar[XB_TMO], 1u); break; } }
    }
    nloc = mine > 0u ? mine : 1u; nx = cnt > 0u ? cnt : 1u;
}

__device__ __forceinline__ void xcd_barrier(const XcdBarrier& b) {
    asm volatile("s_waitcnt vmcnt(0)" ::: "memory");
    __syncthreads();
    if (threadIdx.x == 0) {
        unsigned* bar = b.bar;
        __builtin_amdgcn_s_waitcnt(0);
        unsigned nloc = b.st[0], nx = b.st[1];
        if (nloc == 0u) { xcd_barrier_complete(bar, b.x, nloc, nx); b.st[0] = nloc; b.st[1] = nx; }
        const unsigned old = xb_add(&bar[XB_XSUB(b.x)], 1u);
        const unsigned gen = old / nloc;
        if (old + 1u == (gen + 1u) * nloc) {
            __builtin_amdgcn_fence(__ATOMIC_RELEASE, "agent");
            asm volatile("s_waitcnt vmcnt(0)" ::: "memory");
            const unsigned og = xb_add(&bar[XB_TOP], 1u);
            const unsigned tg = og / nx;
            if (og + 1u == (tg + 1u) * nx) xb_add(&bar[XB_TOPGEN], 1u);
            else XB_SPIN(xb_ld(&bar[XB_TOPGEN]) == tg, bar);
            __builtin_amdgcn_fence(__ATOMIC_ACQUIRE, "agent");
            xb_add(&bar[XB_XGEN(b.x)], 1u);
            asm volatile("s_waitcnt vmcnt(0)" ::: "memory");
        } else {
            XB_SPIN(xb_ld(&bar[XB_XGEN(b.x)]) == gen, bar);
            __builtin_amdgcn_fence(__ATOMIC_ACQUIRE, "agent");
            asm volatile("s_waitcnt vmcnt(0)" ::: "memory");
        }
    }
    __syncthreads();
}


__device__ __forceinline__ unsigned cvtpk(float lo, float hi) { return pk2(lo, hi); }
__device__ __forceinline__ s16x4 vtr(const LAS unsigned char* p) { return __builtin_bit_cast(s16x4, __builtin_amdgcn_ds_read_tr16_b64_v4i16((LAS s16x4*)p)); }
__device__ __forceinline__ void attn_phase(LAS unsigned char* lds, bf16* Qb, const bf16* Kb, const bf16* Vb, const float* rpb_l, int seq_len, int G, int bx, int tid, int wave, int lane) {
    const int fr = lane & 15, fq = lane >> 4;
    const int rows = seq_len >> 6, rows_shift = (seq_len == 2048) ? 5 : 6;
    constexpr int NI = (CH / 64) * 8;
    int nx, xc, lc, per;
    if ((G & 7) == 0) { nx = G >> 3; xc = bx & 7; lc = bx >> 3; per = NI >> 3; } else { nx = G; xc = 0; lc = bx; per = NI; }
    LAS float* bias = (LAS float*)(lds + BIAS_OFF);
    const int qb = wave & 3, hh = wave >> 2;
    const int qc = (qb < 3) ? (8 + 16 * qb + fr) : (fr < 8 ? fr : 48 + fr);
    const int a0 = (qb < 3) ? qb : 0, a1 = (qb < 3) ? qb + 1 : 3;
    const int wst = min(max(qc - 8, 0), 48);
    const int q4 = (lane & 15) >> 2, p4 = lane & 3;
    bool sel[4];
#pragma unroll
    for (int i = 0; i < 4; ++i) sel[i] = (qb < 3) ? (4 * fq + i >= fr) : (fr < 8);
    int voff[4];
#pragma unroll
    for (int i3 = 0; i3 < 4; ++i3) voff[i3] = (lane >> 4) * D + (((lane & 15) ^ (((lane >> 4) << 2) | i3)) * 8);
    if (lc >= per) return;
    int id = xc * per + lc;
    int r = id & (rows - 1), hp = (id >> rows_shift) & 7, tb = (id >> (rows_shift + 3)) * seq_len, r0 = min(max(r - 4, 0), rows - 8);
    bf16x8 qf0, qf1, kf[4][2][2];
    float bnext[2];
#define ATT_PREFETCH() do { \
        const int h_ = 2 * hp + hh; const size_t qo_ = (size_t)(tb + r * 64 + qc) * D + h_ * 64; \
        qf0 = *(const GAS bf16x8*)(Qb + qo_ + 8 * fq); qf1 = *(const GAS bf16x8*)(Qb + qo_ + 32 + 8 * fq); \
        const bf16* kb_ = Kb + ((size_t)(h_ * 8 + fq) * CH + (tb + r0 * 64 + fr)) * 8; \
        _Pragma("unroll") for (int kr = 0; kr < 4; ++kr) _Pragma("unroll") for (int ai = 0; ai < 2; ++ai) { const bf16* kp = kb_ + (kr * 64 + 16 * (ai ? a1 : a0)) * 8; kf[kr][ai][0] = *(const GAS bf16x8*)kp; kf[kr][ai][1] = *(const GAS bf16x8*)(kp + (size_t)4 * CH * 8); } \
        bnext[0] = rpb_l[hp * 930 + tid] * LOG2E; bnext[1] = (tid + 512 < 930) ? rpb_l[hp * 930 + tid + 512] * LOG2E : 0.f; } while (0)
#define ATT_BIAS_WRITE() do { bias[tid] = bnext[0]; if (tid + 512 < 930) bias[tid + 512] = bnext[1]; } while (0)
    ATT_PREFETCH();
    ATT_BIAS_WRITE();
    for (int loc = lc; loc < per; loc += nx) {
        const int h = 2 * hp + hh;
        const size_t qoff = (size_t)(tb + r * 64 + qc) * D + h * 64;
        const bf16* kbase = Kb + ((size_t)(h * 8 + fq) * CH + (tb + r0 * 64 + fr)) * 8;
        const int drb = r0 - r + 7;
        __syncthreads();
        {
            const int a = wave >> 1, ub = (wave & 1) * 2;
#pragma unroll
            for (int i = 0; i < 16; ++i) { const int kr = 2 * (ub + (i >> 3)) + (i & 1), cb = 16 * a + 4 * ((i & 7) >> 1);
                const bf16* src = Vb + (size_t)(tb + (r0 + kr) * 64 + cb) * D + hp * 128 + voff[i & 3];
                __builtin_amdgcn_global_load_lds((const unsigned*)src, (LAS unsigned*)(lds + (wave * 16 + i) * 1024), 16, 0, 0); }
        }
        f32x4 S[8];
        float mx = -3.0e38f;
        const LAS float* bptr[4];
#pragma unroll
        for (int i = 0; i < 4; ++i) { const int kc = 16 * (sel[i] ? a0 : a1) + 4 * fq + i; bptr[i] = bias + hh * 465 + drb * 31 + min(max(kc - qc + 15, 0), 30); }
#pragma unroll
        for (int kr = 0; kr < 8; ++kr) {
            f32x4 z0 = {0.f, 0.f, 0.f, 0.f}, z1 = {0.f, 0.f, 0.f, 0.f};
            z0 = __builtin_amdgcn_mfma_f32_16x16x32_bf16(kf[kr & 3][0][0], qf0, z0, 0, 0, 0);
            z0 = __builtin_amdgcn_mfma_f32_16x16x32_bf16(kf[kr & 3][0][1], qf1, z0, 0, 0, 0);
            z1 = __builtin_amdgcn_mfma_f32_16x16x32_bf16(kf[kr & 3][1][0], qf0, z1, 0, 0, 0);
            z1 = __builtin_amdgcn_mfma_f32_16x16x32_bf16(kf[kr & 3][1][1], qf1, z1, 0, 0, 0);
            f32x4 z;
#pragma unroll
            for (int i = 0; i < 4; ++i) { z[i] = (sel[i] ? z0[i] : z1[i]) + bptr[i][kr * 31]; mx = fmaxf(mx, z[i]); }
            S[kr] = z;
            if (kr < 4) {
#pragma unroll
                for (int ai = 0; ai < 2; ++ai) { const bf16* kp = kbase + ((kr + 4) * 64 + 16 * (ai ? a1 : a0)) * 8; kf[kr & 3][ai][0] = *(const GAS bf16x8*)kp; kf[kr & 3][ai][1] = *(const GAS bf16x8*)(kp + (size_t)4 * CH * 8); }
            }
        }
        mx = fmaxf(mx, __shfl_xor(mx, 16)); mx = fmaxf(mx, __shfl_xor(mx, 32));
        float sum = 0.f;
#pragma unroll
        for (int kr = 0; kr < 8; ++kr)
#pragma unroll
            for (int i = 0; i < 4; ++i) { const float p = __builtin_amdgcn_exp2f(S[kr][i] - mx); S[kr][i] = p; sum += p; }
        sum += __shfl_xor(sum, 16); sum += __shfl_xor(sum, 32);
        bf16x8 pf[4][2];
#pragma unroll
        for (int u = 0; u < 4; ++u)
#pragma unroll
            for (int ai = 0; ai < 2; ++ai) {
                float pa[2][4];
#pragma unroll
                for (int t = 0; t < 2; ++t)
#pragma unroll
                    for (int i = 0; i < 4; ++i) pa[t][i] = (sel[i] == (ai == 0)) ? S[2 * u + t][i] : 0.f;
                v4u pw; pw.x = cvtpk(pa[0][0], pa[0][1]); pw.y = cvtpk(pa[0][2], pa[0][3]); pw.z = cvtpk(pa[1][0], pa[1][1]); pw.w = cvtpk(pa[1][2], pa[1][3]);
                pf[u][ai] = __builtin_bit_cast(bf16x8, pw); }
        asm volatile("s_waitcnt vmcnt(0)" ::: "memory");
        __syncthreads();
        const int nloc = loc + nx; const bool has_next = nloc < per;
        const int r_cur = r, tb_cur = tb;
        if (has_next) { id = xc * per + nloc; r = id & (rows - 1); hp = (id >> rows_shift) & 7; tb = (id >> (rows_shift + 3)) * seq_len; r0 = min(max(r - 4, 0), rows - 8); ATT_PREFETCH(); }
        (void)r_cur; (void)tb_cur;
        f32x4 O[4];
#pragma unroll
        for (int c = 0; c < 4; ++c) O[c] = (f32x4){0.f, 0.f, 0.f, 0.f};
        const LAS unsigned char* vb[2][2][4];
#pragma unroll
        for (int ai = 0; ai < 2; ++ai)
#pragma unroll
            for (int t = 0; t < 2; ++t)
#pragma unroll
                for (int c = 0; c < 4; ++c) { const int rho = 8 * fq + 4 * t + q4, chn = 2 * (4 * hh + c) + (p4 >> 1);
                    vb[ai][t][c] = lds + (ai ? a1 : a0) * 32768 + 256 * rho + 16 * (chn ^ (((rho & 3) << 2) | ((rho >> 2) & 3))) + 8 * (p4 & 1); }
#pragma unroll
        for (int u = 0; u < 4; ++u) {
#pragma unroll
            for (int ai = 0; ai < 2; ++ai) {
#pragma unroll
                for (int c = 0; c < 4; ++c) {
                    const s16x4 v0 = vtr(vb[ai][0][c] + u * 8192), v1 = vtr(vb[ai][1][c] + u * 8192);
                    const bf16x8 vf = __builtin_shufflevector(v0, v1, 0, 1, 2, 3, 4, 5, 6, 7);
                    O[c] = __builtin_amdgcn_mfma_f32_16x16x32_bf16(vf, pf[u][ai], O[c], 0, 0, 0);
                }
            }
        }
        const float inv = 1.0f / sum;
#pragma unroll
        for (int c = 0; c < 4; ++c) { v2u w; w.x = cvtpk(O[c][0] * inv, O[c][1] * inv); w.y = cvtpk(O[c][2] * inv, O[c][3] * inv);
            *(GAS v2u*)(Qb + qoff + 16 * c + 4 * fq) = w; }
        if (has_next) ATT_BIAS_WRITE();
    }
    __syncthreads();
#undef ATT_PREFETCH
#undef ATT_BIAS_WRITE
}
enum { K_POOL = 1, K_GEMM_RES = 3, K_GEMM_QKV = 4, K_GEMM_UP = 5, K_ATTN = 6, K_FINAL = 7 };
enum { F_A_X = 1, F_A_IN = 2, F_AUX_X = 4, F_AUX_IN = 8, F_NOX = 16, F_B16 = 32 };
struct Ph { int kind, flags, N, K; const void* A; const void* B; void* C; const void* aux; float* st; float* rs; unsigned long long a_pn_stride, pad; };
constexpr int PPC = 19;
struct Args { Ptrs p; Ph tab[PPC]; };
__global__ void __launch_bounds__(NWAVES * 64, 2) fwd_megakernel(Args args) {
    extern __shared__ __attribute__((aligned(16))) unsigned char lds_raw[];
    cg::grid_group grid = cg::this_grid();
    LAS unsigned char* lds = (LAS unsigned char*)lds_raw;
    volatile LAS unsigned* MISC = (volatile LAS unsigned*)(lds + MISC_OFF);
    for (int u = threadIdx.x; u < 32; u += NWAVES * 64) MISC[u] = 0u;
    __syncthreads();
    const XcdBarrier bar = xcd_barrier_post((unsigned*)(args.p.ws + WS_CTL), MISC + 8);
    {
        const int tid = threadIdx.x, lane = tid & 63, wave = __builtin_amdgcn_readfirstlane(tid >> 6);
        const int G = gridDim.x, bx = blockIdx.x;
        const int vcu = (G % 8 == 0) ? (bx % 8) * (G / 8) + bx / 8 : bx;
        prologue(args.p, lds, vcu * NWAVES + wave, G * NWAVES, wave, lane);
    }
    grid.sync();

    for (int ph = 0; ph < NCHUNK * PPC; ++ph) {
        int tid = threadIdx.x; asm volatile("" : "+v"(tid));
        int G = gridDim.x, bx = blockIdx.x; asm volatile("" : "+s"(G), "+s"(bx));
        const int lane = tid & 63, wave = __builtin_amdgcn_readfirstlane(tid >> 6);
        const int vcu = (G % 8 == 0) ? (bx % 8) * (G / 8) + bx / 8 : bx;
        const int gw = vcu * NWAVES + wave, NGW = G * NWAVES;
        const int ck = ph / PPC, idx = ph - ck * PPC;
        const Ph& d = args.tab[idx];
        const int tok0 = ck * CH, grp = tok0 / GROUP_TOK, seq_len = grp ? 4096 : 2048;
        const float* xin = args.p.x_in[grp] + (size_t)(tok0 - grp * GROUP_TOK) * D;
        float* X = args.p.out + (size_t)tok0 * D;
        const void* A = (d.flags & F_A_IN) ? (const void*)xin : d.A;
        const void* aux = (d.flags & F_AUX_IN) ? (const void*)xin : d.aux;
#define KIND_IS(x) ([&]() { int kd_ = d.kind; asm volatile("" : "+s"(kd_)); return kd_ == (x); }())
        if (0) {}
        else if (KIND_IS(K_POOL)) { { int tid2 = threadIdx.x; asm volatile("" : "+v"(tid2));
            if (d.flags & F_B16) pool_phase<true>(lds, nullptr, (const bf16*)d.A, d.st, (const float*)aux, (bf16*)d.C, seq_len, vcu, G, tid2, __builtin_amdgcn_readfirstlane(tid2 >> 6), tid2 & 63);
            else pool_phase<false>(lds, (const float*)A, nullptr, nullptr, (const float*)aux, (bf16*)d.C, seq_len, vcu, G, tid2, __builtin_amdgcn_readfirstlane(tid2 >> 6), tid2 & 63); } }
        else if (KIND_IS(K_GEMM_RES)) { pg8::Gemm g{(const bf16*)A, (const bf16*)d.B, CH, d.N, d.K, (size_t)d.a_pn_stride, d.K == FF  }; pg8::StaticOrder S; S.init(CH, d.N, G, bx, d.K == FF);
            pg8::EpiRes E{(const float*)aux, (d.flags & F_NOX) ? nullptr : X, (bf16*)d.C, d.st, D, d.rs, (d.flags & F_B16) ? (const bf16*)args.p.ws + WS_XN / 2 : nullptr};
            pg8::gemm_phase<pg8::EpiRes, pg8::StaticOrder, false, PG8_SP2>(lds, g, S, E, tid); }
        else if (KIND_IS(K_GEMM_QKV)) { pg8::Gemm g{(const bf16*)A, (const bf16*)d.B, CH, d.N, d.K, 0, 1  }; pg8::StaticOrder S; S.init(CH, d.N, G, bx);
            pg8::EpiBf16<0, true> E{(bf16*)d.C, D, D, (size_t)CH * D, 0.125f * LOG2E, d.st, 0};
            pg8::gemm_phase<pg8::EpiBf16<0, true>, pg8::StaticOrder, PG8_ALIGN, PG8_SP2>(lds, g, S, E, tid); }
        else if (KIND_IS(K_GEMM_UP)) { pg8::Gemm g{(const bf16*)A, (const bf16*)d.B, CH, d.N, d.K, 0, 1  }; pg8::StaticOrder S; S.init(CH, d.N, G, bx);
            pg8::EpiBf16<2, false> E{(bf16*)d.C, FF, 0, 0, 1.f, nullptr, 1};
            pg8::gemm_phase<pg8::EpiBf16<2, false>, pg8::StaticOrder, PG8_ALIGN, PG8_SP2>(lds, g, S, E, tid); }
        else if (KIND_IS(K_ATTN)) { attn_phase(lds, (bf16*)d.C, (const bf16*)d.C + (size_t)CH * D, (const bf16*)d.C + 2 * (size_t)CH * D, (const float*)aux, seq_len, G, bx, tid, wave, lane); }
        else { norm_rows_f32_inplace(X, (const float*)aux, CH, gw, NGW, lane); }
#undef KIND_IS
        if (d.kind != K_FINAL) xcd_barrier(bar);
    }
}

extern "C" void kernel_launch(void* const* d_in, const int* in_sizes, int n_in, void* d_out, int out_size, void* d_ws, size_t ws_size, hipStream_t stream) {
    static int grid = 0;
    if (grid == 0) {
        if (n_in != 12 || in_sizes[0] != GROUP_TOK * D || in_sizes[1] != GROUP_TOK * D || out_size != NTOK * D || ws_size < WS_END) {
            fprintf(stderr, "kernel_launch: unexpected shapes (n_in %d, out %d, ws %zu < %zu); nothing launched\n", n_in, out_size, ws_size, (size_t)WS_END); grid = -1; return; }
        int dev = 0, cus = 0, per_cu = 0;
        if (hipGetDevice(&dev) != hipSuccess || hipDeviceGetAttribute(&cus, hipDeviceAttributeMultiprocessorCount, dev) != hipSuccess) { fprintf(stderr, "kernel_launch: device query failed\n"); grid = -1; return; }
        if (hipFuncSetAttribute((const void*)fwd_megakernel, hipFuncAttributeMaxDynamicSharedMemorySize, LDS_BYTES) != hipSuccess) { fprintf(stderr, "kernel_launch: hipFuncSetAttribute failed\n"); grid = -1; return; }
        if (hipOccupancyMaxActiveBlocksPerMultiprocessor(&per_cu, (const void*)fwd_megakernel, NWAVES * 64, LDS_BYTES) != hipSuccess || per_cu < 1) { fprintf(stderr, "kernel_launch: occupancy query gave %d\n", per_cu); per_cu = 1; }
        (void)hipGetLastError();
        grid = cus * per_cu;
    }
    if (grid < 0) return;
    if (hipMemsetAsync((char*)d_ws + WS_CTL, 0, CTL_ZERO_BYTES, stream) != hipSuccess) { fprintf(stderr, "kernel_launch: hipMemsetAsync failed\n"); return; }
    Args a{};
    Ptrs& p = a.p;
    p.x_in[0] = (const float*)d_in[0]; p.x_in[1] = (const float*)d_in[1]; p.norm_mix = (const float*)d_in[2]; p.pool_w = (const float*)d_in[3]; p.pool_scale = (const float*)d_in[4];
    p.w_qkv = (const float*)d_in[5]; p.rpb = (const float*)d_in[6]; p.w_o = (const float*)d_in[7]; p.norm_mlp = (const float*)d_in[8]; p.w_up = (const float*)d_in[9];
    p.w_down = (const float*)d_in[10]; p.norm_final = (const float*)d_in[11]; p.out = (float*)d_out; p.ws = (unsigned char*)d_ws;
    unsigned char* ws = (unsigned char*)d_ws;
    bf16* WPOOL = (bf16*)(ws + WS_WPOOL); bf16* WQKV = (bf16*)(ws + WS_WQKV); bf16* WO = (bf16*)(ws + WS_WO); bf16* WUP = (bf16*)(ws + WS_WUP); bf16* WDN = (bf16*)(ws + WS_WDN);
    bf16* XN = (bf16*)(ws + WS_XN); bf16* PG = (bf16*)(ws + WS_PG); bf16* QB = (bf16*)(ws + WS_ACT); bf16* HB = (bf16*)(ws + WS_ACT);
    float* SA = (float*)(ws + WS_STAT); float* SB = SA + (size_t)CH * 16;
    int n = 0;
    auto add = [&](int kind, int flags, int N, int K, const void* A, const void* B, void* C, const void* aux, float* st, float* rs, unsigned long long aps) {
        Ph& d = a.tab[n++]; d.kind = kind; d.flags = flags; d.N = N; d.K = K; d.A = A; d.B = B; d.C = C; d.aux = aux; d.st = st; d.rs = rs; d.a_pn_stride = aps; d.pad = 0; };
    for (int layer = 0; layer < DEPTH; ++layer) {
        const int j = layer >> 1;
        if ((layer & 1) == 0) {
            add(K_POOL, layer == 0 ? F_A_IN : F_B16, 0, 0, layer == 0 ? nullptr : (const void*)XN, nullptr, PG, p.norm_mix + layer * D, layer == 0 ? nullptr : SB, nullptr, 0);
            add(K_GEMM_RES, (layer == 0 ? F_AUX_IN : F_B16) | F_NOX, D, 256, PG, WPOOL + (size_t)j * 1024 * 256, XN, nullptr, SA, nullptr, (unsigned long long)CH * 256 * 2);
        } else {
            add(K_GEMM_QKV, 0, 3 * D, D, XN, WQKV + (size_t)j * 3 * D * D, QB, nullptr, SB, nullptr, 0);
            add(K_ATTN, 0, 0, 0, nullptr, nullptr, QB, p.rpb + (size_t)j * NH * 15 * 31, nullptr, nullptr, 0);
            add(K_GEMM_RES, F_B16 | F_NOX, D, D, QB, WO + (size_t)j * D * D, XN, nullptr, SA, nullptr, 0);
        }
        add(K_GEMM_UP, 0, FF, D, XN, WUP + (size_t)layer * D * FF, HB, nullptr, SA, nullptr, 0);
        add(K_GEMM_RES, F_B16 | (layer != DEPTH - 1 ? F_NOX : 0), D, FF, HB, WDN + (size_t)layer * D * FF, layer != DEPTH - 1 ? XN : nullptr, nullptr, SB, SA, 0);
    }
    add(K_FINAL, 0, 0, 0, nullptr, nullptr, nullptr, p.norm_final, nullptr, nullptr, 0);
    if (n != PPC) { fprintf(stderr, "kernel_launch: phase table has %d entries, expected %d\n", n, PPC); return; }
    void* kargs[] = {&a};
    hipError_t e = hipLaunchCooperativeKernel((const void*)fwd_megakernel, dim3(grid), dim3(NWAVES * 64), kargs, LDS_BYTES, stream);
    if (e != hipSuccess) fprintf(stderr, "kernel_launch: cooperative launch failed: %s (grid %d)\n", hipGetErrorString(e), grid);
}
```
